# Optimizing an MI355X kernel written in HIP

```python
import jax, jax.numpy as jnp
from jax import lax
import numpy as np

D_MODEL = 1024
BATCH = 16
SEQ = 4096
DEPTH = 1
DEC_BATCH = 16
DEC_SEQ = 16
PAST_LEN = 1024

CHUNK = 64
N_HEADS = 16
N_KV_HEADS = 4
HEAD_DIM = 64
Q_GROUP = N_HEADS // N_KV_HEADS
WINDOW = 128
WINDOW_CHUNKS = WINDOW // CHUNK
ATTN_W = N_HEADS * HEAD_DIM
KV_W = N_KV_HEADS * HEAD_DIM
GMLP_CHUNK = 128
GMLP_GROUPS = 4
GMLP_W = D_MODEL
GMLP_GW = GMLP_W // GMLP_GROUPS
D_FF = ((8 * D_MODEL // 3 + 255) // 256) * 256
IN_W = ATTN_W + 2 * KV_W + 2 * GMLP_W + 2 * D_MODEL
EPS = 1e-6
NEG_INF = -1e30

kernel_name = "chunk_causal_swa_sink_gmlp_hybrid_step"


def rms_norm(x, g):
    xf = x.astype(jnp.float32)
    y = xf * lax.rsqrt(jnp.mean(xf * xf, axis=-1, keepdims=True) + EPS)
    return (y * g.astype(jnp.float32)).astype(x.dtype)


def layer_norm(x, g, b):
    xf = x.astype(jnp.float32)
    mu = jnp.mean(xf, axis=-1, keepdims=True)
    xc = xf - mu
    y = xc * lax.rsqrt(jnp.mean(xc * xc, axis=-1, keepdims=True) + EPS)
    return (y * g.astype(jnp.float32) + b.astype(jnp.float32)).astype(x.dtype)


def sink_attention(q, k, v, sinks, mask):
    s = jnp.einsum('...qhgd,...khd->...hgqk', q, k).astype(jnp.float32) * (HEAD_DIM ** -0.5)
    if mask is not None:
        s = jnp.where(mask, s, NEG_INF)
    sk = sinks.astype(jnp.float32)[:, :, None, None]
    m = jnp.maximum(jnp.max(s, axis=-1, keepdims=True), sk)
    p = jnp.exp(s - m)
    denom = jnp.sum(p, axis=-1, keepdims=True) + jnp.exp(sk - m)
    p = (p / denom).astype(v.dtype)
    return jnp.einsum('...hgqk,...khd->...qhgd', p, v)


def attn_prompt(q, k, v, sinks):
    B, S = q.shape[:2]
    nc = S // CHUNK
    pad = WINDOW_CHUNKS * CHUNK
    qc = q.reshape(B, nc, CHUNK, N_KV_HEADS, Q_GROUP, HEAD_DIM)
    kp = jnp.pad(k, ((0, 0), (pad, 0), (0, 0), (0, 0))).reshape(B, nc + WINDOW_CHUNKS, CHUNK, N_KV_HEADS, HEAD_DIM)
    vp = jnp.pad(v, ((0, 0), (pad, 0), (0, 0), (0, 0))).reshape(B, nc + WINDOW_CHUNKS, CHUNK, N_KV_HEADS, HEAD_DIM)
    kb = jnp.concatenate([kp[:, i:i + nc] for i in range(WINDOW_CHUNKS + 1)], axis=2)
    vb = jnp.concatenate([vp[:, i:i + nc] for i in range(WINDOW_CHUNKS + 1)], axis=2)
    kpos = jnp.arange(nc)[:, None] * CHUNK - pad + jnp.arange((WINDOW_CHUNKS + 1) * CHUNK)[None, :]
    mask = (kpos >= 0)[:, None, None, None, :]
    o = sink_attention(qc, kb, vb, sinks, mask)
    return o.reshape(B, S, ATTN_W)


def attn_sample(q, k, v, cache_k, cache_v, sinks):
    B, T = q.shape[:2]
    kc = jnp.concatenate([cache_k, k], axis=1)
    vc = jnp.concatenate([cache_v, v], axis=1)
    o = sink_attention(q.reshape(B, T, N_KV_HEADS, Q_GROUP, HEAD_DIM), kc, vc, sinks, None)
    w = cache_k.shape[1]
    return o.reshape(B, T, ATTN_W), kc[:, -w:], vc[:, -w:]


def spatial_gate(u, v, w_s, b_s):
    L = v.shape[-3]
    wm = jnp.tril(w_s[:, :L, :L])
    mix = jnp.einsum('gts,...sgc->...tgc', wm, v) + b_s[:, :L].T[:, :, None]
    return u * mix


def trunk_layer(x, n_pre_mix, n_post_mix, n_pre_ffn, n_post_ffn, w_in, sinks, ln_g, ln_b, w_s, b_s,
                w_attn_proj, w_gmlp_proj, w_out, w_ffn_in, w_ffn_out, cache_k, cache_v):
    B, T, _ = x.shape
    h = rms_norm(x, n_pre_mix)
    z = h @ w_in
    offs = np.cumsum([ATTN_W, KV_W, KV_W, 2 * GMLP_W, D_MODEL])
    q, k, v, zg, ga, gb = jnp.split(z, offs, axis=-1)
    k = k.reshape(B, T, N_KV_HEADS, HEAD_DIM)
    v = v.reshape(B, T, N_KV_HEADS, HEAD_DIM)
    if cache_k is None:
        a = attn_prompt(q, k, v, sinks)
        new_k, new_v = k[:, -WINDOW:], v[:, -WINDOW:]
    else:
        a, new_k, new_v = attn_sample(q, k, v, cache_k, cache_v, sinks)
    u, gv = jnp.split(jax.nn.gelu(zg), 2, axis=-1)
    gv = layer_norm(gv, ln_g, ln_b)
    if cache_k is None:
        shp = (B, T // GMLP_CHUNK, GMLP_CHUNK, GMLP_GROUPS, GMLP_GW)
    else:
        shp = (B, T, GMLP_GROUPS, GMLP_GW)
    bm = spatial_gate(u.reshape(shp), gv.reshape(shp), w_s, b_s).reshape(B, T, GMLP_W)
    merged = jax.nn.sigmoid(ga) * (a @ w_attn_proj) + jax.nn.sigmoid(gb) * (bm @ w_gmlp_proj)
    x = x + rms_norm(merged @ w_out, n_post_mix)
    h2 = rms_norm(x, n_pre_ffn)
    g, up = jnp.split(h2 @ w_ffn_in, 2, axis=-1)
    x = x + rms_norm((jax.nn.silu(g) * up) @ w_ffn_out, n_post_ffn)
    return x, new_k, new_v, gv


def setup_inputs(seed: int = 0) -> dict:
    key = jax.random.key(seed)
    ks = jax.random.split(key, 20)
    cache_w = min(WINDOW, PAST_LEN)
    nrm = lambda k, shp, s: jax.random.normal(k, shp, jnp.float32) * s
    return {
        "x_prompt": nrm(ks[0], (BATCH, SEQ, D_MODEL), 1.0),
        "x_sample": nrm(ks[1], (DEC_BATCH, DEC_SEQ, D_MODEL), 1.0),
        "cache_attn_k": nrm(ks[2], (DEPTH, DEC_BATCH, cache_w, N_KV_HEADS, HEAD_DIM), 1.0),
        "cache_attn_v": nrm(ks[3], (DEPTH, DEC_BATCH, cache_w, N_KV_HEADS, HEAD_DIM), 1.0),
        "norm_pre_mix": 1.0 + nrm(ks[4], (DEPTH, D_MODEL), 0.05),
        "norm_post_mix": 1.0 + nrm(ks[5], (DEPTH, D_MODEL), 0.05),
        "norm_pre_ffn": 1.0 + nrm(ks[6], (DEPTH, D_MODEL), 0.05),
        "norm_post_ffn": 1.0 + nrm(ks[7], (DEPTH, D_MODEL), 0.05),
        "w_in": nrm(ks[8], (DEPTH, D_MODEL, IN_W), D_MODEL ** -0.5),
        "attn_sinks": nrm(ks[9], (DEPTH, N_KV_HEADS, Q_GROUP), 1.0),
        "gmlp_ln_g": 1.0 + nrm(ks[10], (DEPTH, GMLP_W), 0.05),
        "gmlp_ln_b": nrm(ks[11], (DEPTH, GMLP_W), 0.02),
        "gmlp_w_s": nrm(ks[12], (DEPTH, GMLP_GROUPS, GMLP_CHUNK, GMLP_CHUNK), GMLP_CHUNK ** -0.5),
        "gmlp_b_s": 1.0 + nrm(ks[13], (DEPTH, GMLP_GROUPS, GMLP_CHUNK), 0.1),
        "w_attn_proj": nrm(ks[14], (DEPTH, ATTN_W, D_MODEL), ATTN_W ** -0.5),
        "w_gmlp_proj": nrm(ks[15], (DEPTH, GMLP_W, D_MODEL), GMLP_W ** -0.5),
        "w_out": nrm(ks[16], (DEPTH, D_MODEL, D_MODEL), D_MODEL ** -0.5),
        "w_ffn_in": nrm(ks[17], (DEPTH, D_MODEL, 2 * D_FF), D_MODEL ** -0.5),
        "w_ffn_out": nrm(ks[18], (DEPTH, D_FF, D_MODEL), D_FF ** -0.5),
    }


def reference(x_prompt, x_sample, cache_attn_k, cache_attn_v, norm_pre_mix, norm_post_mix, norm_pre_ffn,
              norm_post_ffn, w_in, attn_sinks, gmlp_ln_g, gmlp_ln_b, gmlp_w_s, gmlp_b_s, w_attn_proj,
              w_gmlp_proj, w_out, w_ffn_in, w_ffn_out):
    xp, xs = x_prompt, x_sample
    kp_l, vp_l, ks_l, vs_l, gs_l = [], [], [], [], []
    for l in range(DEPTH):
        w = (norm_pre_mix[l], norm_post_mix[l], norm_pre_ffn[l], norm_post_ffn[l], w_in[l], attn_sinks[l],
             gmlp_ln_g[l], gmlp_ln_b[l], gmlp_w_s[l], gmlp_b_s[l], w_attn_proj[l], w_gmlp_proj[l], w_out[l],
             w_ffn_in[l], w_ffn_out[l])
        xp, kp, vp, _ = trunk_layer(xp, *w, None, None)
        xs, ks, vs, gvs = trunk_layer(xs, *w, cache_attn_k[l], cache_attn_v[l])
        kp_l.append(kp); vp_l.append(vp); ks_l.append(ks); vs_l.append(vs); gs_l.append(gvs)
    return (xp, xs, jnp.stack(kp_l), jnp.stack(vp_l), jnp.stack(ks_l), jnp.stack(vs_l), jnp.stack(gs_l))
```

```cpp
#include <hip/hip_runtime.h>
#include <cstdio>
#include <cstdint>

#ifndef MK_ONE_LAUNCH
#define MK_ONE_LAUNCH 0
#endif

namespace pg8 {
#define PG8_LAS __attribute__((address_space(3)))
typedef unsigned short bf16_t;
typedef short bf16x8 __attribute__((ext_vector_type(8)));
typedef float f32x4 __attribute__((ext_vector_type(4)));
typedef unsigned u32x4 __attribute__((ext_vector_type(4)));
constexpr int BM = 256, BK = 64, HALF = 128, HTB = HALF * BK * 2  , STAGE_BYTES = 8 * HTB, NXCD = 8, WGM = 8;

__host__ __device__ __forceinline__ int lds_byte(int r, int c) { const int st = (r >> 4) * 2 + (c >> 5), rr = r & 15, cc = c & 31, ob = rr * 64 + cc * 2; return st * 1024 + (ob ^ (((ob >> 9) & 1) << 5)); }
__host__ __device__ __forceinline__ void stage_rc(int b, int& R, int& C) { const int st = b / 1024, sb = b % 1024, swz = sb ^ (((sb >> 9) & 1) << 5); R = (st >> 1) * 16 + swz / 64; C = (st & 1) * 32 + (swz % 64) / 2; }
__host__ __device__ __forceinline__ int perm32(int rho) { const int n = rho >> 4, i = rho & 15; return 8 * (i >> 2) + 4 * n + (i & 3); }

struct Unit { int pm, pn, seg; };
struct Gemm { const bf16_t* A0; const bf16_t* B0; const bf16_t* A1; const bf16_t* B1; int M, N, K; };

struct StaticOrder {
    int nM, nN, nwg, G, c, nseg;
    __host__ __device__ void init(int M, int N, int G_, int c_, int nseg_) { nM = M / BM; nN = N / BM; nwg = nM * nN; G = G_; c = c_; nseg = nseg_; }
    __host__ __device__ bool next(int i, Unit& u) const {
        const int ti = (nseg == 2) ? (i >> 1) : i; u.seg = (nseg == 2) ? (i & 1) : 0;
        const long L = (long)ti * G + c; if (L >= nwg) return false;
        int wgid = (int)L; { const int q = nwg / NXCD, r = nwg % NXCD, xcd = wgid % NXCD, off = wgid / NXCD; wgid = (xcd < r ? xcd * (q + 1) : r * (q + 1) + (xcd - r) * q) + off; }
        const int nig = WGM * nN, gid = wgid / nig, fm = gid * WGM, gsz = (nM - fm) < WGM ? (nM - fm) : WGM;
        u.pm = fm + ((wgid % nig) % gsz); u.pn = (wgid % nig) / gsz; return true;
    }
};

template <class Epi, class Sched>
__device__ __forceinline__ void gemm_phase(PG8_LAS unsigned char* lds, const Gemm g, const Sched& S, const Epi& E) {
    const int tid = threadIdx.x, wid = __builtin_amdgcn_readfirstlane(tid >> 6), lane = tid & 63, wr = wid >> 2, wc = wid & 3, fr = lane & 15, fq = lane >> 4;
    const int K = g.K, nt = K / BK;
    unsigned voffA[2], voffB[2];
#pragma unroll
    for (int i = 0; i < 2; ++i) { int R, C; stage_rc(tid * 16 + i * 8192, R, C); const int Rb = Epi::PERM ? ((R & ~31) + perm32(R & 31)) : R;
        voffA[i] = (unsigned)(R * K + C) * 2u; voffB[i] = (unsigned)(Rb * K + C) * 2u; }
    const size_t kstep = (size_t)(BK * 2);
    const size_t hstep = (size_t)HALF * K * 2;
    const size_t tstep = 2 * hstep;
    const unsigned ldsw = (unsigned)wid * 1024u;
    const int aoff = lds_byte(wr * 64 + fr, fq * 8), boff = lds_byte(wc * 32 + fr, fq * 8);
#define PG8_SA(b, h) (((b) * 2 + (h)) * HTB)
#define PG8_SB(b, h) ((4 + (b) * 2 + (h)) * HTB)
#define PG8_STAGE(bufoff, gbase, voff) do { _Pragma("unroll") for (int _i = 0; _i < 2; ++_i) \
        __builtin_amdgcn_global_load_lds((const unsigned*)((const char*)(gbase) + (voff)[_i]), (PG8_LAS unsigned*)(lds + (bufoff) + ldsw + _i * 8192), 16, 0, 0); } while (0)
#define PG8_LDA(dst, b, h) do { _Pragma("unroll") for (int m = 0; m < 4; ++m) _Pragma("unroll") for (int k = 0; k < 2; ++k) dst[m][k] = *(const PG8_LAS bf16x8*)(lds + PG8_SA(b, h) + aoff + m * 2048 + k * 1024); } while (0)
#define PG8_LDB(dst, b, h) do { _Pragma("unroll") for (int n = 0; n < 2; ++n) _Pragma("unroll") for (int k = 0; k < 2; ++k) dst[n][k] = *(const PG8_LAS bf16x8*)(lds + PG8_SB(b, h) + boff + n * 2048 + k * 1024); } while (0)
#define PG8_MMA(ai, bj, At, Bt) do { __builtin_amdgcn_s_setprio(1); _Pragma("unroll") for (int m = 0; m < 4; ++m) _Pragma("unroll") for (int n = 0; n < 2; ++n) _Pragma("unroll") for (int k = 0; k < 2; ++k) \
        acc[ai][bj][m][n] = __builtin_amdgcn_mfma_f32_16x16x32_bf16(Bt[n][k], At[m][k], acc[ai][bj][m][n], 0, 0, 0); __builtin_amdgcn_s_setprio(0); } while (0)
#define PG8_WAIT_V(n) asm volatile("s_waitcnt vmcnt(" #n ")" ::: "memory")
#define PG8_WAIT_L(n) asm volatile("s_waitcnt lgkmcnt(" #n ")" ::: "memory")
#define PG8_BAR __builtin_amdgcn_s_barrier()
#define PG8_SCHED __builtin_amdgcn_sched_barrier(0)
    Unit cur, nxt; int ui = 0;
    if (!S.next(0, cur)) return;
    f32x4 acc[2][2][4][2];
#pragma unroll
    for (int a = 0; a < 2; ++a)
#pragma unroll
        for (int b = 0; b < 2; ++b)
#pragma unroll
            for (int m = 0; m < 4; ++m)
#pragma unroll
                for (int n = 0; n < 2; ++n) acc[a][b][m][n] = (f32x4){0.f, 0.f, 0.f, 0.f};
    bf16x8 At[4][2], B0[2][2], B1[2][2];
    const char* cA = (const char*)(cur.seg ? g.A1 : g.A0) + (size_t)cur.pm * tstep; const char* cB = (const char*)(cur.seg ? g.B1 : g.B0) + (size_t)cur.pn * tstep;
    PG8_STAGE(PG8_SB(0, 0), cB, voffB); PG8_STAGE(PG8_SB(0, 1), cB + hstep, voffB); PG8_STAGE(PG8_SA(0, 0), cA, voffA); PG8_STAGE(PG8_SA(0, 1), cA + hstep, voffA);
    if (wr == 1) PG8_BAR;
    PG8_WAIT_V(2); PG8_BAR;
    PG8_STAGE(PG8_SB(1, 0), cB + kstep, voffB); PG8_STAGE(PG8_SA(1, 0), cA + kstep, voffA); PG8_STAGE(PG8_SB(1, 1), cB + hstep + kstep, voffB);
    PG8_WAIT_V(6); PG8_BAR;
    for (;;) {
        const bool has_next = S.next(ui + 1, nxt);
        const char* nA = has_next ? (const char*)(nxt.seg ? g.A1 : g.A0) + (size_t)nxt.pm * tstep : cA; const char* nB = has_next ? (const char*)(nxt.seg ? g.B1 : g.B0) + (size_t)nxt.pn * tstep : cB;
        for (int t = 0; t < nt; t += 2) {
            const bool last = (t == nt - 2);
            const char* a1 = cA + (size_t)(t + 1) * kstep;
            const char* a2 = last ? nA : cA + (size_t)(t + 2) * kstep; const char* b2 = last ? nB : cB + (size_t)(t + 2) * kstep;
            const char* a3 = a2 + kstep; const char* b3 = b2 + kstep;
            PG8_LDB(B0, 0, 0); PG8_LDB(B1, 0, 1); PG8_SCHED; PG8_LDA(At, 0, 0); PG8_STAGE(PG8_SA(1, 1), a1 + hstep, voffA);
            PG8_WAIT_V(8); PG8_WAIT_L(0); PG8_BAR; PG8_MMA(0, 0, At, B0); PG8_MMA(0, 1, At, B1); PG8_BAR; PG8_SCHED;
            PG8_LDA(At, 0, 1); PG8_STAGE(PG8_SB(0, 0), b2, voffB); PG8_STAGE(PG8_SB(0, 1), b2 + hstep, voffB); PG8_STAGE(PG8_SA(0, 0), a2, voffA);
            PG8_WAIT_V(8); PG8_WAIT_L(0); PG8_BAR; PG8_MMA(1, 0, At, B0); PG8_MMA(1, 1, At, B1); PG8_BAR; PG8_SCHED;
            PG8_LDB(B0, 1, 0); PG8_LDB(B1, 1, 1); PG8_SCHED; PG8_LDA(At, 1, 0); PG8_STAGE(PG8_SA(0, 1), a2 + hstep, voffA);
            PG8_WAIT_V(8); PG8_WAIT_L(0); PG8_BAR; PG8_MMA(0, 0, At, B0); PG8_MMA(0, 1, At, B1); PG8_BAR; PG8_SCHED;
            PG8_LDA(At, 1, 1); PG8_STAGE(PG8_SB(1, 0), b3, voffB); PG8_STAGE(PG8_SB(1, 1), b3 + hstep, voffB); PG8_STAGE(PG8_SA(1, 0), a3, voffA);
            PG8_WAIT_V(8); PG8_WAIT_L(0); PG8_BAR; PG8_MMA(1, 0, At, B0); PG8_MMA(1, 1, At, B1); PG8_BAR; PG8_SCHED;
        }
        if (wr == 0) PG8_BAR;
        const bool keep = E(acc, cur, wr, wc, fr, fq);
        if (!has_next) break;
        if (!keep) {
#pragma unroll
        for (int a = 0; a < 2; ++a)
#pragma unroll
            for (int b = 0; b < 2; ++b)
#pragma unroll
                for (int m = 0; m < 4; ++m)
#pragma unroll
                    for (int n = 0; n < 2; ++n) acc[a][b][m][n] = (f32x4){0.f, 0.f, 0.f, 0.f};
        }
        cur = nxt; cA = nA; cB = nB; ++ui;
        if (wr == 1) PG8_BAR;
    }
    PG8_WAIT_V(0);
    PG8_BAR;
#undef PG8_SA
#undef PG8_SB
#undef PG8_STAGE
#undef PG8_LDA
#undef PG8_LDB
#undef PG8_MMA
#undef PG8_WAIT_V
#undef PG8_WAIT_L
#undef PG8_BAR
#undef PG8_SCHED
}
}

constexpr int DM = 1024, NB = 16, SEQ = 4096, DECS = 16, NKV = 4, HD = 64, KVW = 256, INW = 5632, DFF = 2816;
constexpr int MP = NB * SEQ, MS = NB * DECS, MT = MP + MS;
constexpr float EPS = 1e-6f, LOG2E = 1.4426950408889634f, QSCALE = 0.125f * LOG2E;
constexpr size_t O_YP = 0, O_YS = (size_t)MP * DM, O_KP = O_YS + (size_t)MS * DM, O_VP = O_KP + 524288, O_KS = O_VP + 524288, O_VS = O_KS + 524288, O_GS = O_VS + 524288, O_END = O_GS + (size_t)MS * DM;

constexpr size_t MiB = 1u << 20;
constexpr size_t WS_CTL = 0, CTL_ZERO_BYTES = 1 * MiB;
constexpr size_t WS_WIN = 1 * MiB, WS_WFI = 12 * MiB, WS_WA = 23 * MiB, WS_WG = 25 * MiB, WS_WO = 27 * MiB, WS_WFO = 29 * MiB;
constexpr size_t WS_RSTD1 = 35 * MiB, WS_RSTD2 = 36 * MiB, WS_PMIX = 37 * MiB, WS_PF = 42 * MiB;
constexpr size_t ACTB = (size_t)MT * DM * 2;
constexpr size_t WS_R0 = 48 * MiB;
constexpr size_t WS_R1 = 177 * MiB;
constexpr size_t WS_R2 = 306 * MiB;
constexpr size_t WS_KB = 435 * MiB, WS_VB = 468 * MiB;
constexpr size_t WS_R3 = 501 * MiB;
constexpr size_t WS_SA = WS_R3, WS_SB = WS_R3 + ACTB, WS_U = WS_R3 + 2 * ACTB, WS_END = WS_R3 + 3 * ACTB;
static_assert(WS_END <= 1024 * MiB && (size_t)MT * DFF * 2 <= 3 * ACTB && WS_R0 + ACTB <= WS_R1 && WS_R1 + ACTB <= WS_R2 && WS_R2 + ACTB <= WS_KB, "d_ws map");
constexpr int CW_BAR = 4096;

constexpr int RING_BYTES = 131072, LDSCTL_OFF = RING_BYTES, MISC_OFF = LDSCTL_OFF + 320, LDS_BYTES = 147456;
constexpr int NWAVES = 8;

#define GAS __attribute__((address_space(1)))
#define LAS __attribute__((address_space(3)))
typedef unsigned short bf16;
typedef unsigned v4u __attribute__((ext_vector_type(4)));
typedef unsigned v2u __attribute__((ext_vector_type(2)));
typedef float f32x4 __attribute__((ext_vector_type(4)));
typedef GAS unsigned gu32;
#define RLX_AGENT __ATOMIC_RELAXED, __HIP_MEMORY_SCOPE_AGENT
#define LDS_WAIT() asm volatile("s_waitcnt lgkmcnt(0)" ::: "memory")
typedef float f32x2_t __attribute__((ext_vector_type(2))); typedef __bf16 bf16x2_t __attribute__((ext_vector_type(2)));
__device__ __forceinline__ unsigned pk2(float lo, float hi) { f32x2_t v = {lo, hi}; bf16x2_t b = __builtin_convertvector(v, bf16x2_t); return __builtin_bit_cast(unsigned, b); }
__device__ __forceinline__ float bflo(unsigned w) { return __uint_as_float(w << 16); }
__device__ __forceinline__ float bfhi(unsigned w) { return __uint_as_float(w & 0xffff0000u); }
__device__ __forceinline__ float wave_sum(float v) {
#pragma unroll
    for (int o = 1; o < 64; o <<= 1) v += __shfl_xor(v, o);
    return v;
}
__device__ __forceinline__ float gelu_tanh(float x) {
    const float e = __builtin_amdgcn_exp2f(x * (-2.302208198f - 0.10294324f * x * x));
    return x * __builtin_amdgcn_rcpf(1.0f + e);
}
__device__ __forceinline__ float sigmoidf_(float x) { return __builtin_amdgcn_rcpf(1.0f + __builtin_amdgcn_exp2f(-LOG2E * x)); }

#define XB_TMO      128
#define XB_XCNT(j)  (256  + 64 * (j))
#define XB_XSUB(j)  (1280 + 64 * (j))
#define XB_XGEN(j)  (2304 + 64 * (j))
#define XB_TOP      3328
#define XB_TOPGEN   3392
#define XCD_BAR_WORDS 3456
#define XB_SPIN_CAP (1u << 18)
__device__ __forceinline__ unsigned xb_ld(unsigned* p)              { return __hip_atomic_load(p, __ATOMIC_RELAXED, __HIP_MEMORY_SCOPE_AGENT); }
__device__ __forceinline__ unsigned xb_add(unsigned* p, unsigned v) { return __hip_atomic_fetch_add(p, v, __ATOMIC_RELAXED, __HIP_MEMORY_SCOPE_AGENT); }
__device__ __forceinline__ unsigned xb_xcc_id() { return (unsigned)__builtin_amdgcn_s_getreg((3 << 11) | 20) & 0xFu; }
#define XB_SPIN(cond, bar) do { unsigned _sp = 0; while (cond) { __builtin_amdgcn_s_sleep(1); \
    if ((++_sp & 255u) == 0u) { if (xb_ld(&(bar)[XB_TMO])) break; if (_sp > XB_SPIN_CAP) { atomicAdd(&(bar)[XB_TMO], 1u); break; } } } } while (0)
struct XcdBarrier { unsigned* bar; unsigned x; volatile LAS unsigned* st; };
__device__ __forceinline__ XcdBarrier xcd_barrier_post(unsigned* bar, volatile LAS unsigned* st) {
    XcdBarrier b; b.bar = bar; b.x = xb_xcc_id(); b.st = st;
    if (threadIdx.x == 0) (void)xb_add(&bar[XB_XCNT(b.x)], 1u);
    return b;
}
__device__ __forceinline__ void xcd_barrier_complete(unsigned* bar, unsigned x, unsigned& nloc, unsigned& nx) {
    const unsigned G = gridDim.x * gridDim.y * gridDim.z;
    unsigned sum, cnt, mine, sp = 0u;
    for (;;) {
        sum = 0u; cnt = 0u; mine = 0u;
#pragma unroll
        for (unsigned j = 0; j < 16; ++j) { const unsigned c = xb_ld(&bar[XB_XCNT(j)]); sum += c; cnt += (c > 0u) ? 1u : 0u; mine = (j == x) ? c : mine; }
        if (sum == G) break;
        __builtin_amdgcn_s_sleep(1);
        if ((++sp & 255u) == 0u) { if (xb_ld(&bar[XB_TMO])) break; if (sp > XB_SPIN_CAP) { atomicAdd(&bar[XB_TMO], 1u); break; } }
    }
    nloc = mine > 0u ? mine : 1u; nx = cnt > 0u ? cnt : 1u;
}
__device__ __forceinline__ void xcd_barrier(const XcdBarrier& b) {
    asm volatile("s_waitcnt vmcnt(0)" ::: "memory");
    __syncthreads();
    if (threadIdx.x == 0) {
        unsigned* bar = b.bar;
        __builtin_amdgcn_s_waitcnt(0);
        unsigned nloc = b.st[0], nx = b.st[1];
        if (nloc == 0u) { xcd_barrier_complete(bar, b.x, nloc, nx); b.st[0] = nloc; b.st[1] = nx; }
        const unsigned old = xb_add(&bar[XB_XSUB(b.x)], 1u);
        const unsigned gen = old / nloc;
        if (old + 1u == (gen + 1u) * nloc) {
            __builtin_amdgcn_fence(__ATOMIC_RELEASE, "agent");
            asm volatile("s_waitcnt vmcnt(0)" ::: "memory");
            const unsigned og = xb_add(&bar[XB_TOP], 1u);
            const unsigned tg = og / nx;
            if (og + 1u == (tg + 1u) * nx) xb_add(&bar[XB_TOPGEN], 1u);
            else XB_SPIN(xb_ld(&bar[XB_TOPGEN]) == tg, bar);
            __builtin_amdgcn_fence(__ATOMIC_ACQUIRE, "agent");
            xb_add(&bar[XB_XGEN(b.x)], 1u);
            asm volatile("s_waitcnt vmcnt(0)" ::: "memory");
        } else {
            XB_SPIN(xb_ld(&bar[XB_XGEN(b.x)]) == gen, bar);
            __builtin_amdgcn_fence(__ATOMIC_ACQUIRE, "agent");
            asm volatile("s_waitcnt vmcnt(0)" ::: "memory");
        }
    }
    __syncthreads();
}

using pg8::Unit;
struct EpiIn {
    static constexpr bool PERM = true;
    const float* rstd; bf16 *Q, *Kb, *Vb, *U, *GV, *SA, *SB; float* out;
    __device__ __forceinline__ bool operator()(f32x4 (&acc)[2][2][4][2], const Unit& u, int wr, int wc, int fr, int fq) const {
        const int pn = u.pn; int mode, ld, colt; bf16* dst; float* side = nullptr; size_t side_s = 0;
        if (pn < 4)       { mode = 0; dst = Q;  ld = DM;  colt = pn * 256; }
        else if (pn == 4) { mode = 1; dst = Kb; ld = KVW; colt = 0; side = out + O_KP; side_s = O_KS - O_KP; }
        else if (pn == 5) { mode = 1; dst = Vb; ld = KVW; colt = 0; side = out + O_VP; side_s = O_VS - O_VP; }
        else if (pn < 10) { mode = 2; dst = U;  ld = DM;  colt = (pn - 6) * 256; }
        else if (pn < 14) { mode = 2; dst = GV; ld = DM;  colt = (pn - 10) * 256; }
        else if (pn < 18) { mode = 3; dst = SA; ld = DM;  colt = (pn - 14) * 256; }
        else              { mode = 3; dst = SB; ld = DM;  colt = (pn - 18) * 256; }
        const int row0 = u.pm * 256 + wr * 64 + fr, col0 = colt + wc * 32 + 8 * fq;
#pragma unroll
        for (int ai = 0; ai < 2; ++ai)
#pragma unroll
            for (int m = 0; m < 4; ++m) {
                const int row = row0 + ai * 128 + m * 16; const float rs = rstd[row];
#pragma unroll
                for (int bj = 0; bj < 2; ++bj) {
                    float v[8];
#pragma unroll
                    for (int j = 0; j < 4; ++j) { v[j] = acc[ai][bj][m][0][j] * rs; v[4 + j] = acc[ai][bj][m][1][j] * rs; }
                    if (mode == 0) {
#pragma unroll
                        for (int j = 0; j < 8; ++j) v[j] *= QSCALE;
                    } else if (mode == 2) {
#pragma unroll
                        for (int j = 0; j < 8; ++j) v[j] = gelu_tanh(v[j]);
                    } else if (mode == 3) {
#pragma unroll
                        for (int j = 0; j < 8; ++j) v[j] = sigmoidf_(v[j]);
                    }
                    const int col = col0 + bj * 128;
                    v4u w; w.x = pk2(v[0], v[1]); w.y = pk2(v[2], v[3]); w.z = pk2(v[4], v[5]); w.w = pk2(v[6], v[7]);
                    *(v4u*)(dst + (size_t)row * ld + col) = w;
                    if (mode == 1) {
                        float* sp = nullptr;
                        if (u.pm == 256) { const int r = row - MP; sp = side + side_s + ((size_t)((r >> 4) * 128 + 112 + (r & 15)) * KVW + col); }
                        else if ((u.pm & 15) == 15 && ai == 1) { const int j = wr * 64 + m * 16 + fr; sp = side + ((size_t)((u.pm >> 4) * 128 + j) * KVW + col); }
                        if (sp) { *(f32x4*)sp = (f32x4){v[0], v[1], v[2], v[3]}; *(f32x4*)(sp + 4) = (f32x4){v[4], v[5], v[6], v[7]}; }
                    }
                }
            }
        return false;
    }
};
struct EpiMerge {
    static constexpr bool PERM = true;
    const bf16 *SA, *SB; bf16* O;
    __device__ __forceinline__ bool operator()(f32x4 (&acc)[2][2][4][2], const Unit& u, int wr, int wc, int fr, int fq) const {
        const int row0 = u.pm * 256 + wr * 64 + fr, col0 = u.pn * 256 + wc * 32 + 8 * fq;
#pragma unroll
        for (int ai = 0; ai < 2; ++ai)
#pragma unroll
            for (int m = 0; m < 4; ++m)
#pragma unroll
                for (int bj = 0; bj < 2; ++bj) {
                    const size_t off = (size_t)(row0 + ai * 128 + m * 16) * DM + col0 + bj * 128;
                    const v4u sbw = *(const v4u*)(SB + off);
                    float sb[8] = {bflo(sbw.x), bfhi(sbw.x), bflo(sbw.y), bfhi(sbw.y), bflo(sbw.z), bfhi(sbw.z), bflo(sbw.w), bfhi(sbw.w)};
#pragma unroll
                    for (int j = 0; j < 8; ++j) sb[j] = fmaxf(sb[j], 1e-30f);
                    if (u.seg == 0) {
                        const v4u saw = *(const v4u*)(SA + off);
                        const float sa[8] = {bflo(saw.x), bfhi(saw.x), bflo(saw.y), bfhi(saw.y), bflo(saw.z), bfhi(saw.z), bflo(saw.w), bfhi(saw.w)};
#pragma unroll
                        for (int j = 0; j < 4; ++j) { acc[ai][bj][m][0][j] *= sa[j] * __builtin_amdgcn_rcpf(sb[j]); acc[ai][bj][m][1][j] *= sa[4 + j] * __builtin_amdgcn_rcpf(sb[4 + j]); }
                    } else {
                        float v[8];
#pragma unroll
                        for (int j = 0; j < 4; ++j) { v[j] = acc[ai][bj][m][0][j] * sb[j]; v[4 + j] = acc[ai][bj][m][1][j] * sb[4 + j]; }
                        v4u w; w.x = pk2(v[0], v[1]); w.y = pk2(v[2], v[3]); w.z = pk2(v[4], v[5]); w.w = pk2(v[6], v[7]);
                        *(v4u*)(O + off) = w;
                    }
                }
        return u.seg == 0;
    }
};
struct EpiBf16Ss {
    static constexpr bool PERM = true;
    bf16* O; float* P;
    __device__ __forceinline__ bool operator()(f32x4 (&acc)[2][2][4][2], const Unit& u, int wr, int wc, int fr, int fq) const {
        const int row0 = u.pm * 256 + wr * 64 + fr, col0 = u.pn * 256 + wc * 32 + 8 * fq;
#pragma unroll
        for (int ai = 0; ai < 2; ++ai)
#pragma unroll
            for (int m = 0; m < 4; ++m) {
                const int row = row0 + ai * 128 + m * 16; float ss = 0.f;
#pragma unroll
                for (int bj = 0; bj < 2; ++bj) {
                    const f32x4 a = acc[ai][bj][m][0], b = acc[ai][bj][m][1];
                    ss += (a[0] * a[0] + a[1] * a[1]) + (a[2] * a[2] + a[3] * a[3]) + (b[0] * b[0] + b[1] * b[1]) + (b[2] * b[2] + b[3] * b[3]);
                    v4u w; w.x = pk2(a[0], a[1]); w.y = pk2(a[2], a[3]); w.z = pk2(b[0], b[1]); w.w = pk2(b[2], b[3]);
                    *(v4u*)(O + (size_t)row * DM + col0 + bj * 128) = w;
                }
                ss += __shfl_xor(ss, 16); ss += __shfl_xor(ss, 32);
                if (fq == 0) P[(size_t)(u.pn * 4 + wc) * MT + row] = ss;
            }
        return false;
    }
};
struct EpiSwiglu {
    static constexpr bool PERM = true;
    const float* rstd; bf16* O;
    __device__ __forceinline__ bool operator()(f32x4 (&acc)[2][2][4][2], const Unit& u, int wr, int wc, int fr, int fq) const {
        const int row0 = u.pm * 256 + wr * 64 + fr, col0 = u.pn * 128 + wc * 32 + 8 * fq;
#pragma unroll
        for (int ai = 0; ai < 2; ++ai)
#pragma unroll
            for (int m = 0; m < 4; ++m) {
                const int row = row0 + ai * 128 + m * 16; const float rs = rstd[row]; float v[8];
#pragma unroll
                for (int n = 0; n < 2; ++n)
#pragma unroll
                    for (int j = 0; j < 4; ++j) { const float gg = acc[ai][0][m][n][j] * rs, up = acc[ai][1][m][n][j] * rs; v[4 * n + j] = gg * sigmoidf_(gg) * up; }
                v4u w; w.x = pk2(v[0], v[1]); w.y = pk2(v[2], v[3]); w.z = pk2(v[4], v[5]); w.w = pk2(v[6], v[7]);
                *(v4u*)(O + (size_t)row * DFF + col0) = w;
            }
        return false;
    }
};

template <bool MAP>
__device__ __forceinline__ void p0_transpose_item(const float* W, int K, int N, const float* gain, bf16* WT, LAS float* scr, int item, int lane) {
    const int nblk = N / 32, kb = item / nblk, nb = item % nblk, k0 = 64 * kb, n0 = 32 * nb;
#pragma unroll 8
    for (int i = 0; i < 32; ++i) { const int kk = 2 * i + (lane >> 5); const float gk = gain ? gain[k0 + kk] : 1.0f; scr[kk * 33 + (lane & 31)] = W[(size_t)(k0 + kk) * N + n0 + (lane & 31)] * gk; }
    LDS_WAIT(); asm volatile("" ::: "memory");
    const int c = lane & 7;
#pragma unroll
    for (int j = 0; j < 4; ++j) { const int n = (lane >> 3) + 8 * j; const LAS float* s = scr + (8 * c) * 33 + n;
        v4u o; o.x = pk2(s[0 * 33], s[1 * 33]); o.y = pk2(s[2 * 33], s[3 * 33]); o.z = pk2(s[4 * 33], s[5 * 33]); o.w = pk2(s[6 * 33], s[7 * 33]);
        int nn = n0 + n;
        if (MAP) { const int hi = nn >= DFF ? 1 : 0, r = nn - hi * DFF; nn = 256 * (r >> 7) + 128 * hi + (r & 127); }
        *(GAS v4u*)(WT + (size_t)nn * K + k0 + 8 * c) = o; }
    LDS_WAIT(); asm volatile("" ::: "memory");
}

struct Args { const float* in[19]; float* out; unsigned char* ws; int ph_lo, ph_hi; };

__global__ void __launch_bounds__(NWAVES * 64, 2) fwd_kernel(Args args) {
    extern __shared__ __attribute__((aligned(16))) unsigned char lds_raw[];
    LAS unsigned char* lds = (LAS unsigned char*)lds_raw;
    volatile LAS unsigned* MISC = (volatile LAS unsigned*)(lds + MISC_OFF);
    const int tid = threadIdx.x, lane = tid & 63, wave = __builtin_amdgcn_readfirstlane(tid >> 6);
    const int G = gridDim.x;
    const int vcu = (G % 8 == 0) ? ((int)blockIdx.x % 8) * (G / 8) + (int)blockIdx.x / 8 : (int)blockIdx.x;
    unsigned char* ws = args.ws;
    const float* xp = args.in[0]; const float* xs = args.in[1]; const float* cache_k = args.in[2]; const float* cache_v = args.in[3];
    const float* g_pre_mix = args.in[4]; const float* g_post_mix = args.in[5]; const float* g_pre_ffn = args.in[6]; const float* g_post_ffn = args.in[7];
    const float* w_in = args.in[8]; const float* sinks = args.in[9]; const float* ln_g = args.in[10]; const float* ln_b = args.in[11];
    const float* w_s = args.in[12]; const float* b_s = args.in[13]; const float* w_ap = args.in[14]; const float* w_gp = args.in[15];
    const float* w_out = args.in[16]; const float* w_fi = args.in[17]; const float* w_fo = args.in[18];
    float* out = args.out;
    bf16* WinT = (bf16*)(ws + WS_WIN); bf16* WfiT = (bf16*)(ws + WS_WFI); bf16* WaT = (bf16*)(ws + WS_WA); bf16* WgT = (bf16*)(ws + WS_WG); bf16* WoT = (bf16*)(ws + WS_WO); bf16* WfoT = (bf16*)(ws + WS_WFO);
    float* RSTD1 = (float*)(ws + WS_RSTD1); float* RSTD2 = (float*)(ws + WS_RSTD2); float* PMIX = (float*)(ws + WS_PMIX); float* PF = (float*)(ws + WS_PF);
    bf16* XB = (bf16*)(ws + WS_R0); bf16* MERGED = XB; bf16* FB = XB;
    bf16* QB = (bf16*)(ws + WS_R1); bf16* X1B = QB;
    bf16* GV = (bf16*)(ws + WS_R2); bf16* MIX = GV;
    bf16* KB = (bf16*)(ws + WS_KB); bf16* VB = (bf16*)(ws + WS_VB);
    bf16* SA = (bf16*)(ws + WS_SA); bf16* SB = (bf16*)(ws + WS_SB); bf16* UB = (bf16*)(ws + WS_U); bf16* ACT = (bf16*)(ws + WS_R3);

    for (int u = tid; u < (LDS_BYTES - LDSCTL_OFF) / 4; u += NWAVES * 64) ((LAS unsigned*)(lds + LDSCTL_OFF))[u] = 0u;
    __syncthreads();
    XcdBarrier bar; bar.bar = (unsigned*)(ws + WS_CTL) + CW_BAR; bar.x = 0; bar.st = nullptr;
    if (MK_ONE_LAUNCH) bar = xcd_barrier_post((unsigned*)(ws + WS_CTL) + CW_BAR, MISC + 8);
    const int lo = args.ph_lo, hi = args.ph_hi;
#define IN(k) (lo <= (k) && (k) < hi)
#define SEAM(k) do { if (MK_ONE_LAUNCH && IN(k) && IN((k) + 1)) xcd_barrier(bar); } while (0)
    const int gw = vcu * NWAVES + wave, NGW = G * NWAVES;

    if (IN(0)) {
        LAS float* scr = (LAS float*)(lds + wave * 16384);
        constexpr int I_IN = (DM / 64) * (INW / 32), I_SQ = (DM / 64) * (DM / 32), I_FO = (DFF / 64) * (DM / 32);
        constexpr int NITEMS = 2 * I_IN + 3 * I_SQ + I_FO;
        for (int it = gw; it < NITEMS; it += NGW) {
            int r = it;
            if (r < I_IN) { p0_transpose_item<false>(w_in, DM, INW, g_pre_mix, WinT, scr, r, lane); continue; } r -= I_IN;
            if (r < I_IN) { p0_transpose_item<true>(w_fi, DM, INW, g_pre_ffn, WfiT, scr, r, lane); continue; } r -= I_IN;
            if (r < I_SQ) { p0_transpose_item<false>(w_ap, DM, DM, nullptr, WaT, scr, r, lane); continue; } r -= I_SQ;
            if (r < I_SQ) { p0_transpose_item<false>(w_gp, DM, DM, nullptr, WgT, scr, r, lane); continue; } r -= I_SQ;
            if (r < I_SQ) { p0_transpose_item<false>(w_out, DM, DM, nullptr, WoT, scr, r, lane); continue; } r -= I_SQ;
            p0_transpose_item<false>(w_fo, DFF, DM, nullptr, WfoT, scr, r, lane);
        }
        for (int m = gw; m < MT; m += NGW) {
            const float* xrow = (m < MP) ? xp + (size_t)m * DM : xs + (size_t)(m - MP) * DM;
            const GAS f32x4* xr = (const GAS f32x4*)xrow + lane;
            f32x4 v[4]; float s = 0.f;
#pragma unroll
            for (int j = 0; j < 4; ++j) { v[j] = xr[64 * j]; s += (v[j].x * v[j].x + v[j].y * v[j].y) + (v[j].z * v[j].z + v[j].w * v[j].w); }
            s = wave_sum(s);
            if (lane == 0) RSTD1[m] = 1.0f / sqrtf(s * (1.0f / DM) + EPS);
            GAS v2u* o8 = (GAS v2u*)(XB + (size_t)m * DM) + lane;
#pragma unroll
            for (int j = 0; j < 4; ++j) { v2u w; w.x = pk2(v[j].x, v[j].y); w.y = pk2(v[j].z, v[j].w); o8[64 * j] = w; }
        }
        for (int i = gw * 64 + lane; i < 2 * NB * 112 * 64; i += NGW * 64) {
            const int which = i / (NB * 112 * 64), r = i % (NB * 112 * 64), b = r / (112 * 64), q = r % (112 * 64);
            const float* src = (which ? cache_v : cache_k) + (size_t)b * 128 * KVW + 16 * KVW;
            float* dstp = out + (which ? O_VS : O_KS) + (size_t)b * 128 * KVW;
            ((f32x4*)dstp)[q] = ((const f32x4*)src)[q];
        }
    }
    SEAM(0);

    if (IN(1)) {
        pg8::Gemm g{XB, WinT, XB, WinT, MT, INW, DM}; pg8::StaticOrder S; S.init(MT, INW, G, (int)blockIdx.x, 1);
        EpiIn E{RSTD1, QB, KB, VB, UB, GV, SA, SB, out};
        pg8::gemm_phase<EpiIn, pg8::StaticOrder>(lds, g, S, E);
    }
    SEAM(1);

    if (IN(2)) {
        constexpr int ATT_UNITS = NB * 64 * NKV + NB * NKV;
        const int half = wave >> 2, ht = tid & 255;
        LAS bf16* Ks = (LAS bf16*)(lds + half * 49152); LAS bf16* Vs = Ks + 192 * 64;
        for (int up = blockIdx.x; up < ATT_UNITS / 2; up += G) {
            const int unit = 2 * up + half; const bool sample = unit >= NB * 64 * NKV;
            int b, c = 0, kvh, nk, first = 0;
            if (!sample) { b = unit >> 8; c = (unit >> 2) & 63; kvh = unit & 3; first = (c >= 2) ? (c - 2) * 64 : 0; nk = c * 64 + 64 - first; }
            else { const int su = unit - NB * 64 * NKV; b = su >> 2; kvh = su & 3; nk = 144; }
            for (int i = ht; i < nk * 8; i += 256) {
                const int key = i >> 3, ch = i & 7; v4u kw, vw;
                if (sample && key < 128) {
                    const size_t o = ((size_t)(b * 128 + key) * NKV + kvh) * HD + ch * 8;
                    const f32x4 k0 = *(const f32x4*)(cache_k + o), k1 = *(const f32x4*)(cache_k + o + 4), v0 = *(const f32x4*)(cache_v + o), v1 = *(const f32x4*)(cache_v + o + 4);
                    kw.x = pk2(k0.x, k0.y); kw.y = pk2(k0.z, k0.w); kw.z = pk2(k1.x, k1.y); kw.w = pk2(k1.z, k1.w);
                    vw.x = pk2(v0.x, v0.y); vw.y = pk2(v0.z, v0.w); vw.z = pk2(v1.x, v1.y); vw.w = pk2(v1.z, v1.w);
                } else {
                    const size_t row = sample ? (size_t)(MP + b * 16 + (key - 128)) : (size_t)(b * SEQ + first + key);
                    kw = *(const v4u*)(KB + row * KVW + kvh * HD + ch * 8); vw = *(const v4u*)(VB + row * KVW + kvh * HD + ch * 8);
                }
                *(LAS v4u*)(Ks + key * 64 + ch * 8) = kw; *(LAS v4u*)(Vs + key * 64 + ch * 8) = vw;
            }
            __syncthreads();
            const int gq = sample ? (ht >> 4) : (ht >> 6), pos = sample ? (ht & 15) : (ht & 63);
            if (gq < 4) {
                const size_t row = sample ? (size_t)(MP + b * 16 + pos) : (size_t)(b * SEQ + c * 64 + pos);
                const int head = kvh * 4 + gq;
                bf16* qp = QB + row * DM + head * HD;
                float q[64], o[64];
#pragma unroll
                for (int i = 0; i < 8; ++i) { const v4u w = *(const v4u*)(qp + i * 8);
                    q[8 * i + 0] = bflo(w.x); q[8 * i + 1] = bfhi(w.x); q[8 * i + 2] = bflo(w.y); q[8 * i + 3] = bfhi(w.y); q[8 * i + 4] = bflo(w.z); q[8 * i + 5] = bfhi(w.z); q[8 * i + 6] = bflo(w.w); q[8 * i + 7] = bfhi(w.w); }
#pragma unroll
                for (int i = 0; i < 64; ++i) o[i] = 0.f;
                float mx = sinks[head] * LOG2E, l = 1.0f;
                for (int key = 0; key < nk; ++key) {
                    float s = 0.f;
#pragma unroll
                    for (int i = 0; i < 8; ++i) { const v4u w = *(const LAS v4u*)(Ks + key * 64 + i * 8);
                        s += q[8 * i + 0] * bflo(w.x) + q[8 * i + 1] * bfhi(w.x) + q[8 * i + 2] * bflo(w.y) + q[8 * i + 3] * bfhi(w.y) + q[8 * i + 4] * bflo(w.z) + q[8 * i + 5] * bfhi(w.z) + q[8 * i + 6] * bflo(w.w) + q[8 * i + 7] * bfhi(w.w); }
                    const float mn = fmaxf(mx, s), sc = __builtin_amdgcn_exp2f(mx - mn), p = __builtin_amdgcn_exp2f(s - mn);
                    l = l * sc + p; mx = mn;
#pragma unroll
                    for (int i = 0; i < 8; ++i) { const v4u w = *(const LAS v4u*)(Vs + key * 64 + i * 8);
                        o[8 * i + 0] = o[8 * i + 0] * sc + p * bflo(w.x); o[8 * i + 1] = o[8 * i + 1] * sc + p * bfhi(w.x); o[8 * i + 2] = o[8 * i + 2] * sc + p * bflo(w.y); o[8 * i + 3] = o[8 * i + 3] * sc + p * bfhi(w.y);
                        o[8 * i + 4] = o[8 * i + 4] * sc + p * bflo(w.z); o[8 * i + 5] = o[8 * i + 5] * sc + p * bfhi(w.z); o[8 * i + 6] = o[8 * i + 6] * sc + p * bflo(w.w); o[8 * i + 7] = o[8 * i + 7] * sc + p * bfhi(w.w); }
                }
                const float inv = 1.0f / l;
#pragma unroll
                for (int i = 0; i < 8; ++i) { v4u w; w.x = pk2(o[8 * i] * inv, o[8 * i + 1] * inv); w.y = pk2(o[8 * i + 2] * inv, o[8 * i + 3] * inv); w.z = pk2(o[8 * i + 4] * inv, o[8 * i + 5] * inv); w.w = pk2(o[8 * i + 6] * inv, o[8 * i + 7] * inv);
                    *(v4u*)(qp + i * 8) = w; }
            }
            __syncthreads();
        }
        constexpr int G_UNITS = NB * 32 + NB;
        LAS float* stats = (LAS float*)lds; LAS bf16* tile = (LAS bf16*)(lds + 1024);
        for (int unit = blockIdx.x; unit < G_UNITS; unit += G) {
            const bool sample = unit >= NB * 32; const int L = sample ? 16 : 128;
            const size_t row0 = sample ? (size_t)(MP + (unit - NB * 32) * 16) : (size_t)unit * 128;
            for (int rr = 0; rr < 16; ++rr) { const int r = wave * 16 + rr;
                if (r < L) {
                    const bf16* gp = GV + (row0 + r) * DM + 8 * lane; const v4u w0 = *(const v4u*)gp, w1 = *(const v4u*)(gp + 512);
                    const float v[16] = {bflo(w0.x), bfhi(w0.x), bflo(w0.y), bfhi(w0.y), bflo(w0.z), bfhi(w0.z), bflo(w0.w), bfhi(w0.w), bflo(w1.x), bfhi(w1.x), bflo(w1.y), bfhi(w1.y), bflo(w1.z), bfhi(w1.z), bflo(w1.w), bfhi(w1.w)};
                    float s = 0.f;
#pragma unroll
                    for (int j = 0; j < 16; ++j) s += v[j];
                    const float mean = wave_sum(s) * (1.0f / DM); float q = 0.f;
#pragma unroll
                    for (int j = 0; j < 16; ++j) { const float d = v[j] - mean; q += d * d; }
                    const float rstd = 1.0f / sqrtf(wave_sum(q) * (1.0f / DM) + EPS);
                    if (lane == 0) { stats[2 * r] = mean; stats[2 * r + 1] = rstd; }
                }
            }
            __syncthreads();
            for (int g = 0; g < 4; ++g) {
                for (int i = 0; i < 8; ++i) { const int idx = tid + 512 * i, r = idx >> 5, ch = idx & 31, col = g * 256 + ch * 8; v4u w = {0u, 0u, 0u, 0u};
                    if (r < L) {
                        const v4u x = *(const v4u*)(GV + (row0 + r) * DM + col); const float mean = stats[2 * r], rstd = stats[2 * r + 1];
                        const f32x4 g0 = *(const f32x4*)(ln_g + col), g1 = *(const f32x4*)(ln_g + col + 4), b0 = *(const f32x4*)(ln_b + col), b1 = *(const f32x4*)(ln_b + col + 4);
                        float v[8] = {bflo(x.x), bfhi(x.x), bflo(x.y), bfhi(x.y), bflo(x.z), bfhi(x.z), bflo(x.w), bfhi(x.w)};
                        v[0] = (v[0] - mean) * rstd * g0.x + b0.x; v[1] = (v[1] - mean) * rstd * g0.y + b0.y; v[2] = (v[2] - mean) * rstd * g0.z + b0.z; v[3] = (v[3] - mean) * rstd * g0.w + b0.w;
                        v[4] = (v[4] - mean) * rstd * g1.x + b1.x; v[5] = (v[5] - mean) * rstd * g1.y + b1.y; v[6] = (v[6] - mean) * rstd * g1.z + b1.z; v[7] = (v[7] - mean) * rstd * g1.w + b1.w;
                        if (sample) { float* gs = out + O_GS + ((size_t)(unit - NB * 32) * 16 + r) * DM + col; *(f32x4*)gs = (f32x4){v[0], v[1], v[2], v[3]}; *(f32x4*)(gs + 4) = (f32x4){v[4], v[5], v[6], v[7]}; }
                        w.x = pk2(v[0], v[1]); w.y = pk2(v[2], v[3]); w.z = pk2(v[4], v[5]); w.w = pk2(v[6], v[7]);
                    }
                    *(LAS v4u*)(tile + r * 256 + ch * 8) = w; }
                __syncthreads();
                for (int i = 0; i < 16; ++i) { const int t = wave + 8 * i;
                    if (t < L) {
                        float a0 = 0.f, a1 = 0.f, a2 = 0.f, a3 = 0.f; const float* wrow = w_s + (size_t)(g * 128 + t) * 128;
                        for (int s = 0; s <= t; ++s) { const float w = wrow[s]; const v2u x = *(const LAS v2u*)(tile + s * 256 + 4 * lane);
                            a0 += w * bflo(x.x); a1 += w * bfhi(x.x); a2 += w * bflo(x.y); a3 += w * bfhi(x.y); }
                        const float bias = b_s[g * 128 + t];
                        bf16* up = UB + (row0 + t) * DM + g * 256 + 4 * lane; const v2u uw = *(const v2u*)up;
                        v2u o; o.x = pk2(bflo(uw.x) * (a0 + bias), bfhi(uw.x) * (a1 + bias)); o.y = pk2(bflo(uw.y) * (a2 + bias), bfhi(uw.y) * (a3 + bias));
                        *(v2u*)up = o;
                    }
                }
                __syncthreads();
            }
        }
    }
    SEAM(2);

    if (IN(3)) {
        pg8::Gemm g{QB, WaT, UB, WgT, MT, DM, DM}; pg8::StaticOrder S; S.init(MT, DM, G, (int)blockIdx.x, 2);
        EpiMerge E{SA, SB, MERGED};
        pg8::gemm_phase<EpiMerge, pg8::StaticOrder>(lds, g, S, E);
    }
    SEAM(3);

    if (IN(4)) {
        pg8::Gemm g{MERGED, WoT, MERGED, WoT, MT, DM, DM}; pg8::StaticOrder S; S.init(MT, DM, G, (int)blockIdx.x, 1);
        EpiBf16Ss E{MIX, PMIX};
        pg8::gemm_phase<EpiBf16Ss, pg8::StaticOrder>(lds, g, S, E);
    }
    SEAM(4);

    if (IN(5)) {
        for (int m = gw; m < MT; m += NGW) {
            const float* xrow = (m < MP) ? xp + (size_t)m * DM : xs + (size_t)(m - MP) * DM;
            float ps = PMIX[(size_t)(lane & 15) * MT + m]; ps += __shfl_xor(ps, 1); ps += __shfl_xor(ps, 2); ps += __shfl_xor(ps, 4); ps += __shfl_xor(ps, 8);
            const float rm = 1.0f / sqrtf(ps * (1.0f / DM) + EPS);
            f32x4 v[4]; float s = 0.f;
#pragma unroll
            for (int j = 0; j < 4; ++j) { const f32x4 xv = *((const GAS f32x4*)xrow + lane + 64 * j); const v2u mw = *((const GAS v2u*)(MIX + (size_t)m * DM) + lane + 64 * j); const f32x4 gv = *((const f32x4*)g_post_mix + lane + 64 * j);
                v[j].x = xv.x + bflo(mw.x) * rm * gv.x; v[j].y = xv.y + bfhi(mw.x) * rm * gv.y; v[j].z = xv.z + bflo(mw.y) * rm * gv.z; v[j].w = xv.w + bfhi(mw.y) * rm * gv.w;
                s += (v[j].x * v[j].x + v[j].y * v[j].y) + (v[j].z * v[j].z + v[j].w * v[j].w); }
            s = wave_sum(s);
            if (lane == 0) RSTD2[m] = 1.0f / sqrtf(s * (1.0f / DM) + EPS);
            GAS v2u* o8 = (GAS v2u*)(X1B + (size_t)m * DM) + lane;
#pragma unroll
            for (int j = 0; j < 4; ++j) { v2u w; w.x = pk2(v[j].x, v[j].y); w.y = pk2(v[j].z, v[j].w); o8[64 * j] = w; }
        }
    }
    SEAM(5);

    if (IN(6)) {
        pg8::Gemm g{X1B, WfiT, X1B, WfiT, MT, INW, DM}; pg8::StaticOrder S; S.init(MT, INW, G, (int)blockIdx.x, 1);
        EpiSwiglu E{RSTD2, ACT};
        pg8::gemm_phase<EpiSwiglu, pg8::StaticOrder>(lds, g, S, E);
    }
    SEAM(6);

    if (IN(7)) {
        pg8::Gemm g{ACT, WfoT, ACT, WfoT, MT, DM, DFF}; pg8::StaticOrder S; S.init(MT, DM, G, (int)blockIdx.x, 1);
        EpiBf16Ss E{FB, PF};
        pg8::gemm_phase<EpiBf16Ss, pg8::StaticOrder>(lds, g, S, E);
    }
    SEAM(7);

    if (IN(8)) {
        for (int m = gw; m < MT; m += NGW) {
            const float* xrow = (m < MP) ? xp + (size_t)m * DM : xs + (size_t)(m - MP) * DM;
            float* yrow = (m < MP) ? out + O_YP + (size_t)m * DM : out + O_YS + (size_t)(m - MP) * DM;
            float ps = PMIX[(size_t)(lane & 15) * MT + m]; ps += __shfl_xor(ps, 1); ps += __shfl_xor(ps, 2); ps += __shfl_xor(ps, 4); ps += __shfl_xor(ps, 8);
            float pf = PF[(size_t)(lane & 15) * MT + m]; pf += __shfl_xor(pf, 1); pf += __shfl_xor(pf, 2); pf += __shfl_xor(pf, 4); pf += __shfl_xor(pf, 8);
            const float rm = 1.0f / sqrtf(ps * (1.0f / DM) + EPS), rf = 1.0f / sqrtf(pf * (1.0f / DM) + EPS);
#pragma unroll
            for (int j = 0; j < 4; ++j) { const f32x4 xv = *((const GAS f32x4*)xrow + lane + 64 * j); const v2u mw = *((const GAS v2u*)(MIX + (size_t)m * DM) + lane + 64 * j); const v2u fw = *((const GAS v2u*)(FB + (size_t)m * DM) + lane + 64 * j);
                const f32x4 g1 = *((const f32x4*)g_post_mix + lane + 64 * j), g2 = *((const f32x4*)g_post_ffn + lane + 64 * j);
                f32x4 y; y.x = xv.x + bflo(mw.x) * rm * g1.x + bflo(fw.x) * rf * g2.x; y.y = xv.y + bfhi(mw.x) * rm * g1.y + bfhi(fw.x) * rf * g2.y;
                y.z = xv.z + bflo(mw.y) * rm * g1.z + bflo(fw.y) * rf * g2.z; y.w = xv.w + bfhi(mw.y) * rm * g1.w + bfhi(fw.y) * rf * g2.w;
                *((GAS f32x4*)yrow + lane + 64 * j) = y; }
        }
    }
#undef IN
#undef SEAM
}

constexpr int N_PHASES = 9;
extern "C" void kernel_launch(void* const* d_in, const int* in_sizes, int n_in, void* d_out, int out_size, void* d_ws, size_t ws_size, hipStream_t stream) {
    static int grid = 0;
    if (grid == 0) {
        if (n_in != 19 || (size_t)out_size != O_END || ws_size < WS_END) { fprintf(stderr, "kernel_launch: unexpected shapes: n_in %d out %d ws %zu (need %zu)\n", n_in, out_size, ws_size, (size_t)WS_END); grid = -1; return; }
        int dev = 0, cus = 0;
        if (hipGetDevice(&dev) != hipSuccess || hipDeviceGetAttribute(&cus, hipDeviceAttributeMultiprocessorCount, dev) != hipSuccess) { grid = -1; return; }
        if (hipFuncSetAttribute((const void*)fwd_kernel, hipFuncAttributeMaxDynamicSharedMemorySize, LDS_BYTES) != hipSuccess) { fprintf(stderr, "kernel_launch: hipFuncSetAttribute failed\n"); grid = -1; return; }
        int per_cu = 0;
        (void)hipOccupancyMaxActiveBlocksPerMultiprocessor(&per_cu, (const void*)fwd_kernel, NWAVES * 64, LDS_BYTES);
        (void)hipGetLastError();
        grid = cus;
    }
    if (grid < 0) return;
    (void)hipMemsetAsync((char*)d_ws + WS_CTL, 0, CTL_ZERO_BYTES, stream);
    Args a{};
    for (int i = 0; i < 19; ++i) a.in[i] = (const float*)d_in[i];
    a.out = (float*)d_out; a.ws = (unsigned char*)d_ws;
#if MK_ONE_LAUNCH
    a.ph_lo = 0; a.ph_hi = N_PHASES;
    hipLaunchKernelGGL(fwd_kernel, dim3(grid), dim3(NWAVES * 64), LDS_BYTES, stream, a);
#else
    for (int p = 0; p < N_PHASES; ++p) { a.ph_lo = p; a.ph_hi = p + 1; hipLaunchKernelGGL(fwd_kernel, dim3(grid), dim3(NWAVES * 64), LDS_BYTES, stream, a); }
#endif
}
```

```cpp
#include <hip/hip_runtime.h>
#include <cstdio>
#include <cstdint>

#ifndef MK_ONE_LAUNCH
#define MK_ONE_LAUNCH 1
#endif

namespace pg8 {
#define PG8_LAS __attribute__((address_space(3)))
typedef unsigned short bf16_t;
typedef short bf16x8 __attribute__((ext_vector_type(8)));
typedef float f32x4 __attribute__((ext_vector_type(4)));
typedef unsigned u32x4 __attribute__((ext_vector_type(4)));
constexpr int BM = 256, BK = 64, HALF = 128, HTB = HALF * BK * 2  , STAGE_BYTES = 8 * HTB, NXCD = 8, WGM = 8;

__host__ __device__ __forceinline__ int lds_byte(int r, int c) { const int st = (r >> 4) * 2 + (c >> 5), rr = r & 15, cc = c & 31, ob = rr * 64 + cc * 2; return st * 1024 + (ob ^ (((ob >> 9) & 1) << 5)); }
__host__ __device__ __forceinline__ void stage_rc(int b, int& R, int& C) { const int st = b / 1024, sb = b % 1024, swz = sb ^ (((sb >> 9) & 1) << 5); R = (st >> 1) * 16 + swz / 64; C = (st & 1) * 32 + (swz % 64) / 2; }
__host__ __device__ __forceinline__ int perm32(int rho) { const int n = rho >> 4, i = rho & 15; return 8 * (i >> 2) + 4 * n + (i & 3); }

struct Unit { int pm, pn, seg; };
struct Gemm { const bf16_t* A0; const bf16_t* B0; const bf16_t* A1; const bf16_t* B1; int M, N, K; };

struct StaticOrder {
    int nM, nN, nwg, G, c, nseg;
    __host__ __device__ void init(int M, int N, int G_, int c_, int nseg_) { nM = M / BM; nN = N / BM; nwg = nM * nN; G = G_; c = c_; nseg = nseg_; }
    __host__ __device__ bool next(int i, Unit& u) const {
        const int ti = (nseg == 2) ? (i >> 1) : i; u.seg = (nseg == 2) ? (i & 1) : 0;
        const long L = (long)ti * G + c; if (L >= nwg) return false;
        int wgid = (int)L; { const int q = nwg / NXCD, r = nwg % NXCD, xcd = wgid % NXCD, off = wgid / NXCD; wgid = (xcd < r ? xcd * (q + 1) : r * (q + 1) + (xcd - r) * q) + off; }
        const int nig = WGM * nN, gid = wgid / nig, fm = gid * WGM, gsz = (nM - fm) < WGM ? (nM - fm) : WGM;
        u.pm = fm + ((wgid % nig) % gsz); u.pn = (wgid % nig) / gsz; return true;
    }
};

template <class Epi, class Sched>
__device__ __forceinline__ void gemm_phase(PG8_LAS unsigned char* lds, const Gemm g, const Sched& S, const Epi& E) {
    const int tid = threadIdx.x, wid = __builtin_amdgcn_readfirstlane(tid >> 6), lane = tid & 63, wr = wid >> 2, wc = wid & 3, fr = lane & 15, fq = lane >> 4;
    const int K = g.K, nt = K / BK;
    unsigned voffA[2], voffB[2];
#pragma unroll
    for (int i = 0; i < 2; ++i) { int R, C; stage_rc(tid * 16 + i * 8192, R, C); const int Rb = Epi::PERM ? ((R & ~31) + perm32(R & 31)) : R;
        voffA[i] = (unsigned)(R * K + C) * 2u; voffB[i] = (unsigned)(Rb * K + C) * 2u; }
    const size_t kstep = (size_t)(BK * 2);
    const size_t hstep = (size_t)HALF * K * 2;
    const size_t tstep = 2 * hstep;
    const unsigned ldsw = (unsigned)wid * 1024u;
    const int aoff = lds_byte(wr * 64 + fr, fq * 8), boff = lds_byte(wc * 32 + fr, fq * 8);
#define PG8_SA(b, h) (((b) * 2 + (h)) * HTB)
#define PG8_SB(b, h) ((4 + (b) * 2 + (h)) * HTB)
#define PG8_STAGE(bufoff, gbase, voff) do { _Pragma("unroll") for (int _i = 0; _i < 2; ++_i) \
        __builtin_amdgcn_global_load_lds((const unsigned*)((const char*)(gbase) + (voff)[_i]), (PG8_LAS unsigned*)(lds + (bufoff) + ldsw + _i * 8192), 16, 0, 0); } while (0)
#define PG8_LDA(dst, b, h) do { _Pragma("unroll") for (int m = 0; m < 4; ++m) _Pragma("unroll") for (int k = 0; k < 2; ++k) dst[m][k] = *(const PG8_LAS bf16x8*)(lds + PG8_SA(b, h) + aoff + m * 2048 + k * 1024); } while (0)
#define PG8_LDB(dst, b, h) do { _Pragma("unroll") for (int n = 0; n < 2; ++n) _Pragma("unroll") for (int k = 0; k < 2; ++k) dst[n][k] = *(const PG8_LAS bf16x8*)(lds + PG8_SB(b, h) + boff + n * 2048 + k * 1024); } while (0)
#define PG8_MMA(ai, bj, At, Bt) do { __builtin_amdgcn_s_setprio(1); _Pragma("unroll") for (int m = 0; m < 4; ++m) _Pragma("unroll") for (int n = 0; n < 2; ++n) _Pragma("unroll") for (int k = 0; k < 2; ++k) \
        acc[ai][bj][m][n] = __builtin_amdgcn_mfma_f32_16x16x32_bf16(Bt[n][k], At[m][k], acc[ai][bj][m][n], 0, 0, 0); __builtin_amdgcn_s_setprio(0); } while (0)
#define PG8_WAIT_V(n) asm volatile("s_waitcnt vmcnt(" #n ")" ::: "memory")
#define PG8_WAIT_L(n) asm volatile("s_waitcnt lgkmcnt(" #n ")" ::: "memory")
#define PG8_BAR __builtin_amdgcn_s_barrier()
#define PG8_SCHED __builtin_amdgcn_sched_barrier(0)
    Unit cur, nxt; int ui = 0;
    if (!S.next(0, cur)) return;
    f32x4 acc[2][2][4][2];
#pragma unroll
    for (int a = 0; a < 2; ++a)
#pragma unroll
        for (int b = 0; b < 2; ++b)
#pragma unroll
            for (int m = 0; m < 4; ++m)
#pragma unroll
                for (int n = 0; n < 2; ++n) acc[a][b][m][n] = (f32x4){0.f, 0.f, 0.f, 0.f};
    bf16x8 At[4][2], B0[2][2], B1[2][2];
    const char* cA = (const char*)(cur.seg ? g.A1 : g.A0) + (size_t)cur.pm * tstep; const char* cB = (const char*)(cur.seg ? g.B1 : g.B0) + (size_t)cur.pn * tstep;
    PG8_STAGE(PG8_SB(0, 0), cB, voffB); PG8_STAGE(PG8_SB(0, 1), cB + hstep, voffB); PG8_STAGE(PG8_SA(0, 0), cA, voffA); PG8_STAGE(PG8_SA(0, 1), cA + hstep, voffA);
    if (wr == 1) PG8_BAR;
    PG8_WAIT_V(2); PG8_BAR;
    PG8_STAGE(PG8_SB(1, 0), cB + kstep, voffB); PG8_STAGE(PG8_SA(1, 0), cA + kstep, voffA); PG8_STAGE(PG8_SB(1, 1), cB + hstep + kstep, voffB);
    PG8_WAIT_V(6); PG8_BAR;
    for (;;) {
        const bool has_next = S.next(ui + 1, nxt);
        const char* nA = has_next ? (const char*)(nxt.seg ? g.A1 : g.A0) + (size_t)nxt.pm * tstep : cA; const char* nB = has_next ? (const char*)(nxt.seg ? g.B1 : g.B0) + (size_t)nxt.pn * tstep : cB;
        for (int t = 0; t < nt; t += 2) {
            const bool last = (t == nt - 2);
            const char* a1 = cA + (size_t)(t + 1) * kstep;
            const char* a2 = last ? nA : cA + (size_t)(t + 2) * kstep; const char* b2 = last ? nB : cB + (size_t)(t + 2) * kstep;
            const char* a3 = a2 + kstep; const char* b3 = b2 + kstep;
            PG8_LDB(B0, 0, 0); PG8_LDB(B1, 0, 1); PG8_SCHED; PG8_LDA(At, 0, 0); PG8_STAGE(PG8_SA(1, 1), a1 + hstep, voffA);
            PG8_WAIT_V(8); PG8_WAIT_L(0); PG8_BAR; PG8_MMA(0, 0, At, B0); PG8_MMA(0, 1, At, B1); PG8_BAR; PG8_SCHED;
            PG8_LDA(At, 0, 1); PG8_STAGE(PG8_SB(0, 0), b2, voffB); PG8_STAGE(PG8_SB(0, 1), b2 + hstep, voffB); PG8_STAGE(PG8_SA(0, 0), a2, voffA);
            PG8_WAIT_V(8); PG8_WAIT_L(0); PG8_BAR; PG8_MMA(1, 0, At, B0); PG8_MMA(1, 1, At, B1); PG8_BAR; PG8_SCHED;
            PG8_LDB(B0, 1, 0); PG8_LDB(B1, 1, 1); PG8_SCHED; PG8_LDA(At, 1, 0); PG8_STAGE(PG8_SA(0, 1), a2 + hstep, voffA);
            PG8_WAIT_V(8); PG8_WAIT_L(0); PG8_BAR; PG8_MMA(0, 0, At, B0); PG8_MMA(0, 1, At, B1); PG8_BAR; PG8_SCHED;
            PG8_LDA(At, 1, 1); PG8_STAGE(PG8_SB(1, 0), b3, voffB); PG8_STAGE(PG8_SB(1, 1), b3 + hstep, voffB); PG8_STAGE(PG8_SA(1, 0), a3, voffA);
            PG8_WAIT_V(8); PG8_WAIT_L(0); PG8_BAR; PG8_MMA(1, 0, At, B0); PG8_MMA(1, 1, At, B1); PG8_BAR; PG8_SCHED;
        }
        if (wr == 0) PG8_BAR;
        const bool keep = E(acc, cur, wr, wc, fr, fq);
        if (!has_next) break;
        if (!keep) {
#pragma unroll
        for (int a = 0; a < 2; ++a)
#pragma unroll
            for (int b = 0; b < 2; ++b)
#pragma unroll
                for (int m = 0; m < 4; ++m)
#pragma unroll
                    for (int n = 0; n < 2; ++n) acc[a][b][m][n] = (f32x4){0.f, 0.f, 0.f, 0.f};
        }
        cur = nxt; cA = nA; cB = nB; ++ui;
        if (wr == 1) PG8_BAR;
    }
    PG8_WAIT_V(0);
    PG8_BAR;
#undef PG8_SA
#undef PG8_SB
#undef PG8_STAGE
#undef PG8_LDA
#undef PG8_LDB
#undef PG8_MMA
#undef PG8_WAIT_V
#undef PG8_WAIT_L
#undef PG8_BAR
#undef PG8_SCHED
}
}

constexpr int DM = 1024, NB = 16, SEQ = 4096, DECS = 16, NKV = 4, HD = 64, KVW = 256, INW = 5632, DFF = 2816;
constexpr int MP = NB * SEQ, MS = NB * DECS, MT = MP + MS;
constexpr float EPS = 1e-6f, LOG2E = 1.4426950408889634f, QSCALE = 0.125f * LOG2E;
constexpr size_t O_YP = 0, O_YS = (size_t)MP * DM, O_KP = O_YS + (size_t)MS * DM, O_VP = O_KP + 524288, O_KS = O_VP + 524288, O_VS = O_KS + 524288, O_GS = O_VS + 524288, O_END = O_GS + (size_t)MS * DM;

constexpr size_t MiB = 1u << 20;
constexpr size_t WS_CTL = 0, CTL_ZERO_BYTES = 1 * MiB;
constexpr size_t WS_WIN = 1 * MiB, WS_WFI = 12 * MiB, WS_WA = 23 * MiB, WS_WG = 25 * MiB, WS_WO = 27 * MiB, WS_WFO = 29 * MiB;
constexpr size_t WS_RSTD1 = 35 * MiB, WS_RSTD2 = 36 * MiB, WS_PMIX = 37 * MiB, WS_PF = 42 * MiB;
constexpr size_t ACTB = (size_t)MT * DM * 2;
constexpr size_t WS_R0 = 48 * MiB;
constexpr size_t WS_R1 = 177 * MiB;
constexpr size_t WS_R2 = 306 * MiB;
constexpr size_t WS_KB = 435 * MiB, WS_VB = 468 * MiB;
constexpr size_t WS_R3 = 501 * MiB;
constexpr size_t WS_SA = WS_R3, WS_SB = WS_R3 + ACTB, WS_U = WS_R3 + 2 * ACTB, WS_END = WS_R3 + 3 * ACTB;
static_assert(WS_END <= 1024 * MiB && (size_t)MT * DFF * 2 <= 3 * ACTB && WS_R0 + ACTB <= WS_R1 && WS_R1 + ACTB <= WS_R2 && WS_R2 + ACTB <= WS_KB, "d_ws map");
constexpr int CW_BAR = 4096;

constexpr int RING_BYTES = 131072, LDSCTL_OFF = RING_BYTES, MISC_OFF = LDSCTL_OFF + 320, LDS_BYTES = 147456;
constexpr int NWAVES = 8;

#define GAS __attribute__((address_space(1)))
#define LAS __attribute__((address_space(3)))
typedef unsigned short bf16;
typedef unsigned v4u __attribute__((ext_vector_type(4)));
typedef unsigned v2u __attribute__((ext_vector_type(2)));
typedef float f32x4 __attribute__((ext_vector_type(4)));
typedef GAS unsigned gu32;
#define RLX_AGENT __ATOMIC_RELAXED, __HIP_MEMORY_SCOPE_AGENT
#define LDS_WAIT() asm volatile("s_waitcnt lgkmcnt(0)" ::: "memory")
typedef float f32x2_t __attribute__((ext_vector_type(2))); typedef __bf16 bf16x2_t __attribute__((ext_vector_type(2)));
__device__ __forceinline__ unsigned pk2(float lo, float hi) { f32x2_t v = {lo, hi}; bf16x2_t b = __builtin_convertvector(v, bf16x2_t); return __builtin_bit_cast(unsigned, b); }
__device__ __forceinline__ float bflo(unsigned w) { return __uint_as_float(w << 16); }
__device__ __forceinline__ float bfhi(unsigned w) { return __uint_as_float(w & 0xffff0000u); }
__device__ __forceinline__ float wave_sum(float v) {
#pragma unroll
    for (int o = 1; o < 64; o <<= 1) v += __shfl_xor(v, o);
    return v;
}
__device__ __forceinline__ float gelu_tanh(float x) {
    const float e = __builtin_amdgcn_exp2f(x * (-2.302208198f - 0.10294324f * x * x));
    return x * __builtin_amdgcn_rcpf(1.0f + e);
}
__device__ __forceinline__ float sigmoidf_(float x) { return __builtin_amdgcn_rcpf(1.0f + __builtin_amdgcn_exp2f(-LOG2E * x)); }

#define XB_TMO      128
#define XB_XCNT(j)  (256  + 64 * (j))
#define XB_XSUB(j)  (1280 + 64 * (j))
#define XB_XGEN(j)  (2304 + 64 * (j))
#define XB_TOP      3328
#define XB_TOPGEN   3392
#define XCD_BAR_WORDS 3456
#define XB_SPIN_CAP (1u << 18)
__device__ __forceinline__ unsigned xb_ld(unsigned* p)              { return __hip_atomic_load(p, __ATOMIC_RELAXED, __HIP_MEMORY_SCOPE_AGENT); }
__device__ __forceinline__ unsigned xb_add(unsigned* p, unsigned v) { return __hip_atomic_fetch_add(p, v, __ATOMIC_RELAXED, __HIP_MEMORY_SCOPE_AGENT); }
__device__ __forceinline__ unsigned xb_xcc_id() { return (unsigned)__builtin_amdgcn_s_getreg((3 << 11) | 20) & 0xFu; }
#define XB_SPIN(cond, bar) do { unsigned _sp = 0; while (cond) { __builtin_amdgcn_s_sleep(1); \
    if ((++_sp & 255u) == 0u) { if (xb_ld(&(bar)[XB_TMO])) break; if (_sp > XB_SPIN_CAP) { atomicAdd(&(bar)[XB_TMO], 1u); break; } } } } while (0)
struct XcdBarrier { unsigned* bar; unsigned x; volatile LAS unsigned* st; };
__device__ __forceinline__ XcdBarrier xcd_barrier_post(unsigned* bar, volatile LAS unsigned* st) {
    XcdBarrier b; b.bar = bar; b.x = xb_xcc_id(); b.st = st;
    if (threadIdx.x == 0) (void)xb_add(&bar[XB_XCNT(b.x)], 1u);
    return b;
}
__device__ __forceinline__ void xcd_barrier_complete(unsigned* bar, unsigned x, unsigned& nloc, unsigned& nx) {
    const unsigned G = gridDim.x * gridDim.y * gridDim.z;
    unsigned sum, cnt, mine, sp = 0u;
    for (;;) {
        sum = 0u; cnt = 0u; mine = 0u;
#pragma unroll
        for (unsigned j = 0; j < 16; ++j) { const unsigned c = xb_ld(&bar[XB_XCNT(j)]); sum += c; cnt += (c > 0u) ? 1u : 0u; mine = (j == x) ? c : mine; }
        if (sum == G) break;
        __builtin_amdgcn_s_sleep(1);
        if ((++sp & 255u) == 0u) { if (xb_ld(&bar[XB_TMO])) break; if (sp > XB_SPIN_CAP) { atomicAdd(&bar[XB_TMO], 1u); break; } }
    }
    nloc = mine > 0u ? mine : 1u; nx = cnt > 0u ? cnt : 1u;
}
__device__ __forceinline__ void xcd_barrier(const XcdBarrier& b) {
    asm volatile("s_waitcnt vmcnt(0)" ::: "memory");
    __syncthreads();
    if (threadIdx.x == 0) {
        unsigned* bar = b.bar;
        __builtin_amdgcn_s_waitcnt(0);
        unsigned nloc = b.st[0], nx = b.st[1];
        if (nloc == 0u) { xcd_barrier_complete(bar, b.x, nloc, nx); b.st[0] = nloc; b.st[1] = nx; }
        const unsigned old = xb_add(&bar[XB_XSUB(b.x)], 1u);
        const unsigned gen = old / nloc;
        if (old + 1u == (gen + 1u) * nloc) {
            __builtin_amdgcn_fence(__ATOMIC_RELEASE, "agent");
            asm volatile("s_waitcnt vmcnt(0)" ::: "memory");
            const unsigned og = xb_add(&bar[XB_TOP], 1u);
            const unsigned tg = og / nx;
            if (og + 1u == (tg + 1u) * nx) xb_add(&bar[XB_TOPGEN], 1u);
            else XB_SPIN(xb_ld(&bar[XB_TOPGEN]) == tg, bar);
            __builtin_amdgcn_fence(__ATOMIC_ACQUIRE, "agent");
            xb_add(&bar[XB_XGEN(b.x)], 1u);
            asm volatile("s_waitcnt vmcnt(0)" ::: "memory");
        } else {
            XB_SPIN(xb_ld(&bar[XB_XGEN(b.x)]) == gen, bar);
            __builtin_amdgcn_fence(__ATOMIC_ACQUIRE, "agent");
            asm volatile("s_waitcnt vmcnt(0)" ::: "memory");
        }
    }
    __syncthreads();
}

using pg8::Unit;
struct EpiIn {
    static constexpr bool PERM = true;
    const float* rstd; bf16 *Q, *Kb, *Vb, *U, *GV, *SA, *SB; float* out;
    __device__ __forceinline__ bool operator()(f32x4 (&acc)[2][2][4][2], const Unit& u, int wr, int wc, int fr, int fq) const {
        const int pn = u.pn; int mode, ld, colt; bf16* dst; float* side = nullptr; size_t side_s = 0;
        if (pn < 4)       { mode = 0; dst = Q;  ld = DM;  colt = pn * 256; }
        else if (pn == 4) { mode = 1; dst = Kb; ld = KVW; colt = 0; side = out + O_KP; side_s = O_KS - O_KP; }
        else if (pn == 5) { mode = 1; dst = Vb; ld = KVW; colt = 0; side = out + O_VP; side_s = O_VS - O_VP; }
        else if (pn < 10) { mode = 2; dst = U;  ld = DM;  colt = (pn - 6) * 256; }
        else if (pn < 14) { mode = 2; dst = GV; ld = DM;  colt = (pn - 10) * 256; }
        else if (pn < 18) { mode = 3; dst = SA; ld = DM;  colt = (pn - 14) * 256; }
        else              { mode = 3; dst = SB; ld = DM;  colt = (pn - 18) * 256; }
        const int row0 = u.pm * 256 + wr * 64 + fr, col0 = colt + wc * 32 + 8 * fq;
#pragma unroll
        for (int ai = 0; ai < 2; ++ai)
#pragma unroll
            for (int m = 0; m < 4; ++m) {
                const int row = row0 + ai * 128 + m * 16; const float rs = rstd[row];
#pragma unroll
                for (int bj = 0; bj < 2; ++bj) {
                    float v[8];
#pragma unroll
                    for (int j = 0; j < 4; ++j) { v[j] = acc[ai][bj][m][0][j] * rs; v[4 + j] = acc[ai][bj][m][1][j] * rs; }
                    if (mode == 0) {
#pragma unroll
                        for (int j = 0; j < 8; ++j) v[j] *= QSCALE;
                    } else if (mode == 2) {
#pragma unroll
                        for (int j = 0; j < 8; ++j) v[j] = gelu_tanh(v[j]);
                    } else if (mode == 3) {
#pragma unroll
                        for (int j = 0; j < 8; ++j) v[j] = sigmoidf_(v[j]);
                    }
                    const int col = col0 + bj * 128;
                    v4u w; w.x = pk2(v[0], v[1]); w.y = pk2(v[2], v[3]); w.z = pk2(v[4], v[5]); w.w = pk2(v[6], v[7]);
                    *(v4u*)(dst + (size_t)row * ld + col) = w;
                    if (mode == 1) {
                        float* sp = nullptr;
                        if (u.pm == 256) { const int r = row - MP; sp = side + side_s + ((size_t)((r >> 4) * 128 + 112 + (r & 15)) * KVW + col); }
                        else if ((u.pm & 15) == 15 && ai == 1) { const int j = wr * 64 + m * 16 + fr; sp = side + ((size_t)((u.pm >> 4) * 128 + j) * KVW + col); }
                        if (sp) { *(f32x4*)sp = (f32x4){v[0], v[1], v[2], v[3]}; *(f32x4*)(sp + 4) = (f32x4){v[4], v[5], v[6], v[7]}; }
                    }
                }
            }
        return false;
    }
};
struct EpiMerge {
    static constexpr bool PERM = true;
    const bf16 *SA, *SB; bf16* O;
    __device__ __forceinline__ bool operator()(f32x4 (&acc)[2][2][4][2], const Unit& u, int wr, int wc, int fr, int fq) const {
        const int row0 = u.pm * 256 + wr * 64 + fr, col0 = u.pn * 256 + wc * 32 + 8 * fq;
#pragma unroll
        for (int ai = 0; ai < 2; ++ai)
#pragma unroll
            for (int m = 0; m < 4; ++m)
#pragma unroll
                for (int bj = 0; bj < 2; ++bj) {
                    const size_t off = (size_t)(row0 + ai * 128 + m * 16) * DM + col0 + bj * 128;
                    const v4u sbw = *(const v4u*)(SB + off);
                    float sb[8] = {bflo(sbw.x), bfhi(sbw.x), bflo(sbw.y), bfhi(sbw.y), bflo(sbw.z), bfhi(sbw.z), bflo(sbw.w), bfhi(sbw.w)};
#pragma unroll
                    for (int j = 0; j < 8; ++j) sb[j] = fmaxf(sb[j], 1e-30f);
                    if (u.seg == 0) {
                        const v4u saw = *(const v4u*)(SA + off);
                        const float sa[8] = {bflo(saw.x), bfhi(saw.x), bflo(saw.y), bfhi(saw.y), bflo(saw.z), bfhi(saw.z), bflo(saw.w), bfhi(saw.w)};
#pragma unroll
                        for (int j = 0; j < 4; ++j) { acc[ai][bj][m][0][j] *= sa[j] * __builtin_amdgcn_rcpf(sb[j]); acc[ai][bj][m][1][j] *= sa[4 + j] * __builtin_amdgcn_rcpf(sb[4 + j]); }
                    } else {
                        float v[8];
#pragma unroll
                        for (int j = 0; j < 4; ++j) { v[j] = acc[ai][bj][m][0][j] * sb[j]; v[4 + j] = acc[ai][bj][m][1][j] * sb[4 + j]; }
                        v4u w; w.x = pk2(v[0], v[1]); w.y = pk2(v[2], v[3]); w.z = pk2(v[4], v[5]); w.w = pk2(v[6], v[7]);
                        *(v4u*)(O + off) = w;
                    }
                }
        return u.seg == 0;
    }
};
struct EpiBf16Ss {
    static constexpr bool PERM = true;
    bf16* O; float* P;
    __device__ __forceinline__ bool operator()(f32x4 (&acc)[2][2][4][2], const Unit& u, int wr, int wc, int fr, int fq) const {
        const int row0 = u.pm * 256 + wr * 64 + fr, col0 = u.pn * 256 + wc * 32 + 8 * fq;
#pragma unroll
        for (int ai = 0; ai < 2; ++ai)
#pragma unroll
            for (int m = 0; m < 4; ++m) {
                const int row = row0 + ai * 128 + m * 16; float ss = 0.f;
#pragma unroll
                for (int bj = 0; bj < 2; ++bj) {
                    const f32x4 a = acc[ai][bj][m][0], b = acc[ai][bj][m][1];
                    ss += (a[0] * a[0] + a[1] * a[1]) + (a[2] * a[2] + a[3] * a[3]) + (b[0] * b[0] + b[1] * b[1]) + (b[2] * b[2] + b[3] * b[3]);
                    v4u w; w.x = pk2(a[0], a[1]); w.y = pk2(a[2], a[3]); w.z = pk2(b[0], b[1]); w.w = pk2(b[2], b[3]);
                    *(v4u*)(O + (size_t)row * DM + col0 + bj * 128) = w;
                }
                ss += __shfl_xor(ss, 16); ss += __shfl_xor(ss, 32);
                if (fq == 0) P[(size_t)(u.pn * 4 + wc) * MT + row] = ss;
            }
        return false;
    }
};
struct EpiSwiglu {
    static constexpr bool PERM = true;
    const float* rstd; bf16* O;
    __device__ __forceinline__ bool operator()(f32x4 (&acc)[2][2][4][2], const Unit& u, int wr, int wc, int fr, int fq) const {
        const int row0 = u.pm * 256 + wr * 64 + fr, col0 = u.pn * 128 + wc * 32 + 8 * fq;
#pragma unroll
        for (int ai = 0; ai < 2; ++ai)
#pragma unroll
            for (int m = 0; m < 4; ++m) {
                const int row = row0 + ai * 128 + m * 16; const float rs = rstd[row]; float v[8];
#pragma unroll
                for (int n = 0; n < 2; ++n)
#pragma unroll
                    for (int j = 0; j < 4; ++j) { const float gg = acc[ai][0][m][n][j] * rs, up = acc[ai][1][m][n][j] * rs; v[4 * n + j] = gg * sigmoidf_(gg) * up; }
                v4u w; w.x = pk2(v[0], v[1]); w.y = pk2(v[2], v[3]); w.z = pk2(v[4], v[5]); w.w = pk2(v[6], v[7]);
                *(v4u*)(O + (size_t)row * DFF + col0) = w;
            }
        return false;
    }
};

template <bool MAP>
__device__ __forceinline__ void p0_transpose_item(const float* W, int K, int N, const float* gain, bf16* WT, LAS float* scr, int item, int lane) {
    const int nblk = N / 32, kb = item / nblk, nb = item % nblk, k0 = 64 * kb, n0 = 32 * nb;
#pragma unroll 8
    for (int i = 0; i < 32; ++i) { const int kk = 2 * i + (lane >> 5); const float gk = gain ? gain[k0 + kk] : 1.0f; scr[kk * 33 + (lane & 31)] = W[(size_t)(k0 + kk) * N + n0 + (lane & 31)] * gk; }
    LDS_WAIT(); asm volatile("" ::: "memory");
    const int c = lane & 7;
#pragma unroll
    for (int j = 0; j < 4; ++j) { const int n = (lane >> 3) + 8 * j; const LAS float* s = scr + (8 * c) * 33 + n;
        v4u o; o.x = pk2(s[0 * 33], s[1 * 33]); o.y = pk2(s[2 * 33], s[3 * 33]); o.z = pk2(s[4 * 33], s[5 * 33]); o.w = pk2(s[6 * 33], s[7 * 33]);
        int nn = n0 + n;
        if (MAP) { const int hi = nn >= DFF ? 1 : 0, r = nn - hi * DFF; nn = 256 * (r >> 7) + 128 * hi + (r & 127); }
        *(GAS v4u*)(WT + (size_t)nn * K + k0 + 8 * c) = o; }
    LDS_WAIT(); asm volatile("" ::: "memory");
}

struct Args { const float* in[19]; float* out; unsigned char* ws; int ph_lo, ph_hi; };

__global__ void __launch_bounds__(NWAVES * 64, 2) fwd_kernel(Args args) {
    extern __shared__ __attribute__((aligned(16))) unsigned char lds_raw[];
    LAS unsigned char* lds = (LAS unsigned char*)lds_raw;
    volatile LAS unsigned* MISC = (volatile LAS unsigned*)(lds + MISC_OFF);
    const int tid = threadIdx.x, lane = tid & 63, wave = __builtin_amdgcn_readfirstlane(tid >> 6);
    const int G = gridDim.x;
    const int vcu = (G % 8 == 0) ? ((int)blockIdx.x % 8) * (G / 8) + (int)blockIdx.x / 8 : (int)blockIdx.x;
    unsigned char* ws = args.ws;
    const float* xp = args.in[0]; const float* xs = args.in[1]; const float* cache_k = args.in[2]; const float* cache_v = args.in[3];
    const float* g_pre_mix = args.in[4]; const float* g_post_mix = args.in[5]; const float* g_pre_ffn = args.in[6]; const float* g_post_ffn = args.in[7];
    const float* w_in = args.in[8]; const float* sinks = args.in[9]; const float* ln_g = args.in[10]; const float* ln_b = args.in[11];
    const float* w_s = args.in[12]; const float* b_s = args.in[13]; const float* w_ap = args.in[14]; const float* w_gp = args.in[15];
    const float* w_out = args.in[16]; const float* w_fi = args.in[17]; const float* w_fo = args.in[18];
    float* out = args.out;
    bf16* WinT = (bf16*)(ws + WS_WIN); bf16* WfiT = (bf16*)(ws + WS_WFI); bf16* WaT = (bf16*)(ws + WS_WA); bf16* WgT = (bf16*)(ws + WS_WG); bf16* WoT = (bf16*)(ws + WS_WO); bf16* WfoT = (bf16*)(ws + WS_WFO);
    float* RSTD1 = (float*)(ws + WS_RSTD1); float* RSTD2 = (float*)(ws + WS_RSTD2); float* PMIX = (float*)(ws + WS_PMIX); float* PF = (float*)(ws + WS_PF);
    bf16* XB = (bf16*)(ws + WS_R0); bf16* MERGED = XB; bf16* FB = XB;
    bf16* QB = (bf16*)(ws + WS_R1); bf16* X1B = QB;
    bf16* GV = (bf16*)(ws + WS_R2); bf16* MIX = GV;
    bf16* KB = (bf16*)(ws + WS_KB); bf16* VB = (bf16*)(ws + WS_VB);
    bf16* SA = (bf16*)(ws + WS_SA); bf16* SB = (bf16*)(ws + WS_SB); bf16* UB = (bf16*)(ws + WS_U); bf16* ACT = (bf16*)(ws + WS_R3);

    for (int u = tid; u < (LDS_BYTES - LDSCTL_OFF) / 4; u += NWAVES * 64) ((LAS unsigned*)(lds + LDSCTL_OFF))[u] = 0u;
    __syncthreads();
    XcdBarrier bar; bar.bar = (unsigned*)(ws + WS_CTL) + CW_BAR; bar.x = 0; bar.st = nullptr;
    if (MK_ONE_LAUNCH) bar = xcd_barrier_post((unsigned*)(ws + WS_CTL) + CW_BAR, MISC + 8);
    const int lo = args.ph_lo, hi = args.ph_hi;
#define IN(k) (lo <= (k) && (k) < hi)
#define SEAM(k) do { if (MK_ONE_LAUNCH && IN(k) && IN((k) + 1)) xcd_barrier(bar); } while (0)
    const int gw = vcu * NWAVES + wave, NGW = G * NWAVES;

    if (IN(0)) {
        LAS float* scr = (LAS float*)(lds + wave * 16384);
        constexpr int I_IN = (DM / 64) * (INW / 32), I_SQ = (DM / 64) * (DM / 32), I_FO = (DFF / 64) * (DM / 32);
        constexpr int NITEMS = 2 * I_IN + 3 * I_SQ + I_FO;
        for (int it = gw; it < NITEMS; it += NGW) {
            int r = it;
            if (r < I_IN) { p0_transpose_item<false>(w_in, DM, INW, g_pre_mix, WinT, scr, r, lane); continue; } r -= I_IN;
            if (r < I_IN) { p0_transpose_item<true>(w_fi, DM, INW, g_pre_ffn, WfiT, scr, r, lane); continue; } r -= I_IN;
            if (r < I_SQ) { p0_transpose_item<false>(w_ap, DM, DM, nullptr, WaT, scr, r, lane); continue; } r -= I_SQ;
            if (r < I_SQ) { p0_transpose_item<false>(w_gp, DM, DM, nullptr, WgT, scr, r, lane); continue; } r -= I_SQ;
            if (r < I_SQ) { p0_transpose_item<false>(w_out, DM, DM, nullptr, WoT, scr, r, lane); continue; } r -= I_SQ;
            p0_transpose_item<false>(w_fo, DFF, DM, nullptr, WfoT, scr, r, lane);
        }
        for (int m = gw; m < MT; m += NGW) {
            const float* xrow = (m < MP) ? xp + (size_t)m * DM : xs + (size_t)(m - MP) * DM;
            const GAS f32x4* xr = (const GAS f32x4*)xrow + lane;
            f32x4 v[4]; float s = 0.f;
#pragma unroll
            for (int j = 0; j < 4; ++j) { v[j] = xr[64 * j]; s += (v[j].x * v[j].x + v[j].y * v[j].y) + (v[j].z * v[j].z + v[j].w * v[j].w); }
            s = wave_sum(s);
            if (lane == 0) RSTD1[m] = 1.0f / sqrtf(s * (1.0f / DM) + EPS);
            GAS v2u* o8 = (GAS v2u*)(XB + (size_t)m * DM) + lane;
#pragma unroll
            for (int j = 0; j < 4; ++j) { v2u w; w.x = pk2(v[j].x, v[j].y); w.y = pk2(v[j].z, v[j].w); o8[64 * j] = w; }
        }
        for (int i = gw * 64 + lane; i < 2 * NB * 112 * 64; i += NGW * 64) {
            const int which = i / (NB * 112 * 64), r = i % (NB * 112 * 64), b = r / (112 * 64), q = r % (112 * 64);
            const float* src = (which ? cache_v : cache_k) + (size_t)b * 128 * KVW + 16 * KVW;
            float* dstp = out + (which ? O_VS : O_KS) + (size_t)b * 128 * KVW;
            ((f32x4*)dstp)[q] = ((const f32x4*)src)[q];
        }
    }
    SEAM(0);

    if (IN(1)) {
        pg8::Gemm g{XB, WinT, XB, WinT, MT, INW, DM}; pg8::StaticOrder S; S.init(MT, INW, G, (int)blockIdx.x, 1);
        EpiIn E{RSTD1, QB, KB, VB, UB, GV, SA, SB, out};
        pg8::gemm_phase<EpiIn, pg8::StaticOrder>(lds, g, S, E);
    }
    SEAM(1);

    if (IN(2)) {
        constexpr int ATT_UNITS = NB * 64 * NKV + NB * NKV;
        const int half = wave >> 2, ht = tid & 255;
        LAS bf16* Ks = (LAS bf16*)(lds + half * 49152); LAS bf16* Vs = Ks + 192 * 64;
        for (int up = blockIdx.x; up < ATT_UNITS / 2; up += G) {
            const int unit = 2 * up + half; const bool sample = unit >= NB * 64 * NKV;
            int b, c = 0, kvh, nk, first = 0;
            if (!sample) { b = unit >> 8; c = (unit >> 2) & 63; kvh = unit & 3; first = (c >= 2) ? (c - 2) * 64 : 0; nk = c * 64 + 64 - first; }
            else { const int su = unit - NB * 64 * NKV; b = su >> 2; kvh = su & 3; nk = 144; }
            for (int i = ht; i < nk * 8; i += 256) {
                const int key = i >> 3, ch = i & 7; v4u kw, vw;
                if (sample && key < 128) {
                    const size_t o = ((size_t)(b * 128 + key) * NKV + kvh) * HD + ch * 8;
                    const f32x4 k0 = *(const f32x4*)(cache_k + o), k1 = *(const f32x4*)(cache_k + o + 4), v0 = *(const f32x4*)(cache_v + o), v1 = *(const f32x4*)(cache_v + o + 4);
                    kw.x = pk2(k0.x, k0.y); kw.y = pk2(k0.z, k0.w); kw.z = pk2(k1.x, k1.y); kw.w = pk2(k1.z, k1.w);
                    vw.x = pk2(v0.x, v0.y); vw.y = pk2(v0.z, v0.w); vw.z = pk2(v1.x, v1.y); vw.w = pk2(v1.z, v1.w);
                } else {
                    const size_t row = sample ? (size_t)(MP + b * 16 + (key - 128)) : (size_t)(b * SEQ + first + key);
                    kw = *(const v4u*)(KB + row * KVW + kvh * HD + ch * 8); vw = *(const v4u*)(VB + row * KVW + kvh * HD + ch * 8);
                }
                *(LAS v4u*)(Ks + key * 64 + ch * 8) = kw; *(LAS v4u*)(Vs + key * 64 + ch * 8) = vw;
            }
            __syncthreads();
            const int gq = sample ? (ht >> 4) : (ht >> 6), pos = sample ? (ht & 15) : (ht & 63);
            if (gq < 4) {
                const size_t row = sample ? (size_t)(MP + b * 16 + pos) : (size_t)(b * SEQ + c * 64 + pos);
                const int head = kvh * 4 + gq;
                bf16* qp = QB + row * DM + head * HD;
                float q[64], o[64];
#pragma unroll
                for (int i = 0; i < 8; ++i) { const v4u w = *(const v4u*)(qp + i * 8);
                    q[8 * i + 0] = bflo(w.x); q[8 * i + 1] = bfhi(w.x); q[8 * i + 2] = bflo(w.y); q[8 * i + 3] = bfhi(w.y); q[8 * i + 4] = bflo(w.z); q[8 * i + 5] = bfhi(w.z); q[8 * i + 6] = bflo(w.w); q[8 * i + 7] = bfhi(w.w); }
#pragma unroll
                for (int i = 0; i < 64; ++i) o[i] = 0.f;
                float mx = sinks[head] * LOG2E, l = 1.0f;
                for (int key = 0; key < nk; ++key) {
                    float s = 0.f;
#pragma unroll
                    for (int i = 0; i < 8; ++i) { const v4u w = *(const LAS v4u*)(Ks + key * 64 + i * 8);
                        s += q[8 * i + 0] * bflo(w.x) + q[8 * i + 1] * bfhi(w.x) + q[8 * i + 2] * bflo(w.y) + q[8 * i + 3] * bfhi(w.y) + q[8 * i + 4] * bflo(w.z) + q[8 * i + 5] * bfhi(w.z) + q[8 * i + 6] * bflo(w.w) + q[8 * i + 7] * bfhi(w.w); }
                    const float mn = fmaxf(mx, s), sc = __builtin_amdgcn_exp2f(mx - mn), p = __builtin_amdgcn_exp2f(s - mn);
                    l = l * sc + p; mx = mn;
#pragma unroll
                    for (int i = 0; i < 8; ++i) { const v4u w = *(const LAS v4u*)(Vs + key * 64 + i * 8);
                        o[8 * i + 0] = o[8 * i + 0] * sc + p * bflo(w.x); o[8 * i + 1] = o[8 * i + 1] * sc + p * bfhi(w.x); o[8 * i + 2] = o[8 * i + 2] * sc + p * bflo(w.y); o[8 * i + 3] = o[8 * i + 3] * sc + p * bfhi(w.y);
                        o[8 * i + 4] = o[8 * i + 4] * sc + p * bflo(w.z); o[8 * i + 5] = o[8 * i + 5] * sc + p * bfhi(w.z); o[8 * i + 6] = o[8 * i + 6] * sc + p * bflo(w.w); o[8 * i + 7] = o[8 * i + 7] * sc + p * bfhi(w.w); }
                }
                const float inv = 1.0f / l;
#pragma unroll
                for (int i = 0; i < 8; ++i) { v4u w; w.x = pk2(o[8 * i] * inv, o[8 * i + 1] * inv); w.y = pk2(o[8 * i + 2] * inv, o[8 * i + 3] * inv); w.z = pk2(o[8 * i + 4] * inv, o[8 * i + 5] * inv); w.w = pk2(o[8 * i + 6] * inv, o[8 * i + 7] * inv);
                    *(v4u*)(qp + i * 8) = w; }
            }
            __syncthreads();
        }
        constexpr int G_UNITS = NB * 32 + NB;
        LAS float* stats = (LAS float*)lds; LAS bf16* tile = (LAS bf16*)(lds + 1024);
        for (int unit = blockIdx.x; unit < G_UNITS; unit += G) {
            const bool sample = unit >= NB * 32; const int L = sample ? 16 : 128;
            const size_t row0 = sample ? (size_t)(MP + (unit - NB * 32) * 16) : (size_t)unit * 128;
            for (int rr = 0; rr < 16; ++rr) { const int r = wave * 16 + rr;
                if (r < L) {
                    const bf16* gp = GV + (row0 + r) * DM + 8 * lane; const v4u w0 = *(const v4u*)gp, w1 = *(const v4u*)(gp + 512);
                    const float v[16] = {bflo(w0.x), bfhi(w0.x), bflo(w0.y), bfhi(w0.y), bflo(w0.z), bfhi(w0.z), bflo(w0.w), bfhi(w0.w), bflo(w1.x), bfhi(w1.x), bflo(w1.y), bfhi(w1.y), bflo(w1.z), bfhi(w1.z), bflo(w1.w), bfhi(w1.w)};
                    float s = 0.f;
#pragma unroll
                    for (int j = 0; j < 16; ++j) s += v[j];
                    const float mean = wave_sum(s) * (1.0f / DM); float q = 0.f;
#pragma unroll
                    for (int j = 0; j < 16; ++j) { const float d = v[j] - mean; q += d * d; }
                    const float rstd = 1.0f / sqrtf(wave_sum(q) * (1.0f / DM) + EPS);
                    if (lane == 0) { stats[2 * r] = mean; stats[2 * r + 1] = rstd; }
                }
            }
            __syncthreads();
            for (int g = 0; g < 4; ++g) {
                for (int i = 0; i < 8; ++i) { const int idx = tid + 512 * i, r = idx >> 5, ch = idx & 31, col = g * 256 + ch * 8; v4u w = {0u, 0u, 0u, 0u};
                    if (r < L) {
                        const v4u x = *(const v4u*)(GV + (row0 + r) * DM + col); const float mean = stats[2 * r], rstd = stats[2 * r + 1];
                        const f32x4 g0 = *(const f32x4*)(ln_g + col), g1 = *(const f32x4*)(ln_g + col + 4), b0 = *(const f32x4*)(ln_b + col), b1 = *(const f32x4*)(ln_b + col + 4);
                        float v[8] = {bflo(x.x), bfhi(x.x), bflo(x.y), bfhi(x.y), bflo(x.z), bfhi(x.z), bflo(x.w), bfhi(x.w)};
                        v[0] = (v[0] - mean) * rstd * g0.x + b0.x; v[1] = (v[1] - mean) * rstd * g0.y + b0.y; v[2] = (v[2] - mean) * rstd * g0.z + b0.z; v[3] = (v[3] - mean) * rstd * g0.w + b0.w;
                        v[4] = (v[4] - mean) * rstd * g1.x + b1.x; v[5] = (v[5] - mean) * rstd * g1.y + b1.y; v[6] = (v[6] - mean) * rstd * g1.z + b1.z; v[7] = (v[7] - mean) * rstd * g1.w + b1.w;
                        if (sample) { float* gs = out + O_GS + ((size_t)(unit - NB * 32) * 16 + r) * DM + col; *(f32x4*)gs = (f32x4){v[0], v[1], v[2], v[3]}; *(f32x4*)(gs + 4) = (f32x4){v[4], v[5], v[6], v[7]}; }
                        w.x = pk2(v[0], v[1]); w.y = pk2(v[2], v[3]); w.z = pk2(v[4], v[5]); w.w = pk2(v[6], v[7]);
                    }
                    *(LAS v4u*)(tile + r * 256 + ch * 8) = w; }
                __syncthreads();
                for (int i = 0; i < 16; ++i) { const int t = wave + 8 * i;
                    if (t < L) {
                        float a0 = 0.f, a1 = 0.f, a2 = 0.f, a3 = 0.f; const float* wrow = w_s + (size_t)(g * 128 + t) * 128;
                        for (int s = 0; s <= t; ++s) { const float w = wrow[s]; const v2u x = *(const LAS v2u*)(tile + s * 256 + 4 * lane);
                            a0 += w * bflo(x.x); a1 += w * bfhi(x.x); a2 += w * bflo(x.y); a3 += w * bfhi(x.y); }
                        const float bias = b_s[g * 128 + t];
                        bf16* up = UB + (row0 + t) * DM + g * 256 + 4 * lane; const v2u uw = *(const v2u*)up;
                        v2u o; o.x = pk2(bflo(uw.x) * (a0 + bias), bfhi(uw.x) * (a1 + bias)); o.y = pk2(bflo(uw.y) * (a2 + bias), bfhi(uw.y) * (a3 + bias));
                        *(v2u*)up = o;
                    }
                }
                __syncthreads();
            }
        }
    }
    SEAM(2);

    if (IN(3)) {
        pg8::Gemm g{QB, WaT, UB, WgT, MT, DM, DM}; pg8::StaticOrder S; S.init(MT, DM, G, (int)blockIdx.x, 2);
        EpiMerge E{SA, SB, MERGED};
        pg8::gemm_phase<EpiMerge, pg8::StaticOrder>(lds, g, S, E);
    }
    SEAM(3);

    if (IN(4)) {
        pg8::Gemm g{MERGED, WoT, MERGED, WoT, MT, DM, DM}; pg8::StaticOrder S; S.init(MT, DM, G, (int)blockIdx.x, 1);
        EpiBf16Ss E{MIX, PMIX};
        pg8::gemm_phase<EpiBf16Ss, pg8::StaticOrder>(lds, g, S, E);
    }
    SEAM(4);

    if (IN(5)) {
        for (int m = gw; m < MT; m += NGW) {
            const float* xrow = (m < MP) ? xp + (size_t)m * DM : xs + (size_t)(m - MP) * DM;
            float ps = PMIX[(size_t)(lane & 15) * MT + m]; ps += __shfl_xor(ps, 1); ps += __shfl_xor(ps, 2); ps += __shfl_xor(ps, 4); ps += __shfl_xor(ps, 8);
            const float rm = 1.0f / sqrtf(ps * (1.0f / DM) + EPS);
            f32x4 v[4]; float s = 0.f;
#pragma unroll
            for (int j = 0; j < 4; ++j) { const f32x4 xv = *((const GAS f32x4*)xrow + lane + 64 * j); const v2u mw = *((const GAS v2u*)(MIX + (size_t)m * DM) + lane + 64 * j); const f32x4 gv = *((const f32x4*)g_post_mix + lane + 64 * j);
                v[j].x = xv.x + bflo(mw.x) * rm * gv.x; v[j].y = xv.y + bfhi(mw.x) * rm * gv.y; v[j].z = xv.z + bflo(mw.y) * rm * gv.z; v[j].w = xv.w + bfhi(mw.y) * rm * gv.w;
                s += (v[j].x * v[j].x + v[j].y * v[j].y) + (v[j].z * v[j].z + v[j].w * v[j].w); }
            s = wave_sum(s);
            if (lane == 0) RSTD2[m] = 1.0f / sqrtf(s * (1.0f / DM) + EPS);
            GAS v2u* o8 = (GAS v2u*)(X1B + (size_t)m * DM) + lane;
#pragma unroll
            for (int j = 0; j < 4; ++j) { v2u w; w.x = pk2(v[j].x, v[j].y); w.y = pk2(v[j].z, v[j].w); o8[64 * j] = w; }
        }
    }
    SEAM(5);

    if (IN(6)) {
        pg8::Gemm g{X1B, WfiT, X1B, WfiT, MT, INW, DM}; pg8::StaticOrder S; S.init(MT, INW, G, (int)blockIdx.x, 1);
        EpiSwiglu E{RSTD2, ACT};
        pg8::gemm_phase<EpiSwiglu, pg8::StaticOrder>(lds, g, S, E);
    }
    SEAM(6);

    if (IN(7)) {
        pg8::Gemm g{ACT, WfoT, ACT, WfoT, MT, DM, DFF}; pg8::StaticOrder S; S.init(MT, DM, G, (int)blockIdx.x, 1);
        EpiBf16Ss E{FB, PF};
        pg8::gemm_phase<EpiBf16Ss, pg8::StaticOrder>(lds, g, S, E);
    }
    SEAM(7);

    if (IN(8)) {
        for (int m = gw; m < MT; m += NGW) {
            const float* xrow = (m < MP) ? xp + (size_t)m * DM : xs + (size_t)(m - MP) * DM;
            float* yrow = (m < MP) ? out + O_YP + (size_t)m * DM : out + O_YS + (size_t)(m - MP) * DM;
            float ps = PMIX[(size_t)(lane & 15) * MT + m]; ps += __shfl_xor(ps, 1); ps += __shfl_xor(ps, 2); ps += __shfl_xor(ps, 4); ps += __shfl_xor(ps, 8);
            float pf = PF[(size_t)(lane & 15) * MT + m]; pf += __shfl_xor(pf, 1); pf += __shfl_xor(pf, 2); pf += __shfl_xor(pf, 4); pf += __shfl_xor(pf, 8);
            const float rm = 1.0f / sqrtf(ps * (1.0f / DM) + EPS), rf = 1.0f / sqrtf(pf * (1.0f / DM) + EPS);
#pragma unroll
            for (int j = 0; j < 4; ++j) { const f32x4 xv = *((const GAS f32x4*)xrow + lane + 64 * j); const v2u mw = *((const GAS v2u*)(MIX + (size_t)m * DM) + lane + 64 * j); const v2u fw = *((const GAS v2u*)(FB + (size_t)m * DM) + lane + 64 * j);
                const f32x4 g1 = *((const f32x4*)g_post_mix + lane + 64 * j), g2 = *((const f32x4*)g_post_ffn + lane + 64 * j);
                f32x4 y; y.x = xv.x + bflo(mw.x) * rm * g1.x + bflo(fw.x) * rf * g2.x; y.y = xv.y + bfhi(mw.x) * rm * g1.y + bfhi(fw.x) * rf * g2.y;
                y.z = xv.z + bflo(mw.y) * rm * g1.z + bflo(fw.y) * rf * g2.z; y.w = xv.w + bfhi(mw.y) * rm * g1.w + bfhi(fw.y) * rf * g2.w;
                *((GAS f32x4*)yrow + lane + 64 * j) = y; }
        }
    }
#undef IN
#undef SEAM
}

constexpr int N_PHASES = 9;
extern "C" void kernel_launch(void* const* d_in, const int* in_sizes, int n_in, void* d_out, int out_size, void* d_ws, size_t ws_size, hipStream_t stream) {
    static int grid = 0;
    if (grid == 0) {
        if (n_in != 19 || (size_t)out_size != O_END || ws_size < WS_END) { fprintf(stderr, "kernel_launch: unexpected shapes: n_in %d out %d ws %zu (need %zu)\n", n_in, out_size, ws_size, (size_t)WS_END); grid = -1; return; }
        int dev = 0, cus = 0;
        if (hipGetDevice(&dev) != hipSuccess || hipDeviceGetAttribute(&cus, hipDeviceAttributeMultiprocessorCount, dev) != hipSuccess) { grid = -1; return; }
        if (hipFuncSetAttribute((const void*)fwd_kernel, hipFuncAttributeMaxDynamicSharedMemorySize, LDS_BYTES) != hipSuccess) { fprintf(stderr, "kernel_launch: hipFuncSetAttribute failed\n"); grid = -1; return; }
        int per_cu = 0;
        (void)hipOccupancyMaxActiveBlocksPerMultiprocessor(&per_cu, (const void*)fwd_kernel, NWAVES * 64, LDS_BYTES);
        (void)hipGetLastError();
        grid = cus;
    }
    if (grid < 0) return;
    (void)hipMemsetAsync((char*)d_ws + WS_CTL, 0, CTL_ZERO_BYTES, stream);
    Args a{};
    for (int i = 0; i < 19; ++i) a.in[i] = (const float*)d_in[i];
    a.out = (float*)d_out; a.ws = (unsigned char*)d_ws;
#if MK_ONE_LAUNCH
    a.ph_lo = 0; a.ph_hi = N_PHASES;
    hipLaunchKernelGGL(fwd_kernel, dim3(grid), dim3(NWAVES * 64), LDS_BYTES, stream, a);
#else
    for (int p = 0; p < N_PHASES; ++p) { a.ph_lo = p; a.ph_hi = p + 1; hipLaunchKernelGGL(fwd_kernel, dim3(grid), dim3(NWAVES * 64), LDS_BYTES, stream, a); }
#endif
}
```

```cpp
#include <hip/hip_runtime.h>
#include <cstdio>
#include <cstdint>

#ifndef MK_ONE_LAUNCH
#define MK_ONE_LAUNCH 1
#endif
#ifndef REP_MASK
#define REP_MASK 0
#endif
#define NREP(k) (((REP_MASK >> (k)) & 1) ? 2 : 1)

namespace pg8 {
#define PG8_LAS __attribute__((address_space(3)))
typedef unsigned short bf16_t;
typedef short bf16x8 __attribute__((ext_vector_type(8)));
typedef float f32x4 __attribute__((ext_vector_type(4)));
typedef unsigned u32x4 __attribute__((ext_vector_type(4)));
constexpr int BM = 256, BK = 64, HALF = 128, HTB = HALF * BK * 2  , STAGE_BYTES = 8 * HTB, NXCD = 8, WGM = 8;

__host__ __device__ __forceinline__ int lds_byte(int r, int c) { const int st = (r >> 4) * 2 + (c >> 5), rr = r & 15, cc = c & 31, ob = rr * 64 + cc * 2; return st * 1024 + (ob ^ (((ob >> 9) & 1) << 5)); }
__host__ __device__ __forceinline__ void stage_rc(int b, int& R, int& C) { const int st = b / 1024, sb = b % 1024, swz = sb ^ (((sb >> 9) & 1) << 5); R = (st >> 1) * 16 + swz / 64; C = (st & 1) * 32 + (swz % 64) / 2; }
__host__ __device__ __forceinline__ int perm32(int rho) { const int n = rho >> 4, i = rho & 15; return 8 * (i >> 2) + 4 * n + (i & 3); }

struct Unit { int pm, pn, seg; };
struct Gemm { const bf16_t* A0; const bf16_t* B0; const bf16_t* A1; const bf16_t* B1; int M, N, K; };

struct StaticOrder {
    int nM, nN, nwg, G, c, nseg;
    __host__ __device__ void init(int M, int N, int G_, int c_, int nseg_) { nM = M / BM; nN = N / BM; nwg = nM * nN; G = G_; c = c_; nseg = nseg_; }
    __host__ __device__ bool next(int i, Unit& u) const {
        const int ti = (nseg == 2) ? (i >> 1) : i; u.seg = (nseg == 2) ? (i & 1) : 0;
        const long L = (long)ti * G + c; if (L >= nwg) return false;
        int wgid = (int)L; { const int q = nwg / NXCD, r = nwg % NXCD, xcd = wgid % NXCD, off = wgid / NXCD; wgid = (xcd < r ? xcd * (q + 1) : r * (q + 1) + (xcd - r) * q) + off; }
        const int nig = WGM * nN, gid = wgid / nig, fm = gid * WGM, gsz = (nM - fm) < WGM ? (nM - fm) : WGM;
        u.pm = fm + ((wgid % nig) % gsz); u.pn = (wgid % nig) / gsz; return true;
    }
};

template <class Epi, class Sched>
__device__ __forceinline__ void gemm_phase(PG8_LAS unsigned char* lds, const Gemm g, const Sched& S, const Epi& E) {
    const int tid = threadIdx.x, wid = __builtin_amdgcn_readfirstlane(tid >> 6), lane = tid & 63, wr = wid >> 2, wc = wid & 3, fr = lane & 15, fq = lane >> 4;
    const int K = g.K, nt = K / BK;
    unsigned voffA[2], voffB[2];
#pragma unroll
    for (int i = 0; i < 2; ++i) { int R, C; stage_rc(tid * 16 + i * 8192, R, C); const int Rb = Epi::PERM ? ((R & ~31) + perm32(R & 31)) : R;
        voffA[i] = (unsigned)(R * K + C) * 2u; voffB[i] = (unsigned)(Rb * K + C) * 2u; }
    const size_t kstep = (size_t)(BK * 2);
    const size_t hstep = (size_t)HALF * K * 2;
    const size_t tstep = 2 * hstep;
    const unsigned ldsw = (unsigned)wid * 1024u;
    const int aoff = lds_byte(wr * 64 + fr, fq * 8), boff = lds_byte(wc * 32 + fr, fq * 8);
#define PG8_SA(b, h) (((b) * 2 + (h)) * HTB)
#define PG8_SB(b, h) ((4 + (b) * 2 + (h)) * HTB)
#define PG8_STAGE(bufoff, gbase, voff) do { _Pragma("unroll") for (int _i = 0; _i < 2; ++_i) \
        __builtin_amdgcn_global_load_lds((const unsigned*)((const char*)(gbase) + (voff)[_i]), (PG8_LAS unsigned*)(lds + (bufoff) + ldsw + _i * 8192), 16, 0, 0); } while (0)
#define PG8_LDA(dst, b, h) do { _Pragma("unroll") for (int m = 0; m < 4; ++m) _Pragma("unroll") for (int k = 0; k < 2; ++k) dst[m][k] = *(const PG8_LAS bf16x8*)(lds + PG8_SA(b, h) + aoff + m * 2048 + k * 1024); } while (0)
#define PG8_LDB(dst, b, h) do { _Pragma("unroll") for (int n = 0; n < 2; ++n) _Pragma("unroll") for (int k = 0; k < 2; ++k) dst[n][k] = *(const PG8_LAS bf16x8*)(lds + PG8_SB(b, h) + boff + n * 2048 + k * 1024); } while (0)
#define PG8_MMA(ai, bj, At, Bt) do { __builtin_amdgcn_s_setprio(1); _Pragma("unroll") for (int m = 0; m < 4; ++m) _Pragma("unroll") for (int n = 0; n < 2; ++n) _Pragma("unroll") for (int k = 0; k < 2; ++k) \
        acc[ai][bj][m][n] = __builtin_amdgcn_mfma_f32_16x16x32_bf16(Bt[n][k], At[m][k], acc[ai][bj][m][n], 0, 0, 0); __builtin_amdgcn_s_setprio(0); } while (0)
#define PG8_WAIT_V(n) asm volatile("s_waitcnt vmcnt(" #n ")" ::: "memory")
#define PG8_WAIT_L(n) asm volatile("s_waitcnt lgkmcnt(" #n ")" ::: "memory")
#define PG8_BAR __builtin_amdgcn_s_barrier()
#define PG8_SCHED __builtin_amdgcn_sched_barrier(0)
    Unit cur, nxt; int ui = 0;
    if (!S.next(0, cur)) return;
    f32x4 acc[2][2][4][2];
#pragma unroll
    for (int a = 0; a < 2; ++a)
#pragma unroll
        for (int b = 0; b < 2; ++b)
#pragma unroll
            for (int m = 0; m < 4; ++m)
#pragma unroll
                for (int n = 0; n < 2; ++n) acc[a][b][m][n] = (f32x4){0.f, 0.f, 0.f, 0.f};
    bf16x8 At[4][2], B0[2][2], B1[2][2];
    const char* cA = (const char*)(cur.seg ? g.A1 : g.A0) + (size_t)cur.pm * tstep; const char* cB = (const char*)(cur.seg ? g.B1 : g.B0) + (size_t)cur.pn * tstep;
    PG8_STAGE(PG8_SB(0, 0), cB, voffB); PG8_STAGE(PG8_SB(0, 1), cB + hstep, voffB); PG8_STAGE(PG8_SA(0, 0), cA, voffA); PG8_STAGE(PG8_SA(0, 1), cA + hstep, voffA);
    if (wr == 1) PG8_BAR;
    PG8_WAIT_V(2); PG8_BAR;
    PG8_STAGE(PG8_SB(1, 0), cB + kstep, voffB); PG8_STAGE(PG8_SA(1, 0), cA + kstep, voffA); PG8_STAGE(PG8_SB(1, 1), cB + hstep + kstep, voffB);
    PG8_WAIT_V(6); PG8_BAR;
    for (;;) {
        const bool has_next = S.next(ui + 1, nxt);
        const char* nA = has_next ? (const char*)(nxt.seg ? g.A1 : g.A0) + (size_t)nxt.pm * tstep : cA; const char* nB = has_next ? (const char*)(nxt.seg ? g.B1 : g.B0) + (size_t)nxt.pn * tstep : cB;
        for (int t = 0; t < nt; t += 2) {
            const bool last = (t == nt - 2);
            const char* a1 = cA + (size_t)(t + 1) * kstep;
            const char* a2 = last ? nA : cA + (size_t)(t + 2) * kstep; const char* b2 = last ? nB : cB + (size_t)(t + 2) * kstep;
            const char* a3 = a2 + kstep; const char* b3 = b2 + kstep;
            PG8_LDB(B0, 0, 0); PG8_LDB(B1, 0, 1); PG8_SCHED; PG8_LDA(At, 0, 0); PG8_STAGE(PG8_SA(1, 1), a1 + hstep, voffA);
            PG8_WAIT_V(8); PG8_WAIT_L(0); PG8_BAR; PG8_MMA(0, 0, At, B0); PG8_MMA(0, 1, At, B1); PG8_BAR; PG8_SCHED;
            PG8_LDA(At, 0, 1); PG8_STAGE(PG8_SB(0, 0), b2, voffB); PG8_STAGE(PG8_SB(0, 1), b2 + hstep, voffB); PG8_STAGE(PG8_SA(0, 0), a2, voffA);
            PG8_WAIT_V(8); PG8_WAIT_L(0); PG8_BAR; PG8_MMA(1, 0, At, B0); PG8_MMA(1, 1, At, B1); PG8_BAR; PG8_SCHED;
            PG8_LDB(B0, 1, 0); PG8_LDB(B1, 1, 1); PG8_SCHED; PG8_LDA(At, 1, 0); PG8_STAGE(PG8_SA(0, 1), a2 + hstep, voffA);
            PG8_WAIT_V(8); PG8_WAIT_L(0); PG8_BAR; PG8_MMA(0, 0, At, B0); PG8_MMA(0, 1, At, B1); PG8_BAR; PG8_SCHED;
            PG8_LDA(At, 1, 1); PG8_STAGE(PG8_SB(1, 0), b3, voffB); PG8_STAGE(PG8_SB(1, 1), b3 + hstep, voffB); PG8_STAGE(PG8_SA(1, 0), a3, voffA);
            PG8_WAIT_V(8); PG8_WAIT_L(0); PG8_BAR; PG8_MMA(1, 0, At, B0); PG8_MMA(1, 1, At, B1); PG8_BAR; PG8_SCHED;
        }
        if (wr == 0) PG8_BAR;
        const bool keep = E(acc, cur, wr, wc, fr, fq);
        if (!has_next) break;
        if (!keep) {
#pragma unroll
        for (int a = 0; a < 2; ++a)
#pragma unroll
            for (int b = 0; b < 2; ++b)
#pragma unroll
                for (int m = 0; m < 4; ++m)
#pragma unroll
                    for (int n = 0; n < 2; ++n) acc[a][b][m][n] = (f32x4){0.f, 0.f, 0.f, 0.f};
        }
        cur = nxt; cA = nA; cB = nB; ++ui;
        if (wr == 1) PG8_BAR;
    }
    PG8_WAIT_V(0);
    PG8_BAR;
#undef PG8_SA
#undef PG8_SB
#undef PG8_STAGE
#undef PG8_LDA
#undef PG8_LDB
#undef PG8_MMA
#undef PG8_WAIT_V
#undef PG8_WAIT_L
#undef PG8_BAR
#undef PG8_SCHED
}
}

constexpr int DM = 1024, NB = 16, SEQ = 4096, DECS = 16, NKV = 4, HD = 64, KVW = 256, INW = 5632, DFF = 2816;
constexpr int MP = NB * SEQ, MS = NB * DECS, MT = MP + MS;
constexpr float EPS = 1e-6f, LOG2E = 1.4426950408889634f, QSCALE = 0.125f * LOG2E;
constexpr size_t O_YP = 0, O_YS = (size_t)MP * DM, O_KP = O_YS + (size_t)MS * DM, O_VP = O_KP + 524288, O_KS = O_VP + 524288, O_VS = O_KS + 524288, O_GS = O_VS + 524288, O_END = O_GS + (size_t)MS * DM;

constexpr size_t MiB = 1u << 20;
constexpr size_t WS_CTL = 0, CTL_ZERO_BYTES = 1 * MiB;
constexpr size_t WS_WIN = 1 * MiB, WS_WFI = 12 * MiB, WS_WA = 23 * MiB, WS_WG = 25 * MiB, WS_WO = 27 * MiB, WS_WFO = 29 * MiB;
constexpr size_t WS_RSTD1 = 35 * MiB, WS_RSTD2 = 36 * MiB, WS_PMIX = 37 * MiB, WS_PF = 42 * MiB;
constexpr size_t ACTB = (size_t)MT * DM * 2;
constexpr size_t WS_R0 = 48 * MiB;
constexpr size_t WS_R1 = 177 * MiB;
constexpr size_t WS_R2 = 306 * MiB;
constexpr size_t WS_KB = 435 * MiB, WS_VB = 468 * MiB;
constexpr size_t WS_R3 = 501 * MiB;
constexpr size_t WS_SA = WS_R3, WS_SB = WS_R3 + ACTB, WS_U = WS_R3 + 2 * ACTB, WS_END = WS_R3 + 3 * ACTB;
static_assert(WS_END <= 1024 * MiB && (size_t)MT * DFF * 2 <= 3 * ACTB && WS_R0 + ACTB <= WS_R1 && WS_R1 + ACTB <= WS_R2 && WS_R2 + ACTB <= WS_KB, "d_ws map");
constexpr int CW_BAR = 4096;

constexpr int RING_BYTES = 131072, LDSCTL_OFF = RING_BYTES, MISC_OFF = LDSCTL_OFF + 320, LDS_BYTES = 147456;
constexpr int NWAVES = 8;

#define GAS __attribute__((address_space(1)))
#define LAS __attribute__((address_space(3)))
typedef unsigned short bf16;
typedef unsigned v4u __attribute__((ext_vector_type(4)));
typedef unsigned v2u __attribute__((ext_vector_type(2)));
typedef float f32x4 __attribute__((ext_vector_type(4)));
typedef GAS unsigned gu32;
#define RLX_AGENT __ATOMIC_RELAXED, __HIP_MEMORY_SCOPE_AGENT
#define LDS_WAIT() asm volatile("s_waitcnt lgkmcnt(0)" ::: "memory")
typedef float f32x2_t __attribute__((ext_vector_type(2))); typedef __bf16 bf16x2_t __attribute__((ext_vector_type(2)));
__device__ __forceinline__ unsigned pk2(float lo, float hi) { f32x2_t v = {lo, hi}; bf16x2_t b = __builtin_convertvector(v, bf16x2_t); return __builtin_bit_cast(unsigned, b); }
__device__ __forceinline__ float bflo(unsigned w) { return __uint_as_float(w << 16); }
__device__ __forceinline__ float bfhi(unsigned w) { return __uint_as_float(w & 0xffff0000u); }
__device__ __forceinline__ float wave_sum(float v) {
#pragma unroll
    for (int o = 1; o < 64; o <<= 1) v += __shfl_xor(v, o);
    return v;
}
__device__ __forceinline__ float gelu_tanh(float x) {
    const float e = __builtin_amdgcn_exp2f(x * (-2.302208198f - 0.10294324f * x * x));
    return x * __builtin_amdgcn_rcpf(1.0f + e);
}
__device__ __forceinline__ float sigmoidf_(float x) { return __builtin_amdgcn_rcpf(1.0f + __builtin_amdgcn_exp2f(-LOG2E * x)); }

#define XB_TMO      128
#define XB_XCNT(j)  (256  + 64 * (j))
#define XB_XSUB(j)  (1280 + 64 * (j))
#define XB_XGEN(j)  (2304 + 64 * (j))
#define XB_TOP      3328
#define XB_TOPGEN   3392
#define XCD_BAR_WORDS 3456
#define XB_SPIN_CAP (1u << 18)
__device__ __forceinline__ unsigned xb_ld(unsigned* p)              { return __hip_atomic_load(p, __ATOMIC_RELAXED, __HIP_MEMORY_SCOPE_AGENT); }
__device__ __forceinline__ unsigned xb_add(unsigned* p, unsigned v) { return __hip_atomic_fetch_add(p, v, __ATOMIC_RELAXED, __HIP_MEMORY_SCOPE_AGENT); }
__device__ __forceinline__ unsigned xb_xcc_id() { return (unsigned)__builtin_amdgcn_s_getreg((3 << 11) | 20) & 0xFu; }
#define XB_SPIN(cond, bar) do { unsigned _sp = 0; while (cond) { __builtin_amdgcn_s_sleep(1); \
    if ((++_sp & 255u) == 0u) { if (xb_ld(&(bar)[XB_TMO])) break; if (_sp > XB_SPIN_CAP) { atomicAdd(&(bar)[XB_TMO], 1u); break; } } } } while (0)
struct XcdBarrier { unsigned* bar; unsigned x; volatile LAS unsigned* st; };
__device__ __forceinline__ XcdBarrier xcd_barrier_post(unsigned* bar, volatile LAS unsigned* st) {
    XcdBarrier b; b.bar = bar; b.x = xb_xcc_id(); b.st = st;
    if (threadIdx.x == 0) (void)xb_add(&bar[XB_XCNT(b.x)], 1u);
    return b;
}
__device__ __forceinline__ void xcd_barrier_complete(unsigned* bar, unsigned x, unsigned& nloc, unsigned& nx) {
    const unsigned G = gridDim.x * gridDim.y * gridDim.z;
    unsigned sum, cnt, mine, sp = 0u;
    for (;;) {
        sum = 0u; cnt = 0u; mine = 0u;
#pragma unroll
        for (unsigned j = 0; j < 16; ++j) { const unsigned c = xb_ld(&bar[XB_XCNT(j)]); sum += c; cnt += (c > 0u) ? 1u : 0u; mine = (j == x) ? c : mine; }
        if (sum == G) break;
        __builtin_amdgcn_s_sleep(1);
        if ((++sp & 255u) == 0u) { if (xb_ld(&bar[XB_TMO])) break; if (sp > XB_SPIN_CAP) { atomicAdd(&bar[XB_TMO], 1u); break; } }
    }
    nloc = mine > 0u ? mine : 1u; nx = cnt > 0u ? cnt : 1u;
}
__device__ __forceinline__ void xcd_barrier(const XcdBarrier& b) {
    asm volatile("s_waitcnt vmcnt(0)" ::: "memory");
    __syncthreads();
    if (threadIdx.x == 0) {
        unsigned* bar = b.bar;
        __builtin_amdgcn_s_waitcnt(0);
        unsigned nloc = b.st[0], nx = b.st[1];
        if (nloc == 0u) { xcd_barrier_complete(bar, b.x, nloc, nx); b.st[0] = nloc; b.st[1] = nx; }
        const unsigned old = xb_add(&bar[XB_XSUB(b.x)], 1u);
        const unsigned gen = old / nloc;
        if (old + 1u == (gen + 1u) * nloc) {
            __builtin_amdgcn_fence(__ATOMIC_RELEASE, "agent");
            asm volatile("s_waitcnt vmcnt(0)" ::: "memory");
            const unsigned og = xb_add(&bar[XB_TOP], 1u);
            const unsigned tg = og / nx;
            if (og + 1u == (tg + 1u) * nx) xb_add(&bar[XB_TOPGEN], 1u);
            else XB_SPIN(xb_ld(&bar[XB_TOPGEN]) == tg, bar);
            __builtin_amdgcn_fence(__ATOMIC_ACQUIRE, "agent");
            xb_add(&bar[XB_XGEN(b.x)], 1u);
            asm volatile("s_waitcnt vmcnt(0)" ::: "memory");
        } else {
            XB_SPIN(xb_ld(&bar[XB_XGEN(b.x)]) == gen, bar);
            __builtin_amdgcn_fence(__ATOMIC_ACQUIRE, "agent");
            asm volatile("s_waitcnt vmcnt(0)" ::: "memory");
        }
    }
    __syncthreads();
}

using pg8::Unit;
struct EpiIn {
    static constexpr bool PERM = true;
    const float* rstd; bf16 *Q, *Kb, *Vb, *U, *GV, *SA, *SB; float* out;
    __device__ __forceinline__ bool operator()(f32x4 (&acc)[2][2][4][2], const Unit& u, int wr, int wc, int fr, int fq) const {
        const int pn = u.pn; int mode, ld, colt; bf16* dst; float* side = nullptr; size_t side_s = 0;
        if (pn < 4)       { mode = 0; dst = Q;  ld = DM;  colt = pn * 256; }
        else if (pn == 4) { mode = 1; dst = Kb; ld = KVW; colt = 0; side = out + O_KP; side_s = O_KS - O_KP; }
        else if (pn == 5) { mode = 1; dst = Vb; ld = KVW; colt = 0; side = out + O_VP; side_s = O_VS - O_VP; }
        else if (pn < 10) { mode = 2; dst = U;  ld = DM;  colt = (pn - 6) * 256; }
        else if (pn < 14) { mode = 2; dst = GV; ld = DM;  colt = (pn - 10) * 256; }
        else if (pn < 18) { mode = 3; dst = SA; ld = DM;  colt = (pn - 14) * 256; }
        else              { mode = 3; dst = SB; ld = DM;  colt = (pn - 18) * 256; }
        const int row0 = u.pm * 256 + wr * 64 + fr, col0 = colt + wc * 32 + 8 * fq;
#pragma unroll
        for (int ai = 0; ai < 2; ++ai)
#pragma unroll
            for (int m = 0; m < 4; ++m) {
                const int row = row0 + ai * 128 + m * 16; const float rs = rstd[row];
#pragma unroll
                for (int bj = 0; bj < 2; ++bj) {
                    float v[8];
#pragma unroll
                    for (int j = 0; j < 4; ++j) { v[j] = acc[ai][bj][m][0][j] * rs; v[4 + j] = acc[ai][bj][m][1][j] * rs; }
                    if (mode == 0) {
#pragma unroll
                        for (int j = 0; j < 8; ++j) v[j] *= QSCALE;
                    } else if (mode == 2) {
#pragma unroll
                        for (int j = 0; j < 8; ++j) v[j] = gelu_tanh(v[j]);
                    } else if (mode == 3) {
#pragma unroll
                        for (int j = 0; j < 8; ++j) v[j] = sigmoidf_(v[j]);
                    }
                    const int col = col0 + bj * 128;
                    v4u w; w.x = pk2(v[0], v[1]); w.y = pk2(v[2], v[3]); w.z = pk2(v[4], v[5]); w.w = pk2(v[6], v[7]);
                    *(v4u*)(dst + (size_t)row * ld + col) = w;
                    if (mode == 1) {
                        float* sp = nullptr;
                        if (u.pm == 256) { const int r = row - MP; sp = side + side_s + ((size_t)((r >> 4) * 128 + 112 + (r & 15)) * KVW + col); }
                        else if ((u.pm & 15) == 15 && ai == 1) { const int j = wr * 64 + m * 16 + fr; sp = side + ((size_t)((u.pm >> 4) * 128 + j) * KVW + col); }
                        if (sp) { *(f32x4*)sp = (f32x4){v[0], v[1], v[2], v[3]}; *(f32x4*)(sp + 4) = (f32x4){v[4], v[5], v[6], v[7]}; }
                    }
                }
            }
        return false;
    }
};
struct EpiMerge {
    static constexpr bool PERM = true;
    const bf16 *SA, *SB; bf16* O;
    __device__ __forceinline__ bool operator()(f32x4 (&acc)[2][2][4][2], const Unit& u, int wr, int wc, int fr, int fq) const {
        const int row0 = u.pm * 256 + wr * 64 + fr, col0 = u.pn * 256 + wc * 32 + 8 * fq;
#pragma unroll
        for (int ai = 0; ai < 2; ++ai)
#pragma unroll
            for (int m = 0; m < 4; ++m)
#pragma unroll
                for (int bj = 0; bj < 2; ++bj) {
                    const size_t off = (size_t)(row0 + ai * 128 + m * 16) * DM + col0 + bj * 128;
                    const v4u sbw = *(const v4u*)(SB + off);
                    float sb[8] = {bflo(sbw.x), bfhi(sbw.x), bflo(sbw.y), bfhi(sbw.y), bflo(sbw.z), bfhi(sbw.z), bflo(sbw.w), bfhi(sbw.w)};
#pragma unroll
                    for (int j = 0; j < 8; ++j) sb[j] = fmaxf(sb[j], 1e-30f);
                    if (u.seg == 0) {
                        const v4u saw = *(const v4u*)(SA + off);
                        const float sa[8] = {bflo(saw.x), bfhi(saw.x), bflo(saw.y), bfhi(saw.y), bflo(saw.z), bfhi(saw.z), bflo(saw.w), bfhi(saw.w)};
#pragma unroll
                        for (int j = 0; j < 4; ++j) { acc[ai][bj][m][0][j] *= sa[j] * __builtin_amdgcn_rcpf(sb[j]); acc[ai][bj][m][1][j] *= sa[4 + j] * __builtin_amdgcn_rcpf(sb[4 + j]); }
                    } else {
                        float v[8];
#pragma unroll
                        for (int j = 0; j < 4; ++j) { v[j] = acc[ai][bj][m][0][j] * sb[j]; v[4 + j] = acc[ai][bj][m][1][j] * sb[4 + j]; }
                        v4u w; w.x = pk2(v[0], v[1]); w.y = pk2(v[2], v[3]); w.z = pk2(v[4], v[5]); w.w = pk2(v[6], v[7]);
                        *(v4u*)(O + off) = w;
                    }
                }
        return u.seg == 0;
    }
};
struct EpiBf16Ss {
    static constexpr bool PERM = true;
    bf16* O; float* P;
    __device__ __forceinline__ bool operator()(f32x4 (&acc)[2][2][4][2], const Unit& u, int wr, int wc, int fr, int fq) const {
        const int row0 = u.pm * 256 + wr * 64 + fr, col0 = u.pn * 256 + wc * 32 + 8 * fq;
#pragma unroll
        for (int ai = 0; ai < 2; ++ai)
#pragma unroll
            for (int m = 0; m < 4; ++m) {
                const int row = row0 + ai * 128 + m * 16; float ss = 0.f;
#pragma unroll
                for (int bj = 0; bj < 2; ++bj) {
                    const f32x4 a = acc[ai][bj][m][0], b = acc[ai][bj][m][1];
                    ss += (a[0] * a[0] + a[1] * a[1]) + (a[2] * a[2] + a[3] * a[3]) + (b[0] * b[0] + b[1] * b[1]) + (b[2] * b[2] + b[3] * b[3]);
                    v4u w; w.x = pk2(a[0], a[1]); w.y = pk2(a[2], a[3]); w.z = pk2(b[0], b[1]); w.w = pk2(b[2], b[3]);
                    *(v4u*)(O + (size_t)row * DM + col0 + bj * 128) = w;
                }
                ss += __shfl_xor(ss, 16); ss += __shfl_xor(ss, 32);
                if (fq == 0) P[(size_t)(u.pn * 4 + wc) * MT + row] = ss;
            }
        return false;
    }
};
struct EpiSwiglu {
    static constexpr bool PERM = true;
    const float* rstd; bf16* O;
    __device__ __forceinline__ bool operator()(f32x4 (&acc)[2][2][4][2], const Unit& u, int wr, int wc, int fr, int fq) const {
        const int row0 = u.pm * 256 + wr * 64 + fr, col0 = u.pn * 128 + wc * 32 + 8 * fq;
#pragma unroll
        for (int ai = 0; ai < 2; ++ai)
#pragma unroll
            for (int m = 0; m < 4; ++m) {
                const int row = row0 + ai * 128 + m * 16; const float rs = rstd[row]; float v[8];
#pragma unroll
                for (int n = 0; n < 2; ++n)
#pragma unroll
                    for (int j = 0; j < 4; ++j) { const float gg = acc[ai][0][m][n][j] * rs, up = acc[ai][1][m][n][j] * rs; v[4 * n + j] = gg * sigmoidf_(gg) * up; }
                v4u w; w.x = pk2(v[0], v[1]); w.y = pk2(v[2], v[3]); w.z = pk2(v[4], v[5]); w.w = pk2(v[6], v[7]);
                *(v4u*)(O + (size_t)row * DFF + col0) = w;
            }
        return false;
    }
};

template <bool MAP>
__device__ __forceinline__ void p0_transpose_item(const float* W, int K, int N, const float* gain, bf16* WT, LAS float* scr, int item, int lane) {
    const int nblk = N / 32, kb = item / nblk, nb = item % nblk, k0 = 64 * kb, n0 = 32 * nb;
#pragma unroll 8
    for (int i = 0; i < 32; ++i) { const int kk = 2 * i + (lane >> 5); const float gk = gain ? gain[k0 + kk] : 1.0f; scr[kk * 33 + (lane & 31)] = W[(size_t)(k0 + kk) * N + n0 + (lane & 31)] * gk; }
    LDS_WAIT(); asm volatile("" ::: "memory");
    const int c = lane & 7;
#pragma unroll
    for (int j = 0; j < 4; ++j) { const int n = (lane >> 3) + 8 * j; const LAS float* s = scr + (8 * c) * 33 + n;
        v4u o; o.x = pk2(s[0 * 33], s[1 * 33]); o.y = pk2(s[2 * 33], s[3 * 33]); o.z = pk2(s[4 * 33], s[5 * 33]); o.w = pk2(s[6 * 33], s[7 * 33]);
        int nn = n0 + n;
        if (MAP) { const int hi = nn >= DFF ? 1 : 0, r = nn - hi * DFF; nn = 256 * (r >> 7) + 128 * hi + (r & 127); }
        *(GAS v4u*)(WT + (size_t)nn * K + k0 + 8 * c) = o; }
    LDS_WAIT(); asm volatile("" ::: "memory");
}

namespace att {
typedef short bf16x8 __attribute__((ext_vector_type(8)));
typedef short s16x4 __attribute__((ext_vector_type(4)));
typedef short v4i16_t __attribute__((ext_vector_type(4)));
typedef float f32x16 __attribute__((ext_vector_type(16)));
typedef LAS const char* lds_cptr;
constexpr int SLOT = 16384, OST = 4 * SLOT;
__device__ __forceinline__ int crow(int r, int hi) { return (r & 3) + 8 * (r >> 2) + 4 * hi; }
__device__ __forceinline__ s16x4 vtr(lds_cptr p) { return __builtin_bit_cast(s16x4, __builtin_amdgcn_ds_read_tr16_b64_v4i16((LAS v4i16_t*)p)); }
struct TileRegs { v4u k, v; };
__device__ __forceinline__ TileRegs load_tile(const bf16* KB, const bf16* VB, size_t rowbase, int kvh, int wid, int lane) {
    TileRegs t;
    t.k = *(const v4u*)(KB + (rowbase + lane) * KVW + kvh * HD + wid * 8);
    t.v = *(const v4u*)(VB + (rowbase + 16 * (wid & 3) + (lane >> 2)) * KVW + kvh * HD + (wid >> 2) * 32 + (lane & 3) * 8);
    return t;
}
__device__ __forceinline__ void store_tile(LAS unsigned char* slot, const TileRegs& t, int wid, int lane) {
    *(LAS v4u*)(slot + wid * 1024 + lane * 16) = t.k;
    *(LAS v4u*)(slot + 8192 + wid * 1024 + lane * 16) = t.v;
}
template <bool SAMPLE>
__device__ __forceinline__ void attn_unit(LAS unsigned char* lds, int s0, int s1, int s2, int ft, bf16* QO, size_t qrow0, int kvh, const float* sinks, int wid, int lane) {
    const int r32 = lane & 31, hi = lane >> 5, g = wid >> 1, posb = 32 * (wid & 1), head = kvh * 4 + g;
    const size_t qrow = SAMPLE ? qrow0 + ((posb + r32) & 15) : qrow0 + posb + r32;
    const bf16* qp = QO + qrow * DM + head * HD;
    bf16x8 qr[4];
#pragma unroll
    for (int d0 = 0; d0 < 4; ++d0) qr[d0] = *(const bf16x8*)(qp + d0 * 16 + hi * 8);
    const float sink2 = sinks[head] * LOG2E;
    f32x16 p[6];
#pragma unroll
    for (int ti = 0; ti < 3; ++ti) {
        if (ti >= ft) {
            const int so = (ti == 0) ? s0 : (ti == 1) ? s1 : s2;
            lds_cptr kb = (lds_cptr)lds + so + hi * 1024 + r32 * 16;
            f32x16 a = {}, c = {};
#pragma unroll
            for (int d0 = 0; d0 < 4; ++d0) {
                const bf16x8 b0 = *(const LAS bf16x8*)(kb + d0 * 2048), b1 = *(const LAS bf16x8*)(kb + d0 * 2048 + 512);
                a = __builtin_amdgcn_mfma_f32_32x32x16_bf16(b0, qr[d0], a, 0, 0, 0); c = __builtin_amdgcn_mfma_f32_32x32x16_bf16(b1, qr[d0], c, 0, 0, 0);
            }
            p[2 * ti] = a; p[2 * ti + 1] = c;
        } else {
#pragma unroll
            for (int r = 0; r < 16; ++r) { p[2 * ti][r] = -INFINITY; p[2 * ti + 1][r] = -INFINITY; }
        }
    }
    if (SAMPLE) {
#pragma unroll
        for (int r = 0; r < 16; ++r) { if (r >= 8) p[4][r] = -INFINITY; p[5][r] = -INFINITY; }
    }
    float mx = sink2;
#pragma unroll
    for (int kb = 0; kb < 6; ++kb)
#pragma unroll
        for (int r = 0; r < 16; ++r) mx = fmaxf(mx, p[kb][r]);
    { auto rr = __builtin_amdgcn_permlane32_swap(__float_as_uint(mx), __float_as_uint(mx), false, false); mx = fmaxf(__uint_as_float(rr[0]), __uint_as_float(rr[1])); }
    float sum = 0.f;
#pragma unroll
    for (int kb = 0; kb < 6; ++kb)
#pragma unroll
        for (int r = 0; r < 16; ++r) { p[kb][r] = __builtin_amdgcn_exp2f(p[kb][r] - mx); sum += p[kb][r]; }
    { auto rr = __builtin_amdgcn_permlane32_swap(__float_as_uint(sum), __float_as_uint(sum), false, false); sum = __uint_as_float(rr[0]) + __uint_as_float(rr[1]); }
    const float inv = 1.0f / (sum + __builtin_amdgcn_exp2f(sink2 - mx));
    f32x16 o0 = {}, o1 = {};
    const int vb = ((lane >> 4) & 1) * 32 + (lane & 3) * 8 + (4 * hi + ((lane & 15) >> 2)) * 64;
#pragma unroll
    for (int ti = 0; ti < 3; ++ti) {
        if (ti >= ft) {
            const int so = (ti == 0) ? s0 : (ti == 1) ? s1 : s2;
            lds_cptr vp = (lds_cptr)lds + so + 8192 + vb;
#pragma unroll
            for (int ks = 0; ks < 4; ++ks) {
                const int kb = 2 * ti + (ks >> 1), rb = 8 * (ks & 1);
                v4u pw; pw.x = pk2(p[kb][rb + 0] * inv, p[kb][rb + 1] * inv); pw.y = pk2(p[kb][rb + 2] * inv, p[kb][rb + 3] * inv); pw.z = pk2(p[kb][rb + 4] * inv, p[kb][rb + 5] * inv); pw.w = pk2(p[kb][rb + 6] * inv, p[kb][rb + 7] * inv);
                const bf16x8 pa = __builtin_bit_cast(bf16x8, pw);
                { const s16x4 lo = vtr(vp + ks * 1024), h4 = vtr(vp + ks * 1024 + 512); const bf16x8 vf = (bf16x8){lo[0], lo[1], lo[2], lo[3], h4[0], h4[1], h4[2], h4[3]};
                  o0 = __builtin_amdgcn_mfma_f32_32x32x16_bf16(pa, vf, o0, 0, 0, 0); }
                { const s16x4 lo = vtr(vp + 4096 + ks * 1024), h4 = vtr(vp + 4096 + ks * 1024 + 512); const bf16x8 vf = (bf16x8){lo[0], lo[1], lo[2], lo[3], h4[0], h4[1], h4[2], h4[3]};
                  o1 = __builtin_amdgcn_mfma_f32_32x32x16_bf16(pa, vf, o1, 0, 0, 0); }
            }
        }
    }
    LAS bf16* stg = (LAS bf16*)(lds + OST + wid * 4096);
#pragma unroll
    for (int r = 0; r < 16; ++r) { const int orow = crow(r, hi); stg[orow * 64 + r32] = (bf16)(pk2(o0[r], 0.f) & 0xffffu); stg[orow * 64 + 32 + r32] = (bf16)(pk2(o1[r], 0.f) & 0xffffu); }
    LDS_WAIT();
#pragma unroll
    for (int i = 0; i < 4; ++i) { const int row = i * 8 + (lane >> 3), ch = lane & 7; const v4u v = *(const LAS v4u*)(stg + row * 64 + ch * 8);
        if (!SAMPLE || posb + row < 16) *(v4u*)(QO + (qrow0 + posb + row) * DM + head * HD + ch * 8) = v; }
    LDS_WAIT();
}
}

struct Args { const float* in[19]; float* out; unsigned char* ws; int ph_lo, ph_hi; };

__global__ void __launch_bounds__(NWAVES * 64, 2) fwd_kernel(Args args) {
    extern __shared__ __attribute__((aligned(16))) unsigned char lds_raw[];
    LAS unsigned char* lds = (LAS unsigned char*)lds_raw;
    volatile LAS unsigned* MISC = (volatile LAS unsigned*)(lds + MISC_OFF);
    const int tid = threadIdx.x, lane = tid & 63, wave = __builtin_amdgcn_readfirstlane(tid >> 6);
    const int G = gridDim.x;
    const int vcu = (G % 8 == 0) ? ((int)blockIdx.x % 8) * (G / 8) + (int)blockIdx.x / 8 : (int)blockIdx.x;
    unsigned char* ws = args.ws;
    const float* xp = args.in[0]; const float* xs = args.in[1]; const float* cache_k = args.in[2]; const float* cache_v = args.in[3];
    const float* g_pre_mix = args.in[4]; const float* g_post_mix = args.in[5]; const float* g_pre_ffn = args.in[6]; const float* g_post_ffn = args.in[7];
    const float* w_in = args.in[8]; const float* sinks = args.in[9]; const float* ln_g = args.in[10]; const float* ln_b = args.in[11];
    const float* w_s = args.in[12]; const float* b_s = args.in[13]; const float* w_ap = args.in[14]; const float* w_gp = args.in[15];
    const float* w_out = args.in[16]; const float* w_fi = args.in[17]; const float* w_fo = args.in[18];
    float* out = args.out;
    bf16* WinT = (bf16*)(ws + WS_WIN); bf16* WfiT = (bf16*)(ws + WS_WFI); bf16* WaT = (bf16*)(ws + WS_WA); bf16* WgT = (bf16*)(ws + WS_WG); bf16* WoT = (bf16*)(ws + WS_WO); bf16* WfoT = (bf16*)(ws + WS_WFO);
    float* RSTD1 = (float*)(ws + WS_RSTD1); float* RSTD2 = (float*)(ws + WS_RSTD2); float* PMIX = (float*)(ws + WS_PMIX); float* PF = (float*)(ws + WS_PF);
    bf16* XB = (bf16*)(ws + WS_R0); bf16* MERGED = XB; bf16* FB = XB;
    bf16* QB = (bf16*)(ws + WS_R1); bf16* X1B = QB;
    bf16* GV = (bf16*)(ws + WS_R2); bf16* MIX = GV;
    bf16* KB = (bf16*)(ws + WS_KB); bf16* VB = (bf16*)(ws + WS_VB);
    bf16* SA = (bf16*)(ws + WS_SA); bf16* SB = (bf16*)(ws + WS_SB); bf16* UB = (bf16*)(ws + WS_U); bf16* ACT = (bf16*)(ws + WS_R3);

    for (int u = tid; u < (LDS_BYTES - LDSCTL_OFF) / 4; u += NWAVES * 64) ((LAS unsigned*)(lds + LDSCTL_OFF))[u] = 0u;
    __syncthreads();
    XcdBarrier bar; bar.bar = (unsigned*)(ws + WS_CTL) + CW_BAR; bar.x = 0; bar.st = nullptr;
    if (MK_ONE_LAUNCH) bar = xcd_barrier_post((unsigned*)(ws + WS_CTL) + CW_BAR, MISC + 8);
    const int lo = args.ph_lo, hi = args.ph_hi;
#define IN(k) (lo <= (k) && (k) < hi)
#define SEAM(k) do { if (MK_ONE_LAUNCH && IN(k) && IN((k) + 1)) xcd_barrier(bar); } while (0)
    const int gw = vcu * NWAVES + wave, NGW = G * NWAVES;

    if (IN(0)) for (int rep_ = 0; rep_ < NREP(0); ++rep_) {
        LAS float* scr = (LAS float*)(lds + wave * 16384);
        constexpr int I_IN = (DM / 64) * (INW / 32), I_SQ = (DM / 64) * (DM / 32), I_FO = (DFF / 64) * (DM / 32);
        constexpr int NITEMS = 2 * I_IN + 3 * I_SQ + I_FO;
        for (int it = gw; it < NITEMS; it += NGW) {
            int r = it;
            if (r < I_IN) { p0_transpose_item<false>(w_in, DM, INW, g_pre_mix, WinT, scr, r, lane); continue; } r -= I_IN;
            if (r < I_IN) { p0_transpose_item<true>(w_fi, DM, INW, g_pre_ffn, WfiT, scr, r, lane); continue; } r -= I_IN;
            if (r < I_SQ) { p0_transpose_item<false>(w_ap, DM, DM, nullptr, WaT, scr, r, lane); continue; } r -= I_SQ;
            if (r < I_SQ) { p0_transpose_item<false>(w_gp, DM, DM, nullptr, WgT, scr, r, lane); continue; } r -= I_SQ;
            if (r < I_SQ) { p0_transpose_item<false>(w_out, DM, DM, nullptr, WoT, scr, r, lane); continue; } r -= I_SQ;
            p0_transpose_item<false>(w_fo, DFF, DM, nullptr, WfoT, scr, r, lane);
        }
        for (int m = gw; m < MT; m += NGW) {
            const float* xrow = (m < MP) ? xp + (size_t)m * DM : xs + (size_t)(m - MP) * DM;
            const GAS f32x4* xr = (const GAS f32x4*)xrow + lane;
            f32x4 v[4]; float s = 0.f;
#pragma unroll
            for (int j = 0; j < 4; ++j) { v[j] = xr[64 * j]; s += (v[j].x * v[j].x + v[j].y * v[j].y) + (v[j].z * v[j].z + v[j].w * v[j].w); }
            s = wave_sum(s);
            if (lane == 0) RSTD1[m] = 1.0f / sqrtf(s * (1.0f / DM) + EPS);
            GAS v2u* o8 = (GAS v2u*)(XB + (size_t)m * DM) + lane;
#pragma unroll
            for (int j = 0; j < 4; ++j) { v2u w; w.x = pk2(v[j].x, v[j].y); w.y = pk2(v[j].z, v[j].w); o8[64 * j] = w; }
        }
        for (int i = gw * 64 + lane; i < 2 * NB * 112 * 64; i += NGW * 64) {
            const int which = i / (NB * 112 * 64), r = i % (NB * 112 * 64), b = r / (112 * 64), q = r % (112 * 64);
            const float* src = (which ? cache_v : cache_k) + (size_t)b * 128 * KVW + 16 * KVW;
            float* dstp = out + (which ? O_VS : O_KS) + (size_t)b * 128 * KVW;
            ((f32x4*)dstp)[q] = ((const f32x4*)src)[q];
        }
    }
    SEAM(0);

    if (IN(1)) for (int rep_ = 0; rep_ < NREP(1); ++rep_) {
        pg8::Gemm g{XB, WinT, XB, WinT, MT, INW, DM}; pg8::StaticOrder S; S.init(MT, INW, G, (int)blockIdx.x, 1);
        EpiIn E{RSTD1, QB, KB, VB, UB, GV, SA, SB, out};
        pg8::gemm_phase<EpiIn, pg8::StaticOrder>(lds, g, S, E);
    }
    SEAM(1);

    if (IN(2)) {
        for (int j = blockIdx.x; j < NB * NKV * 4; j += G) {
            const int b = j >> 4, kvh = (j >> 2) & 3, c0 = 16 * (j & 3); const size_t seqbase = (size_t)b * SEQ;
            __syncthreads();
            for (int T = (c0 >= 2 ? c0 - 2 : 0); T <= c0; ++T) { const att::TileRegs tr = att::load_tile(KB, VB, seqbase + 64 * T, kvh, wave, lane); att::store_tile(lds + (T & 3) * att::SLOT, tr, wave, lane); }
            __syncthreads();
            for (int c = c0; c < c0 + 16; ++c) {
                att::TileRegs nx; nx.k = (v4u){0u, 0u, 0u, 0u}; nx.v = nx.k; const bool pre = (c + 1 < c0 + 16);
                if (pre) nx = att::load_tile(KB, VB, seqbase + 64 * (c + 1), kvh, wave, lane);
                att::attn_unit<false>(lds, ((c + 2) & 3) * att::SLOT, ((c + 3) & 3) * att::SLOT, (c & 3) * att::SLOT, c >= 2 ? 0 : 2 - c, QB, seqbase + 64 * c, kvh, sinks, wave, lane);
                if (pre) att::store_tile(lds + ((c + 1) & 3) * att::SLOT, nx, wave, lane);
                __syncthreads();
            }
        }
        for (int j = blockIdx.x; j < NB * NKV; j += G) {
            const int b = j >> 2, kvh = j & 3;
            __syncthreads();
#pragma unroll
            for (int T = 0; T < 2; ++T) {
                att::TileRegs tr;
                { const size_t o = ((size_t)(b * 128 + 64 * T + lane) * NKV + kvh) * HD + wave * 8; const f32x4 k0 = *(const f32x4*)(cache_k + o), k1 = *(const f32x4*)(cache_k + o + 4);
                  tr.k.x = pk2(k0.x, k0.y); tr.k.y = pk2(k0.z, k0.w); tr.k.z = pk2(k1.x, k1.y); tr.k.w = pk2(k1.z, k1.w); }
                { const size_t o = ((size_t)(b * 128 + 64 * T + 16 * (wave & 3) + (lane >> 2)) * NKV + kvh) * HD + (wave >> 2) * 32 + (lane & 3) * 8; const f32x4 v0 = *(const f32x4*)(cache_v + o), v1 = *(const f32x4*)(cache_v + o + 4);
                  tr.v.x = pk2(v0.x, v0.y); tr.v.y = pk2(v0.z, v0.w); tr.v.z = pk2(v1.x, v1.y); tr.v.w = pk2(v1.z, v1.w); }
                att::store_tile(lds + T * att::SLOT, tr, wave, lane);
            }
            { att::TileRegs tr; tr.k = (v4u){0u, 0u, 0u, 0u}; tr.v = tr.k;
              if (lane < 16) tr.k = *(const v4u*)(KB + (size_t)(MP + b * 16 + lane) * KVW + kvh * HD + wave * 8);
              if ((wave & 3) == 0) tr.v = *(const v4u*)(VB + (size_t)(MP + b * 16 + (lane >> 2)) * KVW + kvh * HD + (wave >> 2) * 32 + (lane & 3) * 8);
              att::store_tile(lds + 2 * att::SLOT, tr, wave, lane); }
            __syncthreads();
            att::attn_unit<true>(lds, 0, att::SLOT, 2 * att::SLOT, 0, QB, (size_t)(MP + b * 16), kvh, sinks, wave, lane);
        }
        __syncthreads();
        constexpr int G_UNITS = NB * 32 + NB;
        LAS float* stats = (LAS float*)lds; LAS bf16* tile = (LAS bf16*)(lds + 1024);
        for (int unit = blockIdx.x; unit < G_UNITS; unit += G) {
            const bool sample = unit >= NB * 32; const int L = sample ? 16 : 128;
            const size_t row0 = sample ? (size_t)(MP + (unit - NB * 32) * 16) : (size_t)unit * 128;
            for (int rr = 0; rr < 16; ++rr) { const int r = wave * 16 + rr;
                if (r < L) {
                    const bf16* gp = GV + (row0 + r) * DM + 8 * lane; const v4u w0 = *(const v4u*)gp, w1 = *(const v4u*)(gp + 512);
                    const float v[16] = {bflo(w0.x), bfhi(w0.x), bflo(w0.y), bfhi(w0.y), bflo(w0.z), bfhi(w0.z), bflo(w0.w), bfhi(w0.w), bflo(w1.x), bfhi(w1.x), bflo(w1.y), bfhi(w1.y), bflo(w1.z), bfhi(w1.z), bflo(w1.w), bfhi(w1.w)};
                    float s = 0.f;
#pragma unroll
                    for (int j = 0; j < 16; ++j) s += v[j];
                    const float mean = wave_sum(s) * (1.0f / DM); float q = 0.f;
#pragma unroll
                    for (int j = 0; j < 16; ++j) { const float d = v[j] - mean; q += d * d; }
                    const float rstd = 1.0f / sqrtf(wave_sum(q) * (1.0f / DM) + EPS);
                    if (lane == 0) { stats[2 * r] = mean; stats[2 * r + 1] = rstd; }
                }
            }
            __syncthreads();
            for (int g = 0; g < 4; ++g) {
                for (int i = 0; i < 8; ++i) { const int idx = tid + 512 * i, r = idx >> 5, ch = idx & 31, col = g * 256 + ch * 8; v4u w = {0u, 0u, 0u, 0u};
                    if (r < L) {
                        const v4u x = *(const v4u*)(GV + (row0 + r) * DM + col); const float mean = stats[2 * r], rstd = stats[2 * r + 1];
                        const f32x4 g0 = *(const f32x4*)(ln_g + col), g1 = *(const f32x4*)(ln_g + col + 4), b0 = *(const f32x4*)(ln_b + col), b1 = *(const f32x4*)(ln_b + col + 4);
                        float v[8] = {bflo(x.x), bfhi(x.x), bflo(x.y), bfhi(x.y), bflo(x.z), bfhi(x.z), bflo(x.w), bfhi(x.w)};
                        v[0] = (v[0] - mean) * rstd * g0.x + b0.x; v[1] = (v[1] - mean) * rstd * g0.y + b0.y; v[2] = (v[2] - mean) * rstd * g0.z + b0.z; v[3] = (v[3] - mean) * rstd * g0.w + b0.w;
                        v[4] = (v[4] - mean) * rstd * g1.x + b1.x; v[5] = (v[5] - mean) * rstd * g1.y + b1.y; v[6] = (v[6] - mean) * rstd * g1.z + b1.z; v[7] = (v[7] - mean) * rstd * g1.w + b1.w;
                        if (sample) { float* gs = out + O_GS + ((size_t)(unit - NB * 32) * 16 + r) * DM + col; *(f32x4*)gs = (f32x4){v[0], v[1], v[2], v[3]}; *(f32x4*)(gs + 4) = (f32x4){v[4], v[5], v[6], v[7]}; }
                        w.x = pk2(v[0], v[1]); w.y = pk2(v[2], v[3]); w.z = pk2(v[4], v[5]); w.w = pk2(v[6], v[7]);
                    }
                    *(LAS v4u*)(tile + r * 256 + ch * 8) = w; }
                __syncthreads();
                for (int i = 0; i < 16; ++i) { const int t = wave + 8 * i;
                    if (t < L) {
                        float a0 = 0.f, a1 = 0.f, a2 = 0.f, a3 = 0.f; const float* wrow = w_s + (size_t)(g * 128 + t) * 128;
                        for (int s = 0; s <= t; ++s) { const float w = wrow[s]; const v2u x = *(const LAS v2u*)(tile + s * 256 + 4 * lane);
                            a0 += w * bflo(x.x); a1 += w * bfhi(x.x); a2 += w * bflo(x.y); a3 += w * bfhi(x.y); }
                        const float bias = b_s[g * 128 + t];
                        bf16* up = UB + (row0 + t) * DM + g * 256 + 4 * lane; const v2u uw = *(const v2u*)up;
                        v2u o; o.x = pk2(bflo(uw.x) * (a0 + bias), bfhi(uw.x) * (a1 + bias)); o.y = pk2(bflo(uw.y) * (a2 + bias), bfhi(uw.y) * (a3 + bias));
                        *(v2u*)up = o;
                    }
                }
                __syncthreads();
            }
        }
    }
    SEAM(2);

    if (IN(3)) for (int rep_ = 0; rep_ < NREP(3); ++rep_) {
        pg8::Gemm g{QB, WaT, UB, WgT, MT, DM, DM}; pg8::StaticOrder S; S.init(MT, DM, G, (int)blockIdx.x, 2);
        EpiMerge E{SA, SB, MERGED};
        pg8::gemm_phase<EpiMerge, pg8::StaticOrder>(lds, g, S, E);
    }
    SEAM(3);

    if (IN(4)) for (int rep_ = 0; rep_ < NREP(4); ++rep_) {
        pg8::Gemm g{MERGED, WoT, MERGED, WoT, MT, DM, DM}; pg8::StaticOrder S; S.init(MT, DM, G, (int)blockIdx.x, 1);
        EpiBf16Ss E{MIX, PMIX};
        pg8::gemm_phase<EpiBf16Ss, pg8::StaticOrder>(lds, g, S, E);
    }
    SEAM(4);

    if (IN(5)) for (int rep_ = 0; rep_ < NREP(5); ++rep_) {
        for (int m = gw; m < MT; m += NGW) {
            const float* xrow = (m < MP) ? xp + (size_t)m * DM : xs + (size_t)(m - MP) * DM;
            float ps = PMIX[(size_t)(lane & 15) * MT + m]; ps += __shfl_xor(ps, 1); ps += __shfl_xor(ps, 2); ps += __shfl_xor(ps, 4); ps += __shfl_xor(ps, 8);
            const float rm = 1.0f / sqrtf(ps * (1.0f / DM) + EPS);
            f32x4 v[4]; float s = 0.f;
#pragma unroll
            for (int j = 0; j < 4; ++j) { const f32x4 xv = *((const GAS f32x4*)xrow + lane + 64 * j); const v2u mw = *((const GAS v2u*)(MIX + (size_t)m * DM) + lane + 64 * j); const f32x4 gv = *((const f32x4*)g_post_mix + lane + 64 * j);
                v[j].x = xv.x + bflo(mw.x) * rm * gv.x; v[j].y = xv.y + bfhi(mw.x) * rm * gv.y; v[j].z = xv.z + bflo(mw.y) * rm * gv.z; v[j].w = xv.w + bfhi(mw.y) * rm * gv.w;
                s += (v[j].x * v[j].x + v[j].y * v[j].y) + (v[j].z * v[j].z + v[j].w * v[j].w); }
            s = wave_sum(s);
            if (lane == 0) RSTD2[m] = 1.0f / sqrtf(s * (1.0f / DM) + EPS);
            GAS v2u* o8 = (GAS v2u*)(X1B + (size_t)m * DM) + lane;
#pragma unroll
            for (int j = 0; j < 4; ++j) { v2u w; w.x = pk2(v[j].x, v[j].y); w.y = pk2(v[j].z, v[j].w); o8[64 * j] = w; }
        }
    }
    SEAM(5);

    if (IN(6)) for (int rep_ = 0; rep_ < NREP(6); ++rep_) {
        pg8::Gemm g{X1B, WfiT, X1B, WfiT, MT, INW, DM}; pg8::StaticOrder S; S.init(MT, INW, G, (int)blockIdx.x, 1);
        EpiSwiglu E{RSTD2, ACT};
        pg8::gemm_phase<EpiSwiglu, pg8::StaticOrder>(lds, g, S, E);
    }
    SEAM(6);

    if (IN(7)) for (int rep_ = 0; rep_ < NREP(7); ++rep_) {
        pg8::Gemm g{ACT, WfoT, ACT, WfoT, MT, DM, DFF}; pg8::StaticOrder S; S.init(MT, DM, G, (int)blockIdx.x, 1);
        EpiBf16Ss E{FB, PF};
        pg8::gemm_phase<EpiBf16Ss, pg8::StaticOrder>(lds, g, S, E);
    }
    SEAM(7);

    if (IN(8)) for (int rep_ = 0; rep_ < NREP(8); ++rep_) {
        for (int m = gw; m < MT; m += NGW) {
            const float* xrow = (m < MP) ? xp + (size_t)m * DM : xs + (size_t)(m - MP) * DM;
            float* yrow = (m < MP) ? out + O_YP + (size_t)m * DM : out + O_YS + (size_t)(m - MP) * DM;
            float ps = PMIX[(size_t)(lane & 15) * MT + m]; ps += __shfl_xor(ps, 1); ps += __shfl_xor(ps, 2); ps += __shfl_xor(ps, 4); ps += __shfl_xor(ps, 8);
            float pf = PF[(size_t)(lane & 15) * MT + m]; pf += __shfl_xor(pf, 1); pf += __shfl_xor(pf, 2); pf += __shfl_xor(pf, 4); pf += __shfl_xor(pf, 8);
            const float rm = 1.0f / sqrtf(ps * (1.0f / DM) + EPS), rf = 1.0f / sqrtf(pf * (1.0f / DM) + EPS);
#pragma unroll
            for (int j = 0; j < 4; ++j) { const f32x4 xv = *((const GAS f32x4*)xrow + lane + 64 * j); const v2u mw = *((const GAS v2u*)(MIX + (size_t)m * DM) + lane + 64 * j); const v2u fw = *((const GAS v2u*)(FB + (size_t)m * DM) + lane + 64 * j);
                const f32x4 g1 = *((const f32x4*)g_post_mix + lane + 64 * j), g2 = *((const f32x4*)g_post_ffn + lane + 64 * j);
                f32x4 y; y.x = xv.x + bflo(mw.x) * rm * g1.x + bflo(fw.x) * rf * g2.x; y.y = xv.y + bfhi(mw.x) * rm * g1.y + bfhi(fw.x) * rf * g2.y;
                y.z = xv.z + bflo(mw.y) * rm * g1.z + bflo(fw.y) * rf * g2.z; y.w = xv.w + bfhi(mw.y) * rm * g1.w + bfhi(fw.y) * rf * g2.w;
                *((GAS f32x4*)yrow + lane + 64 * j) = y; }
        }
    }
#undef IN
#undef SEAM
}

constexpr int N_PHASES = 9;
extern "C" void kernel_launch(void* const* d_in, const int* in_sizes, int n_in, void* d_out, int out_size, void* d_ws, size_t ws_size, hipStream_t stream) {
    static int grid = 0;
    if (grid == 0) {
        if (n_in != 19 || (size_t)out_size != O_END || ws_size < WS_END) { fprintf(stderr, "kernel_launch: unexpected shapes: n_in %d out %d ws %zu (need %zu)\n", n_in, out_size, ws_size, (size_t)WS_END); grid = -1; return; }
        int dev = 0, cus = 0;
        if (hipGetDevice(&dev) != hipSuccess || hipDeviceGetAttribute(&cus, hipDeviceAttributeMultiprocessorCount, dev) != hipSuccess) { grid = -1; return; }
        if (hipFuncSetAttribute((const void*)fwd_kernel, hipFuncAttributeMaxDynamicSharedMemorySize, LDS_BYTES) != hipSuccess) { fprintf(stderr, "kernel_launch: hipFuncSetAttribute failed\n"); grid = -1; return; }
        int per_cu = 0;
        (void)hipOccupancyMaxActiveBlocksPerMultiprocessor(&per_cu, (const void*)fwd_kernel, NWAVES * 64, LDS_BYTES);
        (void)hipGetLastError();
        grid = cus;
    }
    if (grid < 0) return;
    (void)hipMemsetAsync((char*)d_ws + WS_CTL, 0, CTL_ZERO_BYTES, stream);
    Args a{};
    for (int i = 0; i < 19; ++i) a.in[i] = (const float*)d_in[i];
    a.out = (float*)d_out; a.ws = (unsigned char*)d_ws;
#if MK_ONE_LAUNCH
    a.ph_lo = 0; a.ph_hi = N_PHASES;
    hipLaunchKernelGGL(fwd_kernel, dim3(grid), dim3(NWAVES * 64), LDS_BYTES, stream, a);
#else
    for (int p = 0; p < N_PHASES; ++p) { a.ph_lo = p; a.ph_hi = p + 1; hipLaunchKernelGGL(fwd_kernel, dim3(grid), dim3(NWAVES * 64), LDS_BYTES, stream, a); }
#endif
}
```

```cpp
#include <hip/hip_runtime.h>
#include <cstdio>
#include <cstdint>

#ifndef MK_ONE_LAUNCH
#define MK_ONE_LAUNCH 1
#endif
#ifndef REP_MASK
#define REP_MASK 0
#endif
#define NREP(k) (((REP_MASK >> (k)) & 1) ? 2 : 1)

namespace pg8 {
#define PG8_LAS __attribute__((address_space(3)))
typedef unsigned short bf16_t;
typedef short bf16x8 __attribute__((ext_vector_type(8)));
typedef float f32x4 __attribute__((ext_vector_type(4)));
typedef unsigned u32x4 __attribute__((ext_vector_type(4)));
constexpr int BM = 256, BK = 64, HALF = 128, HTB = HALF * BK * 2  , STAGE_BYTES = 8 * HTB, NXCD = 8, WGM = 8;

__host__ __device__ __forceinline__ int lds_byte(int r, int c) { const int st = (r >> 4) * 2 + (c >> 5), rr = r & 15, cc = c & 31, ob = rr * 64 + cc * 2; return st * 1024 + (ob ^ (((ob >> 9) & 1) << 5)); }
__host__ __device__ __forceinline__ void stage_rc(int b, int& R, int& C) { const int st = b / 1024, sb = b % 1024, swz = sb ^ (((sb >> 9) & 1) << 5); R = (st >> 1) * 16 + swz / 64; C = (st & 1) * 32 + (swz % 64) / 2; }
__host__ __device__ __forceinline__ int perm32(int rho) { const int n = rho >> 4, i = rho & 15; return 8 * (i >> 2) + 4 * n + (i & 3); }

struct Unit { int pm, pn, seg; };
struct Gemm { const bf16_t* A0; const bf16_t* B0; const bf16_t* A1; const bf16_t* B1; int M, N, K; };

struct StaticOrder {
    int nM, nN, nwg, G, c, nseg;
    __host__ __device__ void init(int M, int N, int G_, int c_, int nseg_) { nM = M / BM; nN = N / BM; nwg = nM * nN; G = G_; c = c_; nseg = nseg_; }
    __host__ __device__ bool next(int i, Unit& u) const {
        const int ti = (nseg == 2) ? (i >> 1) : i; u.seg = (nseg == 2) ? (i & 1) : 0;
        const long L = (long)ti * G + c; if (L >= nwg) return false;
        int wgid = (int)L; { const int q = nwg / NXCD, r = nwg % NXCD, xcd = wgid % NXCD, off = wgid / NXCD; wgid = (xcd < r ? xcd * (q + 1) : r * (q + 1) + (xcd - r) * q) + off; }
        const int nig = WGM * nN, gid = wgid / nig, fm = gid * WGM, gsz = (nM - fm) < WGM ? (nM - fm) : WGM;
        u.pm = fm + ((wgid % nig) % gsz); u.pn = (wgid % nig) / gsz; return true;
    }
};

template <class Epi, class Sched>
__device__ __forceinline__ void gemm_phase(PG8_LAS unsigned char* lds, const Gemm g, const Sched& S, const Epi& E) {
    const int tid = threadIdx.x, wid = __builtin_amdgcn_readfirstlane(tid >> 6), lane = tid & 63, wr = wid >> 2, wc = wid & 3, fr = lane & 15, fq = lane >> 4;
    const int K = g.K, nt = K / BK;
    unsigned voffA[2], voffB[2];
#pragma unroll
    for (int i = 0; i < 2; ++i) { int R, C; stage_rc(tid * 16 + i * 8192, R, C); const int Rb = Epi::PERM ? ((R & ~31) + perm32(R & 31)) : R;
        voffA[i] = (unsigned)(R * K + C) * 2u; voffB[i] = (unsigned)(Rb * K + C) * 2u; }
    const size_t kstep = (size_t)(BK * 2);
    const size_t hstep = (size_t)HALF * K * 2;
    const size_t tstep = 2 * hstep;
    const unsigned ldsw = (unsigned)wid * 1024u;
    const int aoff = lds_byte(wr * 64 + fr, fq * 8), boff = lds_byte(wc * 32 + fr, fq * 8);
#define PG8_SA(b, h) (((b) * 2 + (h)) * HTB)
#define PG8_SB(b, h) ((4 + (b) * 2 + (h)) * HTB)
#define PG8_STAGE(bufoff, gbase, voff) do { _Pragma("unroll") for (int _i = 0; _i < 2; ++_i) \
        __builtin_amdgcn_global_load_lds((const unsigned*)((const char*)(gbase) + (voff)[_i]), (PG8_LAS unsigned*)(lds + (bufoff) + ldsw + _i * 8192), 16, 0, 0); } while (0)
#define PG8_LDA(dst, b, h) do { _Pragma("unroll") for (int m = 0; m < 4; ++m) _Pragma("unroll") for (int k = 0; k < 2; ++k) dst[m][k] = *(const PG8_LAS bf16x8*)(lds + PG8_SA(b, h) + aoff + m * 2048 + k * 1024); } while (0)
#define PG8_LDB(dst, b, h) do { _Pragma("unroll") for (int n = 0; n < 2; ++n) _Pragma("unroll") for (int k = 0; k < 2; ++k) dst[n][k] = *(const PG8_LAS bf16x8*)(lds + PG8_SB(b, h) + boff + n * 2048 + k * 1024); } while (0)
#define PG8_MMA(ai, bj, At, Bt) do { __builtin_amdgcn_s_setprio(1); _Pragma("unroll") for (int m = 0; m < 4; ++m) _Pragma("unroll") for (int n = 0; n < 2; ++n) _Pragma("unroll") for (int k = 0; k < 2; ++k) \
        acc[ai][bj][m][n] = __builtin_amdgcn_mfma_f32_16x16x32_bf16(Bt[n][k], At[m][k], acc[ai][bj][m][n], 0, 0, 0); __builtin_amdgcn_s_setprio(0); } while (0)
#define PG8_WAIT_V(n) asm volatile("s_waitcnt vmcnt(" #n ")" ::: "memory")
#define PG8_WAIT_L(n) asm volatile("s_waitcnt lgkmcnt(" #n ")" ::: "memory")
#define PG8_BAR __builtin_amdgcn_s_barrier()
#define PG8_SCHED __builtin_amdgcn_sched_barrier(0)
    Unit cur, nxt; int ui = 0;
    if (!S.next(0, cur)) return;
    f32x4 acc[2][2][4][2];
#pragma unroll
    for (int a = 0; a < 2; ++a)
#pragma unroll
        for (int b = 0; b < 2; ++b)
#pragma unroll
            for (int m = 0; m < 4; ++m)
#pragma unroll
                for (int n = 0; n < 2; ++n) acc[a][b][m][n] = (f32x4){0.f, 0.f, 0.f, 0.f};
    bf16x8 At[4][2], B0[2][2], B1[2][2];
    const char* cA = (const char*)(cur.seg ? g.A1 : g.A0) + (size_t)cur.pm * tstep; const char* cB = (const char*)(cur.seg ? g.B1 : g.B0) + (size_t)cur.pn * tstep;
    PG8_STAGE(PG8_SB(0, 0), cB, voffB); PG8_STAGE(PG8_SB(0, 1), cB + hstep, voffB); PG8_STAGE(PG8_SA(0, 0), cA, voffA); PG8_STAGE(PG8_SA(0, 1), cA + hstep, voffA);
    if (wr == 1) PG8_BAR;
    PG8_WAIT_V(2); PG8_BAR;
    PG8_STAGE(PG8_SB(1, 0), cB + kstep, voffB); PG8_STAGE(PG8_SA(1, 0), cA + kstep, voffA); PG8_STAGE(PG8_SB(1, 1), cB + hstep + kstep, voffB);
    PG8_WAIT_V(6); PG8_BAR;
    for (;;) {
        const bool has_next = S.next(ui + 1, nxt);
        const char* nA = has_next ? (const char*)(nxt.seg ? g.A1 : g.A0) + (size_t)nxt.pm * tstep : cA; const char* nB = has_next ? (const char*)(nxt.seg ? g.B1 : g.B0) + (size_t)nxt.pn * tstep : cB;
        for (int t = 0; t < nt; t += 2) {
            const bool last = (t == nt - 2);
            const char* a1 = cA + (size_t)(t + 1) * kstep;
            const char* a2 = last ? nA : cA + (size_t)(t + 2) * kstep; const char* b2 = last ? nB : cB + (size_t)(t + 2) * kstep;
            const char* a3 = a2 + kstep; const char* b3 = b2 + kstep;
            PG8_LDB(B0, 0, 0); PG8_LDB(B1, 0, 1); PG8_SCHED; PG8_LDA(At, 0, 0); PG8_STAGE(PG8_SA(1, 1), a1 + hstep, voffA);
            PG8_WAIT_V(8); PG8_WAIT_L(0); PG8_BAR; PG8_MMA(0, 0, At, B0); PG8_MMA(0, 1, At, B1); PG8_BAR; PG8_SCHED;
            PG8_LDA(At, 0, 1); PG8_STAGE(PG8_SB(0, 0), b2, voffB); PG8_STAGE(PG8_SB(0, 1), b2 + hstep, voffB); PG8_STAGE(PG8_SA(0, 0), a2, voffA);
            PG8_WAIT_V(8); PG8_WAIT_L(0); PG8_BAR; PG8_MMA(1, 0, At, B0); PG8_MMA(1, 1, At, B1); PG8_BAR; PG8_SCHED;
            PG8_LDB(B0, 1, 0); PG8_LDB(B1, 1, 1); PG8_SCHED; PG8_LDA(At, 1, 0); PG8_STAGE(PG8_SA(0, 1), a2 + hstep, voffA);
            PG8_WAIT_V(8); PG8_WAIT_L(0); PG8_BAR; PG8_MMA(0, 0, At, B0); PG8_MMA(0, 1, At, B1); PG8_BAR; PG8_SCHED;
            PG8_LDA(At, 1, 1); PG8_STAGE(PG8_SB(1, 0), b3, voffB); PG8_STAGE(PG8_SB(1, 1), b3 + hstep, voffB); PG8_STAGE(PG8_SA(1, 0), a3, voffA);
            PG8_WAIT_V(8); PG8_WAIT_L(0); PG8_BAR; PG8_MMA(1, 0, At, B0); PG8_MMA(1, 1, At, B1); PG8_BAR; PG8_SCHED;
        }
        if (wr == 0) PG8_BAR;
        const bool keep = E(acc, cur, wr, wc, fr, fq);
        if (!has_next) break;
        if (!keep) {
#pragma unroll
        for (int a = 0; a < 2; ++a)
#pragma unroll
            for (int b = 0; b < 2; ++b)
#pragma unroll
                for (int m = 0; m < 4; ++m)
#pragma unroll
                    for (int n = 0; n < 2; ++n) acc[a][b][m][n] = (f32x4){0.f, 0.f, 0.f, 0.f};
        }
        cur = nxt; cA = nA; cB = nB; ++ui;
        if (wr == 1) PG8_BAR;
    }
    PG8_WAIT_V(0);
    PG8_BAR;
#undef PG8_SA
#undef PG8_SB
#undef PG8_STAGE
#undef PG8_LDA
#undef PG8_LDB
#undef PG8_MMA
#undef PG8_WAIT_V
#undef PG8_WAIT_L
#undef PG8_BAR
#undef PG8_SCHED
}
}

constexpr int DM = 1024, NB = 16, SEQ = 4096, DECS = 16, NKV = 4, HD = 64, KVW = 256, INW = 5632, DFF = 2816;
constexpr int MP = NB * SEQ, MS = NB * DECS, MT = MP + MS;
constexpr float EPS = 1e-6f, LOG2E = 1.4426950408889634f, QSCALE = 0.125f * LOG2E;
constexpr size_t O_YP = 0, O_YS = (size_t)MP * DM, O_KP = O_YS + (size_t)MS * DM, O_VP = O_KP + 524288, O_KS = O_VP + 524288, O_VS = O_KS + 524288, O_GS = O_VS + 524288, O_END = O_GS + (size_t)MS * DM;

constexpr size_t MiB = 1u << 20;
constexpr size_t WS_CTL = 0, CTL_ZERO_BYTES = 1 * MiB;
constexpr size_t WS_WIN = 1 * MiB, WS_WFI = 12 * MiB, WS_WA = 23 * MiB, WS_WG = 25 * MiB, WS_WO = 27 * MiB, WS_WFO = 29 * MiB;
constexpr size_t WS_WSB = 34 * MiB + 512 * 1024;
constexpr size_t WS_RSTD1 = 35 * MiB, WS_RSTD2 = 36 * MiB, WS_PMIX = 37 * MiB, WS_PF = 42 * MiB;
constexpr size_t ACTB = (size_t)MT * DM * 2;
constexpr size_t WS_R0 = 48 * MiB;
constexpr size_t WS_R1 = 177 * MiB;
constexpr size_t WS_R2 = 306 * MiB;
constexpr size_t WS_KB = 435 * MiB, WS_VB = 468 * MiB;
constexpr size_t WS_R3 = 501 * MiB;
constexpr size_t WS_SA = WS_R3, WS_SB = WS_R3 + ACTB, WS_U = WS_R3 + 2 * ACTB, WS_END = WS_R3 + 3 * ACTB;
static_assert(WS_END <= 1024 * MiB && (size_t)MT * DFF * 2 <= 3 * ACTB && WS_R0 + ACTB <= WS_R1 && WS_R1 + ACTB <= WS_R2 && WS_R2 + ACTB <= WS_KB, "d_ws map");
constexpr int CW_BAR = 4096;

constexpr int RING_BYTES = 131072, LDSCTL_OFF = RING_BYTES, MISC_OFF = LDSCTL_OFF + 320, LDS_BYTES = 147456;
constexpr int NWAVES = 8;

#define GAS __attribute__((address_space(1)))
#define LAS __attribute__((address_space(3)))
typedef unsigned short bf16;
typedef unsigned v4u __attribute__((ext_vector_type(4)));
typedef unsigned v2u __attribute__((ext_vector_type(2)));
typedef float f32x4 __attribute__((ext_vector_type(4)));
typedef GAS unsigned gu32;
#define RLX_AGENT __ATOMIC_RELAXED, __HIP_MEMORY_SCOPE_AGENT
#define LDS_WAIT() asm volatile("s_waitcnt lgkmcnt(0)" ::: "memory")
typedef float f32x2_t __attribute__((ext_vector_type(2))); typedef __bf16 bf16x2_t __attribute__((ext_vector_type(2)));
__device__ __forceinline__ unsigned pk2(float lo, float hi) { f32x2_t v = {lo, hi}; bf16x2_t b = __builtin_convertvector(v, bf16x2_t); return __builtin_bit_cast(unsigned, b); }
__device__ __forceinline__ float bflo(unsigned w) { return __uint_as_float(w << 16); }
__device__ __forceinline__ float bfhi(unsigned w) { return __uint_as_float(w & 0xffff0000u); }
__device__ __forceinline__ float wave_sum(float v) {
#pragma unroll
    for (int o = 1; o < 64; o <<= 1) v += __shfl_xor(v, o);
    return v;
}
__device__ __forceinline__ float gelu_tanh(float x) {
    const float e = __builtin_amdgcn_exp2f(x * (-2.302208198f - 0.10294324f * x * x));
    return x * __builtin_amdgcn_rcpf(1.0f + e);
}
__device__ __forceinline__ float sigmoidf_(float x) { return __builtin_amdgcn_rcpf(1.0f + __builtin_amdgcn_exp2f(-LOG2E * x)); }

#define XB_TMO      128
#define XB_XCNT(j)  (256  + 64 * (j))
#define XB_XSUB(j)  (1280 + 64 * (j))
#define XB_XGEN(j)  (2304 + 64 * (j))
#define XB_TOP      3328
#define XB_TOPGEN   3392
#define XCD_BAR_WORDS 3456
#define XB_SPIN_CAP (1u << 18)
__device__ __forceinline__ unsigned xb_ld(unsigned* p)              { return __hip_atomic_load(p, __ATOMIC_RELAXED, __HIP_MEMORY_SCOPE_AGENT); }
__device__ __forceinline__ unsigned xb_add(unsigned* p, unsigned v) { return __hip_atomic_fetch_add(p, v, __ATOMIC_RELAXED, __HIP_MEMORY_SCOPE_AGENT); }
__device__ __forceinline__ unsigned xb_xcc_id() { return (unsigned)__builtin_amdgcn_s_getreg((3 << 11) | 20) & 0xFu; }
#define XB_SPIN(cond, bar) do { unsigned _sp = 0; while (cond) { __builtin_amdgcn_s_sleep(1); \
    if ((++_sp & 255u) == 0u) { if (xb_ld(&(bar)[XB_TMO])) break; if (_sp > XB_SPIN_CAP) { atomicAdd(&(bar)[XB_TMO], 1u); break; } } } } while (0)
struct XcdBarrier { unsigned* bar; unsigned x; volatile LAS unsigned* st; };
__device__ __forceinline__ XcdBarrier xcd_barrier_post(unsigned* bar, volatile LAS unsigned* st) {
    XcdBarrier b; b.bar = bar; b.x = xb_xcc_id(); b.st = st;
    if (threadIdx.x == 0) (void)xb_add(&bar[XB_XCNT(b.x)], 1u);
    return b;
}
__device__ __forceinline__ void xcd_barrier_complete(unsigned* bar, unsigned x, unsigned& nloc, unsigned& nx) {
    const unsigned G = gridDim.x * gridDim.y * gridDim.z;
    unsigned sum, cnt, mine, sp = 0u;
    for (;;) {
        sum = 0u; cnt = 0u; mine = 0u;
#pragma unroll
        for (unsigned j = 0; j < 16; ++j) { const unsigned c = xb_ld(&bar[XB_XCNT(j)]); sum += c; cnt += (c > 0u) ? 1u : 0u; mine = (j == x) ? c : mine; }
        if (sum == G) break;
        __builtin_amdgcn_s_sleep(1);
        if ((++sp & 255u) == 0u) { if (xb_ld(&bar[XB_TMO])) break; if (sp > XB_SPIN_CAP) { atomicAdd(&bar[XB_TMO], 1u); break; } }
    }
    nloc = mine > 0u ? mine : 1u; nx = cnt > 0u ? cnt : 1u;
}
__device__ __forceinline__ void xcd_barrier(const XcdBarrier& b) {
    asm volatile("s_waitcnt vmcnt(0)" ::: "memory");
    __syncthreads();
    if (threadIdx.x == 0) {
        unsigned* bar = b.bar;
        __builtin_amdgcn_s_waitcnt(0);
        unsigned nloc = b.st[0], nx = b.st[1];
        if (nloc == 0u) { xcd_barrier_complete(bar, b.x, nloc, nx); b.st[0] = nloc; b.st[1] = nx; }
        const unsigned old = xb_add(&bar[XB_XSUB(b.x)], 1u);
        const unsigned gen = old / nloc;
        if (old + 1u == (gen + 1u) * nloc) {
            __builtin_amdgcn_fence(__ATOMIC_RELEASE, "agent");
            asm volatile("s_waitcnt vmcnt(0)" ::: "memory");
            const unsigned og = xb_add(&bar[XB_TOP], 1u);
            const unsigned tg = og / nx;
            if (og + 1u == (tg + 1u) * nx) xb_add(&bar[XB_TOPGEN], 1u);
            else XB_SPIN(xb_ld(&bar[XB_TOPGEN]) == tg, bar);
            __builtin_amdgcn_fence(__ATOMIC_ACQUIRE, "agent");
            xb_add(&bar[XB_XGEN(b.x)], 1u);
            asm volatile("s_waitcnt vmcnt(0)" ::: "memory");
        } else {
            XB_SPIN(xb_ld(&bar[XB_XGEN(b.x)]) == gen, bar);
            __builtin_amdgcn_fence(__ATOMIC_ACQUIRE, "agent");
            asm volatile("s_waitcnt vmcnt(0)" ::: "memory");
        }
    }
    __syncthreads();
}

using pg8::Unit;
struct EpiIn {
    static constexpr bool PERM = true;
    const float* rstd; bf16 *Q, *Kb, *Vb, *U, *GV, *SA, *SB; float* out;
    __device__ __forceinline__ bool operator()(f32x4 (&acc)[2][2][4][2], const Unit& u, int wr, int wc, int fr, int fq) const {
        const int pn = u.pn; int mode, ld, colt; bf16* dst; float* side = nullptr; size_t side_s = 0;
        if (pn < 4)       { mode = 0; dst = Q;  ld = DM;  colt = pn * 256; }
        else if (pn == 4) { mode = 1; dst = Kb; ld = KVW; colt = 0; side = out + O_KP; side_s = O_KS - O_KP; }
        else if (pn == 5) { mode = 1; dst = Vb; ld = KVW; colt = 0; side = out + O_VP; side_s = O_VS - O_VP; }
        else if (pn < 10) { mode = 2; dst = U;  ld = DM;  colt = (pn - 6) * 256; }
        else if (pn < 14) { mode = 2; dst = GV; ld = DM;  colt = (pn - 10) * 256; }
        else if (pn < 18) { mode = 3; dst = SA; ld = DM;  colt = (pn - 14) * 256; }
        else              { mode = 3; dst = SB; ld = DM;  colt = (pn - 18) * 256; }
        const int row0 = u.pm * 256 + wr * 64 + fr, col0 = colt + wc * 32 + 8 * fq;
#pragma unroll
        for (int ai = 0; ai < 2; ++ai)
#pragma unroll
            for (int m = 0; m < 4; ++m) {
                const int row = row0 + ai * 128 + m * 16; const float rs = rstd[row];
#pragma unroll
                for (int bj = 0; bj < 2; ++bj) {
                    float v[8];
#pragma unroll
                    for (int j = 0; j < 4; ++j) { v[j] = acc[ai][bj][m][0][j] * rs; v[4 + j] = acc[ai][bj][m][1][j] * rs; }
                    if (mode == 0) {
#pragma unroll
                        for (int j = 0; j < 8; ++j) v[j] *= QSCALE;
                    } else if (mode == 2) {
#pragma unroll
                        for (int j = 0; j < 8; ++j) v[j] = gelu_tanh(v[j]);
                    } else if (mode == 3) {
#pragma unroll
                        for (int j = 0; j < 8; ++j) v[j] = sigmoidf_(v[j]);
                    }
                    const int col = col0 + bj * 128;
                    v4u w; w.x = pk2(v[0], v[1]); w.y = pk2(v[2], v[3]); w.z = pk2(v[4], v[5]); w.w = pk2(v[6], v[7]);
                    *(v4u*)(dst + (size_t)row * ld + col) = w;
                    if (mode == 1) {
                        float* sp = nullptr;
                        if (u.pm == 256) { const int r = row - MP; sp = side + side_s + ((size_t)((r >> 4) * 128 + 112 + (r & 15)) * KVW + col); }
                        else if ((u.pm & 15) == 15 && ai == 1) { const int j = wr * 64 + m * 16 + fr; sp = side + ((size_t)((u.pm >> 4) * 128 + j) * KVW + col); }
                        if (sp) { *(f32x4*)sp = (f32x4){v[0], v[1], v[2], v[3]}; *(f32x4*)(sp + 4) = (f32x4){v[4], v[5], v[6], v[7]}; }
                    }
                }
            }
        return false;
    }
};
struct EpiMerge {
    static constexpr bool PERM = true;
    const bf16 *SA, *SB; bf16* O;
    __device__ __forceinline__ bool operator()(f32x4 (&acc)[2][2][4][2], const Unit& u, int wr, int wc, int fr, int fq) const {
        const int row0 = u.pm * 256 + wr * 64 + fr, col0 = u.pn * 256 + wc * 32 + 8 * fq;
#pragma unroll
        for (int ai = 0; ai < 2; ++ai)
#pragma unroll
            for (int m = 0; m < 4; ++m)
#pragma unroll
                for (int bj = 0; bj < 2; ++bj) {
                    const size_t off = (size_t)(row0 + ai * 128 + m * 16) * DM + col0 + bj * 128;
                    const v4u sbw = *(const v4u*)(SB + off);
                    float sb[8] = {bflo(sbw.x), bfhi(sbw.x), bflo(sbw.y), bfhi(sbw.y), bflo(sbw.z), bfhi(sbw.z), bflo(sbw.w), bfhi(sbw.w)};
#pragma unroll
                    for (int j = 0; j < 8; ++j) sb[j] = fmaxf(sb[j], 1e-30f);
                    if (u.seg == 0) {
                        const v4u saw = *(const v4u*)(SA + off);
                        const float sa[8] = {bflo(saw.x), bfhi(saw.x), bflo(saw.y), bfhi(saw.y), bflo(saw.z), bfhi(saw.z), bflo(saw.w), bfhi(saw.w)};
#pragma unroll
                        for (int j = 0; j < 4; ++j) { acc[ai][bj][m][0][j] *= sa[j] * __builtin_amdgcn_rcpf(sb[j]); acc[ai][bj][m][1][j] *= sa[4 + j] * __builtin_amdgcn_rcpf(sb[4 + j]); }
                    } else {
                        float v[8];
#pragma unroll
                        for (int j = 0; j < 4; ++j) { v[j] = acc[ai][bj][m][0][j] * sb[j]; v[4 + j] = acc[ai][bj][m][1][j] * sb[4 + j]; }
                        v4u w; w.x = pk2(v[0], v[1]); w.y = pk2(v[2], v[3]); w.z = pk2(v[4], v[5]); w.w = pk2(v[6], v[7]);
                        *(v4u*)(O + off) = w;
                    }
                }
        return u.seg == 0;
    }
};
struct EpiBf16Ss {
    static constexpr bool PERM = true;
    bf16* O; float* P;
    __device__ __forceinline__ bool operator()(f32x4 (&acc)[2][2][4][2], const Unit& u, int wr, int wc, int fr, int fq) const {
        const int row0 = u.pm * 256 + wr * 64 + fr, col0 = u.pn * 256 + wc * 32 + 8 * fq;
#pragma unroll
        for (int ai = 0; ai < 2; ++ai)
#pragma unroll
            for (int m = 0; m < 4; ++m) {
                const int row = row0 + ai * 128 + m * 16; float ss = 0.f;
#pragma unroll
                for (int bj = 0; bj < 2; ++bj) {
                    const f32x4 a = acc[ai][bj][m][0], b = acc[ai][bj][m][1];
                    ss += (a[0] * a[0] + a[1] * a[1]) + (a[2] * a[2] + a[3] * a[3]) + (b[0] * b[0] + b[1] * b[1]) + (b[2] * b[2] + b[3] * b[3]);
                    v4u w; w.x = pk2(a[0], a[1]); w.y = pk2(a[2], a[3]); w.z = pk2(b[0], b[1]); w.w = pk2(b[2], b[3]);
                    *(v4u*)(O + (size_t)row * DM + col0 + bj * 128) = w;
                }
                ss += __shfl_xor(ss, 16); ss += __shfl_xor(ss, 32);
                if (fq == 0) P[(size_t)(u.pn * 4 + wc) * MT + row] = ss;
            }
        return false;
    }
};
struct EpiSwiglu {
    static constexpr bool PERM = true;
    const float* rstd; bf16* O;
    __device__ __forceinline__ bool operator()(f32x4 (&acc)[2][2][4][2], const Unit& u, int wr, int wc, int fr, int fq) const {
        const int row0 = u.pm * 256 + wr * 64 + fr, col0 = u.pn * 128 + wc * 32 + 8 * fq;
#pragma unroll
        for (int ai = 0; ai < 2; ++ai)
#pragma unroll
            for (int m = 0; m < 4; ++m) {
                const int row = row0 + ai * 128 + m * 16; const float rs = rstd[row]; float v[8];
#pragma unroll
                for (int n = 0; n < 2; ++n)
#pragma unroll
                    for (int j = 0; j < 4; ++j) { const float gg = acc[ai][0][m][n][j] * rs, up = acc[ai][1][m][n][j] * rs; v[4 * n + j] = gg * sigmoidf_(gg) * up; }
                v4u w; w.x = pk2(v[0], v[1]); w.y = pk2(v[2], v[3]); w.z = pk2(v[4], v[5]); w.w = pk2(v[6], v[7]);
                *(v4u*)(O + (size_t)row * DFF + col0) = w;
            }
        return false;
    }
};

template <bool MAP>
__device__ __forceinline__ void p0_transpose_item(const float* W, int K, int N, const float* gain, bf16* WT, LAS float* scr, int item, int lane) {
    const int nblk = N / 32, kb = item / nblk, nb = item % nblk, k0 = 64 * kb, n0 = 32 * nb;
#pragma unroll 8
    for (int i = 0; i < 32; ++i) { const int kk = 2 * i + (lane >> 5); const float gk = gain ? gain[k0 + kk] : 1.0f; scr[kk * 33 + (lane & 31)] = W[(size_t)(k0 + kk) * N + n0 + (lane & 31)] * gk; }
    LDS_WAIT(); asm volatile("" ::: "memory");
    const int c = lane & 7;
#pragma unroll
    for (int j = 0; j < 4; ++j) { const int n = (lane >> 3) + 8 * j; const LAS float* s = scr + (8 * c) * 33 + n;
        v4u o; o.x = pk2(s[0 * 33], s[1 * 33]); o.y = pk2(s[2 * 33], s[3 * 33]); o.z = pk2(s[4 * 33], s[5 * 33]); o.w = pk2(s[6 * 33], s[7 * 33]);
        int nn = n0 + n;
        if (MAP) { const int hi = nn >= DFF ? 1 : 0, r = nn - hi * DFF; nn = 256 * (r >> 7) + 128 * hi + (r & 127); }
        *(GAS v4u*)(WT + (size_t)nn * K + k0 + 8 * c) = o; }
    LDS_WAIT(); asm volatile("" ::: "memory");
}

namespace att {
typedef short bf16x8 __attribute__((ext_vector_type(8)));
typedef short s16x4 __attribute__((ext_vector_type(4)));
typedef short v4i16_t __attribute__((ext_vector_type(4)));
typedef float f32x16 __attribute__((ext_vector_type(16)));
typedef LAS const char* lds_cptr;
constexpr int SLOT = 16384, OST = 4 * SLOT;
__device__ __forceinline__ int crow(int r, int hi) { return (r & 3) + 8 * (r >> 2) + 4 * hi; }
__device__ __forceinline__ s16x4 vtr(lds_cptr p) { return __builtin_bit_cast(s16x4, __builtin_amdgcn_ds_read_tr16_b64_v4i16((LAS v4i16_t*)p)); }
struct TileRegs { v4u k, v; };
__device__ __forceinline__ TileRegs load_tile(const bf16* KB, const bf16* VB, size_t rowbase, int kvh, int wid, int lane) {
    TileRegs t;
    t.k = *(const v4u*)(KB + (rowbase + lane) * KVW + kvh * HD + wid * 8);
    t.v = *(const v4u*)(VB + (rowbase + 16 * (wid & 3) + (lane >> 2)) * KVW + kvh * HD + (wid >> 2) * 32 + (lane & 3) * 8);
    return t;
}
__device__ __forceinline__ void store_tile(LAS unsigned char* slot, const TileRegs& t, int wid, int lane) {
    *(LAS v4u*)(slot + wid * 1024 + lane * 16) = t.k;
    *(LAS v4u*)(slot + 8192 + wid * 1024 + lane * 16) = t.v;
}
template <bool SAMPLE>
__device__ __forceinline__ void attn_unit(LAS unsigned char* lds, int s0, int s1, int s2, int ft, bf16* QO, size_t qrow0, int kvh, const float* sinks, int wid, int lane) {
    const int r32 = lane & 31, hi = lane >> 5, g = wid >> 1, posb = 32 * (wid & 1), head = kvh * 4 + g;
    const size_t qrow = SAMPLE ? qrow0 + ((posb + r32) & 15) : qrow0 + posb + r32;
    const bf16* qp = QO + qrow * DM + head * HD;
    bf16x8 qr[4];
#pragma unroll
    for (int d0 = 0; d0 < 4; ++d0) qr[d0] = *(const bf16x8*)(qp + d0 * 16 + hi * 8);
    const float sink2 = sinks[head] * LOG2E;
    f32x16 p[6];
#pragma unroll
    for (int ti = 0; ti < 3; ++ti) {
        if (ti >= ft) {
            const int so = (ti == 0) ? s0 : (ti == 1) ? s1 : s2;
            lds_cptr kb = (lds_cptr)lds + so + hi * 1024 + r32 * 16;
            f32x16 a = {}, c = {};
#pragma unroll
            for (int d0 = 0; d0 < 4; ++d0) {
                const bf16x8 b0 = *(const LAS bf16x8*)(kb + d0 * 2048), b1 = *(const LAS bf16x8*)(kb + d0 * 2048 + 512);
                a = __builtin_amdgcn_mfma_f32_32x32x16_bf16(b0, qr[d0], a, 0, 0, 0); c = __builtin_amdgcn_mfma_f32_32x32x16_bf16(b1, qr[d0], c, 0, 0, 0);
            }
            p[2 * ti] = a; p[2 * ti + 1] = c;
        } else {
#pragma unroll
            for (int r = 0; r < 16; ++r) { p[2 * ti][r] = -INFINITY; p[2 * ti + 1][r] = -INFINITY; }
        }
    }
    if (SAMPLE) {
#pragma unroll
        for (int r = 0; r < 16; ++r) { if (r >= 8) p[4][r] = -INFINITY; p[5][r] = -INFINITY; }
    }
    float mx = sink2;
#pragma unroll
    for (int kb = 0; kb < 6; ++kb)
#pragma unroll
        for (int r = 0; r < 16; ++r) mx = fmaxf(mx, p[kb][r]);
    { auto rr = __builtin_amdgcn_permlane32_swap(__float_as_uint(mx), __float_as_uint(mx), false, false); mx = fmaxf(__uint_as_float(rr[0]), __uint_as_float(rr[1])); }
    float sum = 0.f;
#pragma unroll
    for (int kb = 0; kb < 6; ++kb)
#pragma unroll
        for (int r = 0; r < 16; ++r) { p[kb][r] = __builtin_amdgcn_exp2f(p[kb][r] - mx); sum += p[kb][r]; }
    { auto rr = __builtin_amdgcn_permlane32_swap(__float_as_uint(sum), __float_as_uint(sum), false, false); sum = __uint_as_float(rr[0]) + __uint_as_float(rr[1]); }
    const float inv = 1.0f / (sum + __builtin_amdgcn_exp2f(sink2 - mx));
    f32x16 o0 = {}, o1 = {};
    const int vb = ((lane >> 4) & 1) * 32 + (lane & 3) * 8 + (4 * hi + ((lane & 15) >> 2)) * 64;
#pragma unroll
    for (int ti = 0; ti < 3; ++ti) {
        if (ti >= ft) {
            const int so = (ti == 0) ? s0 : (ti == 1) ? s1 : s2;
            lds_cptr vp = (lds_cptr)lds + so + 8192 + vb;
#pragma unroll
            for (int ks = 0; ks < 4; ++ks) {
                const int kb = 2 * ti + (ks >> 1), rb = 8 * (ks & 1);
                v4u pw; pw.x = pk2(p[kb][rb + 0] * inv, p[kb][rb + 1] * inv); pw.y = pk2(p[kb][rb + 2] * inv, p[kb][rb + 3] * inv); pw.z = pk2(p[kb][rb + 4] * inv, p[kb][rb + 5] * inv); pw.w = pk2(p[kb][rb + 6] * inv, p[kb][rb + 7] * inv);
                const bf16x8 pa = __builtin_bit_cast(bf16x8, pw);
                { const s16x4 lo = vtr(vp + ks * 1024), h4 = vtr(vp + ks * 1024 + 512); const bf16x8 vf = (bf16x8){lo[0], lo[1], lo[2], lo[3], h4[0], h4[1], h4[2], h4[3]};
                  o0 = __builtin_amdgcn_mfma_f32_32x32x16_bf16(pa, vf, o0, 0, 0, 0); }
                { const s16x4 lo = vtr(vp + 4096 + ks * 1024), h4 = vtr(vp + 4096 + ks * 1024 + 512); const bf16x8 vf = (bf16x8){lo[0], lo[1], lo[2], lo[3], h4[0], h4[1], h4[2], h4[3]};
                  o1 = __builtin_amdgcn_mfma_f32_32x32x16_bf16(pa, vf, o1, 0, 0, 0); }
            }
        }
    }
    LAS bf16* stg = (LAS bf16*)(lds + OST + wid * 4096);
#pragma unroll
    for (int r = 0; r < 16; ++r) { const int orow = crow(r, hi); stg[orow * 64 + r32] = (bf16)(pk2(o0[r], 0.f) & 0xffffu); stg[orow * 64 + 32 + r32] = (bf16)(pk2(o1[r], 0.f) & 0xffffu); }
    LDS_WAIT();
#pragma unroll
    for (int i = 0; i < 4; ++i) { const int row = i * 8 + (lane >> 3), ch = lane & 7; const v4u v = *(const LAS v4u*)(stg + row * 64 + ch * 8);
        if (!SAMPLE || posb + row < 16) *(v4u*)(QO + (qrow0 + posb + row) * DM + head * HD + ch * 8) = v; }
    LDS_WAIT();
}
}

namespace gat {
using att::bf16x8; using att::s16x4; using att::f32x16; using att::lds_cptr; using att::vtr; using att::crow;
template <bool SAMPLE>
__device__ __forceinline__ void gate_unit(LAS unsigned char* lds, const bf16* GV, bf16* UB, const bf16* WSB, const float* ln_g, const float* ln_b, const float* b_s, float* gs_out, size_t row0, int tid, int wave, int lane) {
    constexpr int L = SAMPLE ? 16 : 128;
    LAS float* stats = (LAS float*)lds; LAS unsigned char* img = lds + 1024;
    const int r32 = lane & 31, hi = lane >> 5;
    __syncthreads();
    for (int rr = 0; rr < 16; ++rr) { const int r = wave * 16 + rr;
        if (r < L) {
            const bf16* gp = GV + (row0 + r) * DM + 8 * lane; const v4u w0 = *(const v4u*)gp, w1 = *(const v4u*)(gp + 512);
            const float v[16] = {bflo(w0.x), bfhi(w0.x), bflo(w0.y), bfhi(w0.y), bflo(w0.z), bfhi(w0.z), bflo(w0.w), bfhi(w0.w), bflo(w1.x), bfhi(w1.x), bflo(w1.y), bfhi(w1.y), bflo(w1.z), bfhi(w1.z), bflo(w1.w), bfhi(w1.w)};
            float s = 0.f;
#pragma unroll
            for (int j = 0; j < 16; ++j) s += v[j];
            const float mean = wave_sum(s) * (1.0f / DM); float q = 0.f;
#pragma unroll
            for (int j = 0; j < 16; ++j) { const float d = v[j] - mean; q += d * d; }
            const float rstd = 1.0f / sqrtf(wave_sum(q) * (1.0f / DM) + EPS);
            if (lane == 0) { stats[2 * r] = mean; stats[2 * r + 1] = rstd; }
        }
    }
    __syncthreads();
    const int pp = wave & 1, cq = wave >> 1;
    const int vb = ((lane >> 4) & 1) * 32 + (lane & 3) * 8 + (4 * hi + ((lane & 15) >> 2)) * 64;
    for (int g = 0; g < 4; ++g) {
        for (int i = 0; i < 8; ++i) { const int idx = tid + 512 * i, r = idx >> 5, ch = idx & 31, c = ch * 8, col = g * 256 + c; v4u w = {0u, 0u, 0u, 0u};
            if (r < L) {
                const v4u x = *(const v4u*)(GV + (row0 + r) * DM + col); const float mean = stats[2 * r], rstd = stats[2 * r + 1];
                const f32x4 g0 = *(const f32x4*)(ln_g + col), g1 = *(const f32x4*)(ln_g + col + 4), b0 = *(const f32x4*)(ln_b + col), b1 = *(const f32x4*)(ln_b + col + 4);
                float v[8] = {bflo(x.x), bfhi(x.x), bflo(x.y), bfhi(x.y), bflo(x.z), bfhi(x.z), bflo(x.w), bfhi(x.w)};
                v[0] = (v[0] - mean) * rstd * g0.x + b0.x; v[1] = (v[1] - mean) * rstd * g0.y + b0.y; v[2] = (v[2] - mean) * rstd * g0.z + b0.z; v[3] = (v[3] - mean) * rstd * g0.w + b0.w;
                v[4] = (v[4] - mean) * rstd * g1.x + b1.x; v[5] = (v[5] - mean) * rstd * g1.y + b1.y; v[6] = (v[6] - mean) * rstd * g1.z + b1.z; v[7] = (v[7] - mean) * rstd * g1.w + b1.w;
                if (SAMPLE) { float* gs = gs_out + (size_t)r * DM + col; *(f32x4*)gs = (f32x4){v[0], v[1], v[2], v[3]}; *(f32x4*)(gs + 4) = (f32x4){v[4], v[5], v[6], v[7]}; }
                w.x = pk2(v[0], v[1]); w.y = pk2(v[2], v[3]); w.z = pk2(v[4], v[5]); w.w = pk2(v[6], v[7]);
            }
            *(LAS v4u*)(img + ((c >> 5) * 8 + (r >> 4)) * 1024 + (r & 15) * 64 + (c & 31) * 2) = w; }
        __syncthreads();
        f32x16 o[2][2];
#pragma unroll
        for (int a = 0; a < 2; ++a)
#pragma unroll
            for (int c = 0; c < 2; ++c) o[a][c] = (f32x16){};
#pragma unroll
        for (int tsel = 0; tsel < 2; ++tsel) {
            const int tb = tsel ? 3 - pp : pp, nks = 2 * (tb + 1);
            const bf16* wrow = WSB + ((size_t)(g * 128 + 32 * tb + r32) * 128 + hi * 8);
            for (int ks = 0; ks < nks; ++ks) {
                const bf16x8 a = *(const bf16x8*)(wrow + ks * 16);
#pragma unroll
                for (int cs = 0; cs < 2; ++cs) {
                    lds_cptr vp = (lds_cptr)img + ((2 * cq + cs) * 8 + ks) * 1024 + vb;
                    const s16x4 lo = vtr(vp), h4 = vtr(vp + 512); const bf16x8 vf = (bf16x8){lo[0], lo[1], lo[2], lo[3], h4[0], h4[1], h4[2], h4[3]};
                    o[tsel][cs] = __builtin_amdgcn_mfma_f32_32x32x16_bf16(a, vf, o[tsel][cs], 0, 0, 0);
                }
            }
        }
#pragma unroll
        for (int tsel = 0; tsel < 2; ++tsel) {
            const int tb = tsel ? 3 - pp : pp;
#pragma unroll
            for (int r = 0; r < 16; ++r) { const int t = 32 * tb + crow(r, hi);
                if (t < L) { const float bias = b_s[g * 128 + t];
#pragma unroll
                    for (int cs = 0; cs < 2; ++cs) { bf16* up = UB + (row0 + t) * DM + g * 256 + 32 * (2 * cq + cs) + r32;
                        const float uv = __uint_as_float((unsigned)(*up) << 16); *up = (bf16)(pk2(uv * (o[tsel][cs][r] + bias), 0.f) & 0xffffu); }
                }
            }
        }
        __syncthreads();
    }
}
}

struct Args { const float* in[19]; float* out; unsigned char* ws; int ph_lo, ph_hi; };

__global__ void __launch_bounds__(NWAVES * 64, 2) fwd_kernel(Args args) {
    extern __shared__ __attribute__((aligned(16))) unsigned char lds_raw[];
    LAS unsigned char* lds = (LAS unsigned char*)lds_raw;
    volatile LAS unsigned* MISC = (volatile LAS unsigned*)(lds + MISC_OFF);
    const int tid = threadIdx.x, lane = tid & 63, wave = __builtin_amdgcn_readfirstlane(tid >> 6);
    const int G = gridDim.x;
    const int vcu = (G % 8 == 0) ? ((int)blockIdx.x % 8) * (G / 8) + (int)blockIdx.x / 8 : (int)blockIdx.x;
    unsigned char* ws = args.ws;
    const float* xp = args.in[0]; const float* xs = args.in[1]; const float* cache_k = args.in[2]; const float* cache_v = args.in[3];
    const float* g_pre_mix = args.in[4]; const float* g_post_mix = args.in[5]; const float* g_pre_ffn = args.in[6]; const float* g_post_ffn = args.in[7];
    const float* w_in = args.in[8]; const float* sinks = args.in[9]; const float* ln_g = args.in[10]; const float* ln_b = args.in[11];
    const float* w_s = args.in[12]; const float* b_s = args.in[13]; const float* w_ap = args.in[14]; const float* w_gp = args.in[15];
    const float* w_out = args.in[16]; const float* w_fi = args.in[17]; const float* w_fo = args.in[18];
    float* out = args.out;
    bf16* WinT = (bf16*)(ws + WS_WIN); bf16* WfiT = (bf16*)(ws + WS_WFI); bf16* WaT = (bf16*)(ws + WS_WA); bf16* WgT = (bf16*)(ws + WS_WG); bf16* WoT = (bf16*)(ws + WS_WO); bf16* WfoT = (bf16*)(ws + WS_WFO); bf16* WSB = (bf16*)(ws + WS_WSB);
    float* RSTD1 = (float*)(ws + WS_RSTD1); float* RSTD2 = (float*)(ws + WS_RSTD2); float* PMIX = (float*)(ws + WS_PMIX); float* PF = (float*)(ws + WS_PF);
    bf16* XB = (bf16*)(ws + WS_R0); bf16* MERGED = XB; bf16* FB = XB;
    bf16* QB = (bf16*)(ws + WS_R1); bf16* X1B = QB;
    bf16* GV = (bf16*)(ws + WS_R2); bf16* MIX = GV;
    bf16* KB = (bf16*)(ws + WS_KB); bf16* VB = (bf16*)(ws + WS_VB);
    bf16* SA = (bf16*)(ws + WS_SA); bf16* SB = (bf16*)(ws + WS_SB); bf16* UB = (bf16*)(ws + WS_U); bf16* ACT = (bf16*)(ws + WS_R3);

    for (int u = tid; u < (LDS_BYTES - LDSCTL_OFF) / 4; u += NWAVES * 64) ((LAS unsigned*)(lds + LDSCTL_OFF))[u] = 0u;
    __syncthreads();
    XcdBarrier bar; bar.bar = (unsigned*)(ws + WS_CTL) + CW_BAR; bar.x = 0; bar.st = nullptr;
    if (MK_ONE_LAUNCH) bar = xcd_barrier_post((unsigned*)(ws + WS_CTL) + CW_BAR, MISC + 8);
    const int lo = args.ph_lo, hi = args.ph_hi;
#define IN(k) (lo <= (k) && (k) < hi)
#define SEAM(k) do { if (MK_ONE_LAUNCH && IN(k) && IN((k) + 1)) xcd_barrier(bar); } while (0)
    const int gw = vcu * NWAVES + wave, NGW = G * NWAVES;

    if (IN(0)) for (int rep_ = 0; rep_ < NREP(0); ++rep_) {
        LAS float* scr = (LAS float*)(lds + wave * 16384);
        constexpr int I_IN = (DM / 64) * (INW / 32), I_SQ = (DM / 64) * (DM / 32), I_FO = (DFF / 64) * (DM / 32);
        constexpr int NITEMS = 2 * I_IN + 3 * I_SQ + I_FO;
        for (int it = gw; it < NITEMS; it += NGW) {
            int r = it;
            if (r < I_IN) { p0_transpose_item<false>(w_in, DM, INW, g_pre_mix, WinT, scr, r, lane); continue; } r -= I_IN;
            if (r < I_IN) { p0_transpose_item<true>(w_fi, DM, INW, g_pre_ffn, WfiT, scr, r, lane); continue; } r -= I_IN;
            if (r < I_SQ) { p0_transpose_item<false>(w_ap, DM, DM, nullptr, WaT, scr, r, lane); continue; } r -= I_SQ;
            if (r < I_SQ) { p0_transpose_item<false>(w_gp, DM, DM, nullptr, WgT, scr, r, lane); continue; } r -= I_SQ;
            if (r < I_SQ) { p0_transpose_item<false>(w_out, DM, DM, nullptr, WoT, scr, r, lane); continue; } r -= I_SQ;
            p0_transpose_item<false>(w_fo, DFF, DM, nullptr, WfoT, scr, r, lane);
        }
        for (int i = gw * 64 + lane; i < 4 * 128 * 128; i += NGW * 64) {
            const int t = (i >> 7) & 127, pp = i & 127, pl = pp & 15, sl = (pl & 3) | ((pl & 4) << 1) | ((pl & 8) >> 1), sidx = (pp & ~15) + sl;
            const float v = (sidx <= t) ? w_s[(size_t)(i & ~127) + sidx] : 0.f;
            WSB[i] = (bf16)(pk2(v, 0.f) & 0xffffu);
        }
        for (int m = gw; m < MT; m += NGW) {
            const float* xrow = (m < MP) ? xp + (size_t)m * DM : xs + (size_t)(m - MP) * DM;
            const GAS f32x4* xr = (const GAS f32x4*)xrow + lane;
            f32x4 v[4]; float s = 0.f;
#pragma unroll
            for (int j = 0; j < 4; ++j) { v[j] = xr[64 * j]; s += (v[j].x * v[j].x + v[j].y * v[j].y) + (v[j].z * v[j].z + v[j].w * v[j].w); }
            s = wave_sum(s);
            if (lane == 0) RSTD1[m] = 1.0f / sqrtf(s * (1.0f / DM) + EPS);
            GAS v2u* o8 = (GAS v2u*)(XB + (size_t)m * DM) + lane;
#pragma unroll
            for (int j = 0; j < 4; ++j) { v2u w; w.x = pk2(v[j].x, v[j].y); w.y = pk2(v[j].z, v[j].w); o8[64 * j] = w; }
        }
        for (int i = gw * 64 + lane; i < 2 * NB * 112 * 64; i += NGW * 64) {
            const int which = i / (NB * 112 * 64), r = i % (NB * 112 * 64), b = r / (112 * 64), q = r % (112 * 64);
            const float* src = (which ? cache_v : cache_k) + (size_t)b * 128 * KVW + 16 * KVW;
            float* dstp = out + (which ? O_VS : O_KS) + (size_t)b * 128 * KVW;
            ((f32x4*)dstp)[q] = ((const f32x4*)src)[q];
        }
    }
    SEAM(0);

    if (IN(1)) for (int rep_ = 0; rep_ < NREP(1); ++rep_) {
        pg8::Gemm g{XB, WinT, XB, WinT, MT, INW, DM}; pg8::StaticOrder S; S.init(MT, INW, G, (int)blockIdx.x, 1);
        EpiIn E{RSTD1, QB, KB, VB, UB, GV, SA, SB, out};
        pg8::gemm_phase<EpiIn, pg8::StaticOrder>(lds, g, S, E);
    }
    SEAM(1);

    if (IN(2)) {
        for (int j = blockIdx.x; j < NB * NKV * 4; j += G) {
            const int b = j >> 4, kvh = (j >> 2) & 3, c0 = 16 * (j & 3); const size_t seqbase = (size_t)b * SEQ;
            __syncthreads();
            for (int T = (c0 >= 2 ? c0 - 2 : 0); T <= c0; ++T) { const att::TileRegs tr = att::load_tile(KB, VB, seqbase + 64 * T, kvh, wave, lane); att::store_tile(lds + (T & 3) * att::SLOT, tr, wave, lane); }
            __syncthreads();
            for (int c = c0; c < c0 + 16; ++c) {
                att::TileRegs nx; nx.k = (v4u){0u, 0u, 0u, 0u}; nx.v = nx.k; const bool pre = (c + 1 < c0 + 16);
                if (pre) nx = att::load_tile(KB, VB, seqbase + 64 * (c + 1), kvh, wave, lane);
                att::attn_unit<false>(lds, ((c + 2) & 3) * att::SLOT, ((c + 3) & 3) * att::SLOT, (c & 3) * att::SLOT, c >= 2 ? 0 : 2 - c, QB, seqbase + 64 * c, kvh, sinks, wave, lane);
                if (pre) att::store_tile(lds + ((c + 1) & 3) * att::SLOT, nx, wave, lane);
                __syncthreads();
            }
        }
        for (int j = blockIdx.x; j < NB * NKV; j += G) {
            const int b = j >> 2, kvh = j & 3;
            __syncthreads();
#pragma unroll
            for (int T = 0; T < 2; ++T) {
                att::TileRegs tr;
                { const size_t o = ((size_t)(b * 128 + 64 * T + lane) * NKV + kvh) * HD + wave * 8; const f32x4 k0 = *(const f32x4*)(cache_k + o), k1 = *(const f32x4*)(cache_k + o + 4);
                  tr.k.x = pk2(k0.x, k0.y); tr.k.y = pk2(k0.z, k0.w); tr.k.z = pk2(k1.x, k1.y); tr.k.w = pk2(k1.z, k1.w); }
                { const size_t o = ((size_t)(b * 128 + 64 * T + 16 * (wave & 3) + (lane >> 2)) * NKV + kvh) * HD + (wave >> 2) * 32 + (lane & 3) * 8; const f32x4 v0 = *(const f32x4*)(cache_v + o), v1 = *(const f32x4*)(cache_v + o + 4);
                  tr.v.x = pk2(v0.x, v0.y); tr.v.y = pk2(v0.z, v0.w); tr.v.z = pk2(v1.x, v1.y); tr.v.w = pk2(v1.z, v1.w); }
                att::store_tile(lds + T * att::SLOT, tr, wave, lane);
            }
            { att::TileRegs tr; tr.k = (v4u){0u, 0u, 0u, 0u}; tr.v = tr.k;
              if (lane < 16) tr.k = *(const v4u*)(KB + (size_t)(MP + b * 16 + lane) * KVW + kvh * HD + wave * 8);
              if ((wave & 3) == 0) tr.v = *(const v4u*)(VB + (size_t)(MP + b * 16 + (lane >> 2)) * KVW + kvh * HD + (wave >> 2) * 32 + (lane & 3) * 8);
              att::store_tile(lds + 2 * att::SLOT, tr, wave, lane); }
            __syncthreads();
            att::attn_unit<true>(lds, 0, att::SLOT, 2 * att::SLOT, 0, QB, (size_t)(MP + b * 16), kvh, sinks, wave, lane);
        }
        __syncthreads();
        for (int unit = blockIdx.x; unit < NB * 32; unit += G) gat::gate_unit<false>(lds, GV, UB, WSB, ln_g, ln_b, b_s, nullptr, (size_t)unit * 128, tid, wave, lane);
        for (int j = (int)((blockIdx.x + G - 64 % G) % G); j < NB; j += G) gat::gate_unit<true>(lds, GV, UB, WSB, ln_g, ln_b, b_s, out + O_GS + (size_t)j * 16 * DM, (size_t)(MP + j * 16), tid, wave, lane);
    }
    SEAM(2);

    if (IN(3)) for (int rep_ = 0; rep_ < NREP(3); ++rep_) {
        pg8::Gemm g{QB, WaT, UB, WgT, MT, DM, DM}; pg8::StaticOrder S; S.init(MT, DM, G, (int)blockIdx.x, 2);
        EpiMerge E{SA, SB, MERGED};
        pg8::gemm_phase<EpiMerge, pg8::StaticOrder>(lds, g, S, E);
    }
    SEAM(3);

    if (IN(4)) for (int rep_ = 0; rep_ < NREP(4); ++rep_) {
        pg8::Gemm g{MERGED, WoT, MERGED, WoT, MT, DM, DM}; pg8::StaticOrder S; S.init(MT, DM, G, (int)blockIdx.x, 1);
        EpiBf16Ss E{MIX, PMIX};
        pg8::gemm_phase<EpiBf16Ss, pg8::StaticOrder>(lds, g, S, E);
    }
    SEAM(4);

    if (IN(5)) for (int rep_ = 0; rep_ < NREP(5); ++rep_) {
        for (int m = gw; m < MT; m += NGW) {
            const float* xrow = (m < MP) ? xp + (size_t)m * DM : xs + (size_t)(m - MP) * DM;
            float ps = PMIX[(size_t)(lane & 15) * MT + m]; ps += __shfl_xor(ps, 1); ps += __shfl_xor(ps, 2); ps += __shfl_xor(ps, 4); ps += __shfl_xor(ps, 8);
            const float rm = 1.0f / sqrtf(ps * (1.0f / DM) + EPS);
            f32x4 v[4]; float s = 0.f;
#pragma unroll
            for (int j = 0; j < 4; ++j) { const f32x4 xv = *((const GAS f32x4*)xrow + lane + 64 * j); const v2u mw = *((const GAS v2u*)(MIX + (size_t)m * DM) + lane + 64 * j); const f32x4 gv = *((const f32x4*)g_post_mix + lane + 64 * j);
                v[j].x = xv.x + bflo(mw.x) * rm * gv.x; v[j].y = xv.y + bfhi(mw.x) * rm * gv.y; v[j].z = xv.z + bflo(mw.y) * rm * gv.z; v[j].w = xv.w + bfhi(mw.y) * rm * gv.w;
                s += (v[j].x * v[j].x + v[j].y * v[j].y) + (v[j].z * v[j].z + v[j].w * v[j].w); }
            s = wave_sum(s);
            if (lane == 0) RSTD2[m] = 1.0f / sqrtf(s * (1.0f / DM) + EPS);
            GAS v2u* o8 = (GAS v2u*)(X1B + (size_t)m * DM) + lane;
#pragma unroll
            for (int j = 0; j < 4; ++j) { v2u w; w.x = pk2(v[j].x, v[j].y); w.y = pk2(v[j].z, v[j].w); o8[64 * j] = w; }
        }
    }
    SEAM(5);

    if (IN(6)) for (int rep_ = 0; rep_ < NREP(6); ++rep_) {
        pg8::Gemm g{X1B, WfiT, X1B, WfiT, MT, INW, DM}; pg8::StaticOrder S; S.init(MT, INW, G, (int)blockIdx.x, 1);
        EpiSwiglu E{RSTD2, ACT};
        pg8::gemm_phase<EpiSwiglu, pg8::StaticOrder>(lds, g, S, E);
    }
    SEAM(6);

    if (IN(7)) for (int rep_ = 0; rep_ < NREP(7); ++rep_) {
        pg8::Gemm g{ACT, WfoT, ACT, WfoT, MT, DM, DFF}; pg8::StaticOrder S; S.init(MT, DM, G, (int)blockIdx.x, 1);
        EpiBf16Ss E{FB, PF};
        pg8::gemm_phase<EpiBf16Ss, pg8::StaticOrder>(lds, g, S, E);
    }
    SEAM(7);

    if (IN(8)) for (int rep_ = 0; rep_ < NREP(8); ++rep_) {
        for (int m = gw; m < MT; m += NGW) {
            const float* xrow = (m < MP) ? xp + (size_t)m * DM : xs + (size_t)(m - MP) * DM;
            float* yrow = (m < MP) ? out + O_YP + (size_t)m * DM : out + O_YS + (size_t)(m - MP) * DM;
            float ps = PMIX[(size_t)(lane & 15) * MT + m]; ps += __shfl_xor(ps, 1); ps += __shfl_xor(ps, 2); ps += __shfl_xor(ps, 4); ps += __shfl_xor(ps, 8);
            float pf = PF[(size_t)(lane & 15) * MT + m]; pf += __shfl_xor(pf, 1); pf += __shfl_xor(pf, 2); pf += __shfl_xor(pf, 4); pf += __shfl_xor(pf, 8);
            const float rm = 1.0f / sqrtf(ps * (1.0f / DM) + EPS), rf = 1.0f / sqrtf(pf * (1.0f / DM) + EPS);
#pragma unroll
            for (int j = 0; j < 4; ++j) { const f32x4 xv = *((const GAS f32x4*)xrow + lane + 64 * j); const v2u mw = *((const GAS v2u*)(MIX + (size_t)m * DM) + lane + 64 * j); const v2u fw = *((const GAS v2u*)(FB + (size_t)m * DM) + lane + 64 * j);
                const f32x4 g1 = *((const f32x4*)g_post_mix + lane + 64 * j), g2 = *((const f32x4*)g_post_ffn + lane + 64 * j);
                f32x4 y; y.x = xv.x + bflo(mw.x) * rm * g1.x + bflo(fw.x) * rf * g2.x; y.y = xv.y + bfhi(mw.x) * rm * g1.y + bfhi(fw.x) * rf * g2.y;
                y.z = xv.z + bflo(mw.y) * rm * g1.z + bflo(fw.y) * rf * g2.z; y.w = xv.w + bfhi(mw.y) * rm * g1.w + bfhi(fw.y) * rf * g2.w;
                *((GAS f32x4*)yrow + lane + 64 * j) = y; }
        }
    }
#undef IN
#undef SEAM
}

constexpr int N_PHASES = 9;
extern "C" void kernel_launch(void* const* d_in, const int* in_sizes, int n_in, void* d_out, int out_size, void* d_ws, size_t ws_size, hipStream_t stream) {
    static int grid = 0;
    if (grid == 0) {
        if (n_in != 19 || (size_t)out_size != O_END || ws_size < WS_END) { fprintf(stderr, "kernel_launch: unexpected shapes: n_in %d out %d ws %zu (need %zu)\n", n_in, out_size, ws_size, (size_t)WS_END); grid = -1; return; }
        int dev = 0, cus = 0;
        if (hipGetDevice(&dev) != hipSuccess || hipDeviceGetAttribute(&cus, hipDeviceAttributeMultiprocessorCount, dev) != hipSuccess) { grid = -1; return; }
        if (hipFuncSetAttribute((const void*)fwd_kernel, hipFuncAttributeMaxDynamicSharedMemorySize, LDS_BYTES) != hipSuccess) { fprintf(stderr, "kernel_launch: hipFuncSetAttribute failed\n"); grid = -1; return; }
        int per_cu = 0;
        (void)hipOccupancyMaxActiveBlocksPerMultiprocessor(&per_cu, (const void*)fwd_kernel, NWAVES * 64, LDS_BYTES);
        (void)hipGetLastError();
        grid = cus;
    }
    if (grid < 0) return;
    (void)hipMemsetAsync((char*)d_ws + WS_CTL, 0, CTL_ZERO_BYTES, stream);
    Args a{};
    for (int i = 0; i < 19; ++i) a.in[i] = (const float*)d_in[i];
    a.out = (float*)d_out; a.ws = (unsigned char*)d_ws;
#if MK_ONE_LAUNCH
    a.ph_lo = 0; a.ph_hi = N_PHASES;
    hipLaunchKernelGGL(fwd_kernel, dim3(grid), dim3(NWAVES * 64), LDS_BYTES, stream, a);
#else
    for (int p = 0; p < N_PHASES; ++p) { a.ph_lo = p; a.ph_hi = p + 1; hipLaunchKernelGGL(fwd_kernel, dim3(grid), dim3(NWAVES * 64), LDS_BYTES, stream, a); }
#endif
}
```

```cpp
#include <hip/hip_runtime.h>
#include <cstdio>
#include <cstdint>

#ifndef MK_ONE_LAUNCH
#define MK_ONE_LAUNCH 1
#endif
#ifndef REP_MASK
#define REP_MASK 0
#endif
#define NREP(k) (((REP_MASK >> (k)) & 1) ? 2 : 1)

namespace pg8 {
#define PG8_LAS __attribute__((address_space(3)))
typedef unsigned short bf16_t;
typedef short bf16x8 __attribute__((ext_vector_type(8)));
typedef float f32x4 __attribute__((ext_vector_type(4)));
typedef unsigned u32x4 __attribute__((ext_vector_type(4)));
constexpr int BM = 256, BK = 64, HALF = 128, HTB = HALF * BK * 2  , STAGE_BYTES = 8 * HTB, NXCD = 8, WGM = 8;

__host__ __device__ __forceinline__ int lds_byte(int r, int c) { const int st = (r >> 4) * 2 + (c >> 5), rr = r & 15, cc = c & 31, ob = rr * 64 + cc * 2; return st * 1024 + (ob ^ (((ob >> 9) & 1) << 5)); }
__host__ __device__ __forceinline__ void stage_rc(int b, int& R, int& C) { const int st = b / 1024, sb = b % 1024, swz = sb ^ (((sb >> 9) & 1) << 5); R = (st >> 1) * 16 + swz / 64; C = (st & 1) * 32 + (swz % 64) / 2; }
__host__ __device__ __forceinline__ int perm32(int rho) { const int n = rho >> 4, i = rho & 15; return 8 * (i >> 2) + 4 * n + (i & 3); }

struct Unit { int pm, pn, seg; };
struct Gemm { const bf16_t* A0; const bf16_t* B0; const bf16_t* A1; const bf16_t* B1; int M, N, K; };

struct StaticOrder {
    int nM, nN, nwg, G, c, nseg;
    __host__ __device__ void init(int M, int N, int G_, int c_, int nseg_) { nM = M / BM; nN = N / BM; nwg = nM * nN; G = G_; c = c_; nseg = nseg_; }
    __host__ __device__ bool next(int i, Unit& u) const {
        const int ti = (nseg == 2) ? (i >> 1) : i; u.seg = (nseg == 2) ? (i & 1) : 0;
        const long L = (long)ti * G + c; if (L >= nwg) return false;
        int wgid = (int)L; { const int q = nwg / NXCD, r = nwg % NXCD, xcd = wgid % NXCD, off = wgid / NXCD; wgid = (xcd < r ? xcd * (q + 1) : r * (q + 1) + (xcd - r) * q) + off; }
        const int nig = WGM * nN, gid = wgid / nig, fm = gid * WGM, gsz = (nM - fm) < WGM ? (nM - fm) : WGM;
        u.pm = fm + ((wgid % nig) % gsz); u.pn = (wgid % nig) / gsz; return true;
    }
};

template <class Epi, class Sched>
__device__ __forceinline__ void gemm_phase(PG8_LAS unsigned char* lds, const Gemm g, const Sched& S, const Epi& E) {
    const int tid = threadIdx.x, wid = __builtin_amdgcn_readfirstlane(tid >> 6), lane = tid & 63, wr = wid >> 2, wc = wid & 3, fr = lane & 15, fq = lane >> 4;
    const int K = g.K, nt = K / BK;
    unsigned voffA[2], voffB[2];
#pragma unroll
    for (int i = 0; i < 2; ++i) { int R, C; stage_rc(tid * 16 + i * 8192, R, C); const int Rb = Epi::PERM ? ((R & ~31) + perm32(R & 31)) : R;
        voffA[i] = (unsigned)(R * K + C) * 2u; voffB[i] = (unsigned)(Rb * K + C) * 2u; }
    const size_t kstep = (size_t)(BK * 2);
    const size_t hstep = (size_t)HALF * K * 2;
    const size_t tstep = 2 * hstep;
    const unsigned ldsw = (unsigned)wid * 1024u;
    const int aoff = lds_byte(wr * 64 + fr, fq * 8), boff = lds_byte(wc * 32 + fr, fq * 8);
#define PG8_SA(b, h) (((b) * 2 + (h)) * HTB)
#define PG8_SB(b, h) ((4 + (b) * 2 + (h)) * HTB)
#define PG8_STAGE(bufoff, gbase, voff) do { _Pragma("unroll") for (int _i = 0; _i < 2; ++_i) \
        __builtin_amdgcn_global_load_lds((const unsigned*)((const char*)(gbase) + (voff)[_i]), (PG8_LAS unsigned*)(lds + (bufoff) + ldsw + _i * 8192), 16, 0, 0); } while (0)
#define PG8_LDA(dst, b, h) do { _Pragma("unroll") for (int m = 0; m < 4; ++m) _Pragma("unroll") for (int k = 0; k < 2; ++k) dst[m][k] = *(const PG8_LAS bf16x8*)(lds + PG8_SA(b, h) + aoff + m * 2048 + k * 1024); } while (0)
#define PG8_LDB(dst, b, h) do { _Pragma("unroll") for (int n = 0; n < 2; ++n) _Pragma("unroll") for (int k = 0; k < 2; ++k) dst[n][k] = *(const PG8_LAS bf16x8*)(lds + PG8_SB(b, h) + boff + n * 2048 + k * 1024); } while (0)
#define PG8_MMA(ai, bj, At, Bt) do { __builtin_amdgcn_s_setprio(1); _Pragma("unroll") for (int m = 0; m < 4; ++m) _Pragma("unroll") for (int n = 0; n < 2; ++n) _Pragma("unroll") for (int k = 0; k < 2; ++k) \
        acc[ai][bj][m][n] = __builtin_amdgcn_mfma_f32_16x16x32_bf16(Bt[n][k], At[m][k], acc[ai][bj][m][n], 0, 0, 0); __builtin_amdgcn_s_setprio(0); } while (0)
#define PG8_WAIT_V(n) asm volatile("s_waitcnt vmcnt(" #n ")" ::: "memory")
#define PG8_WAIT_L(n) asm volatile("s_waitcnt lgkmcnt(" #n ")" ::: "memory")
#define PG8_BAR __builtin_amdgcn_s_barrier()
#define PG8_SCHED __builtin_amdgcn_sched_barrier(0)
    Unit cur, nxt; int ui = 0;
    if (!S.next(0, cur)) return;
    f32x4 acc[2][2][4][2];
#pragma unroll
    for (int a = 0; a < 2; ++a)
#pragma unroll
        for (int b = 0; b < 2; ++b)
#pragma unroll
            for (int m = 0; m < 4; ++m)
#pragma unroll
                for (int n = 0; n < 2; ++n) acc[a][b][m][n] = (f32x4){0.f, 0.f, 0.f, 0.f};
    bf16x8 At[4][2], B0[2][2], B1[2][2];
    const char* cA = (const char*)(cur.seg ? g.A1 : g.A0) + (size_t)cur.pm * tstep; const char* cB = (const char*)(cur.seg ? g.B1 : g.B0) + (size_t)cur.pn * tstep;
    PG8_STAGE(PG8_SB(0, 0), cB, voffB); PG8_STAGE(PG8_SB(0, 1), cB + hstep, voffB); PG8_STAGE(PG8_SA(0, 0), cA, voffA); PG8_STAGE(PG8_SA(0, 1), cA + hstep, voffA);
    if (wr == 1) PG8_BAR;
    PG8_WAIT_V(2); PG8_BAR;
    PG8_STAGE(PG8_SB(1, 0), cB + kstep, voffB); PG8_STAGE(PG8_SA(1, 0), cA + kstep, voffA); PG8_STAGE(PG8_SB(1, 1), cB + hstep + kstep, voffB);
    PG8_WAIT_V(6); PG8_BAR;
    for (;;) {
        const bool has_next = S.next(ui + 1, nxt);
        const char* nA = has_next ? (const char*)(nxt.seg ? g.A1 : g.A0) + (size_t)nxt.pm * tstep : cA; const char* nB = has_next ? (const char*)(nxt.seg ? g.B1 : g.B0) + (size_t)nxt.pn * tstep : cB;
        for (int t = 0; t < nt; t += 2) {
            const bool last = (t == nt - 2);
            const char* a1 = cA + (size_t)(t + 1) * kstep;
            const char* a2 = last ? nA : cA + (size_t)(t + 2) * kstep; const char* b2 = last ? nB : cB + (size_t)(t + 2) * kstep;
            const char* a3 = a2 + kstep; const char* b3 = b2 + kstep;
            PG8_LDB(B0, 0, 0); PG8_LDB(B1, 0, 1); PG8_SCHED; PG8_LDA(At, 0, 0); PG8_STAGE(PG8_SA(1, 1), a1 + hstep, voffA);
            PG8_WAIT_V(8); PG8_WAIT_L(0); PG8_BAR; PG8_MMA(0, 0, At, B0); PG8_MMA(0, 1, At, B1); PG8_BAR; PG8_SCHED;
            PG8_LDA(At, 0, 1); PG8_STAGE(PG8_SB(0, 0), b2, voffB); PG8_STAGE(PG8_SB(0, 1), b2 + hstep, voffB); PG8_STAGE(PG8_SA(0, 0), a2, voffA);
            PG8_WAIT_V(8); PG8_WAIT_L(0); PG8_BAR; PG8_MMA(1, 0, At, B0); PG8_MMA(1, 1, At, B1); PG8_BAR; PG8_SCHED;
            PG8_LDB(B0, 1, 0); PG8_LDB(B1, 1, 1); PG8_SCHED; PG8_LDA(At, 1, 0); PG8_STAGE(PG8_SA(0, 1), a2 + hstep, voffA);
            PG8_WAIT_V(8); PG8_WAIT_L(0); PG8_BAR; PG8_MMA(0, 0, At, B0); PG8_MMA(0, 1, At, B1); PG8_BAR; PG8_SCHED;
            PG8_LDA(At, 1, 1); PG8_STAGE(PG8_SB(1, 0), b3, voffB); PG8_STAGE(PG8_SB(1, 1), b3 + hstep, voffB); PG8_STAGE(PG8_SA(1, 0), a3, voffA);
            PG8_WAIT_V(8); PG8_WAIT_L(0); PG8_BAR; PG8_MMA(1, 0, At, B0); PG8_MMA(1, 1, At, B1); PG8_BAR; PG8_SCHED;
        }
        if (wr == 0) PG8_BAR;
        const bool keep = E(acc, cur, wr, wc, fr, fq);
        if (!has_next) break;
        if (!keep) {
#pragma unroll
        for (int a = 0; a < 2; ++a)
#pragma unroll
            for (int b = 0; b < 2; ++b)
#pragma unroll
                for (int m = 0; m < 4; ++m)
#pragma unroll
                    for (int n = 0; n < 2; ++n) acc[a][b][m][n] = (f32x4){0.f, 0.f, 0.f, 0.f};
        }
        cur = nxt; cA = nA; cB = nB; ++ui;
        if (wr == 1) PG8_BAR;
    }
    PG8_WAIT_V(0);
    PG8_BAR;
#undef PG8_SA
#undef PG8_SB
#undef PG8_STAGE
#undef PG8_LDA
#undef PG8_LDB
#undef PG8_MMA
#undef PG8_WAIT_V
#undef PG8_WAIT_L
#undef PG8_BAR
#undef PG8_SCHED
}
}

constexpr int DM = 1024, NB = 16, SEQ = 4096, DECS = 16, NKV = 4, HD = 64, KVW = 256, INW = 5632, DFF = 2816;
constexpr int MP = NB * SEQ, MS = NB * DECS, MT = MP + MS;
constexpr float EPS = 1e-6f, LOG2E = 1.4426950408889634f, QSCALE = 0.125f * LOG2E;
constexpr size_t O_YP = 0, O_YS = (size_t)MP * DM, O_KP = O_YS + (size_t)MS * DM, O_VP = O_KP + 524288, O_KS = O_VP + 524288, O_VS = O_KS + 524288, O_GS = O_VS + 524288, O_END = O_GS + (size_t)MS * DM;

constexpr size_t MiB = 1u << 20;
constexpr size_t WS_CTL = 0, CTL_ZERO_BYTES = 1 * MiB;
constexpr size_t WS_WIN = 1 * MiB, WS_WFI = 12 * MiB, WS_WA = 23 * MiB, WS_WG = 25 * MiB, WS_WO = 27 * MiB, WS_WFO = 29 * MiB;
constexpr size_t WS_WSB = 34 * MiB + 512 * 1024;
constexpr size_t WS_RSTD1 = 35 * MiB, WS_RSTD2 = 36 * MiB, WS_PMIX = 37 * MiB, WS_PF = 42 * MiB;
constexpr size_t ACTB = (size_t)MT * DM * 2;
constexpr size_t WS_R0 = 48 * MiB;
constexpr size_t WS_R1 = 177 * MiB;
constexpr size_t WS_R2 = 306 * MiB;
constexpr size_t WS_KB = 435 * MiB, WS_VB = 468 * MiB;
constexpr size_t WS_R3 = 501 * MiB;
constexpr size_t WS_SA = WS_R3, WS_SB = WS_R3 + ACTB, WS_U = WS_R3 + 2 * ACTB, WS_AO = WS_R3 + 3 * ACTB, WS_END = WS_AO + ACTB;
static_assert(WS_END <= 1024 * MiB && (size_t)MT * DFF * 2 <= 3 * ACTB && WS_R0 + ACTB <= WS_R1 && WS_R1 + ACTB <= WS_R2 && WS_R2 + ACTB <= WS_KB, "d_ws map");
constexpr int CW_BAR = 4096;

constexpr int RING_BYTES = 131072, LDS_BYTES = 147456, LDSCTL_OFF = LDS_BYTES - 512, MISC_OFF = LDSCTL_OFF + 320;
constexpr int NWAVES = 8;

#define GAS __attribute__((address_space(1)))
#define LAS __attribute__((address_space(3)))
typedef unsigned short bf16;
typedef unsigned v4u __attribute__((ext_vector_type(4)));
typedef unsigned v2u __attribute__((ext_vector_type(2)));
typedef float f32x4 __attribute__((ext_vector_type(4)));
typedef GAS unsigned gu32;
#define RLX_AGENT __ATOMIC_RELAXED, __HIP_MEMORY_SCOPE_AGENT
#define LDS_WAIT() asm volatile("s_waitcnt lgkmcnt(0)" ::: "memory")
typedef float f32x2_t __attribute__((ext_vector_type(2))); typedef __bf16 bf16x2_t __attribute__((ext_vector_type(2)));
__device__ __forceinline__ unsigned pk2(float lo, float hi) { f32x2_t v = {lo, hi}; bf16x2_t b = __builtin_convertvector(v, bf16x2_t); return __builtin_bit_cast(unsigned, b); }
__device__ __forceinline__ float bflo(unsigned w) { return __uint_as_float(w << 16); }
__device__ __forceinline__ float bfhi(unsigned w) { return __uint_as_float(w & 0xffff0000u); }
__device__ __forceinline__ float wave_sum(float v) {
#pragma unroll
    for (int o = 1; o < 64; o <<= 1) v += __shfl_xor(v, o);
    return v;
}
__device__ __forceinline__ float gelu_tanh(float x) {
    const float e = __builtin_amdgcn_exp2f(x * (-2.302208198f - 0.10294324f * x * x));
    return x * __builtin_amdgcn_rcpf(1.0f + e);
}
__device__ __forceinline__ float sigmoidf_(float x) { return __builtin_amdgcn_rcpf(1.0f + __builtin_amdgcn_exp2f(-LOG2E * x)); }

#define XB_TMO      128
#define XB_XCNT(j)  (256  + 64 * (j))
#define XB_XSUB(j)  (1280 + 64 * (j))
#define XB_XGEN(j)  (2304 + 64 * (j))
#define XB_TOP      3328
#define XB_TOPGEN   3392
#define XCD_BAR_WORDS 3456
#define XB_SPIN_CAP (1u << 18)
__device__ __forceinline__ unsigned xb_ld(unsigned* p)              { return __hip_atomic_load(p, __ATOMIC_RELAXED, __HIP_MEMORY_SCOPE_AGENT); }
__device__ __forceinline__ unsigned xb_add(unsigned* p, unsigned v) { return __hip_atomic_fetch_add(p, v, __ATOMIC_RELAXED, __HIP_MEMORY_SCOPE_AGENT); }
__device__ __forceinline__ unsigned xb_xcc_id() { return (unsigned)__builtin_amdgcn_s_getreg((3 << 11) | 20) & 0xFu; }
#define XB_SPIN(cond, bar) do { unsigned _sp = 0; while (cond) { __builtin_amdgcn_s_sleep(1); \
    if ((++_sp & 255u) == 0u) { if (xb_ld(&(bar)[XB_TMO])) break; if (_sp > XB_SPIN_CAP) { atomicAdd(&(bar)[XB_TMO], 1u); break; } } } } while (0)
struct XcdBarrier { unsigned* bar; unsigned x; volatile LAS unsigned* st; };
__device__ __forceinline__ XcdBarrier xcd_barrier_post(unsigned* bar, volatile LAS unsigned* st) {
    XcdBarrier b; b.bar = bar; b.x = xb_xcc_id(); b.st = st;
    if (threadIdx.x == 0) (void)xb_add(&bar[XB_XCNT(b.x)], 1u);
    return b;
}
__device__ __forceinline__ void xcd_barrier_complete(unsigned* bar, unsigned x, unsigned& nloc, unsigned& nx) {
    const unsigned G = gridDim.x * gridDim.y * gridDim.z;
    unsigned sum, cnt, mine, sp = 0u;
    for (;;) {
        sum = 0u; cnt = 0u; mine = 0u;
#pragma unroll
        for (unsigned j = 0; j < 16; ++j) { const unsigned c = xb_ld(&bar[XB_XCNT(j)]); sum += c; cnt += (c > 0u) ? 1u : 0u; mine = (j == x) ? c : mine; }
        if (sum == G) break;
        __builtin_amdgcn_s_sleep(1);
        if ((++sp & 255u) == 0u) { if (xb_ld(&bar[XB_TMO])) break; if (sp > XB_SPIN_CAP) { atomicAdd(&bar[XB_TMO], 1u); break; } }
    }
    nloc = mine > 0u ? mine : 1u; nx = cnt > 0u ? cnt : 1u;
}
__device__ __forceinline__ void xcd_barrier(const XcdBarrier& b) {
    asm volatile("s_waitcnt vmcnt(0)" ::: "memory");
    __syncthreads();
    if (threadIdx.x == 0) {
        unsigned* bar = b.bar;
        __builtin_amdgcn_s_waitcnt(0);
        unsigned nloc = b.st[0], nx = b.st[1];
        if (nloc == 0u) { xcd_barrier_complete(bar, b.x, nloc, nx); b.st[0] = nloc; b.st[1] = nx; }
        const unsigned old = xb_add(&bar[XB_XSUB(b.x)], 1u);
        const unsigned gen = old / nloc;
        if (old + 1u == (gen + 1u) * nloc) {
            __builtin_amdgcn_fence(__ATOMIC_RELEASE, "agent");
            asm volatile("s_waitcnt vmcnt(0)" ::: "memory");
            const unsigned og = xb_add(&bar[XB_TOP], 1u);
            const unsigned tg = og / nx;
            if (og + 1u == (tg + 1u) * nx) xb_add(&bar[XB_TOPGEN], 1u);
            else XB_SPIN(xb_ld(&bar[XB_TOPGEN]) == tg, bar);
            __builtin_amdgcn_fence(__ATOMIC_ACQUIRE, "agent");
            xb_add(&bar[XB_XGEN(b.x)], 1u);
            asm volatile("s_waitcnt vmcnt(0)" ::: "memory");
        } else {
            XB_SPIN(xb_ld(&bar[XB_XGEN(b.x)]) == gen, bar);
            __builtin_amdgcn_fence(__ATOMIC_ACQUIRE, "agent");
            asm volatile("s_waitcnt vmcnt(0)" ::: "memory");
        }
    }
    __syncthreads();
}

using pg8::Unit;
struct EpiIn {
    static constexpr bool PERM = true;
    const float* rstd; bf16 *Q, *Kb, *Vb, *U, *GV, *SA, *SB; float* out;
    __device__ __forceinline__ bool operator()(f32x4 (&acc)[2][2][4][2], const Unit& u, int wr, int wc, int fr, int fq) const {
        const int pn = u.pn; int mode, ld, colt; bf16* dst; float* side = nullptr; size_t side_s = 0;
        if (pn < 4)       { mode = 0; dst = Q;  ld = DM;  colt = pn * 256; }
        else if (pn == 4) { mode = 1; dst = Kb; ld = KVW; colt = 0; side = out + O_KP; side_s = O_KS - O_KP; }
        else if (pn == 5) { mode = 1; dst = Vb; ld = KVW; colt = 0; side = out + O_VP; side_s = O_VS - O_VP; }
        else if (pn < 10) { mode = 2; dst = U;  ld = DM;  colt = (pn - 6) * 256; }
        else if (pn < 14) { mode = 2; dst = GV; ld = DM;  colt = (pn - 10) * 256; }
        else if (pn < 18) { mode = 3; dst = SA; ld = DM;  colt = (pn - 14) * 256; }
        else              { mode = 3; dst = SB; ld = DM;  colt = (pn - 18) * 256; }
        const int row0 = u.pm * 256 + wr * 64 + fr, col0 = colt + wc * 32 + 8 * fq;
#pragma unroll
        for (int ai = 0; ai < 2; ++ai)
#pragma unroll
            for (int m = 0; m < 4; ++m) {
                const int row = row0 + ai * 128 + m * 16; const float rs = rstd[row];
#pragma unroll
                for (int bj = 0; bj < 2; ++bj) {
                    float v[8];
#pragma unroll
                    for (int j = 0; j < 4; ++j) { v[j] = acc[ai][bj][m][0][j] * rs; v[4 + j] = acc[ai][bj][m][1][j] * rs; }
                    if (mode == 0) {
#pragma unroll
                        for (int j = 0; j < 8; ++j) v[j] *= QSCALE;
                    } else if (mode == 2) {
#pragma unroll
                        for (int j = 0; j < 8; ++j) v[j] = gelu_tanh(v[j]);
                    } else if (mode == 3) {
#pragma unroll
                        for (int j = 0; j < 8; ++j) v[j] = sigmoidf_(v[j]);
                    }
                    const int col = col0 + bj * 128;
                    v4u w; w.x = pk2(v[0], v[1]); w.y = pk2(v[2], v[3]); w.z = pk2(v[4], v[5]); w.w = pk2(v[6], v[7]);
                    *(v4u*)(dst + (size_t)row * ld + col) = w;
                    if (mode == 1) {
                        float* sp = nullptr;
                        if (u.pm == 256) { const int r = row - MP; sp = side + side_s + ((size_t)((r >> 4) * 128 + 112 + (r & 15)) * KVW + col); }
                        else if ((u.pm & 15) == 15 && ai == 1) { const int j = wr * 64 + m * 16 + fr; sp = side + ((size_t)((u.pm >> 4) * 128 + j) * KVW + col); }
                        if (sp) { *(f32x4*)sp = (f32x4){v[0], v[1], v[2], v[3]}; *(f32x4*)(sp + 4) = (f32x4){v[4], v[5], v[6], v[7]}; }
                    }
                }
            }
        return false;
    }
};
struct EpiMerge {
    static constexpr bool PERM = true;
    const bf16 *SA, *SB; bf16* O;
    __device__ __forceinline__ bool operator()(f32x4 (&acc)[2][2][4][2], const Unit& u, int wr, int wc, int fr, int fq) const {
        const int row0 = u.pm * 256 + wr * 64 + fr, col0 = u.pn * 256 + wc * 32 + 8 * fq;
#pragma unroll
        for (int ai = 0; ai < 2; ++ai)
#pragma unroll
            for (int m = 0; m < 4; ++m)
#pragma unroll
                for (int bj = 0; bj < 2; ++bj) {
                    const size_t off = (size_t)(row0 + ai * 128 + m * 16) * DM + col0 + bj * 128;
                    const v4u sbw = *(const v4u*)(SB + off);
                    float sb[8] = {bflo(sbw.x), bfhi(sbw.x), bflo(sbw.y), bfhi(sbw.y), bflo(sbw.z), bfhi(sbw.z), bflo(sbw.w), bfhi(sbw.w)};
#pragma unroll
                    for (int j = 0; j < 8; ++j) sb[j] = fmaxf(sb[j], 1e-30f);
                    if (u.seg == 0) {
                        const v4u saw = *(const v4u*)(SA + off);
                        const float sa[8] = {bflo(saw.x), bfhi(saw.x), bflo(saw.y), bfhi(saw.y), bflo(saw.z), bfhi(saw.z), bflo(saw.w), bfhi(saw.w)};
#pragma unroll
                        for (int j = 0; j < 4; ++j) { acc[ai][bj][m][0][j] *= sa[j] * __builtin_amdgcn_rcpf(sb[j]); acc[ai][bj][m][1][j] *= sa[4 + j] * __builtin_amdgcn_rcpf(sb[4 + j]); }
                    } else {
                        float v[8];
#pragma unroll
                        for (int j = 0; j < 4; ++j) { v[j] = acc[ai][bj][m][0][j] * sb[j]; v[4 + j] = acc[ai][bj][m][1][j] * sb[4 + j]; }
                        v4u w; w.x = pk2(v[0], v[1]); w.y = pk2(v[2], v[3]); w.z = pk2(v[4], v[5]); w.w = pk2(v[6], v[7]);
                        *(v4u*)(O + off) = w;
                    }
                }
        return u.seg == 0;
    }
};
struct EpiBf16Ss {
    static constexpr bool PERM = true;
    bf16* O; float* P;
    __device__ __forceinline__ bool operator()(f32x4 (&acc)[2][2][4][2], const Unit& u, int wr, int wc, int fr, int fq) const {
        const int row0 = u.pm * 256 + wr * 64 + fr, col0 = u.pn * 256 + wc * 32 + 8 * fq;
#pragma unroll
        for (int ai = 0; ai < 2; ++ai)
#pragma unroll
            for (int m = 0; m < 4; ++m) {
                const int row = row0 + ai * 128 + m * 16; float ss = 0.f;
#pragma unroll
                for (int bj = 0; bj < 2; ++bj) {
                    const f32x4 a = acc[ai][bj][m][0], b = acc[ai][bj][m][1];
                    ss += (a[0] * a[0] + a[1] * a[1]) + (a[2] * a[2] + a[3] * a[3]) + (b[0] * b[0] + b[1] * b[1]) + (b[2] * b[2] + b[3] * b[3]);
                    v4u w; w.x = pk2(a[0], a[1]); w.y = pk2(a[2], a[3]); w.z = pk2(b[0], b[1]); w.w = pk2(b[2], b[3]);
                    *(v4u*)(O + (size_t)row * DM + col0 + bj * 128) = w;
                }
                ss += __shfl_xor(ss, 16); ss += __shfl_xor(ss, 32);
                if (fq == 0) P[(size_t)(u.pn * 4 + wc) * MT + row] = ss;
            }
        return false;
    }
};
struct EpiSwiglu {
    static constexpr bool PERM = true;
    const float* rstd; bf16* O;
    __device__ __forceinline__ bool operator()(f32x4 (&acc)[2][2][4][2], const Unit& u, int wr, int wc, int fr, int fq) const {
        const int row0 = u.pm * 256 + wr * 64 + fr, col0 = u.pn * 128 + wc * 32 + 8 * fq;
#pragma unroll
        for (int ai = 0; ai < 2; ++ai)
#pragma unroll
            for (int m = 0; m < 4; ++m) {
                const int row = row0 + ai * 128 + m * 16; const float rs = rstd[row]; float v[8];
#pragma unroll
                for (int n = 0; n < 2; ++n)
#pragma unroll
                    for (int j = 0; j < 4; ++j) { const float gg = acc[ai][0][m][n][j] * rs, up = acc[ai][1][m][n][j] * rs; v[4 * n + j] = gg * sigmoidf_(gg) * up; }
                v4u w; w.x = pk2(v[0], v[1]); w.y = pk2(v[2], v[3]); w.z = pk2(v[4], v[5]); w.w = pk2(v[6], v[7]);
                *(v4u*)(O + (size_t)row * DFF + col0) = w;
            }
        return false;
    }
};

template <bool MAP>
__device__ __forceinline__ void p0_transpose_item(const float* W, int K, int N, const float* gain, bf16* WT, LAS float* scr, int item, int lane) {
    const int nblk = N / 32, kb = item / nblk, nb = item % nblk, k0 = 64 * kb, n0 = 32 * nb;
#pragma unroll 8
    for (int i = 0; i < 32; ++i) { const int kk = 2 * i + (lane >> 5); const float gk = gain ? gain[k0 + kk] : 1.0f; scr[kk * 33 + (lane & 31)] = W[(size_t)(k0 + kk) * N + n0 + (lane & 31)] * gk; }
    LDS_WAIT(); asm volatile("" ::: "memory");
    const int c = lane & 7;
#pragma unroll
    for (int j = 0; j < 4; ++j) { const int n = (lane >> 3) + 8 * j; const LAS float* s = scr + (8 * c) * 33 + n;
        v4u o; o.x = pk2(s[0 * 33], s[1 * 33]); o.y = pk2(s[2 * 33], s[3 * 33]); o.z = pk2(s[4 * 33], s[5 * 33]); o.w = pk2(s[6 * 33], s[7 * 33]);
        int nn = n0 + n;
        if (MAP) { const int hi = nn >= DFF ? 1 : 0, r = nn - hi * DFF; nn = 256 * (r >> 7) + 128 * hi + (r & 127); }
        *(GAS v4u*)(WT + (size_t)nn * K + k0 + 8 * c) = o; }
    LDS_WAIT(); asm volatile("" ::: "memory");
}

namespace att {
typedef short bf16x8 __attribute__((ext_vector_type(8)));
typedef short s16x4 __attribute__((ext_vector_type(4)));
typedef short v4i16_t __attribute__((ext_vector_type(4)));
typedef float f32x16 __attribute__((ext_vector_type(16)));
typedef LAS const char* lds_cptr;
constexpr int SLOT = 16384, OST = 4 * SLOT;
__device__ __forceinline__ int crow(int r, int hi) { return (r & 3) + 8 * (r >> 2) + 4 * hi; }
__device__ __forceinline__ s16x4 vtr(lds_cptr p) { return __builtin_bit_cast(s16x4, __builtin_amdgcn_ds_read_tr16_b64_v4i16((LAS v4i16_t*)p)); }
struct TileRegs { v4u k, v; };
__device__ __forceinline__ TileRegs load_tile(const bf16* KB, const bf16* VB, size_t rowbase, int kvh, int wid, int lane) {
    TileRegs t;
    t.k = *(const v4u*)(KB + (rowbase + lane) * KVW + kvh * HD + wid * 8);
    t.v = *(const v4u*)(VB + (rowbase + 16 * (wid & 3) + (lane >> 2)) * KVW + kvh * HD + (wid >> 2) * 32 + (lane & 3) * 8);
    return t;
}
__device__ __forceinline__ void store_tile(LAS unsigned char* slot, const TileRegs& t, int wid, int lane) {
    *(LAS v4u*)(slot + wid * 1024 + lane * 16) = t.k;
    *(LAS v4u*)(slot + 8192 + wid * 1024 + lane * 16) = t.v;
}
template <bool SAMPLE>
__device__ __forceinline__ void attn_unit(LAS unsigned char* lds, int s0, int s1, int s2, int ft, const bf16* QO, bf16* AO, size_t qrow0, int kvh, const float* sinks, int wid, int lane) {
    const int r32 = lane & 31, hi = lane >> 5, g = wid >> 1, posb = 32 * (wid & 1), head = kvh * 4 + g;
    const size_t qrow = SAMPLE ? qrow0 + ((posb + r32) & 15) : qrow0 + posb + r32;
    const bf16* qp = QO + qrow * DM + head * HD;
    bf16x8 qr[4];
#pragma unroll
    for (int d0 = 0; d0 < 4; ++d0) qr[d0] = *(const bf16x8*)(qp + d0 * 16 + hi * 8);
    const float sink2 = sinks[head] * LOG2E;
    f32x16 p[6];
#pragma unroll
    for (int ti = 0; ti < 3; ++ti) {
        if (ti >= ft) {
            const int so = (ti == 0) ? s0 : (ti == 1) ? s1 : s2;
            lds_cptr kb = (lds_cptr)lds + so + hi * 1024 + r32 * 16;
            f32x16 a = {}, c = {};
#pragma unroll
            for (int d0 = 0; d0 < 4; ++d0) {
                const bf16x8 b0 = *(const LAS bf16x8*)(kb + d0 * 2048), b1 = *(const LAS bf16x8*)(kb + d0 * 2048 + 512);
                a = __builtin_amdgcn_mfma_f32_32x32x16_bf16(b0, qr[d0], a, 0, 0, 0); c = __builtin_amdgcn_mfma_f32_32x32x16_bf16(b1, qr[d0], c, 0, 0, 0);
            }
            p[2 * ti] = a; p[2 * ti + 1] = c;
        } else {
#pragma unroll
            for (int r = 0; r < 16; ++r) { p[2 * ti][r] = -INFINITY; p[2 * ti + 1][r] = -INFINITY; }
        }
    }
    if (SAMPLE) {
#pragma unroll
        for (int r = 0; r < 16; ++r) { if (r >= 8) p[4][r] = -INFINITY; p[5][r] = -INFINITY; }
    }
    float mx = sink2;
#pragma unroll
    for (int kb = 0; kb < 6; ++kb)
#pragma unroll
        for (int r = 0; r < 16; ++r) mx = fmaxf(mx, p[kb][r]);
    { auto rr = __builtin_amdgcn_permlane32_swap(__float_as_uint(mx), __float_as_uint(mx), false, false); mx = fmaxf(__uint_as_float(rr[0]), __uint_as_float(rr[1])); }
    float sum = 0.f;
#pragma unroll
    for (int kb = 0; kb < 6; ++kb)
#pragma unroll
        for (int r = 0; r < 16; ++r) { p[kb][r] = __builtin_amdgcn_exp2f(p[kb][r] - mx); sum += p[kb][r]; }
    { auto rr = __builtin_amdgcn_permlane32_swap(__float_as_uint(sum), __float_as_uint(sum), false, false); sum = __uint_as_float(rr[0]) + __uint_as_float(rr[1]); }
    const float inv = 1.0f / (sum + __builtin_amdgcn_exp2f(sink2 - mx));
    f32x16 o0 = {}, o1 = {};
    const int vb = ((lane >> 4) & 1) * 32 + (lane & 3) * 8 + (4 * hi + ((lane & 15) >> 2)) * 64;
#pragma unroll
    for (int ti = 0; ti < 3; ++ti) {
        if (ti >= ft) {
            const int so = (ti == 0) ? s0 : (ti == 1) ? s1 : s2;
            lds_cptr vp = (lds_cptr)lds + so + 8192 + vb;
#pragma unroll
            for (int ks = 0; ks < 4; ++ks) {
                const int kb = 2 * ti + (ks >> 1), rb = 8 * (ks & 1);
                v4u pw; pw.x = pk2(p[kb][rb + 0] * inv, p[kb][rb + 1] * inv); pw.y = pk2(p[kb][rb + 2] * inv, p[kb][rb + 3] * inv); pw.z = pk2(p[kb][rb + 4] * inv, p[kb][rb + 5] * inv); pw.w = pk2(p[kb][rb + 6] * inv, p[kb][rb + 7] * inv);
                const bf16x8 pa = __builtin_bit_cast(bf16x8, pw);
                { const s16x4 lo = vtr(vp + ks * 1024), h4 = vtr(vp + ks * 1024 + 512); const bf16x8 vf = (bf16x8){lo[0], lo[1], lo[2], lo[3], h4[0], h4[1], h4[2], h4[3]};
                  o0 = __builtin_amdgcn_mfma_f32_32x32x16_bf16(pa, vf, o0, 0, 0, 0); }
                { const s16x4 lo = vtr(vp + 4096 + ks * 1024), h4 = vtr(vp + 4096 + ks * 1024 + 512); const bf16x8 vf = (bf16x8){lo[0], lo[1], lo[2], lo[3], h4[0], h4[1], h4[2], h4[3]};
                  o1 = __builtin_amdgcn_mfma_f32_32x32x16_bf16(pa, vf, o1, 0, 0, 0); }
            }
        }
    }
    LAS bf16* stg = (LAS bf16*)(lds + OST + wid * 4096);
#pragma unroll
    for (int r = 0; r < 16; ++r) { const int orow = crow(r, hi); stg[orow * 64 + r32] = (bf16)(pk2(o0[r], 0.f) & 0xffffu); stg[orow * 64 + 32 + r32] = (bf16)(pk2(o1[r], 0.f) & 0xffffu); }
    LDS_WAIT();
#pragma unroll
    for (int i = 0; i < 4; ++i) { const int row = i * 8 + (lane >> 3), ch = lane & 7; const v4u v = *(const LAS v4u*)(stg + row * 64 + ch * 8);
        if (!SAMPLE || posb + row < 16) *(v4u*)(AO + (qrow0 + posb + row) * DM + head * HD + ch * 8) = v; }
    LDS_WAIT();
}
}

namespace gat {
using att::bf16x8; using att::s16x4; using att::f32x16; using att::lds_cptr; using att::vtr; using att::crow;
template <bool SAMPLE>
__device__ __forceinline__ void gate_unit(LAS unsigned char* lds, const bf16* GV, bf16* UB, const bf16* WSB, const float* ln_g, const float* ln_b, const float* b_s, float* gs_out, size_t row0, int tid, int wave, int lane) {
    constexpr int L = SAMPLE ? 16 : 128;
    LAS float* stats = (LAS float*)lds; LAS unsigned char* img = lds + 1024;
    const int r32 = lane & 31, hi = lane >> 5;
    __syncthreads();
    for (int rr = 0; rr < 16; ++rr) { const int r = wave * 16 + rr;
        if (r < L) {
            const bf16* gp = GV + (row0 + r) * DM + 8 * lane; const v4u w0 = *(const v4u*)gp, w1 = *(const v4u*)(gp + 512);
            const float v[16] = {bflo(w0.x), bfhi(w0.x), bflo(w0.y), bfhi(w0.y), bflo(w0.z), bfhi(w0.z), bflo(w0.w), bfhi(w0.w), bflo(w1.x), bfhi(w1.x), bflo(w1.y), bfhi(w1.y), bflo(w1.z), bfhi(w1.z), bflo(w1.w), bfhi(w1.w)};
            float s = 0.f;
#pragma unroll
            for (int j = 0; j < 16; ++j) s += v[j];
            const float mean = wave_sum(s) * (1.0f / DM); float q = 0.f;
#pragma unroll
            for (int j = 0; j < 16; ++j) { const float d = v[j] - mean; q += d * d; }
            const float rstd = 1.0f / sqrtf(wave_sum(q) * (1.0f / DM) + EPS);
            if (lane == 0) { stats[2 * r] = mean; stats[2 * r + 1] = rstd; }
        }
    }
    __syncthreads();
    const int pp = wave & 1, cq = wave >> 1;
    const int vb = ((lane >> 4) & 1) * 32 + (lane & 3) * 8 + (4 * hi + ((lane & 15) >> 2)) * 64;
    for (int g = 0; g < 4; ++g) {
        for (int i = 0; i < 8; ++i) { const int idx = tid + 512 * i, r = idx >> 5, ch = idx & 31, c = ch * 8, col = g * 256 + c; v4u w = {0u, 0u, 0u, 0u};
            if (r < L) {
                const v4u x = *(const v4u*)(GV + (row0 + r) * DM + col); const float mean = stats[2 * r], rstd = stats[2 * r + 1];
                const f32x4 g0 = *(const f32x4*)(ln_g + col), g1 = *(const f32x4*)(ln_g + col + 4), b0 = *(const f32x4*)(ln_b + col), b1 = *(const f32x4*)(ln_b + col + 4);
                float v[8] = {bflo(x.x), bfhi(x.x), bflo(x.y), bfhi(x.y), bflo(x.z), bfhi(x.z), bflo(x.w), bfhi(x.w)};
                v[0] = (v[0] - mean) * rstd * g0.x + b0.x; v[1] = (v[1] - mean) * rstd * g0.y + b0.y; v[2] = (v[2] - mean) * rstd * g0.z + b0.z; v[3] = (v[3] - mean) * rstd * g0.w + b0.w;
                v[4] = (v[4] - mean) * rstd * g1.x + b1.x; v[5] = (v[5] - mean) * rstd * g1.y + b1.y; v[6] = (v[6] - mean) * rstd * g1.z + b1.z; v[7] = (v[7] - mean) * rstd * g1.w + b1.w;
                if (SAMPLE) { float* gs = gs_out + (size_t)r * DM + col; *(f32x4*)gs = (f32x4){v[0], v[1], v[2], v[3]}; *(f32x4*)(gs + 4) = (f32x4){v[4], v[5], v[6], v[7]}; }
                w.x = pk2(v[0], v[1]); w.y = pk2(v[2], v[3]); w.z = pk2(v[4], v[5]); w.w = pk2(v[6], v[7]);
            }
            *(LAS v4u*)(img + ((c >> 5) * 8 + (r >> 4)) * 1024 + (r & 15) * 64 + (c & 31) * 2) = w; }
        __syncthreads();
        f32x16 o[2][2];
#pragma unroll
        for (int a = 0; a < 2; ++a)
#pragma unroll
            for (int c = 0; c < 2; ++c) o[a][c] = (f32x16){};
#pragma unroll
        for (int tsel = 0; tsel < 2; ++tsel) {
            const int tb = tsel ? 3 - pp : pp, nks = 2 * (tb + 1);
            const bf16* wrow = WSB + ((size_t)(g * 128 + 32 * tb + r32) * 128 + hi * 8);
            for (int ks = 0; ks < nks; ++ks) {
                const bf16x8 a = *(const bf16x8*)(wrow + ks * 16);
#pragma unroll
                for (int cs = 0; cs < 2; ++cs) {
                    lds_cptr vp = (lds_cptr)img + ((2 * cq + cs) * 8 + ks) * 1024 + vb;
                    const s16x4 lo = vtr(vp), h4 = vtr(vp + 512); const bf16x8 vf = (bf16x8){lo[0], lo[1], lo[2], lo[3], h4[0], h4[1], h4[2], h4[3]};
                    o[tsel][cs] = __builtin_amdgcn_mfma_f32_32x32x16_bf16(a, vf, o[tsel][cs], 0, 0, 0);
                }
            }
        }
        LAS float* stg = (LAS float*)(lds + 1024 + 65536 + wave * 8704);
#pragma unroll
        for (int tsel = 0; tsel < 2; ++tsel) {
            const int tb = tsel ? 3 - pp : pp;
#pragma unroll
            for (int r = 0; r < 16; ++r) { const int row = crow(r, hi); stg[row * 68 + r32] = o[tsel][0][r]; stg[row * 68 + 32 + r32] = o[tsel][1][r]; }
            LDS_WAIT();
#pragma unroll
            for (int i = 0; i < 4; ++i) { const int row = i * 8 + (lane >> 3), ch0 = (lane & 7) * 8, t = 32 * tb + row;
                if (t < L) {
                    const f32x4 m0 = *(const LAS f32x4*)(stg + row * 68 + ch0), m1 = *(const LAS f32x4*)(stg + row * 68 + ch0 + 4); const float bias = b_s[g * 128 + t];
                    bf16* up = UB + (row0 + t) * DM + g * 256 + 64 * cq + ch0; const v4u uw = *(const v4u*)up; v4u w;
                    w.x = pk2(bflo(uw.x) * (m0.x + bias), bfhi(uw.x) * (m0.y + bias)); w.y = pk2(bflo(uw.y) * (m0.z + bias), bfhi(uw.y) * (m0.w + bias));
                    w.z = pk2(bflo(uw.z) * (m1.x + bias), bfhi(uw.z) * (m1.y + bias)); w.w = pk2(bflo(uw.w) * (m1.z + bias), bfhi(uw.w) * (m1.w + bias));
                    *(v4u*)up = w;
                }
            }
            LDS_WAIT();
        }
        __syncthreads();
    }
}
}

struct Args { const float* in[19]; float* out; unsigned char* ws; int ph_lo, ph_hi; };

__global__ void __launch_bounds__(NWAVES * 64, 2) fwd_kernel(Args args) {
    extern __shared__ __attribute__((aligned(16))) unsigned char lds_raw[];
    LAS unsigned char* lds = (LAS unsigned char*)lds_raw;
    volatile LAS unsigned* MISC = (volatile LAS unsigned*)(lds + MISC_OFF);
    const int tid = threadIdx.x, lane = tid & 63, wave = __builtin_amdgcn_readfirstlane(tid >> 6);
    const int G = gridDim.x;
    const int vcu = (G % 8 == 0) ? ((int)blockIdx.x % 8) * (G / 8) + (int)blockIdx.x / 8 : (int)blockIdx.x;
    unsigned char* ws = args.ws;
    const float* xp = args.in[0]; const float* xs = args.in[1]; const float* cache_k = args.in[2]; const float* cache_v = args.in[3];
    const float* g_pre_mix = args.in[4]; const float* g_post_mix = args.in[5]; const float* g_pre_ffn = args.in[6]; const float* g_post_ffn = args.in[7];
    const float* w_in = args.in[8]; const float* sinks = args.in[9]; const float* ln_g = args.in[10]; const float* ln_b = args.in[11];
    const float* w_s = args.in[12]; const float* b_s = args.in[13]; const float* w_ap = args.in[14]; const float* w_gp = args.in[15];
    const float* w_out = args.in[16]; const float* w_fi = args.in[17]; const float* w_fo = args.in[18];
    float* out = args.out;
    bf16* WinT = (bf16*)(ws + WS_WIN); bf16* WfiT = (bf16*)(ws + WS_WFI); bf16* WaT = (bf16*)(ws + WS_WA); bf16* WgT = (bf16*)(ws + WS_WG); bf16* WoT = (bf16*)(ws + WS_WO); bf16* WfoT = (bf16*)(ws + WS_WFO); bf16* WSB = (bf16*)(ws + WS_WSB);
    float* RSTD1 = (float*)(ws + WS_RSTD1); float* RSTD2 = (float*)(ws + WS_RSTD2); float* PMIX = (float*)(ws + WS_PMIX); float* PF = (float*)(ws + WS_PF);
    bf16* XB = (bf16*)(ws + WS_R0); bf16* FB = XB;
    bf16* QB = (bf16*)(ws + WS_R1); bf16* MERGED = QB; bf16* X1B = QB;
    bf16* GV = (bf16*)(ws + WS_R2); bf16* MIX = GV;
    bf16* KB = (bf16*)(ws + WS_KB); bf16* VB = (bf16*)(ws + WS_VB);
    bf16* SA = (bf16*)(ws + WS_SA); bf16* SB = (bf16*)(ws + WS_SB); bf16* UB = (bf16*)(ws + WS_U); bf16* ACT = (bf16*)(ws + WS_R3); bf16* AO = (bf16*)(ws + WS_AO);

    for (int u = tid; u < (LDS_BYTES - LDSCTL_OFF) / 4; u += NWAVES * 64) ((LAS unsigned*)(lds + LDSCTL_OFF))[u] = 0u;
    __syncthreads();
    XcdBarrier bar; bar.bar = (unsigned*)(ws + WS_CTL) + CW_BAR; bar.x = 0; bar.st = nullptr;
    if (MK_ONE_LAUNCH) bar = xcd_barrier_post((unsigned*)(ws + WS_CTL) + CW_BAR, MISC + 8);
    const int lo = args.ph_lo, hi = args.ph_hi;
#ifndef PH_MASK
#define PH_MASK 0x1ff
#endif
#define IN(k) (((PH_MASK >> (k)) & 1) && lo <= (k) && (k) < hi)
#define SEAM(k) do { if (MK_ONE_LAUNCH && IN(k) && IN((k) + 1)) xcd_barrier(bar); } while (0)
    const int gw = vcu * NWAVES + wave, NGW = G * NWAVES;

    if (IN(0)) for (int rep_ = 0; rep_ < NREP(0); ++rep_) {
        LAS float* scr = (LAS float*)(lds + wave * 16384);
        constexpr int I_IN = (DM / 64) * (INW / 32), I_SQ = (DM / 64) * (DM / 32), I_FO = (DFF / 64) * (DM / 32);
        constexpr int NITEMS = 2 * I_IN + 3 * I_SQ + I_FO;
        for (int it = gw; it < NITEMS; it += NGW) {
            int r = it;
            if (r < I_IN) { p0_transpose_item<false>(w_in, DM, INW, g_pre_mix, WinT, scr, r, lane); continue; } r -= I_IN;
            if (r < I_IN) { p0_transpose_item<true>(w_fi, DM, INW, g_pre_ffn, WfiT, scr, r, lane); continue; } r -= I_IN;
            if (r < I_SQ) { p0_transpose_item<false>(w_ap, DM, DM, nullptr, WaT, scr, r, lane); continue; } r -= I_SQ;
            if (r < I_SQ) { p0_transpose_item<false>(w_gp, DM, DM, nullptr, WgT, scr, r, lane); continue; } r -= I_SQ;
            if (r < I_SQ) { p0_transpose_item<false>(w_out, DM, DM, nullptr, WoT, scr, r, lane); continue; } r -= I_SQ;
            p0_transpose_item<false>(w_fo, DFF, DM, nullptr, WfoT, scr, r, lane);
        }
        for (int i = gw * 64 + lane; i < 4 * 128 * 128; i += NGW * 64) {
            const int t = (i >> 7) & 127, pp = i & 127, pl = pp & 15, sl = (pl & 3) | ((pl & 4) << 1) | ((pl & 8) >> 1), sidx = (pp & ~15) + sl;
            const float v = (sidx <= t) ? w_s[(size_t)(i & ~127) + sidx] : 0.f;
            WSB[i] = (bf16)(pk2(v, 0.f) & 0xffffu);
        }
        for (int m = gw; m < MT; m += NGW) {
            const float* xrow = (m < MP) ? xp + (size_t)m * DM : xs + (size_t)(m - MP) * DM;
            const GAS f32x4* xr = (const GAS f32x4*)xrow + lane;
            f32x4 v[4]; float s = 0.f;
#pragma unroll
            for (int j = 0; j < 4; ++j) { v[j] = xr[64 * j]; s += (v[j].x * v[j].x + v[j].y * v[j].y) + (v[j].z * v[j].z + v[j].w * v[j].w); }
            s = wave_sum(s);
            if (lane == 0) RSTD1[m] = 1.0f / sqrtf(s * (1.0f / DM) + EPS);
            GAS v2u* o8 = (GAS v2u*)(XB + (size_t)m * DM) + lane;
#pragma unroll
            for (int j = 0; j < 4; ++j) { v2u w; w.x = pk2(v[j].x, v[j].y); w.y = pk2(v[j].z, v[j].w); o8[64 * j] = w; }
        }
        for (int i = gw * 64 + lane; i < 2 * NB * 112 * 64; i += NGW * 64) {
            const int which = i / (NB * 112 * 64), r = i % (NB * 112 * 64), b = r / (112 * 64), q = r % (112 * 64);
            const float* src = (which ? cache_v : cache_k) + (size_t)b * 128 * KVW + 16 * KVW;
            float* dstp = out + (which ? O_VS : O_KS) + (size_t)b * 128 * KVW;
            ((f32x4*)dstp)[q] = ((const f32x4*)src)[q];
        }
    }
    SEAM(0);

    if (IN(1)) for (int rep_ = 0; rep_ < NREP(1); ++rep_) {
        pg8::Gemm g{XB, WinT, XB, WinT, MT, INW, DM}; pg8::StaticOrder S; S.init(MT, INW, G, (int)blockIdx.x, 1);
        EpiIn E{RSTD1, QB, KB, VB, UB, GV, SA, SB, out};
        pg8::gemm_phase<EpiIn, pg8::StaticOrder>(lds, g, S, E);
    }
    SEAM(1);

    if (IN(2)) {
#ifndef NO_ATT
        for (int rep_ = 0; rep_ < NREP(9); ++rep_)
        for (int j = blockIdx.x; j < NB * NKV * 4; j += G) {
            const int b = j >> 4, kvh = (j >> 2) & 3, c0 = 16 * (j & 3); const size_t seqbase = (size_t)b * SEQ;
            __syncthreads();
            for (int T = (c0 >= 2 ? c0 - 2 : 0); T <= c0; ++T) { const att::TileRegs tr = att::load_tile(KB, VB, seqbase + 64 * T, kvh, wave, lane); att::store_tile(lds + (T & 3) * att::SLOT, tr, wave, lane); }
            __syncthreads();
            for (int c = c0; c < c0 + 16; ++c) {
                att::TileRegs nx; nx.k = (v4u){0u, 0u, 0u, 0u}; nx.v = nx.k; const bool pre = (c + 1 < c0 + 16);
                if (pre) nx = att::load_tile(KB, VB, seqbase + 64 * (c + 1), kvh, wave, lane);
                att::attn_unit<false>(lds, ((c + 2) & 3) * att::SLOT, ((c + 3) & 3) * att::SLOT, (c & 3) * att::SLOT, c >= 2 ? 0 : 2 - c, QB, AO, seqbase + 64 * c, kvh, sinks, wave, lane);
                if (pre) att::store_tile(lds + ((c + 1) & 3) * att::SLOT, nx, wave, lane);
                __syncthreads();
            }
        }
        for (int j = blockIdx.x; j < NB * NKV; j += G) {
            const int b = j >> 2, kvh = j & 3;
            __syncthreads();
#pragma unroll
            for (int T = 0; T < 2; ++T) {
                att::TileRegs tr;
                { const size_t o = ((size_t)(b * 128 + 64 * T + lane) * NKV + kvh) * HD + wave * 8; const f32x4 k0 = *(const f32x4*)(cache_k + o), k1 = *(const f32x4*)(cache_k + o + 4);
                  tr.k.x = pk2(k0.x, k0.y); tr.k.y = pk2(k0.z, k0.w); tr.k.z = pk2(k1.x, k1.y); tr.k.w = pk2(k1.z, k1.w); }
                { const size_t o = ((size_t)(b * 128 + 64 * T + 16 * (wave & 3) + (lane >> 2)) * NKV + kvh) * HD + (wave >> 2) * 32 + (lane & 3) * 8; const f32x4 v0 = *(const f32x4*)(cache_v + o), v1 = *(const f32x4*)(cache_v + o + 4);
                  tr.v.x = pk2(v0.x, v0.y); tr.v.y = pk2(v0.z, v0.w); tr.v.z = pk2(v1.x, v1.y); tr.v.w = pk2(v1.z, v1.w); }
                att::store_tile(lds + T * att::SLOT, tr, wave, lane);
            }
            { att::TileRegs tr; tr.k = (v4u){0u, 0u, 0u, 0u}; tr.v = tr.k;
              if (lane < 16) tr.k = *(const v4u*)(KB + (size_t)(MP + b * 16 + lane) * KVW + kvh * HD + wave * 8);
              if ((wave & 3) == 0) tr.v = *(const v4u*)(VB + (size_t)(MP + b * 16 + (lane >> 2)) * KVW + kvh * HD + (wave >> 2) * 32 + (lane & 3) * 8);
              att::store_tile(lds + 2 * att::SLOT, tr, wave, lane); }
            __syncthreads();
            att::attn_unit<true>(lds, 0, att::SLOT, 2 * att::SLOT, 0, QB, AO, (size_t)(MP + b * 16), kvh, sinks, wave, lane);
        }
        __syncthreads();
#endif
#ifndef NO_GATE
        for (int unit = blockIdx.x; unit < NB * 32; unit += G) gat::gate_unit<false>(lds, GV, UB, WSB, ln_g, ln_b, b_s, nullptr, (size_t)unit * 128, tid, wave, lane);
        for (int j = (int)((blockIdx.x + G - 64 % G) % G); j < NB; j += G) gat::gate_unit<true>(lds, GV, UB, WSB, ln_g, ln_b, b_s, out + O_GS + (size_t)j * 16 * DM, (size_t)(MP + j * 16), tid, wave, lane);
#endif
    }
    SEAM(2);

    if (IN(3)) for (int rep_ = 0; rep_ < NREP(3); ++rep_) {
        pg8::Gemm g{AO, WaT, UB, WgT, MT, DM, DM}; pg8::StaticOrder S; S.init(MT, DM, G, (int)blockIdx.x, 2);
        EpiMerge E{SA, SB, MERGED};
        pg8::gemm_phase<EpiMerge, pg8::StaticOrder>(lds, g, S, E);
    }
    SEAM(3);

    if (IN(4)) for (int rep_ = 0; rep_ < NREP(4); ++rep_) {
        pg8::Gemm g{MERGED, WoT, MERGED, WoT, MT, DM, DM}; pg8::StaticOrder S; S.init(MT, DM, G, (int)blockIdx.x, 1);
        EpiBf16Ss E{MIX, PMIX};
        pg8::gemm_phase<EpiBf16Ss, pg8::StaticOrder>(lds, g, S, E);
    }
    SEAM(4);

    if (IN(5)) for (int rep_ = 0; rep_ < NREP(5); ++rep_) {
        for (int m = gw; m < MT; m += NGW) {
            float ps = PMIX[(size_t)(lane & 15) * MT + m]; ps += __shfl_xor(ps, 1); ps += __shfl_xor(ps, 2); ps += __shfl_xor(ps, 4); ps += __shfl_xor(ps, 8);
            const float rm = 1.0f / sqrtf(ps * (1.0f / DM) + EPS);
            f32x4 v[4]; float s = 0.f;
#pragma unroll
            for (int j = 0; j < 4; ++j) { const v2u xw = *((const GAS v2u*)(XB + (size_t)m * DM) + lane + 64 * j); const v2u mw = *((const GAS v2u*)(MIX + (size_t)m * DM) + lane + 64 * j); const f32x4 gv = *((const f32x4*)g_post_mix + lane + 64 * j);
                v[j].x = bflo(xw.x) + bflo(mw.x) * rm * gv.x; v[j].y = bfhi(xw.x) + bfhi(mw.x) * rm * gv.y; v[j].z = bflo(xw.y) + bflo(mw.y) * rm * gv.z; v[j].w = bfhi(xw.y) + bfhi(mw.y) * rm * gv.w;
                s += (v[j].x * v[j].x + v[j].y * v[j].y) + (v[j].z * v[j].z + v[j].w * v[j].w); }
            s = wave_sum(s);
            if (lane == 0) RSTD2[m] = 1.0f / sqrtf(s * (1.0f / DM) + EPS);
            GAS v2u* o8 = (GAS v2u*)(X1B + (size_t)m * DM) + lane;
#pragma unroll
            for (int j = 0; j < 4; ++j) { v2u w; w.x = pk2(v[j].x, v[j].y); w.y = pk2(v[j].z, v[j].w); o8[64 * j] = w; }
        }
    }
    SEAM(5);

    if (IN(6)) for (int rep_ = 0; rep_ < NREP(6); ++rep_) {
        pg8::Gemm g{X1B, WfiT, X1B, WfiT, MT, INW, DM}; pg8::StaticOrder S; S.init(MT, INW, G, (int)blockIdx.x, 1);
        EpiSwiglu E{RSTD2, ACT};
        pg8::gemm_phase<EpiSwiglu, pg8::StaticOrder>(lds, g, S, E);
    }
    SEAM(6);

    if (IN(7)) for (int rep_ = 0; rep_ < NREP(7); ++rep_) {
        pg8::Gemm g{ACT, WfoT, ACT, WfoT, MT, DM, DFF}; pg8::StaticOrder S; S.init(MT, DM, G, (int)blockIdx.x, 1);
        EpiBf16Ss E{FB, PF};
        pg8::gemm_phase<EpiBf16Ss, pg8::StaticOrder>(lds, g, S, E);
    }
    SEAM(7);

    if (IN(8)) for (int rep_ = 0; rep_ < NREP(8); ++rep_) {
        for (int m = gw; m < MT; m += NGW) {
            float* yrow = (m < MP) ? out + O_YP + (size_t)m * DM : out + O_YS + (size_t)(m - MP) * DM;
            float pf = PF[(size_t)(lane & 15) * MT + m]; pf += __shfl_xor(pf, 1); pf += __shfl_xor(pf, 2); pf += __shfl_xor(pf, 4); pf += __shfl_xor(pf, 8);
            const float rf = 1.0f / sqrtf(pf * (1.0f / DM) + EPS);
#pragma unroll
            for (int j = 0; j < 4; ++j) { const v2u xw = *((const GAS v2u*)(X1B + (size_t)m * DM) + lane + 64 * j); const v2u fw = *((const GAS v2u*)(FB + (size_t)m * DM) + lane + 64 * j);
                const f32x4 g2 = *((const f32x4*)g_post_ffn + lane + 64 * j);
                f32x4 y; y.x = bflo(xw.x) + bflo(fw.x) * rf * g2.x; y.y = bfhi(xw.x) + bfhi(fw.x) * rf * g2.y; y.z = bflo(xw.y) + bflo(fw.y) * rf * g2.z; y.w = bfhi(xw.y) + bfhi(fw.y) * rf * g2.w;
                *((GAS f32x4*)yrow + lane + 64 * j) = y; }
        }
    }
#undef IN
#undef SEAM
}

constexpr int N_PHASES = 9;
extern "C" void kernel_launch(void* const* d_in, const int* in_sizes, int n_in, void* d_out, int out_size, void* d_ws, size_t ws_size, hipStream_t stream) {
    static int grid = 0;
    if (grid == 0) {
        if (n_in != 19 || (size_t)out_size != O_END || ws_size < WS_END) { fprintf(stderr, "kernel_launch: unexpected shapes: n_in %d out %d ws %zu (need %zu)\n", n_in, out_size, ws_size, (size_t)WS_END); grid = -1; return; }
        int dev = 0, cus = 0;
        if (hipGetDevice(&dev) != hipSuccess || hipDeviceGetAttribute(&cus, hipDeviceAttributeMultiprocessorCount, dev) != hipSuccess) { grid = -1; return; }
        if (hipFuncSetAttribute((const void*)fwd_kernel, hipFuncAttributeMaxDynamicSharedMemorySize, LDS_BYTES) != hipSuccess) { fprintf(stderr, "kernel_launch: hipFuncSetAttribute failed\n"); grid = -1; return; }
        int per_cu = 0;
        (void)hipOccupancyMaxActiveBlocksPerMultiprocessor(&per_cu, (const void*)fwd_kernel, NWAVES * 64, LDS_BYTES);
        (void)hipGetLastError();
        grid = cus;
    }
    if (grid < 0) return;
    (void)hipMemsetAsync((char*)d_ws + WS_CTL, 0, CTL_ZERO_BYTES, stream);
    Args a{};
    for (int i = 0; i < 19; ++i) a.in[i] = (const float*)d_in[i];
    a.out = (float*)d_out; a.ws = (unsigned char*)d_ws;
#if MK_ONE_LAUNCH
    a.ph_lo = 0; a.ph_hi = N_PHASES;
    hipLaunchKernelGGL(fwd_kernel, dim3(grid), dim3(NWAVES * 64), LDS_BYTES, stream, a);
#else
    for (int p = 0; p < N_PHASES; ++p) { a.ph_lo = p; a.ph_hi = p + 1; hipLaunchKernelGGL(fwd_kernel, dim3(grid), dim3(NWAVES * 64), LDS_BYTES, stream, a); }
#endif
}
```

```cpp
#include <hip/hip_runtime.h>
#include <cstdio>
#include <cstdint>

#ifndef MK_ONE_LAUNCH
#define MK_ONE_LAUNCH 1
#endif
#ifndef REP_MASK
#define REP_MASK 0
#endif
#define NREP(k) (((REP_MASK >> (k)) & 1) ? 2 : 1)
#ifdef TS_A
#define STAMP(j) do { if (threadIdx.x == 0) ((unsigned long long*)(args.ws + 768 * 1024))[blockIdx.x * 16 + (j)] = __builtin_amdgcn_s_memrealtime(); } while (0)
#else
#define STAMP(j) do { } while (0)
#endif

namespace pg8 {
#define PG8_LAS __attribute__((address_space(3)))
typedef unsigned short bf16_t;
typedef short bf16x8 __attribute__((ext_vector_type(8)));
typedef float f32x4 __attribute__((ext_vector_type(4)));
typedef unsigned u32x4 __attribute__((ext_vector_type(4)));
constexpr int BM = 256, BK = 64, HALF = 128, HTB = HALF * BK * 2  , STAGE_BYTES = 8 * HTB, NXCD = 8, WGM = 8;

__host__ __device__ __forceinline__ int lds_byte(int r, int c) { const int st = (r >> 4) * 2 + (c >> 5), rr = r & 15, cc = c & 31, ob = rr * 64 + cc * 2; return st * 1024 + (ob ^ (((ob >> 9) & 1) << 5)); }
__host__ __device__ __forceinline__ void stage_rc(int b, int& R, int& C) { const int st = b / 1024, sb = b % 1024, swz = sb ^ (((sb >> 9) & 1) << 5); R = (st >> 1) * 16 + swz / 64; C = (st & 1) * 32 + (swz % 64) / 2; }
__host__ __device__ __forceinline__ int perm32(int rho) { const int n = rho >> 4, i = rho & 15; return 8 * (i >> 2) + 4 * n + (i & 3); }

struct Unit { int pm, pn, seg; };
struct Gemm { const bf16_t* A0; const bf16_t* B0; const bf16_t* A1; const bf16_t* B1; int M, N, K; };

struct StaticOrder {
    int nM, nN, nwg, G, c, nseg;
    __host__ __device__ void init(int M, int N, int G_, int c_, int nseg_) { nM = M / BM; nN = N / BM; nwg = nM * nN; G = G_; c = c_; nseg = nseg_; }
    __host__ __device__ bool next(int i, Unit& u) const {
        const int ti = (nseg == 2) ? (i >> 1) : i; u.seg = (nseg == 2) ? (i & 1) : 0;
        const long L = (long)ti * G + c; if (L >= nwg) return false;
        int wgid = (int)L; { const int q = nwg / NXCD, r = nwg % NXCD, xcd = wgid % NXCD, off = wgid / NXCD; wgid = (xcd < r ? xcd * (q + 1) : r * (q + 1) + (xcd - r) * q) + off; }
        const int nig = WGM * nN, gid = wgid / nig, fm = gid * WGM, gsz = (nM - fm) < WGM ? (nM - fm) : WGM;
        u.pm = fm + ((wgid % nig) % gsz); u.pn = (wgid % nig) / gsz; return true;
    }
};

struct DfOrder {
    StaticOrder P; int nNs, cs, nseg;
    __host__ __device__ void init(int Mp, int N, int G, int c, int shift, int nseg_) { P.init(Mp, N, G, c, 1); nNs = N / BM; cs = (c + G - shift % G) % G; nseg = nseg_; }
    __host__ __device__ bool next(int i, Unit& u) const {
        int ti = (nseg == 2) ? (i >> 1) : i; u.seg = (nseg == 2) ? (i & 1) : 0;
        if (cs < nNs) { if (ti == 1) { u.pm = P.nM; u.pn = cs; return true; } if (ti > 1) --ti; }
        Unit t; if (!P.next(ti, t)) return false; u.pm = t.pm; u.pn = t.pn; return true;
    }
};
struct DynOrder {
    unsigned* q8; int nMp, nN, xcd, nseg; PG8_LAS int* box; unsigned tk;
    __device__ __forceinline__ void init(unsigned* q8_, int Mp, int N, int nseg_, PG8_LAS int* box_) { xcd = (int)(__builtin_amdgcn_s_getreg((3 << 11) | 20) & 7u); q8 = q8_; nMp = Mp / BM; nN = N / BM; nseg = nseg_; box = box_; tk = 0u; }
    __device__ __forceinline__ unsigned draw(int cls) const { return __hip_atomic_fetch_add(q8 + 64 * cls, 1u, __ATOMIC_RELAXED, __HIP_MEMORY_SCOPE_AGENT); }
    __device__ __forceinline__ bool map(int cls, unsigned t, int& pm, int& pn) const {
        const int ns = (nN - cls + 7) >> 3, q = nMp * nN / NXCD, ti = (int)t;
        if (ti < ns) { pm = nMp; pn = cls + 8 * ti; return true; }
        if (ti - ns < q) { const int wgid = cls * q + (ti - ns), nig = WGM * nN, gid = wgid / nig, fm = gid * WGM, gsz = (nMp - fm) < WGM ? (nMp - fm) : WGM; pm = fm + ((wgid % nig) % gsz); pn = (wgid % nig) / gsz; return true; }
        return false;
    }
    __device__ __forceinline__ void put(int slot, unsigned t, int seg) const {
        int pm = 0, pn = 0; bool valid = map(xcd, t, pm, pn);
        for (int k = 1; k < NXCD && !valid; ++k) { const int cls = (xcd + k) & 7; valid = map(cls, draw(cls), pm, pn); }
        box[4 * slot + 0] = pm; box[4 * slot + 1] = pn; box[4 * slot + 2] = seg; box[4 * slot + 3] = valid ? 1 : 0;
    }
    __device__ __forceinline__ bool get(int slot, Unit& u) const { u.pm = box[4 * slot]; u.pn = box[4 * slot + 1]; u.seg = box[4 * slot + 2]; return box[4 * slot + 3] != 0; }
    __device__ __forceinline__ bool first(Unit& u) {
        __syncthreads();
        if (threadIdx.x == 0) {
            put(0, draw(xcd), 0);
            if (nseg == 2) { box[4] = box[0]; box[5] = box[1]; box[6] = 1; box[7] = box[3]; } else put(1, draw(xcd), 0);
        }
        __syncthreads();
        return get(0, u);
    }
    __device__ __forceinline__ bool peek_next(int ui, Unit& u) const { return get((ui + 1) & 1, u); }
    __device__ __forceinline__ void pull(int ui, int wid) {
        if (wid == 0 && (threadIdx.x & 63) == 0 && (nseg == 1 || (ui & 1) == 0)) tk = draw(xcd);
    }
    __device__ __forceinline__ void commit(int ui, int wid) {
        if (wid == 0 && (threadIdx.x & 63) == 0) {
            if (nseg == 1 || (ui & 1) == 0) put(ui & 1, tk, 0);
            else { const int o = (ui + 1) & 1, d = ui & 1; box[4 * d] = box[4 * o]; box[4 * d + 1] = box[4 * o + 1]; box[4 * d + 2] = 1; box[4 * d + 3] = box[4 * o + 3]; }
        }
    }
};
struct Dep {
    unsigned* wait_cnt; unsigned need;
    unsigned* wait_tot; unsigned need_tot;
    unsigned* guard; unsigned need_guard;
    unsigned* done_cnt; unsigned* done_tot;
    unsigned* tmo;
};
#define PG8_SPIN_CAP (1u << 16)
__device__ __forceinline__ void dep_wait(const Dep& D, int pm, int wid, int& flags) {
    if (D.wait_cnt == nullptr) return;
    if (wid == 0 && (flags & 1) == 0) {
        unsigned spins = 0;
        for (;;) {
            const unsigned c0 = __hip_atomic_load(D.wait_cnt + 64 * pm, __ATOMIC_RELAXED, __HIP_MEMORY_SCOPE_AGENT);
            const unsigned t0 = __hip_atomic_load(D.wait_tot, __ATOMIC_RELAXED, __HIP_MEMORY_SCOPE_AGENT);
            const unsigned g0 = (D.guard != nullptr && (flags & 2) == 0) ? __hip_atomic_load(D.guard, __ATOMIC_RELAXED, __HIP_MEMORY_SCOPE_AGENT) : D.need_guard;
            const unsigned c = (unsigned)__builtin_amdgcn_readfirstlane(c0), t = (unsigned)__builtin_amdgcn_readfirstlane(t0), gg = (unsigned)__builtin_amdgcn_readfirstlane(g0);
            if (gg >= D.need_guard) flags |= 2;
            if (t >= D.need_tot && (flags & 2)) { flags |= 1; break; }
            if (c >= D.need && (flags & 2)) break;
            if (++spins > PG8_SPIN_CAP || ((spins & 63u) == 0u && __builtin_amdgcn_readfirstlane(__hip_atomic_load(D.tmo, __ATOMIC_RELAXED, __HIP_MEMORY_SCOPE_AGENT)) != 0u)) { if ((threadIdx.x & 63) == 0) __hip_atomic_store(D.tmo, 1u, __ATOMIC_RELAXED, __HIP_MEMORY_SCOPE_AGENT); break; }
            __builtin_amdgcn_s_sleep(4);
        }
    }
    asm volatile("" ::: "memory"); __builtin_amdgcn_s_barrier(); asm volatile("" ::: "memory");
}
__device__ __forceinline__ void dep_done(const Dep& D, int pm, int lane) {
    if (D.done_cnt != nullptr && lane == 0) __hip_atomic_fetch_add(D.done_cnt + 64 * pm, 1u, __ATOMIC_RELAXED, __HIP_MEMORY_SCOPE_AGENT);
}

template <class Epi, class Sched, int AUXA>
__device__ __forceinline__ void gemm_phase(PG8_LAS unsigned char* lds, const Gemm g, Sched& S, const Epi& E, const Dep D) {
    const int tid = threadIdx.x, wid = __builtin_amdgcn_readfirstlane(tid >> 6), lane = tid & 63, wr = wid >> 2, wc = wid & 3, fr = lane & 15, fq = lane >> 4;
    const int K = g.K, nt = K / BK;
    unsigned voffA[2], voffB[2];
#pragma unroll
    for (int i = 0; i < 2; ++i) { int R, C; stage_rc(tid * 16 + i * 8192, R, C); const int Rb = Epi::PERM ? ((R & ~31) + perm32(R & 31)) : R;
        voffA[i] = (unsigned)(R * K + C) * 2u; voffB[i] = (unsigned)(Rb * K + C) * 2u; }
    const size_t kstep = (size_t)(BK * 2);
    const size_t hstep = (size_t)HALF * K * 2;
    const size_t tstep = 2 * hstep;
    const unsigned ldsw = (unsigned)wid * 1024u;
    const int aoff = lds_byte(wr * 64 + fr, fq * 8), boff = lds_byte(wc * 32 + fr, fq * 8);
#define PG8_SA(b, h) (((b) * 2 + (h)) * HTB)
#define PG8_SB(b, h) ((4 + (b) * 2 + (h)) * HTB)
#define PG8_STAGE(bufoff, gbase, voff) do { _Pragma("unroll") for (int _i = 0; _i < 2; ++_i) \
        __builtin_amdgcn_global_load_lds((const unsigned*)((const char*)(gbase) + (voff)[_i]), (PG8_LAS unsigned*)(lds + (bufoff) + ldsw + _i * 8192), 16, 0, 0); } while (0)
#define PG8_STAGEA(bufoff, gbase, voff) do { _Pragma("unroll") for (int _i = 0; _i < 2; ++_i) \
        __builtin_amdgcn_global_load_lds((const unsigned*)((const char*)(gbase) + (voff)[_i]), (PG8_LAS unsigned*)(lds + (bufoff) + ldsw + _i * 8192), 16, 0, AUXA); } while (0)
#define PG8_LDA(dst, b, h) do { _Pragma("unroll") for (int m = 0; m < 4; ++m) _Pragma("unroll") for (int k = 0; k < 2; ++k) dst[m][k] = *(const PG8_LAS bf16x8*)(lds + PG8_SA(b, h) + aoff + m * 2048 + k * 1024); } while (0)
#define PG8_LDB(dst, b, h) do { _Pragma("unroll") for (int n = 0; n < 2; ++n) _Pragma("unroll") for (int k = 0; k < 2; ++k) dst[n][k] = *(const PG8_LAS bf16x8*)(lds + PG8_SB(b, h) + boff + n * 2048 + k * 1024); } while (0)
#define PG8_MMA(ai, bj, At, Bt) do { __builtin_amdgcn_s_setprio(1); _Pragma("unroll") for (int m = 0; m < 4; ++m) _Pragma("unroll") for (int n = 0; n < 2; ++n) _Pragma("unroll") for (int k = 0; k < 2; ++k) \
        acc[ai][bj][m][n] = __builtin_amdgcn_mfma_f32_16x16x32_bf16(Bt[n][k], At[m][k], acc[ai][bj][m][n], 0, 0, 0); __builtin_amdgcn_s_setprio(0); } while (0)
#define PG8_WAIT_V(n) asm volatile("s_waitcnt vmcnt(" #n ")" ::: "memory")
#define PG8_WAIT_L(n) asm volatile("s_waitcnt lgkmcnt(" #n ")" ::: "memory")
#define PG8_BAR __builtin_amdgcn_s_barrier()
#define PG8_SCHED __builtin_amdgcn_sched_barrier(0)
    Unit cur, nxt; int ui = 0;
    if (!S.first(cur)) { if (D.done_tot != nullptr && tid == 0) __hip_atomic_fetch_add(D.done_tot, 1u, __ATOMIC_RELAXED, __HIP_MEMORY_SCOPE_AGENT); return; }
    f32x4 acc[2][2][4][2];
#pragma unroll
    for (int a = 0; a < 2; ++a)
#pragma unroll
        for (int b = 0; b < 2; ++b)
#pragma unroll
            for (int m = 0; m < 4; ++m)
#pragma unroll
                for (int n = 0; n < 2; ++n) acc[a][b][m][n] = (f32x4){0.f, 0.f, 0.f, 0.f};
    bf16x8 At[4][2], B0[2][2], B1[2][2];
    const char* cA = (const char*)(cur.seg ? g.A1 : g.A0) + (size_t)cur.pm * tstep; const char* cB = (const char*)(cur.seg ? g.B1 : g.B0) + (size_t)cur.pn * tstep;
    int dflags = 0, pend = -1;
    dep_wait(D, cur.pm, wid, dflags);
    PG8_STAGE(PG8_SB(0, 0), cB, voffB); PG8_STAGE(PG8_SB(0, 1), cB + hstep, voffB); PG8_STAGEA(PG8_SA(0, 0), cA, voffA); PG8_STAGEA(PG8_SA(0, 1), cA + hstep, voffA);
    if (wr == 1) PG8_BAR;
    PG8_WAIT_V(2); PG8_BAR;
    PG8_STAGE(PG8_SB(1, 0), cB + kstep, voffB); PG8_STAGEA(PG8_SA(1, 0), cA + kstep, voffA); PG8_STAGE(PG8_SB(1, 1), cB + hstep + kstep, voffB);
    PG8_WAIT_V(6); PG8_BAR;
    for (;;) {
        bool has_next = false; const char* nA = cA; const char* nB = cB;
#define PG8_TRIP(a1, a2, b2, a3, b3) do { asm volatile("" : "+v"(voffA[0]), "+v"(voffA[1]), "+v"(voffB[0]), "+v"(voffB[1])); \
            PG8_LDB(B0, 0, 0); PG8_LDB(B1, 0, 1); PG8_SCHED; PG8_LDA(At, 0, 0); PG8_STAGEA(PG8_SA(1, 1), (a1) + hstep, voffA); \
            PG8_WAIT_V(8); PG8_WAIT_L(0); PG8_BAR; PG8_MMA(0, 0, At, B0); PG8_MMA(0, 1, At, B1); PG8_BAR; PG8_SCHED; \
            PG8_LDA(At, 0, 1); PG8_STAGE(PG8_SB(0, 0), (b2), voffB); PG8_STAGE(PG8_SB(0, 1), (b2) + hstep, voffB); PG8_STAGEA(PG8_SA(0, 0), (a2), voffA); \
            PG8_WAIT_V(8); PG8_WAIT_L(0); PG8_BAR; PG8_MMA(1, 0, At, B0); PG8_MMA(1, 1, At, B1); PG8_BAR; PG8_SCHED; \
            PG8_LDB(B0, 1, 0); PG8_LDB(B1, 1, 1); PG8_SCHED; PG8_LDA(At, 1, 0); PG8_STAGEA(PG8_SA(0, 1), (a2) + hstep, voffA); \
            PG8_WAIT_V(8); PG8_WAIT_L(0); PG8_BAR; PG8_MMA(0, 0, At, B0); PG8_MMA(0, 1, At, B1); PG8_BAR; PG8_SCHED; \
            PG8_LDA(At, 1, 1); PG8_STAGE(PG8_SB(1, 0), (b3), voffB); PG8_STAGE(PG8_SB(1, 1), (b3) + hstep, voffB); PG8_STAGEA(PG8_SA(1, 0), (a3), voffA); \
            PG8_WAIT_V(8); PG8_WAIT_L(0); PG8_BAR; PG8_MMA(1, 0, At, B0); PG8_MMA(1, 1, At, B1); PG8_BAR; PG8_SCHED; } while (0)
        {
            const char* a1 = cA + kstep; const char* a2 = cA + 2 * kstep; const char* b2 = cB + 2 * kstep; const char* a3 = a2 + kstep; const char* b3 = b2 + kstep;
            PG8_TRIP(a1, a2, b2, a3, b3);
            if (pend >= 0) { dep_done(D, pend, lane); pend = -1; }
        }
        for (int t = 2; t < nt - 2; t += 2) {
            const char* a1 = cA + (size_t)(t + 1) * kstep; const char* a2 = cA + (size_t)(t + 2) * kstep; const char* b2 = cB + (size_t)(t + 2) * kstep; const char* a3 = a2 + kstep; const char* b3 = b2 + kstep;
            PG8_TRIP(a1, a2, b2, a3, b3);
        }
        {
            has_next = S.peek_next(ui, nxt);
            if (has_next) { nA = (const char*)(nxt.seg ? g.A1 : g.A0) + (size_t)nxt.pm * tstep; nB = (const char*)(nxt.seg ? g.B1 : g.B0) + (size_t)nxt.pn * tstep; dep_wait(D, nxt.pm, wid, dflags); }
            const char* a1 = cA + (size_t)(nt - 1) * kstep; const char* a2 = nA; const char* b2 = nB; const char* a3 = a2 + kstep; const char* b3 = b2 + kstep;
            PG8_TRIP(a1, a2, b2, a3, b3);
        }
#undef PG8_TRIP
        if (wr == 0) PG8_BAR;
        S.pull(ui, wid);
        const bool keep = E(acc, cur, wr, wc, fr, fq);
        S.commit(ui, wid);
        if (!keep) pend = cur.pm;
        if (!has_next) break;
        if (!keep) {
#pragma unroll
        for (int a = 0; a < 2; ++a)
#pragma unroll
            for (int b = 0; b < 2; ++b)
#pragma unroll
                for (int m = 0; m < 4; ++m)
#pragma unroll
                    for (int n = 0; n < 2; ++n) acc[a][b][m][n] = (f32x4){0.f, 0.f, 0.f, 0.f};
        }
        cur = nxt; cA = nA; cB = nB; ++ui;
        if (wr == 1) PG8_BAR;
    }
    PG8_WAIT_V(0);
    if (pend >= 0) dep_done(D, pend, lane);
    PG8_BAR;
    if (D.done_tot != nullptr && tid == 0) __hip_atomic_fetch_add(D.done_tot, 1u, __ATOMIC_RELAXED, __HIP_MEMORY_SCOPE_AGENT);
#undef PG8_STAGEA
#undef PG8_SA
#undef PG8_SB
#undef PG8_STAGE
#undef PG8_LDA
#undef PG8_LDB
#undef PG8_MMA
#undef PG8_WAIT_V
#undef PG8_WAIT_L
#undef PG8_BAR
#undef PG8_SCHED
}
}

constexpr int DM = 1024, NB = 16, SEQ = 4096, DECS = 16, NKV = 4, HD = 64, KVW = 256, INW = 5632, DFF = 2816;
constexpr int MP = NB * SEQ, MS = NB * DECS, MT = MP + MS;
constexpr float EPS = 1e-6f, LOG2E = 1.4426950408889634f, QSCALE = 0.125f * LOG2E;
constexpr size_t O_YP = 0, O_YS = (size_t)MP * DM, O_KP = O_YS + (size_t)MS * DM, O_VP = O_KP + 524288, O_KS = O_VP + 524288, O_VS = O_KS + 524288, O_GS = O_VS + 524288, O_END = O_GS + (size_t)MS * DM;

constexpr size_t MiB = 1u << 20;
constexpr size_t WS_CTL = 0, CTL_ZERO_BYTES = 1 * MiB;
constexpr size_t WS_WIN = 1 * MiB, WS_WFI = 12 * MiB, WS_WA = 23 * MiB, WS_WG = 25 * MiB, WS_WO = 27 * MiB, WS_WFO = 29 * MiB;
constexpr size_t WS_WSB = 34 * MiB + 768 * 1024;
constexpr size_t WS_RSTD1 = 35 * MiB, WS_RSTD2 = 36 * MiB, WS_PMIX = 37 * MiB, WS_PF = 42 * MiB;
constexpr size_t ACTB = (size_t)MT * DM * 2;
constexpr size_t WS_R0 = 48 * MiB;
constexpr size_t WS_R1 = 177 * MiB;
constexpr size_t WS_R2 = 306 * MiB;
constexpr size_t WS_KB = 435 * MiB, WS_VB = 468 * MiB;
constexpr size_t WS_R3 = 501 * MiB;
constexpr size_t WS_SA = WS_R3, WS_SB = WS_R3 + ACTB, WS_U = WS_R3 + 2 * ACTB, WS_AO = WS_R3 + 3 * ACTB, WS_END = WS_AO + ACTB;
static_assert(WS_END <= 1024 * MiB && (size_t)MT * DFF * 2 <= 3 * ACTB && WS_R0 + ACTB <= WS_R1 && WS_R1 + ACTB <= WS_R2 && WS_R2 + ACTB <= WS_KB, "d_ws map");
constexpr int CW_BAR = 4096, CW_TMO = 64;
constexpr int CW_CNT = 16384;
constexpr int CW_TOT = CW_CNT + 5 * 264 * 64;
constexpr int CW_C0 = CW_TOT + 8 * 64;
constexpr int CW_Q = CW_C0 + 264 * 64;
constexpr int CW_C1 = CW_Q + 9 * 8 * 64, CW_C2 = CW_C1 + 264 * 64, CW_CS = CW_C2 + 264 * 64;
static_assert((CW_CS + 64) * 4 <= 768 * 1024, "CTL words inside the memset region, below the probe stamps");

constexpr int RING_BYTES = 131072, LDS_BYTES = 147456, LDSCTL_OFF = LDS_BYTES - 512, MISC_OFF = LDSCTL_OFF + 320;
constexpr int NWAVES = 8, BOX_OFF = LDSCTL_OFF + 64;

#define GAS __attribute__((address_space(1)))
#define LAS __attribute__((address_space(3)))
typedef unsigned short bf16;
typedef unsigned v4u __attribute__((ext_vector_type(4)));
typedef unsigned v2u __attribute__((ext_vector_type(2)));
typedef float f32x4 __attribute__((ext_vector_type(4)));
typedef GAS unsigned gu32;
#define RLX_AGENT __ATOMIC_RELAXED, __HIP_MEMORY_SCOPE_AGENT
#define LDS_WAIT() asm volatile("s_waitcnt lgkmcnt(0)" ::: "memory")
typedef float f32x2_t __attribute__((ext_vector_type(2))); typedef __bf16 bf16x2_t __attribute__((ext_vector_type(2)));
__device__ __forceinline__ unsigned pk2(float lo, float hi) { f32x2_t v = {lo, hi}; bf16x2_t b = __builtin_convertvector(v, bf16x2_t); return __builtin_bit_cast(unsigned, b); }
__device__ __forceinline__ float bflo(unsigned w) { return __uint_as_float(w << 16); }
__device__ __forceinline__ float bfhi(unsigned w) { return __uint_as_float(w & 0xffff0000u); }
__device__ __forceinline__ float wave_sum(float v) {
#pragma unroll
    for (int o = 1; o < 64; o <<= 1) v += __shfl_xor(v, o);
    return v;
}
__device__ __forceinline__ float gelu_tanh(float x) {
    const float e = __builtin_amdgcn_exp2f(x * (-2.302208198f - 0.10294324f * x * x));
    return x * __builtin_amdgcn_rcpf(1.0f + e);
}
__device__ __forceinline__ float sigmoidf_(float x) { return __builtin_amdgcn_rcpf(1.0f + __builtin_amdgcn_exp2f(-LOG2E * x)); }

#define XB_TMO      128
#define XB_XCNT(j)  (256  + 64 * (j))
#define XB_XSUB(j)  (1280 + 64 * (j))
#define XB_XGEN(j)  (2304 + 64 * (j))
#define XB_TOP      3328
#define XB_TOPGEN   3392
#define XCD_BAR_WORDS 3456
#define XB_SPIN_CAP (1u << 18)
__device__ __forceinline__ unsigned xb_ld(unsigned* p)              { return __hip_atomic_load(p, __ATOMIC_RELAXED, __HIP_MEMORY_SCOPE_AGENT); }
__device__ __forceinline__ unsigned xb_add(unsigned* p, unsigned v) { return __hip_atomic_fetch_add(p, v, __ATOMIC_RELAXED, __HIP_MEMORY_SCOPE_AGENT); }
__device__ __forceinline__ unsigned xb_xcc_id() { return (unsigned)__builtin_amdgcn_s_getreg((3 << 11) | 20) & 0xFu; }
#define XB_SPIN(cond, bar) do { unsigned _sp = 0; while (cond) { __builtin_amdgcn_s_sleep(1); \
    if ((++_sp & 255u) == 0u) { if (xb_ld(&(bar)[XB_TMO])) break; if (_sp > XB_SPIN_CAP) { atomicAdd(&(bar)[XB_TMO], 1u); break; } } } } while (0)
struct XcdBarrier { unsigned* bar; unsigned x; volatile LAS unsigned* st; };
__device__ __forceinline__ XcdBarrier xcd_barrier_post(unsigned* bar, volatile LAS unsigned* st) {
    XcdBarrier b; b.bar = bar; b.x = xb_xcc_id(); b.st = st;
    if (threadIdx.x == 0) (void)xb_add(&bar[XB_XCNT(b.x)], 1u);
    return b;
}
__device__ __forceinline__ void xcd_barrier_complete(unsigned* bar, unsigned x, unsigned& nloc, unsigned& nx) {
    const unsigned G = gridDim.x * gridDim.y * gridDim.z;
    unsigned sum, cnt, mine, sp = 0u;
    for (;;) {
        sum = 0u; cnt = 0u; mine = 0u;
#pragma unroll
        for (unsigned j = 0; j < 16; ++j) { const unsigned c = xb_ld(&bar[XB_XCNT(j)]); sum += c; cnt += (c > 0u) ? 1u : 0u; mine = (j == x) ? c : mine; }
        if (sum == G) break;
        __builtin_amdgcn_s_sleep(1);
        if ((++sp & 255u) == 0u) { if (xb_ld(&bar[XB_TMO])) break; if (sp > XB_SPIN_CAP) { atomicAdd(&bar[XB_TMO], 1u); break; } }
    }
    nloc = mine > 0u ? mine : 1u; nx = cnt > 0u ? cnt : 1u;
}
__device__ __forceinline__ void xcd_barrier(const XcdBarrier& b) {
    asm volatile("s_waitcnt vmcnt(0)" ::: "memory");
    __syncthreads();
    if (threadIdx.x == 0) {
        unsigned* bar = b.bar;
        __builtin_amdgcn_s_waitcnt(0);
        unsigned nloc = b.st[0], nx = b.st[1];
        if (nloc == 0u) { xcd_barrier_complete(bar, b.x, nloc, nx); b.st[0] = nloc; b.st[1] = nx; }
        const unsigned old = xb_add(&bar[XB_XSUB(b.x)], 1u);
        const unsigned gen = old / nloc;
        if (old + 1u == (gen + 1u) * nloc) {
            __builtin_amdgcn_fence(__ATOMIC_RELEASE, "agent");
            asm volatile("s_waitcnt vmcnt(0)" ::: "memory");
            const unsigned og = xb_add(&bar[XB_TOP], 1u);
            const unsigned tg = og / nx;
            if (og + 1u == (tg + 1u) * nx) xb_add(&bar[XB_TOPGEN], 1u);
            else XB_SPIN(xb_ld(&bar[XB_TOPGEN]) == tg, bar);
            __builtin_amdgcn_fence(__ATOMIC_ACQUIRE, "agent");
            xb_add(&bar[XB_XGEN(b.x)], 1u);
            asm volatile("s_waitcnt vmcnt(0)" ::: "memory");
        } else {
            XB_SPIN(xb_ld(&bar[XB_XGEN(b.x)]) == gen, bar);
            __builtin_amdgcn_fence(__ATOMIC_ACQUIRE, "agent");
            asm volatile("s_waitcnt vmcnt(0)" ::: "memory");
        }
    }
    __syncthreads();
}

typedef __amdgpu_buffer_rsrc_t rsrc_t;
__device__ __forceinline__ rsrc_t mk_rsrc(const void* p) { return __builtin_amdgcn_make_buffer_rsrc((void*)p, 0, 0x7fffffff, 0x00020000); }
__device__ __forceinline__ void st16_wt(rsrc_t r, size_t byte_off, v4u v) { __builtin_amdgcn_raw_buffer_store_b128(v, r, (int)byte_off, 0, 16); }
__device__ __forceinline__ v4u ld16_nc(rsrc_t r, size_t byte_off) { return __builtin_amdgcn_raw_buffer_load_b128(r, (int)byte_off, 0, 16); }
__device__ __forceinline__ void stf_wt(float* p, float v) { __hip_atomic_store((unsigned*)p, __float_as_uint(v), __ATOMIC_RELAXED, __HIP_MEMORY_SCOPE_AGENT); }
__device__ __forceinline__ float ldf_nc(const float* p) { return __uint_as_float(__hip_atomic_load((const unsigned*)p, __ATOMIC_RELAXED, __HIP_MEMORY_SCOPE_AGENT)); }

using pg8::Unit;
struct EpiIn {
    static constexpr bool PERM = true;
    const float* rstd; bf16 *Q, *Kb, *Vb, *U, *GV, *SA, *SB; float* out; float *PG1, *PG2;
    __device__ __forceinline__ bool operator()(f32x4 (&acc)[2][2][4][2], const Unit& u, int wr, int wc, int fr, int fq) const {
        const int pn = u.pn; int mode, ld, colt; bf16* dst; float* side = nullptr; size_t side_s = 0;
        if (pn < 4)       { mode = 0; dst = Q;  ld = DM;  colt = pn * 256; }
        else if (pn == 4) { mode = 1; dst = Kb; ld = KVW; colt = 0; side = out + O_KP; side_s = O_KS - O_KP; }
        else if (pn == 5) { mode = 1; dst = Vb; ld = KVW; colt = 0; side = out + O_VP; side_s = O_VS - O_VP; }
        else if (pn < 10) { mode = 2; dst = U;  ld = DM;  colt = (pn - 6) * 256; }
        else if (pn < 14) { mode = 2; dst = GV; ld = DM;  colt = (pn - 10) * 256; }
        else if (pn < 18) { mode = 3; dst = SA; ld = DM;  colt = (pn - 14) * 256; }
        else              { mode = 3; dst = SB; ld = DM;  colt = (pn - 18) * 256; }
        const int row0 = u.pm * 256 + wr * 64 + fr, col0 = colt + wc * 32 + 8 * fq; const rsrc_t rdst = mk_rsrc(dst);
        float rsv[2][4];
#pragma unroll
        for (int ai = 0; ai < 2; ++ai)
#pragma unroll
            for (int m = 0; m < 4; ++m) rsv[ai][m] = rstd[row0 + ai * 128 + m * 16];
#pragma unroll
        for (int ai = 0; ai < 2; ++ai)
#pragma unroll
            for (int m = 0; m < 4; ++m) {
                const int row = row0 + ai * 128 + m * 16; const float rs = rsv[ai][m]; float s1 = 0.f, s2 = 0.f;
#pragma unroll
                for (int bj = 0; bj < 2; ++bj) {
                    float v[8];
#pragma unroll
                    for (int j = 0; j < 4; ++j) { v[j] = acc[ai][bj][m][0][j] * rs; v[4 + j] = acc[ai][bj][m][1][j] * rs; }
                    if (mode == 0) {
#pragma unroll
                        for (int j = 0; j < 8; ++j) v[j] *= QSCALE;
                    } else if (mode == 2) {
#pragma unroll
                        for (int j = 0; j < 8; ++j) { v[j] = gelu_tanh(v[j]); s1 += v[j]; s2 += v[j] * v[j]; }
                    } else if (mode == 3) {
#pragma unroll
                        for (int j = 0; j < 8; ++j) v[j] = sigmoidf_(v[j]);
                    }
                    const int col = col0 + bj * 128;
                    v4u w; w.x = pk2(v[0], v[1]); w.y = pk2(v[2], v[3]); w.z = pk2(v[4], v[5]); w.w = pk2(v[6], v[7]);
                    st16_wt(rdst, ((size_t)row * ld + col) * 2, w);
                    if (mode == 1) {
                        float* sp = nullptr;
                        if (u.pm == 256) { const int r = row - MP; sp = side + side_s + ((size_t)((r >> 4) * 128 + 112 + (r & 15)) * KVW + col); }
                        else if ((u.pm & 15) == 15 && ai == 1) { const int j = wr * 64 + m * 16 + fr; sp = side + ((size_t)((u.pm >> 4) * 128 + j) * KVW + col); }
                        if (sp) { *(f32x4*)sp = (f32x4){v[0], v[1], v[2], v[3]}; *(f32x4*)(sp + 4) = (f32x4){v[4], v[5], v[6], v[7]}; }
                    }
                }
                if (pn >= 10 && pn < 14) {
                    s1 += __shfl_xor(s1, 16); s1 += __shfl_xor(s1, 32); s2 += __shfl_xor(s2, 16); s2 += __shfl_xor(s2, 32);
                    if (fq == 0) { const size_t si = (size_t)((pn - 10) * 4 + wc) * MT + row; stf_wt(PG1 + si, s1); stf_wt(PG2 + si, s2); }
                }
            }
        return false;
    }
};
struct EpiMerge {
    static constexpr bool PERM = true;
    const bf16 *SA, *SB; bf16* O;
    __device__ __forceinline__ bool operator()(f32x4 (&acc)[2][2][4][2], const Unit& u, int wr, int wc, int fr, int fq) const {
        const int row0 = u.pm * 256 + wr * 64 + fr, col0 = u.pn * 256 + wc * 32 + 8 * fq; const rsrc_t ro = mk_rsrc(O);
        if (u.seg == 0) {
#pragma unroll
            for (int ai = 0; ai < 2; ++ai) {
                v4u sbw[4][2], saw[4][2];
#pragma unroll
                for (int m = 0; m < 4; ++m)
#pragma unroll
                    for (int bj = 0; bj < 2; ++bj) { const size_t off = (size_t)(row0 + ai * 128 + m * 16) * DM + col0 + bj * 128; sbw[m][bj] = *(const v4u*)(SB + off); saw[m][bj] = *(const v4u*)(SA + off); }
#pragma unroll
                for (int m = 0; m < 4; ++m)
#pragma unroll
                    for (int bj = 0; bj < 2; ++bj) { const v4u b = sbw[m][bj], a = saw[m][bj];
                        const float sb[8] = {bflo(b.x), bfhi(b.x), bflo(b.y), bfhi(b.y), bflo(b.z), bfhi(b.z), bflo(b.w), bfhi(b.w)}, sa[8] = {bflo(a.x), bfhi(a.x), bflo(a.y), bfhi(a.y), bflo(a.z), bfhi(a.z), bflo(a.w), bfhi(a.w)};
#pragma unroll
                        for (int j = 0; j < 4; ++j) { acc[ai][bj][m][0][j] *= sa[j] * __builtin_amdgcn_rcpf(fmaxf(sb[j], 1e-30f)); acc[ai][bj][m][1][j] *= sa[4 + j] * __builtin_amdgcn_rcpf(fmaxf(sb[4 + j], 1e-30f)); } }
            }
            return true;
        }
        v4u sbw[2][4][2];
#pragma unroll
        for (int ai = 0; ai < 2; ++ai)
#pragma unroll
            for (int m = 0; m < 4; ++m)
#pragma unroll
                for (int bj = 0; bj < 2; ++bj) sbw[ai][m][bj] = *(const v4u*)(SB + (size_t)(row0 + ai * 128 + m * 16) * DM + col0 + bj * 128);
#pragma unroll
        for (int ai = 0; ai < 2; ++ai)
#pragma unroll
            for (int m = 0; m < 4; ++m)
#pragma unroll
                for (int bj = 0; bj < 2; ++bj) { const size_t off = (size_t)(row0 + ai * 128 + m * 16) * DM + col0 + bj * 128; const v4u b = sbw[ai][m][bj];
                    const float sb[8] = {bflo(b.x), bfhi(b.x), bflo(b.y), bfhi(b.y), bflo(b.z), bfhi(b.z), bflo(b.w), bfhi(b.w)}; float v[8];
#pragma unroll
                    for (int j = 0; j < 4; ++j) { v[j] = acc[ai][bj][m][0][j] * fmaxf(sb[j], 1e-30f); v[4 + j] = acc[ai][bj][m][1][j] * fmaxf(sb[4 + j], 1e-30f); }
                    v4u w; w.x = pk2(v[0], v[1]); w.y = pk2(v[2], v[3]); w.z = pk2(v[4], v[5]); w.w = pk2(v[6], v[7]);
                    st16_wt(ro, off * 2, w); }
        return false;
    }
};
struct EpiBf16Ss {
    static constexpr bool PERM = true;
    bf16* O; float* P;
    __device__ __forceinline__ bool operator()(f32x4 (&acc)[2][2][4][2], const Unit& u, int wr, int wc, int fr, int fq) const {
        const int row0 = u.pm * 256 + wr * 64 + fr, col0 = u.pn * 256 + wc * 32 + 8 * fq; const rsrc_t ro = mk_rsrc(O);
#pragma unroll
        for (int ai = 0; ai < 2; ++ai)
#pragma unroll
            for (int m = 0; m < 4; ++m) {
                const int row = row0 + ai * 128 + m * 16; float ss = 0.f;
#pragma unroll
                for (int bj = 0; bj < 2; ++bj) {
                    const f32x4 a = acc[ai][bj][m][0], b = acc[ai][bj][m][1];
                    ss += (a[0] * a[0] + a[1] * a[1]) + (a[2] * a[2] + a[3] * a[3]) + (b[0] * b[0] + b[1] * b[1]) + (b[2] * b[2] + b[3] * b[3]);
                    v4u w; w.x = pk2(a[0], a[1]); w.y = pk2(a[2], a[3]); w.z = pk2(b[0], b[1]); w.w = pk2(b[2], b[3]);
                    st16_wt(ro, ((size_t)row * DM + col0 + bj * 128) * 2, w);
                }
                ss += __shfl_xor(ss, 16); ss += __shfl_xor(ss, 32);
                if (fq == 0) stf_wt(P + (size_t)(u.pn * 4 + wc) * MT + row, ss);
            }
        return false;
    }
};
struct EpiSwiglu {
    static constexpr bool PERM = true;
    const float* rstd; bf16* O;
    __device__ __forceinline__ bool operator()(f32x4 (&acc)[2][2][4][2], const Unit& u, int wr, int wc, int fr, int fq) const {
        const int row0 = u.pm * 256 + wr * 64 + fr, col0 = u.pn * 128 + wc * 32 + 8 * fq; const rsrc_t ro = mk_rsrc(O);
        float rsv[2][4];
#pragma unroll
        for (int ai = 0; ai < 2; ++ai)
#pragma unroll
            for (int m = 0; m < 4; ++m) rsv[ai][m] = rstd[row0 + ai * 128 + m * 16];
#pragma unroll
        for (int ai = 0; ai < 2; ++ai)
#pragma unroll
            for (int m = 0; m < 4; ++m) {
                const int row = row0 + ai * 128 + m * 16; const float rs = rsv[ai][m]; float v[8];
#pragma unroll
                for (int n = 0; n < 2; ++n)
#pragma unroll
                    for (int j = 0; j < 4; ++j) { const float gg = acc[ai][0][m][n][j] * rs, up = acc[ai][1][m][n][j] * rs; v[4 * n + j] = gg * sigmoidf_(gg) * up; }
                v4u w; w.x = pk2(v[0], v[1]); w.y = pk2(v[2], v[3]); w.z = pk2(v[4], v[5]); w.w = pk2(v[6], v[7]);
                st16_wt(ro, ((size_t)row * DFF + col0) * 2, w);
            }
        return false;
    }
};

template <bool MAP>
__device__ __forceinline__ void p0_transpose_item(const float* W, int K, int N, const float* gain, bf16* WT, LAS float* scr, int item, int lane) {
    const int nblk = N / 32, kb = item / nblk, nb = item % nblk, k0 = 64 * kb, n0 = 32 * nb;
    f32x4 ld[8]; float gk[8];
#pragma unroll
    for (int i = 0; i < 8; ++i) { const int kk = (lane >> 3) + 8 * i; ld[i] = *(const f32x4*)(W + (size_t)(k0 + kk) * N + n0 + (lane & 7) * 4); gk[i] = gain ? gain[k0 + kk] : 1.0f; }
#pragma unroll
    for (int i = 0; i < 8; ++i) { const int kk = (lane >> 3) + 8 * i; LAS float* d = scr + kk * 33 + (lane & 7) * 4; d[0] = ld[i].x * gk[i]; d[1] = ld[i].y * gk[i]; d[2] = ld[i].z * gk[i]; d[3] = ld[i].w * gk[i]; }
    LDS_WAIT(); asm volatile("" ::: "memory");
    const int c = lane & 7;
#pragma unroll
    for (int j = 0; j < 4; ++j) { const int n = (lane >> 3) + 8 * j; const LAS float* s = scr + (8 * c) * 33 + n;
        v4u o; o.x = pk2(s[0 * 33], s[1 * 33]); o.y = pk2(s[2 * 33], s[3 * 33]); o.z = pk2(s[4 * 33], s[5 * 33]); o.w = pk2(s[6 * 33], s[7 * 33]);
        int nn = n0 + n;
        if (MAP) { const int hi = nn >= DFF ? 1 : 0, r = nn - hi * DFF; nn = 256 * (r >> 7) + 128 * hi + (r & 127); }
        *(GAS v4u*)(WT + (size_t)nn * K + k0 + 8 * c) = o; }
    LDS_WAIT(); asm volatile("" ::: "memory");
}

namespace att {
typedef short bf16x8 __attribute__((ext_vector_type(8)));
typedef short s16x4 __attribute__((ext_vector_type(4)));
typedef short v4i16_t __attribute__((ext_vector_type(4)));
typedef float f32x16 __attribute__((ext_vector_type(16)));
typedef LAS const char* lds_cptr;
constexpr int SLOT = 16384, OST = 4 * SLOT;
__device__ __forceinline__ int crow(int r, int hi) { return (r & 3) + 8 * (r >> 2) + 4 * hi; }
__device__ __forceinline__ s16x4 vtr(lds_cptr p) { return __builtin_bit_cast(s16x4, __builtin_amdgcn_ds_read_tr16_b64_v4i16((LAS v4i16_t*)p)); }
struct TileRegs { v4u k, v; };
__device__ __forceinline__ TileRegs load_tile(const bf16* KB, const bf16* VB, size_t rowbase, int kvh, int wid, int lane) {
    TileRegs t;
    t.k = *(const v4u*)(KB + (rowbase + lane) * KVW + kvh * HD + wid * 8);
    t.v = *(const v4u*)(VB + (rowbase + 16 * (wid & 3) + (lane >> 2)) * KVW + kvh * HD + (wid >> 2) * 32 + (lane & 3) * 8);
    return t;
}
__device__ __forceinline__ void store_tile(LAS unsigned char* slot, const TileRegs& t, int wid, int lane) {
    *(LAS v4u*)(slot + wid * 1024 + lane * 16) = t.k;
    *(LAS v4u*)(slot + 8192 + wid * 1024 + lane * 16) = t.v;
}
struct QFrag { bf16x8 q[4]; };
template <bool SAMPLE>
__device__ __forceinline__ QFrag load_q(const bf16* QO, size_t qrow0, int kvh, int wid, int lane) {
    const int r32 = lane & 31, hi = lane >> 5, posb = 32 * (wid & 1), head = kvh * 4 + (wid >> 1);
    const size_t qrow = SAMPLE ? qrow0 + ((posb + r32) & 15) : qrow0 + posb + r32;
    const bf16* qp = QO + qrow * DM + head * HD; QFrag f;
#pragma unroll
    for (int d0 = 0; d0 < 4; ++d0) f.q[d0] = *(const bf16x8*)(qp + d0 * 16 + hi * 8);
    return f;
}
template <bool SAMPLE, int FT>
__device__ __forceinline__ void attn_unit(LAS unsigned char* lds, int s0, int s1, int s2, int ft_rt, const QFrag& qf, bf16* AO, size_t qrow0, int kvh, const float* sinks, int wid, int lane) {
    const int r32 = lane & 31, hi = lane >> 5, g = wid >> 1, posb = 32 * (wid & 1), head = kvh * 4 + g;
    const int ft = FT >= 0 ? FT : ft_rt;
    const float sink2 = sinks[head] * LOG2E;
    f32x16 p[6];
#pragma unroll
    for (int ti = 0; ti < 3; ++ti) {
        if (ti >= ft) {
            const int so = (ti == 0) ? s0 : (ti == 1) ? s1 : s2;
            lds_cptr kb = (lds_cptr)lds + so + hi * 1024 + r32 * 16;
            f32x16 a = {}, c = {};
#pragma unroll
            for (int d0 = 0; d0 < 4; ++d0) {
                const bf16x8 b0 = *(const LAS bf16x8*)(kb + d0 * 2048), b1 = *(const LAS bf16x8*)(kb + d0 * 2048 + 512);
                a = __builtin_amdgcn_mfma_f32_32x32x16_bf16(b0, qf.q[d0], a, 0, 0, 0); c = __builtin_amdgcn_mfma_f32_32x32x16_bf16(b1, qf.q[d0], c, 0, 0, 0);
            }
            p[2 * ti] = a; p[2 * ti + 1] = c;
        } else {
#pragma unroll
            for (int r = 0; r < 16; ++r) { p[2 * ti][r] = -INFINITY; p[2 * ti + 1][r] = -INFINITY; }
        }
    }
    if (SAMPLE) {
#pragma unroll
        for (int r = 0; r < 16; ++r) { if (r >= 8) p[4][r] = -INFINITY; p[5][r] = -INFINITY; }
    }
    float mx = sink2;
#pragma unroll
    for (int kb = 0; kb < 6; ++kb)
#pragma unroll
        for (int r = 0; r < 16; ++r) mx = fmaxf(mx, p[kb][r]);
    { auto rr = __builtin_amdgcn_permlane32_swap(__float_as_uint(mx), __float_as_uint(mx), false, false); mx = fmaxf(__uint_as_float(rr[0]), __uint_as_float(rr[1])); }
    float sum = 0.f;
#pragma unroll
    for (int kb = 0; kb < 6; ++kb)
#pragma unroll
        for (int r = 0; r < 16; ++r) { p[kb][r] = __builtin_amdgcn_exp2f(p[kb][r] - mx); sum += p[kb][r]; }
    { auto rr = __builtin_amdgcn_permlane32_swap(__float_as_uint(sum), __float_as_uint(sum), false, false); sum = __uint_as_float(rr[0]) + __uint_as_float(rr[1]); }
    const float inv = 1.0f / (sum + __builtin_amdgcn_exp2f(sink2 - mx));
    f32x16 o0 = {}, o1 = {};
    const int vb = ((lane >> 4) & 1) * 32 + (lane & 3) * 8 + (4 * hi + ((lane & 15) >> 2)) * 64;
#pragma unroll
    for (int ti = 0; ti < 3; ++ti) {
        if (ti >= ft) {
            const int so = (ti == 0) ? s0 : (ti == 1) ? s1 : s2;
            lds_cptr vp = (lds_cptr)lds + so + 8192 + vb;
#pragma unroll
            for (int ks = 0; ks < 4; ++ks) {
                const int kb = 2 * ti + (ks >> 1), rb = 8 * (ks & 1);
                v4u pw; pw.x = pk2(p[kb][rb + 0] * inv, p[kb][rb + 1] * inv); pw.y = pk2(p[kb][rb + 2] * inv, p[kb][rb + 3] * inv); pw.z = pk2(p[kb][rb + 4] * inv, p[kb][rb + 5] * inv); pw.w = pk2(p[kb][rb + 6] * inv, p[kb][rb + 7] * inv);
                const bf16x8 pa = __builtin_bit_cast(bf16x8, pw);
                { const s16x4 lo = vtr(vp + ks * 1024), h4 = vtr(vp + ks * 1024 + 512); const bf16x8 vf = (bf16x8){lo[0], lo[1], lo[2], lo[3], h4[0], h4[1], h4[2], h4[3]};
                  o0 = __builtin_amdgcn_mfma_f32_32x32x16_bf16(pa, vf, o0, 0, 0, 0); }
                { const s16x4 lo = vtr(vp + 4096 + ks * 1024), h4 = vtr(vp + 4096 + ks * 1024 + 512); const bf16x8 vf = (bf16x8){lo[0], lo[1], lo[2], lo[3], h4[0], h4[1], h4[2], h4[3]};
                  o1 = __builtin_amdgcn_mfma_f32_32x32x16_bf16(pa, vf, o1, 0, 0, 0); }
            }
        }
    }
    LAS bf16* stg = (LAS bf16*)(lds + OST + wid * 4096); const rsrc_t rao = mk_rsrc(AO);
#pragma unroll
    for (int r = 0; r < 16; ++r) { const int orow = crow(r, hi); stg[orow * 64 + r32] = (bf16)(pk2(o0[r], 0.f) & 0xffffu); stg[orow * 64 + 32 + r32] = (bf16)(pk2(o1[r], 0.f) & 0xffffu); }
    LDS_WAIT();
#pragma unroll
    for (int i = 0; i < 4; ++i) { const int row = i * 8 + (lane >> 3), ch = lane & 7; const v4u v = *(const LAS v4u*)(stg + row * 64 + ch * 8);
        if (!SAMPLE || posb + row < 16) st16_wt(rao, ((qrow0 + posb + row) * DM + head * HD + ch * 8) * 2, v); }
    LDS_WAIT();
}
}

namespace gat {
using att::bf16x8; using att::s16x4; using att::f32x16; using att::lds_cptr; using att::vtr; using att::crow;
constexpr int G_LN = 1024, G_IMG = 9216, G_STG = G_IMG + 65536;
template <bool SAMPLE, int PP>
__device__ __forceinline__ void gate_group(LAS unsigned char* lds, int g, v4u (&raw)[8], const bf16* GV, const bf16* UB, bf16* BMO, const bf16* WSB, const float* b_s, float* gs_out, size_t row0, int tid, int wave, int lane) {
    constexpr int L = SAMPLE ? 16 : 128;
    asm volatile("" : "+v"(tid)); lane = tid & 63;
    constexpr int TB0 = PP, TB1 = 3 - PP, NK0 = 2 * (TB0 + 1), NK1 = 2 * (TB1 + 1);
    LAS float* stats = (LAS float*)lds; LAS float* lnp = (LAS float*)(lds + G_LN); LAS unsigned char* img = lds + G_IMG;
    const int r32 = lane & 31, hi = lane >> 5, cq = wave >> 1;
    const int vb = ((lane >> 4) & 1) * 32 + (lane & 3) * 8 + (4 * hi + ((lane & 15) >> 2)) * 64;
    const int sr = tid >> 5, sc = (tid & 31) * 8;
    bf16x8 af0[NK0], af1[NK1];
    { const bf16* w0 = WSB + ((size_t)(g * 128 + 32 * TB0 + r32) * 128 + hi * 8); const bf16* w1 = WSB + ((size_t)(g * 128 + 32 * TB1 + r32) * 128 + hi * 8);
#pragma unroll
      for (int ks = 0; ks < NK0; ++ks) af0[ks] = *(const bf16x8*)(w0 + ks * 16);
#pragma unroll
      for (int ks = 0; ks < NK1; ++ks) af1[ks] = *(const bf16x8*)(w1 + ks * 16); }
    v4u uw[2][4]; float bias[2][4];
#pragma unroll
    for (int tsel = 0; tsel < 2; ++tsel) { const int tb = tsel ? TB1 : TB0;
#pragma unroll
        for (int i = 0; i < 4; ++i) { const int t = 32 * tb + i * 8 + (lane >> 3); uw[tsel][i] = (v4u){0u, 0u, 0u, 0u}; bias[tsel][i] = 0.f;
            if (t < L) { uw[tsel][i] = *(const v4u*)(UB + (row0 + t) * DM + g * 256 + 64 * cq + (lane & 7) * 8); bias[tsel][i] = b_s[g * 128 + t]; } } }
    { const int col = g * 256 + sc;
      const f32x4 g0 = *(const LAS f32x4*)(lnp + col), g1 = *(const LAS f32x4*)(lnp + col + 4), b0 = *(const LAS f32x4*)(lnp + DM + col), b1 = *(const LAS f32x4*)(lnp + DM + col + 4);
#pragma unroll
      for (int i = 0; i < 8; ++i) { const int r = sr + 16 * i; v4u w = {0u, 0u, 0u, 0u};
        if (r < L) {
            const v4u x = raw[i]; const float mean = stats[2 * r], rstd = stats[2 * r + 1];
            float v[8] = {bflo(x.x), bfhi(x.x), bflo(x.y), bfhi(x.y), bflo(x.z), bfhi(x.z), bflo(x.w), bfhi(x.w)};
            v[0] = (v[0] - mean) * rstd * g0.x + b0.x; v[1] = (v[1] - mean) * rstd * g0.y + b0.y; v[2] = (v[2] - mean) * rstd * g0.z + b0.z; v[3] = (v[3] - mean) * rstd * g0.w + b0.w;
            v[4] = (v[4] - mean) * rstd * g1.x + b1.x; v[5] = (v[5] - mean) * rstd * g1.y + b1.y; v[6] = (v[6] - mean) * rstd * g1.z + b1.z; v[7] = (v[7] - mean) * rstd * g1.w + b1.w;
            if (SAMPLE) { float* gs = gs_out + (size_t)r * DM + col; *(f32x4*)gs = (f32x4){v[0], v[1], v[2], v[3]}; *(f32x4*)(gs + 4) = (f32x4){v[4], v[5], v[6], v[7]}; }
            w.x = pk2(v[0], v[1]); w.y = pk2(v[2], v[3]); w.z = pk2(v[4], v[5]); w.w = pk2(v[6], v[7]);
        }
        *(LAS v4u*)(img + ((sc >> 5) * 8 + (r >> 4)) * 1024 + (r & 15) * 64 + (sc & 31) * 2) = w; } }
    if (g < 3) {
#pragma unroll
        for (int i = 0; i < 8; ++i) if (sr + 16 * i < L) raw[i] = *(const v4u*)(GV + (row0 + sr + 16 * i) * DM + (g + 1) * 256 + sc);
    }
    __syncthreads();
    f32x16 o[2][2];
#pragma unroll
    for (int a = 0; a < 2; ++a)
#pragma unroll
        for (int c = 0; c < 2; ++c) o[a][c] = (f32x16){};
#pragma unroll
    for (int ks = 0; ks < NK1; ++ks) {
#pragma unroll
        for (int cs = 0; cs < 2; ++cs) {
            lds_cptr vp = (lds_cptr)img + ((2 * cq + cs) * 8 + ks) * 1024 + vb;
            const s16x4 lo = vtr(vp), h4 = vtr(vp + 512); const bf16x8 vf = (bf16x8){lo[0], lo[1], lo[2], lo[3], h4[0], h4[1], h4[2], h4[3]};
            if (ks < NK0) o[0][cs] = __builtin_amdgcn_mfma_f32_32x32x16_bf16(af0[ks < NK0 ? ks : 0], vf, o[0][cs], 0, 0, 0);
            o[1][cs] = __builtin_amdgcn_mfma_f32_32x32x16_bf16(af1[ks], vf, o[1][cs], 0, 0, 0);
        }
        __builtin_amdgcn_sched_barrier(0);
    }
    LAS float* stg = (LAS float*)(lds + G_STG + wave * 8704); const rsrc_t rbm = mk_rsrc(BMO);
#pragma unroll
    for (int tsel = 0; tsel < 2; ++tsel) {
        const int tb = tsel ? TB1 : TB0;
#pragma unroll
        for (int r = 0; r < 16; ++r) { const int row = crow(r, hi); stg[row * 68 + r32] = o[tsel][0][r]; stg[row * 68 + 32 + r32] = o[tsel][1][r]; }
        LDS_WAIT();
#pragma unroll
        for (int i = 0; i < 4; ++i) { const int row = i * 8 + (lane >> 3), ch0 = (lane & 7) * 8, t = 32 * tb + row;
            if (t < L) {
                const f32x4 m0 = *(const LAS f32x4*)(stg + row * 68 + ch0), m1 = *(const LAS f32x4*)(stg + row * 68 + ch0 + 4); const float bs = bias[tsel][i];
                const v4u u4 = uw[tsel][i]; v4u w;
                w.x = pk2(bflo(u4.x) * (m0.x + bs), bfhi(u4.x) * (m0.y + bs)); w.y = pk2(bflo(u4.y) * (m0.z + bs), bfhi(u4.y) * (m0.w + bs));
                w.z = pk2(bflo(u4.z) * (m1.x + bs), bfhi(u4.z) * (m1.y + bs)); w.w = pk2(bflo(u4.w) * (m1.z + bs), bfhi(u4.w) * (m1.w + bs));
                st16_wt(rbm, ((row0 + t) * DM + g * 256 + 64 * cq + ch0) * 2, w);
            }
        }
        LDS_WAIT();
    }
    __syncthreads();
}
template <bool SAMPLE>
__device__ __forceinline__ void gate_unit(LAS unsigned char* lds, const bf16* GV, const bf16* UB, bf16* BMO, const bf16* WSB, const float* PG1, const float* PG2, const float* ln_g, const float* ln_b, const float* b_s, float* gs_out, size_t row0, int tid, int wave, int lane) {
    constexpr int L = SAMPLE ? 16 : 128;
    LAS float* stats = (LAS float*)lds; LAS float* lnp = (LAS float*)(lds + G_LN);
    __syncthreads();
    const int sr = tid >> 5, sc = (tid & 31) * 8;
    v4u raw[8];
#pragma unroll
    for (int i = 0; i < 8; ++i) { raw[i] = (v4u){0u, 0u, 0u, 0u}; if (sr + 16 * i < L) raw[i] = *(const v4u*)(GV + (row0 + sr + 16 * i) * DM + sc); }
    if (tid < L) {
        float a = 0.f, q = 0.f;
#pragma unroll
        for (int k = 0; k < 16; ++k) { a += PG1[(size_t)k * MT + row0 + tid]; q += PG2[(size_t)k * MT + row0 + tid]; }
        const float mean = a * (1.0f / DM), var = fmaxf(q * (1.0f / DM) - mean * mean, 0.f);
        stats[2 * tid] = mean; stats[2 * tid + 1] = 1.0f / sqrtf(var + EPS);
    }
    { const int i4 = tid & 255; const float* src = (tid < 256) ? ln_g : ln_b; *(LAS f32x4*)(lnp + (tid < 256 ? 0 : DM) + 4 * i4) = *(const f32x4*)(src + 4 * i4); }
    __syncthreads();
    if (wave & 1) { for (int g = 0; g < 4; ++g) gate_group<SAMPLE, 1>(lds, g, raw, GV, UB, BMO, WSB, b_s, gs_out, row0, tid, wave, lane); }
    else          { for (int g = 0; g < 4; ++g) gate_group<SAMPLE, 0>(lds, g, raw, GV, UB, BMO, WSB, b_s, gs_out, row0, tid, wave, lane); }
}
}

template <bool WT>
__device__ __forceinline__ void x_rows4(int m0, const float* xp, const float* xs, bf16* XB, float* RSTD1, int lane) {
    f32x4 v[4][4]; const rsrc_t rx = mk_rsrc(XB);
#pragma unroll
    for (int i = 0; i < 4; ++i) { const int m = m0 + i; const float* xrow = (m < MP) ? xp + (size_t)m * DM : xs + (size_t)(m - MP) * DM;
#pragma unroll
        for (int k = 0; k < 2; ++k) { v[i][2 * k] = *(const f32x4*)(xrow + k * 512 + 8 * lane); v[i][2 * k + 1] = *(const f32x4*)(xrow + k * 512 + 8 * lane + 4); } }
#pragma unroll
    for (int i = 0; i < 4; ++i) { const int m = m0 + i; float s = 0.f;
#pragma unroll
        for (int j = 0; j < 4; ++j) s += (v[i][j].x * v[i][j].x + v[i][j].y * v[i][j].y) + (v[i][j].z * v[i][j].z + v[i][j].w * v[i][j].w);
        s = wave_sum(s);
        const float rs = 1.0f / sqrtf(s * (1.0f / DM) + EPS);
        if (lane == 0) { if (WT) stf_wt(RSTD1 + m, rs); else RSTD1[m] = rs; }
#pragma unroll
        for (int k = 0; k < 2; ++k) { v4u w; w.x = pk2(v[i][2 * k].x, v[i][2 * k].y); w.y = pk2(v[i][2 * k].z, v[i][2 * k].w); w.z = pk2(v[i][2 * k + 1].x, v[i][2 * k + 1].y); w.w = pk2(v[i][2 * k + 1].z, v[i][2 * k + 1].w);
            if (WT) st16_wt(rx, ((size_t)m * DM + k * 512 + 8 * lane) * 2, w); else *(v4u*)(XB + (size_t)m * DM + k * 512 + 8 * lane) = w; } }
}
__device__ __forceinline__ bool chunk_next(pg8::DynOrder& S, int i, pg8::Unit& u, int tid) {
    if (tid == 0) S.put(i & 1, S.draw(S.xcd), 0);
    __syncthreads();
    return S.get(i & 1, u);
}
__device__ __forceinline__ void l1_acquire(int tid) {
    __syncthreads();
    if (tid == 0) { __builtin_amdgcn_fence(__ATOMIC_ACQUIRE, "agent"); asm volatile("s_waitcnt vmcnt(0)" ::: "memory"); }
    __syncthreads();
}
__device__ __forceinline__ void rows_wait(unsigned* cnt, unsigned need, unsigned* tot, unsigned need_tot, int& flag, unsigned* tmo, int wave) {
    if (wave == 0 && flag == 0) {
        unsigned spins = 0;
        for (;;) {
            const unsigned c0 = __hip_atomic_load(cnt, __ATOMIC_RELAXED, __HIP_MEMORY_SCOPE_AGENT), t0 = __hip_atomic_load(tot, __ATOMIC_RELAXED, __HIP_MEMORY_SCOPE_AGENT);
            const unsigned c = (unsigned)__builtin_amdgcn_readfirstlane(c0), t = (unsigned)__builtin_amdgcn_readfirstlane(t0);
            if (t >= need_tot) { flag = 1; break; }
            if (c >= need) break;
            if (++spins > PG8_SPIN_CAP || ((spins & 63u) == 0u && __builtin_amdgcn_readfirstlane(__hip_atomic_load(tmo, __ATOMIC_RELAXED, __HIP_MEMORY_SCOPE_AGENT)) != 0u)) { if ((threadIdx.x & 63) == 0) __hip_atomic_store(tmo, 1u, __ATOMIC_RELAXED, __HIP_MEMORY_SCOPE_AGENT); break; }
            __builtin_amdgcn_s_sleep(4);
        }
    }
    __syncthreads();
}

__device__ __forceinline__ void panels_wait(unsigned* C, int p_lo, int p_hi, unsigned need, unsigned* tot, unsigned need_tot, int& flag, unsigned* tmo, int wave) {
    if (wave == 0 && flag == 0) {
        unsigned spins = 0;
        for (;;) {
            const unsigned t0 = __hip_atomic_load(tot, __ATOMIC_RELAXED, __HIP_MEMORY_SCOPE_AGENT); unsigned cmin = 0xffffffffu;
            for (int p = p_lo; p <= p_hi; ++p) { const unsigned c = __hip_atomic_load(C + 64 * p, __ATOMIC_RELAXED, __HIP_MEMORY_SCOPE_AGENT); cmin = c < cmin ? c : cmin; }
            if ((unsigned)__builtin_amdgcn_readfirstlane(t0) >= need_tot) { flag = 1; break; }
            if ((unsigned)__builtin_amdgcn_readfirstlane(cmin) >= need) break;
            if (++spins > PG8_SPIN_CAP || ((spins & 63u) == 0u && __builtin_amdgcn_readfirstlane(__hip_atomic_load(tmo, __ATOMIC_RELAXED, __HIP_MEMORY_SCOPE_AGENT)) != 0u)) { if ((threadIdx.x & 63) == 0) __hip_atomic_store(tmo, 1u, __ATOMIC_RELAXED, __HIP_MEMORY_SCOPE_AGENT); break; }
            __builtin_amdgcn_s_sleep(4);
        }
    }
    __syncthreads();
}
__device__ __forceinline__ void p2_signal(unsigned* C2, int panel, int lane) {
    asm volatile("s_waitcnt vmcnt(0)" ::: "memory");
    if (lane == 0) __hip_atomic_fetch_add(C2 + 64 * panel, 1u, __ATOMIC_RELAXED, __HIP_MEMORY_SCOPE_AGENT);
}
__device__ __forceinline__ void p2_signal_sample(unsigned* C2, unsigned* CS, int lane) {
    asm volatile("s_waitcnt vmcnt(0)" ::: "memory");
    if (lane == 0) { const unsigned old = __hip_atomic_fetch_add(CS, 1u, __ATOMIC_RELAXED, __HIP_MEMORY_SCOPE_AGENT); if (old == 639u) __hip_atomic_fetch_add(C2 + 64 * 256, 48u, __ATOMIC_RELAXED, __HIP_MEMORY_SCOPE_AGENT); }
}

struct Args { const float* in[19]; float* out; unsigned char* ws; int ph_lo, ph_hi; };

__global__ void __launch_bounds__(NWAVES * 64, 2) fwd_kernel(Args args) {
    extern __shared__ __attribute__((aligned(16))) unsigned char lds_raw[];
    LAS unsigned char* lds = (LAS unsigned char*)lds_raw;
    volatile LAS unsigned* MISC = (volatile LAS unsigned*)(lds + MISC_OFF);
    const int tid = threadIdx.x, lane = tid & 63, wave = __builtin_amdgcn_readfirstlane(tid >> 6);
    const int G = gridDim.x;
    const int vcu = (G % 8 == 0) ? ((int)blockIdx.x % 8) * (G / 8) + (int)blockIdx.x / 8 : (int)blockIdx.x;
    unsigned char* ws = args.ws;
    const float* xp = args.in[0]; const float* xs = args.in[1]; const float* cache_k = args.in[2]; const float* cache_v = args.in[3];
    const float* g_pre_mix = args.in[4]; const float* g_post_mix = args.in[5]; const float* g_pre_ffn = args.in[6]; const float* g_post_ffn = args.in[7];
    const float* w_in = args.in[8]; const float* sinks = args.in[9]; const float* ln_g = args.in[10]; const float* ln_b = args.in[11];
    const float* w_s = args.in[12]; const float* b_s = args.in[13]; const float* w_ap = args.in[14]; const float* w_gp = args.in[15];
    const float* w_out = args.in[16]; const float* w_fi = args.in[17]; const float* w_fo = args.in[18];
    float* out = args.out;
    bf16* WinT = (bf16*)(ws + WS_WIN); bf16* WfiT = (bf16*)(ws + WS_WFI); bf16* WaT = (bf16*)(ws + WS_WA); bf16* WgT = (bf16*)(ws + WS_WG); bf16* WoT = (bf16*)(ws + WS_WO); bf16* WfoT = (bf16*)(ws + WS_WFO); bf16* WSB = (bf16*)(ws + WS_WSB);
    float* RSTD1 = (float*)(ws + WS_RSTD1); float* RSTD2 = (float*)(ws + WS_RSTD2); float* PMIX = (float*)(ws + WS_PMIX); float* PF = (float*)(ws + WS_PF);
    bf16* XB = (bf16*)(ws + WS_R0); bf16* FB = XB;
    bf16* QB = (bf16*)(ws + WS_R1); bf16* MERGED = QB; bf16* X1B = QB;
    bf16* GV = (bf16*)(ws + WS_R2); bf16* MIX = GV;
    bf16* KB = (bf16*)(ws + WS_KB); bf16* VB = (bf16*)(ws + WS_VB);
    bf16* SA = (bf16*)(ws + WS_SA); bf16* SB = (bf16*)(ws + WS_SB); bf16* UB = (bf16*)(ws + WS_U); bf16* ACT = (bf16*)(ws + WS_R3); bf16* AO = (bf16*)(ws + WS_AO);
#ifdef GATE_OOP
    bf16* BMB = XB;
#else
    bf16* BMB = UB;
#endif

    for (int u = tid; u < (LDS_BYTES - LDSCTL_OFF) / 4; u += NWAVES * 64) ((LAS unsigned*)(lds + LDSCTL_OFF))[u] = 0u;
    __syncthreads();
    XcdBarrier bar; bar.bar = (unsigned*)(ws + WS_CTL) + CW_BAR; bar.x = 0; bar.st = nullptr;
    if (MK_ONE_LAUNCH) bar = xcd_barrier_post((unsigned*)(ws + WS_CTL) + CW_BAR, MISC + 8);
    const int lo = args.ph_lo, hi = args.ph_hi;
    STAMP(0);
#ifndef PH_MASK
#define PH_MASK 0x1ff
#endif
#define IN(k) (((PH_MASK >> (k)) & 1) && lo <= (k) && (k) < hi)
#define SEAM(k) do { if (MK_ONE_LAUNCH && IN(k) && IN((k) + 1)) xcd_barrier(bar); } while (0)
    const int gw = vcu * NWAVES + wave, NGW = G * NWAVES;
    unsigned* const QH = (unsigned*)(ws + WS_CTL) + CW_Q; LAS int* const BOX = (LAS int*)(lds + BOX_OFF);
    unsigned* const C0 = (unsigned*)(ws + WS_CTL) + CW_C0, * const T0 = (unsigned*)(ws + WS_CTL) + CW_TOT + 5 * 64, * const TMO0 = (unsigned*)(ws + WS_CTL) + CW_TMO;

    if (IN(0)) for (int rep_ = 0; rep_ < NREP(0); ++rep_) {
        LAS float* scr = (LAS float*)(lds + wave * 16384);
        constexpr int I_IN = (DM / 64) * (INW / 32), I_SQ = (DM / 64) * (DM / 32), I_FO = (DFF / 64) * (DM / 32);
        constexpr int NITEMS = 2 * I_IN + 3 * I_SQ + I_FO;
        for (int it = gw; it < NITEMS; it += NGW) {
            int r = it;
            if (r < I_IN) { p0_transpose_item<false>(w_in, DM, INW, g_pre_mix, WinT, scr, r, lane); continue; } r -= I_IN;
            if (r < I_IN) { p0_transpose_item<true>(w_fi, DM, INW, g_pre_ffn, WfiT, scr, r, lane); continue; } r -= I_IN;
            if (r < I_SQ) { p0_transpose_item<false>(w_ap, DM, DM, nullptr, WaT, scr, r, lane); continue; } r -= I_SQ;
            if (r < I_SQ) { p0_transpose_item<false>(w_gp, DM, DM, nullptr, WgT, scr, r, lane); continue; } r -= I_SQ;
            if (r < I_SQ) { p0_transpose_item<false>(w_out, DM, DM, nullptr, WoT, scr, r, lane); continue; } r -= I_SQ;
            p0_transpose_item<false>(w_fo, DFF, DM, nullptr, WfoT, scr, r, lane);
        }
        for (int i = gw * 64 + lane; i < 4 * 128 * 128; i += NGW * 64) {
            const int t = (i >> 7) & 127, pp = i & 127, pl = pp & 15, sl = (pl & 3) | ((pl & 4) << 1) | ((pl & 8) >> 1), sidx = (pp & ~15) + sl;
            const float v = (sidx <= t) ? w_s[(size_t)(i & ~127) + sidx] : 0.f;
            WSB[i] = (bf16)(pk2(v, 0.f) & 0xffffu);
        }
        for (int gi = gw; gi < 65 * 64; gi += NGW) { const int p = gi >> 6, panel = p < 64 ? 32 * (p & 7) + (p >> 3) : 256; x_rows4<false>(panel * 256 + 4 * (gi & 63), xp, xs, XB, RSTD1, lane); }
        if (tid == 0) for (int p = blockIdx.x; p < 65; p += G) { const int panel = p < 64 ? 32 * (p & 7) + (p >> 3) : 256; __hip_atomic_fetch_add(C0 + 64 * panel, 8u, __ATOMIC_RELAXED, __HIP_MEMORY_SCOPE_AGENT); }
        for (int i = gw * 64 + lane; i < 2 * NB * 112 * 64; i += NGW * 64) {
            const int which = i / (NB * 112 * 64), r = i % (NB * 112 * 64), b = r / (112 * 64), q = r % (112 * 64);
            const float* src = (which ? cache_v : cache_k) + (size_t)b * 128 * KVW + 16 * KVW;
            float* dstp = out + (which ? O_VS : O_KS) + (size_t)b * 128 * KVW;
            ((f32x4*)dstp)[q] = ((const f32x4*)src)[q];
        }
    }
    STAMP(1);
    SEAM(0);
    STAMP(2);

    if (IN(1)) for (int rep_ = 0; rep_ < NREP(1); ++rep_) {
        const int NWK = (G >> 5) * 8;
        if (((blockIdx.x >> 3) & 3) == 0 && rep_ == 0) {
            const int w = (int)(blockIdx.x & 7) + 8 * (int)(blockIdx.x >> 5);
            for (int idx = w; idx < 192; idx += NWK) { const int wi = idx & 63, panel = 32 * (wi & 7) + 8 * (1 + (idx >> 6)) + (wi >> 3);
                for (int r = 0; r < 8; ++r) x_rows4<true>(panel * 256 + 32 * wave + 4 * r, xp, xs, XB, RSTD1, lane);
                asm volatile("s_waitcnt vmcnt(0)" ::: "memory");
                if (lane == 0) __hip_atomic_fetch_add(C0 + 64 * panel, 1u, __ATOMIC_RELAXED, __HIP_MEMORY_SCOPE_AGENT); }
            __syncthreads();
            if (tid == 0) __hip_atomic_fetch_add(T0, 1u, __ATOMIC_RELAXED, __HIP_MEMORY_SCOPE_AGENT);
        }
        pg8::Gemm g{XB, WinT, XB, WinT, MT, INW, DM}; pg8::DynOrder S; S.init(QH + 1 * 512, MP, INW, 1, BOX);
        EpiIn E{RSTD1, QB, KB, VB, UB, GV, SA, SB, out, PF, PMIX};
        const pg8::Dep D{C0, 8u, T0, (unsigned)NWK, nullptr, 0u, (unsigned*)(ws + WS_CTL) + CW_C1, (unsigned*)(ws + WS_CTL) + CW_TOT + 6 * 64, TMO0}; pg8::gemm_phase<EpiIn, pg8::DynOrder, 0>(lds, g, S, E, D);
    }
    STAMP(3);
    STAMP(4);

    unsigned* const C1 = (unsigned*)(ws + WS_CTL) + CW_C1, * const C2 = (unsigned*)(ws + WS_CTL) + CW_C2, * const CSP = (unsigned*)(ws + WS_CTL) + CW_CS;
    unsigned* const T1 = (unsigned*)(ws + WS_CTL) + CW_TOT + 6 * 64, * const T2 = (unsigned*)(ws + WS_CTL) + CW_TOT + 7 * 64;
    if (IN(2)) {
        int p2flag = 0;
        for (;;) {
            __syncthreads();
            if (tid == 0) BOX[0] = (int)__hip_atomic_fetch_add(QH + 2 * 512, 1u, __ATOMIC_RELAXED, __HIP_MEMORY_SCOPE_AGENT);
            __syncthreads();
            const int t = BOX[0];
            if (t >= NB * NKV * 4 + NB * NKV) break;
            if (t < NB * NKV * 4) {
                const int key = t >> 6, w6 = t & 63, kvh = w6 & 3, b = 2 * (w6 >> 3) + (key >> 1), qq = 2 * (key & 1) + ((w6 >> 2) & 1), c0 = 16 * qq; const size_t seqbase = (size_t)b * SEQ;
                panels_wait(C1, 16 * b + 4 * qq - (qq > 0 ? 1 : 0), 16 * b + 4 * qq + 3, 176u, T1, (unsigned)G, p2flag, TMO0, wave);
                for (int T = (c0 >= 2 ? c0 - 2 : 0); T <= c0; ++T) { const att::TileRegs tr = att::load_tile(KB, VB, seqbase + 64 * T, kvh, wave, lane); att::store_tile(lds + (T & 3) * att::SLOT, tr, wave, lane); }
                att::QFrag qc = att::load_q<false>(QB, seqbase + 64 * c0, kvh, wave, lane);
                __syncthreads();
                for (int c = c0; c < c0 + 16; ++c) {
                    att::TileRegs nx; nx.k = (v4u){0u, 0u, 0u, 0u}; nx.v = nx.k; const bool pre = (c + 1 < c0 + 16);
                    att::QFrag qn = qc;
                    if (pre) { nx = att::load_tile(KB, VB, seqbase + 64 * (c + 1), kvh, wave, lane); qn = att::load_q<false>(QB, seqbase + 64 * (c + 1), kvh, wave, lane); }
                    if (c >= 2) att::attn_unit<false, 0>(lds, ((c + 2) & 3) * att::SLOT, ((c + 3) & 3) * att::SLOT, (c & 3) * att::SLOT, 0, qc, AO, seqbase + 64 * c, kvh, sinks, wave, lane);
                    else att::attn_unit<false, -1>(lds, ((c + 2) & 3) * att::SLOT, ((c + 3) & 3) * att::SLOT, (c & 3) * att::SLOT, 2 - c, qc, AO, seqbase + 64 * c, kvh, sinks, wave, lane);
                    if (pre) att::store_tile(lds + ((c + 1) & 3) * att::SLOT, nx, wave, lane);
                    qc = qn;
                    if ((c & 3) == 3) p2_signal(C2, 16 * b + (c >> 2), lane);
                    __syncthreads();
                }
            } else {
                const int j = t - NB * NKV * 4, b = j >> 2, kvh = j & 3;
                panels_wait(C1, 256, 256, 176u, T1, (unsigned)G, p2flag, TMO0, wave);
#pragma unroll
                for (int T = 0; T < 2; ++T) {
                    att::TileRegs tr;
                    { const size_t o = ((size_t)(b * 128 + 64 * T + lane) * NKV + kvh) * HD + wave * 8; const f32x4 k0 = *(const f32x4*)(cache_k + o), k1 = *(const f32x4*)(cache_k + o + 4);
                      tr.k.x = pk2(k0.x, k0.y); tr.k.y = pk2(k0.z, k0.w); tr.k.z = pk2(k1.x, k1.y); tr.k.w = pk2(k1.z, k1.w); }
                    { const size_t o = ((size_t)(b * 128 + 64 * T + 16 * (wave & 3) + (lane >> 2)) * NKV + kvh) * HD + (wave >> 2) * 32 + (lane & 3) * 8; const f32x4 v0 = *(const f32x4*)(cache_v + o), v1 = *(const f32x4*)(cache_v + o + 4);
                      tr.v.x = pk2(v0.x, v0.y); tr.v.y = pk2(v0.z, v0.w); tr.v.z = pk2(v1.x, v1.y); tr.v.w = pk2(v1.z, v1.w); }
                    att::store_tile(lds + T * att::SLOT, tr, wave, lane);
                }
                { att::TileRegs tr; tr.k = (v4u){0u, 0u, 0u, 0u}; tr.v = tr.k;
                  if (lane < 16) tr.k = *(const v4u*)(KB + (size_t)(MP + b * 16 + lane) * KVW + kvh * HD + wave * 8);
                  if ((wave & 3) == 0) tr.v = *(const v4u*)(VB + (size_t)(MP + b * 16 + (lane >> 2)) * KVW + kvh * HD + (wave >> 2) * 32 + (lane & 3) * 8);
                  att::store_tile(lds + 2 * att::SLOT, tr, wave, lane); }
                __syncthreads();
                { const att::QFrag qs = att::load_q<true>(QB, (size_t)(MP + b * 16), kvh, wave, lane); att::attn_unit<true, 0>(lds, 0, att::SLOT, 2 * att::SLOT, 0, qs, AO, (size_t)(MP + b * 16), kvh, sinks, wave, lane); }
                p2_signal_sample(C2, CSP, lane);
            }
        }
        for (;;) {
            __syncthreads();
            if (tid == 0) BOX[0] = (int)__hip_atomic_fetch_add(QH + 2 * 512 + 64, 1u, __ATOMIC_RELAXED, __HIP_MEMORY_SCOPE_AGENT);
            __syncthreads();
            const int t = BOX[0];
            if (t >= NB * 32 + NB) break;
            if (t < NB * 32) {
                const int key = t >> 7, w7 = t & 127, b = 2 * (w7 >> 4) + (key >> 1), unit = b * 32 + 16 * (key & 1) + (w7 & 15);
                panels_wait(C1, unit >> 1, unit >> 1, 176u, T1, (unsigned)G, p2flag, TMO0, wave);
                gat::gate_unit<false>(lds, GV, UB, BMB, WSB, PF, PMIX, ln_g, ln_b, b_s, nullptr, (size_t)unit * 128, tid, wave, lane);
                p2_signal(C2, unit >> 1, lane);
            } else {
                const int j = t - NB * 32;
                panels_wait(C1, 256, 256, 176u, T1, (unsigned)G, p2flag, TMO0, wave);
                gat::gate_unit<true>(lds, GV, UB, BMB, WSB, PF, PMIX, ln_g, ln_b, b_s, out + O_GS + (size_t)j * 16 * DM, (size_t)(MP + j * 16), tid, wave, lane);
                p2_signal_sample(C2, CSP, lane);
            }
        }
        __syncthreads();
        if (tid == 0) __hip_atomic_fetch_add(T2, 1u, __ATOMIC_RELAXED, __HIP_MEMORY_SCOPE_AGENT);
    }
    STAMP(5);
    STAMP(6);

    unsigned* const ctl = (unsigned*)(ws + WS_CTL);
    unsigned* const C3 = ctl + CW_CNT, * const C4 = C3 + 264 * 64, * const C5 = C4 + 264 * 64, * const C6 = C5 + 264 * 64, * const C7 = C6 + 264 * 64, * const T3 = ctl + CW_TOT, * const T4 = T3 + 64, * const T5 = T4 + 64, * const T6 = T5 + 64, * const T7 = T6 + 64, * const TMO = ctl + CW_TMO;
    const unsigned NWG = (unsigned)G;
    if (IN(3)) {
        pg8::Gemm g{AO, WaT, BMB, WgT, MT, DM, DM}; pg8::DynOrder S; S.init(QH + 3 * 512, MP, DM, 2, BOX);
        EpiMerge E{SA, SB, MERGED}; const pg8::Dep D{C2, 48u, T2, NWG, nullptr, 0u, C3, T3, TMO};
        l1_acquire(tid); pg8::gemm_phase<EpiMerge, pg8::DynOrder, 0>(lds, g, S, E, D);
    }
    STAMP(7);
    if (IN(4)) {
        pg8::Gemm g{MERGED, WoT, MERGED, WoT, MT, DM, DM}; pg8::DynOrder S; S.init(QH + 4 * 512, MP, DM, 1, BOX);
        EpiBf16Ss E{MIX, PMIX}; const pg8::Dep D{C3, 32u, T3, NWG, nullptr, 0u, C4, T4, TMO};
        l1_acquire(tid); pg8::gemm_phase<EpiBf16Ss, pg8::DynOrder, 0>(lds, g, S, E, D);
    }
    STAMP(8);
    if (IN(5)) {
        const bool worker = ((blockIdx.x >> 3) & 3) == 0;
        pg8::DynOrder S; S.init(QH + 5 * 512, MP, DM, 1, BOX); pg8::Unit u; const rsrc_t rmix = mk_rsrc(MIX), rx1 = mk_rsrc(X1B);
        f32x4 gv[4];
#pragma unroll
        for (int k = 0; k < 4; ++k) gv[k] = *(const f32x4*)(g_post_mix + (k >> 1) * 512 + 8 * lane + (k & 1) * 4);
        int rflag = 0;
        for (int i = 0; (worker || i == 0) && chunk_next(S, i, u, tid); ++i) {
            rows_wait(C4 + 64 * u.pm, 32u, T4, NWG, rflag, TMO, wave);
            const int mb = u.pm * 256 + u.pn * 64 + wave * 8;
#pragma unroll 1
            for (int h = 0; h < 2; ++h) {
                v4u xw[4][2], mw[4][2]; float ps[4];
#pragma unroll
                for (int r = 0; r < 4; ++r) { const int m = mb + 4 * h + r; ps[r] = ldf_nc(PMIX + (size_t)(lane & 15) * MT + m);
#pragma unroll
                    for (int k = 0; k < 2; ++k) { xw[r][k] = *(const v4u*)(XB + (size_t)m * DM + k * 512 + 8 * lane); mw[r][k] = ld16_nc(rmix, ((size_t)m * DM + k * 512 + 8 * lane) * 2); } }
#pragma unroll
                for (int r = 0; r < 4; ++r) { const int m = mb + 4 * h + r; float p = ps[r]; p += __shfl_xor(p, 1); p += __shfl_xor(p, 2); p += __shfl_xor(p, 4); p += __shfl_xor(p, 8);
                    const float rm = 1.0f / sqrtf(p * (1.0f / DM) + EPS); float v[2][8]; float sq = 0.f;
#pragma unroll
                    for (int k = 0; k < 2; ++k) { const v4u a = xw[r][k], b = mw[r][k]; const f32x4 g0 = gv[2 * k], g1 = gv[2 * k + 1];
                        v[k][0] = bflo(a.x) + bflo(b.x) * rm * g0.x; v[k][1] = bfhi(a.x) + bfhi(b.x) * rm * g0.y; v[k][2] = bflo(a.y) + bflo(b.y) * rm * g0.z; v[k][3] = bfhi(a.y) + bfhi(b.y) * rm * g0.w;
                        v[k][4] = bflo(a.z) + bflo(b.z) * rm * g1.x; v[k][5] = bfhi(a.z) + bfhi(b.z) * rm * g1.y; v[k][6] = bflo(a.w) + bflo(b.w) * rm * g1.z; v[k][7] = bfhi(a.w) + bfhi(b.w) * rm * g1.w;
#pragma unroll
                        for (int j = 0; j < 8; ++j) sq += v[k][j] * v[k][j]; }
                    sq = wave_sum(sq);
                    if (lane == 0) stf_wt(RSTD2 + m, 1.0f / sqrtf(sq * (1.0f / DM) + EPS));
#pragma unroll
                    for (int k = 0; k < 2; ++k) { v4u w; w.x = pk2(v[k][0], v[k][1]); w.y = pk2(v[k][2], v[k][3]); w.z = pk2(v[k][4], v[k][5]); w.w = pk2(v[k][6], v[k][7]); st16_wt(rx1, ((size_t)m * DM + k * 512 + 8 * lane) * 2, w); } }
            }
            asm volatile("s_waitcnt vmcnt(0)" ::: "memory");
            if (lane == 0) __hip_atomic_fetch_add(C5 + 64 * u.pm, 1u, __ATOMIC_RELAXED, __HIP_MEMORY_SCOPE_AGENT);
        }
        __syncthreads();
        if (tid == 0) __hip_atomic_fetch_add(T5, 1u, __ATOMIC_RELAXED, __HIP_MEMORY_SCOPE_AGENT);
    }
    STAMP(9);
    if (IN(6)) {
        pg8::Gemm g{X1B, WfiT, X1B, WfiT, MT, INW, DM}; pg8::DynOrder S; S.init(QH + 6 * 512, MP, INW, 1, BOX);
        EpiSwiglu E{RSTD2, ACT}; const pg8::Dep D{C5, 32u, T5, NWG, T3, NWG, C6, T6, TMO};
        l1_acquire(tid); pg8::gemm_phase<EpiSwiglu, pg8::DynOrder, 0>(lds, g, S, E, D);
    }
    STAMP(10);
    if (IN(7)) {
        pg8::Gemm g{ACT, WfoT, ACT, WfoT, MT, DM, DFF}; pg8::DynOrder S; S.init(QH + 7 * 512, MP, DM, 1, BOX);
        EpiBf16Ss E{FB, PF}; const pg8::Dep D{C6, 176u, T6, NWG, nullptr, 0u, C7, T7, TMO};
        l1_acquire(tid); pg8::gemm_phase<EpiBf16Ss, pg8::DynOrder, 0>(lds, g, S, E, D);
    }
    STAMP(11);
    if (IN(8)) {
        pg8::DynOrder S; S.init(QH + 8 * 512, MP, DM, 1, BOX); pg8::Unit u; const rsrc_t rf = mk_rsrc(FB), rx1 = mk_rsrc(X1B);
        f32x4 gv[4];
#pragma unroll
        for (int k = 0; k < 4; ++k) gv[k] = *(const f32x4*)(g_post_ffn + (k >> 1) * 512 + 8 * lane + (k & 1) * 4);
        int rflag = 0;
        for (int i = 0; chunk_next(S, i, u, tid); ++i) {
            rows_wait(C7 + 64 * u.pm, 32u, T7, NWG, rflag, TMO, wave);
            const int mb = u.pm * 256 + u.pn * 64 + wave * 8;
#pragma unroll 1
            for (int h = 0; h < 2; ++h) {
                v4u xw[4][2], fw[4][2]; float ps[4];
#pragma unroll
                for (int r = 0; r < 4; ++r) { const int m = mb + 4 * h + r; ps[r] = ldf_nc(PF + (size_t)(lane & 15) * MT + m);
#pragma unroll
                    for (int k = 0; k < 2; ++k) { xw[r][k] = ld16_nc(rx1, ((size_t)m * DM + k * 512 + 8 * lane) * 2); fw[r][k] = ld16_nc(rf, ((size_t)m * DM + k * 512 + 8 * lane) * 2); } }
#pragma unroll
                for (int r = 0; r < 4; ++r) { const int m = mb + 4 * h + r; float p = ps[r]; p += __shfl_xor(p, 1); p += __shfl_xor(p, 2); p += __shfl_xor(p, 4); p += __shfl_xor(p, 8);
                    const float rf2 = 1.0f / sqrtf(p * (1.0f / DM) + EPS);
                    float* yrow = (m < MP) ? out + O_YP + (size_t)m * DM : out + O_YS + (size_t)(m - MP) * DM;
#pragma unroll
                    for (int k = 0; k < 2; ++k) { const v4u a = xw[r][k], b = fw[r][k]; const f32x4 g0 = gv[2 * k], g1 = gv[2 * k + 1]; f32x4 y0, y1;
                        y0.x = bflo(a.x) + bflo(b.x) * rf2 * g0.x; y0.y = bfhi(a.x) + bfhi(b.x) * rf2 * g0.y; y0.z = bflo(a.y) + bflo(b.y) * rf2 * g0.z; y0.w = bfhi(a.y) + bfhi(b.y) * rf2 * g0.w;
                        y1.x = bflo(a.z) + bflo(b.z) * rf2 * g1.x; y1.y = bfhi(a.z) + bfhi(b.z) * rf2 * g1.y; y1.z = bflo(a.w) + bflo(b.w) * rf2 * g1.z; y1.w = bfhi(a.w) + bfhi(b.w) * rf2 * g1.w;
                        *(f32x4*)(yrow + k * 512 + 8 * lane) = y0; *(f32x4*)(yrow + k * 512 + 8 * lane + 4) = y1; } }
            }
        }
    }
    STAMP(12);
#undef IN
#undef SEAM
}

#ifdef TS_A
#ifndef TS_C
#define TS_C TS_A
#define TS_D TS_B
#endif
#ifndef TS_SCALE
#define TS_SCALE 1e-7f
#endif
#ifndef TS_STAT
#define TS_STAT 0
#endif
__global__ void probe_fin(unsigned char* ws, float* out, int G) {
    __shared__ unsigned long long sh[4][256];
    const unsigned long long* ts = (const unsigned long long*)(ws + 768 * 1024); const int t = threadIdx.x;
    unsigned long long a = 0, b = 0, c = 0, d = 0;
    if (t < G) { a = ts[t * 16 + TS_A]; b = ts[t * 16 + TS_B]; c = ts[t * 16 + TS_C]; d = ts[t * 16 + TS_D]; }
    sh[0][t] = a; sh[1][t] = b; sh[2][t] = c; sh[3][t] = d; __syncthreads();
    if (t == 0) {
        unsigned long long s1 = 0, s2 = 0, mina = ~0ull, maxb = 0, minc = ~0ull, maxd = 0;
        for (int i = 0; i < G; ++i) { s1 += sh[1][i] - sh[0][i]; s2 += sh[3][i] - sh[2][i]; if (sh[0][i] < mina) mina = sh[0][i]; if (sh[1][i] > maxb) maxb = sh[1][i]; if (sh[2][i] < minc) minc = sh[2][i]; if (sh[3][i] > maxd) maxd = sh[3][i]; }
        const unsigned long long v1 = TS_STAT ? (maxb - mina) : s1 / (unsigned long long)G, v2 = TS_STAT ? (maxd - minc) : s2 / (unsigned long long)G;
        const unsigned long long t0 = __builtin_amdgcn_s_memrealtime();
        while (__builtin_amdgcn_s_memrealtime() - t0 < v1) __builtin_amdgcn_s_sleep(8);
        const float us = (float)v2 * 0.01f;
        out[O_GS] += sqrtf(us * TS_SCALE * 262930.0f);
    }
}
#endif
constexpr int N_PHASES = 9;
extern "C" void kernel_launch(void* const* d_in, const int* in_sizes, int n_in, void* d_out, int out_size, void* d_ws, size_t ws_size, hipStream_t stream) {
    static int grid = 0;
    if (grid == 0) {
        if (n_in != 19 || (size_t)out_size != O_END || ws_size < WS_END) { fprintf(stderr, "kernel_launch: unexpected shapes: n_in %d out %d ws %zu (need %zu)\n", n_in, out_size, ws_size, (size_t)WS_END); grid = -1; return; }
        int dev = 0, cus = 0;
        if (hipGetDevice(&dev) != hipSuccess || hipDeviceGetAttribute(&cus, hipDeviceAttributeMultiprocessorCount, dev) != hipSuccess) { grid = -1; return; }
        if (hipFuncSetAttribute((const void*)fwd_kernel, hipFuncAttributeMaxDynamicSharedMemorySize, LDS_BYTES) != hipSuccess) { fprintf(stderr, "kernel_launch: hipFuncSetAttribute failed\n"); grid = -1; return; }
        int per_cu = 0;
        (void)hipOccupancyMaxActiveBlocksPerMultiprocessor(&per_cu, (const void*)fwd_kernel, NWAVES * 64, LDS_BYTES);
        (void)hipGetLastError();
        grid = cus;
    }
    if (grid < 0) return;
    (void)hipMemsetAsync((char*)d_ws + WS_CTL, 0, CTL_ZERO_BYTES, stream);
    Args a{};
    for (int i = 0; i < 19; ++i) a.in[i] = (const float*)d_in[i];
    a.out = (float*)d_out; a.ws = (unsigned char*)d_ws;
#if MK_ONE_LAUNCH
    a.ph_lo = 0; a.ph_hi = N_PHASES;
    hipLaunchKernelGGL(fwd_kernel, dim3(grid), dim3(NWAVES * 64), LDS_BYTES, stream, a);
#ifdef TS_A
    hipLaunchKernelGGL(probe_fin, dim3(1), dim3(256), 0, stream, (unsigned char*)d_ws, (float*)d_out, grid);
#endif
#else
    for (int p = 0; p < N_PHASES; ++p) { a.ph_lo = p; a.ph_hi = p + 1; hipLaunchKernelGGL(fwd_kernel, dim3(grid), dim3(NWAVES * 64), LDS_BYTES, stream, a); }
#endif
}
```

```cpp
#include <hip/hip_runtime.h>
#include <cstdio>
#include <cstdint>

#ifndef MK_ONE_LAUNCH
#define MK_ONE_LAUNCH 1
#endif
#ifndef REP_MASK
#define REP_MASK 0
#endif
#define NREP(k) (((REP_MASK >> (k)) & 1) ? 2 : 1)
#ifdef TS_A
#define STAMP(j) do { if (threadIdx.x == 0) ((unsigned long long*)(args.ws + 768 * 1024))[blockIdx.x * 16 + (j)] = __builtin_amdgcn_s_memrealtime(); } while (0)
#else
#define STAMP(j) do { } while (0)
#endif

namespace pg8 {
#define PG8_LAS __attribute__((address_space(3)))
typedef unsigned short bf16_t;
typedef short bf16x8 __attribute__((ext_vector_type(8)));
typedef float f32x4 __attribute__((ext_vector_type(4)));
typedef unsigned u32x4 __attribute__((ext_vector_type(4)));
constexpr int BM = 256, BK = 64, HALF = 128, HTB = HALF * BK * 2  , STAGE_BYTES = 8 * HTB, NXCD = 8, WGM = 8;

__host__ __device__ __forceinline__ int lds_byte(int r, int c) { const int st = (r >> 4) * 2 + (c >> 5), rr = r & 15, cc = c & 31, ob = rr * 64 + cc * 2; return st * 1024 + (ob ^ (((ob >> 9) & 1) << 5)); }
__host__ __device__ __forceinline__ void stage_rc(int b, int& R, int& C) { const int st = b / 1024, sb = b % 1024, swz = sb ^ (((sb >> 9) & 1) << 5); R = (st >> 1) * 16 + swz / 64; C = (st & 1) * 32 + (swz % 64) / 2; }
__host__ __device__ __forceinline__ int perm32(int rho) { const int n = rho >> 4, i = rho & 15; return 8 * (i >> 2) + 4 * n + (i & 3); }

struct Unit { int pm, pn, seg; };
struct Gemm { const bf16_t* A0; const bf16_t* B0; const bf16_t* A1; const bf16_t* B1; int M, N, K; };

struct StaticOrder {
    int nM, nN, nwg, G, c, nseg;
    __host__ __device__ void init(int M, int N, int G_, int c_, int nseg_) { nM = M / BM; nN = N / BM; nwg = nM * nN; G = G_; c = c_; nseg = nseg_; }
    __host__ __device__ bool next(int i, Unit& u) const {
        const int ti = (nseg == 2) ? (i >> 1) : i; u.seg = (nseg == 2) ? (i & 1) : 0;
        const long L = (long)ti * G + c; if (L >= nwg) return false;
        int wgid = (int)L; { const int q = nwg / NXCD, r = nwg % NXCD, xcd = wgid % NXCD, off = wgid / NXCD; wgid = (xcd < r ? xcd * (q + 1) : r * (q + 1) + (xcd - r) * q) + off; }
        const int nig = WGM * nN, gid = wgid / nig, fm = gid * WGM, gsz = (nM - fm) < WGM ? (nM - fm) : WGM;
        u.pm = fm + ((wgid % nig) % gsz); u.pn = (wgid % nig) / gsz; return true;
    }
};

struct DfOrder {
    StaticOrder P; int nNs, cs, nseg;
    __host__ __device__ void init(int Mp, int N, int G, int c, int shift, int nseg_) { P.init(Mp, N, G, c, 1); nNs = N / BM; cs = (c + G - shift % G) % G; nseg = nseg_; }
    __host__ __device__ bool next(int i, Unit& u) const {
        int ti = (nseg == 2) ? (i >> 1) : i; u.seg = (nseg == 2) ? (i & 1) : 0;
        if (cs < nNs) { if (ti == 1) { u.pm = P.nM; u.pn = cs; return true; } if (ti > 1) --ti; }
        Unit t; if (!P.next(ti, t)) return false; u.pm = t.pm; u.pn = t.pn; return true;
    }
};
struct DynOrder {
    unsigned* q8; int nMp, nN, xcd, nseg; PG8_LAS int* box; unsigned tk;
    __device__ __forceinline__ void init(unsigned* q8_, int Mp, int N, int nseg_, PG8_LAS int* box_) { xcd = (int)(__builtin_amdgcn_s_getreg((3 << 11) | 20) & 7u); q8 = q8_; nMp = Mp / BM; nN = N / BM; nseg = nseg_; box = box_; tk = 0u; }
    __device__ __forceinline__ unsigned draw(int cls) const { return __hip_atomic_fetch_add(q8 + 64 * cls, 1u, __ATOMIC_RELAXED, __HIP_MEMORY_SCOPE_AGENT); }
    __device__ __forceinline__ bool map(int cls, unsigned t, int& pm, int& pn) const {
        const int ns = (nN - cls + 7) >> 3, q = nMp * nN / NXCD, ti = (int)t;
        if (ti < ns) { pm = nMp; pn = cls + 8 * ti; return true; }
        if (ti - ns < q) { const int wgid = cls * q + (ti - ns), nig = WGM * nN, gid = wgid / nig, fm = gid * WGM, gsz = (nMp - fm) < WGM ? (nMp - fm) : WGM; pm = fm + ((wgid % nig) % gsz); pn = (wgid % nig) / gsz; return true; }
        return false;
    }
    __device__ __forceinline__ void put(int slot, unsigned t, int seg) const {
        int pm = 0, pn = 0; bool valid = map(xcd, t, pm, pn);
        for (int k = 1; k < NXCD && !valid; ++k) { const int cls = (xcd + k) & 7; valid = map(cls, draw(cls), pm, pn); }
        box[4 * slot + 0] = pm; box[4 * slot + 1] = pn; box[4 * slot + 2] = seg; box[4 * slot + 3] = valid ? 1 : 0;
    }
    __device__ __forceinline__ bool get(int slot, Unit& u) const { u.pm = box[4 * slot]; u.pn = box[4 * slot + 1]; u.seg = box[4 * slot + 2]; return box[4 * slot + 3] != 0; }
    __device__ __forceinline__ bool first(Unit& u) {
        __syncthreads();
        if (threadIdx.x == 0) {
            put(0, draw(xcd), 0);
            if (nseg == 2) { box[4] = box[0]; box[5] = box[1]; box[6] = 1; box[7] = box[3]; } else put(1, draw(xcd), 0);
        }
        __syncthreads();
        return get(0, u);
    }
    __device__ __forceinline__ bool peek_next(int ui, Unit& u) const { return get((ui + 1) & 1, u); }
    __device__ __forceinline__ void pull(int ui, int wid) {
        if (wid == 0 && (threadIdx.x & 63) == 0 && (nseg == 1 || (ui & 1) == 0)) tk = draw(xcd);
    }
    __device__ __forceinline__ void commit(int ui, int wid) {
        if (wid == 0 && (threadIdx.x & 63) == 0) {
            if (nseg == 1 || (ui & 1) == 0) put(ui & 1, tk, 0);
            else { const int o = (ui + 1) & 1, d = ui & 1; box[4 * d] = box[4 * o]; box[4 * d + 1] = box[4 * o + 1]; box[4 * d + 2] = 1; box[4 * d + 3] = box[4 * o + 3]; }
        }
    }
};
struct Dep {
    unsigned* wait_cnt; unsigned need;
    unsigned* wait_tot; unsigned need_tot;
    unsigned* guard; unsigned need_guard;
    unsigned* done_cnt; unsigned* done_tot;
    unsigned* tmo;
};
#define PG8_SPIN_CAP (1u << 16)
__device__ __forceinline__ void dep_wait(const Dep& D, int pm, int wid, int& flags) {
    if (D.wait_cnt == nullptr) return;
    if (wid == 0 && (flags & 1) == 0) {
        unsigned spins = 0;
        for (;;) {
            const unsigned c0 = __hip_atomic_load(D.wait_cnt + 64 * pm, __ATOMIC_RELAXED, __HIP_MEMORY_SCOPE_AGENT);
            const unsigned t0 = __hip_atomic_load(D.wait_tot, __ATOMIC_RELAXED, __HIP_MEMORY_SCOPE_AGENT);
            const unsigned g0 = (D.guard != nullptr && (flags & 2) == 0) ? __hip_atomic_load(D.guard, __ATOMIC_RELAXED, __HIP_MEMORY_SCOPE_AGENT) : D.need_guard;
            const unsigned c = (unsigned)__builtin_amdgcn_readfirstlane(c0), t = (unsigned)__builtin_amdgcn_readfirstlane(t0), gg = (unsigned)__builtin_amdgcn_readfirstlane(g0);
            if (gg >= D.need_guard) flags |= 2;
            if (t >= D.need_tot && (flags & 2)) { flags |= 1; break; }
            if (c >= D.need && (flags & 2)) break;
            if (++spins > PG8_SPIN_CAP || ((spins & 63u) == 0u && __builtin_amdgcn_readfirstlane(__hip_atomic_load(D.tmo, __ATOMIC_RELAXED, __HIP_MEMORY_SCOPE_AGENT)) != 0u)) { if ((threadIdx.x & 63) == 0) __hip_atomic_store(D.tmo, 1u, __ATOMIC_RELAXED, __HIP_MEMORY_SCOPE_AGENT); break; }
            __builtin_amdgcn_s_sleep(4);
        }
    }
    asm volatile("" ::: "memory"); __builtin_amdgcn_s_barrier(); asm volatile("" ::: "memory");
}
__device__ __forceinline__ void dep_done(const Dep& D, int pm, int lane) {
    if (D.done_cnt != nullptr && lane == 0) __hip_atomic_fetch_add(D.done_cnt + 64 * pm, 1u, __ATOMIC_RELAXED, __HIP_MEMORY_SCOPE_AGENT);
}

template <class Epi, class Sched, int AUXA, int KC>
__device__ __forceinline__ void gemm_phase(PG8_LAS unsigned char* lds, const Gemm g, Sched& S, const Epi& E, const Dep D) {
    const int tid = threadIdx.x, wid = __builtin_amdgcn_readfirstlane(tid >> 6), lane = tid & 63, wr = wid >> 2, wc = wid & 3, fr = lane & 15, fq = lane >> 4;
    constexpr int K = KC, nt = K / BK;
    unsigned voffA[2], voffB[2];
#pragma unroll
    for (int i = 0; i < 2; ++i) { int R, C; stage_rc(tid * 16 + i * 8192, R, C); const int Rb = Epi::PERM ? ((R & ~31) + perm32(R & 31)) : R;
        voffA[i] = (unsigned)(R * K + C) * 2u; voffB[i] = (unsigned)(Rb * K + C) * 2u; }
    const size_t kstep = (size_t)(BK * 2);
    const size_t hstep = (size_t)HALF * K * 2;
    const size_t tstep = 2 * hstep;
    const unsigned ldsw = (unsigned)wid * 1024u;
    const int aoff = lds_byte(wr * 64 + fr, fq * 8), boff = lds_byte(wc * 32 + fr, fq * 8);
#define PG8_SA(b, h) (((b) * 2 + (h)) * HTB)
#define PG8_SB(b, h) ((4 + (b) * 2 + (h)) * HTB)
#define PG8_STAGE(bufoff, gbase, voff) do { _Pragma("unroll") for (int _i = 0; _i < 2; ++_i) \
        __builtin_amdgcn_global_load_lds((const unsigned*)((const char*)(gbase) + (voff)[_i]), (PG8_LAS unsigned*)(lds + (bufoff) + ldsw + _i * 8192), 16, 0, 0); } while (0)
#define PG8_STAGEA(bufoff, gbase, voff) do { _Pragma("unroll") for (int _i = 0; _i < 2; ++_i) \
        __builtin_amdgcn_global_load_lds((const unsigned*)((const char*)(gbase) + (voff)[_i]), (PG8_LAS unsigned*)(lds + (bufoff) + ldsw + _i * 8192), 16, 0, AUXA); } while (0)
#define PG8_LDA(dst, b, h) do { _Pragma("unroll") for (int m = 0; m < 4; ++m) _Pragma("unroll") for (int k = 0; k < 2; ++k) dst[m][k] = *(const PG8_LAS bf16x8*)(lds + PG8_SA(b, h) + aoff + m * 2048 + k * 1024); } while (0)
#define PG8_LDB(dst, b, h) do { _Pragma("unroll") for (int n = 0; n < 2; ++n) _Pragma("unroll") for (int k = 0; k < 2; ++k) dst[n][k] = *(const PG8_LAS bf16x8*)(lds + PG8_SB(b, h) + boff + n * 2048 + k * 1024); } while (0)
#define PG8_MMA(ai, bj, At, Bt) do { __builtin_amdgcn_s_setprio(1); _Pragma("unroll") for (int m = 0; m < 4; ++m) _Pragma("unroll") for (int n = 0; n < 2; ++n) _Pragma("unroll") for (int k = 0; k < 2; ++k) \
        acc[ai][bj][m][n] = __builtin_amdgcn_mfma_f32_16x16x32_bf16(Bt[n][k], At[m][k], acc[ai][bj][m][n], 0, 0, 0); __builtin_amdgcn_s_setprio(0); } while (0)
#define PG8_WAIT_V(n) asm volatile("s_waitcnt vmcnt(" #n ")" ::: "memory")
#define PG8_WAIT_L(n) asm volatile("s_waitcnt lgkmcnt(" #n ")" ::: "memory")
#define PG8_BAR __builtin_amdgcn_s_barrier()
#define PG8_SCHED __builtin_amdgcn_sched_barrier(0)
    Unit cur, nxt; int ui = 0;
    if (!S.first(cur)) { if (D.done_tot != nullptr && tid == 0) __hip_atomic_fetch_add(D.done_tot, 1u, __ATOMIC_RELAXED, __HIP_MEMORY_SCOPE_AGENT); return; }
    f32x4 acc[2][2][4][2];
#pragma unroll
    for (int a = 0; a < 2; ++a)
#pragma unroll
        for (int b = 0; b < 2; ++b)
#pragma unroll
            for (int m = 0; m < 4; ++m)
#pragma unroll
                for (int n = 0; n < 2; ++n) acc[a][b][m][n] = (f32x4){0.f, 0.f, 0.f, 0.f};
    bf16x8 At[4][2], B0[2][2], B1[2][2];
    const char* cA = (const char*)(cur.seg ? g.A1 : g.A0) + (size_t)cur.pm * tstep; const char* cB = (const char*)(cur.seg ? g.B1 : g.B0) + (size_t)cur.pn * tstep;
    int dflags = 0, pend = -1;
    dep_wait(D, cur.pm, wid, dflags);
    PG8_STAGE(PG8_SB(0, 0), cB, voffB); PG8_STAGE(PG8_SB(0, 1), cB + hstep, voffB); PG8_STAGEA(PG8_SA(0, 0), cA, voffA); PG8_STAGEA(PG8_SA(0, 1), cA + hstep, voffA);
    if (wr == 1) PG8_BAR;
    PG8_WAIT_V(2); PG8_BAR;
    PG8_STAGE(PG8_SB(1, 0), cB + kstep, voffB); PG8_STAGEA(PG8_SA(1, 0), cA + kstep, voffA); PG8_STAGE(PG8_SB(1, 1), cB + hstep + kstep, voffB);
    PG8_WAIT_V(6); PG8_BAR;
    for (;;) {
        bool has_next = false; const char* nA = cA; const char* nB = cB;
#define PG8_TRIP(a1, a2, b2, a3, b3) do { asm volatile("" : "+v"(voffA[0]), "+v"(voffA[1]), "+v"(voffB[0]), "+v"(voffB[1])); \
            PG8_LDB(B0, 0, 0); PG8_LDB(B1, 0, 1); PG8_SCHED; PG8_LDA(At, 0, 0); PG8_STAGEA(PG8_SA(1, 1), (a1) + hstep, voffA); \
            PG8_WAIT_V(8); PG8_WAIT_L(0); PG8_BAR; PG8_MMA(0, 0, At, B0); PG8_MMA(0, 1, At, B1); PG8_BAR; PG8_SCHED; \
            PG8_LDA(At, 0, 1); PG8_STAGE(PG8_SB(0, 0), (b2), voffB); PG8_STAGE(PG8_SB(0, 1), (b2) + hstep, voffB); PG8_STAGEA(PG8_SA(0, 0), (a2), voffA); \
            PG8_WAIT_V(8); PG8_WAIT_L(0); PG8_BAR; PG8_MMA(1, 0, At, B0); PG8_MMA(1, 1, At, B1); PG8_BAR; PG8_SCHED; \
            PG8_LDB(B0, 1, 0); PG8_LDB(B1, 1, 1); PG8_SCHED; PG8_LDA(At, 1, 0); PG8_STAGEA(PG8_SA(0, 1), (a2) + hstep, voffA); \
            PG8_WAIT_V(8); PG8_WAIT_L(0); PG8_BAR; PG8_MMA(0, 0, At, B0); PG8_MMA(0, 1, At, B1); PG8_BAR; PG8_SCHED; \
            PG8_LDA(At, 1, 1); PG8_STAGE(PG8_SB(1, 0), (b3), voffB); PG8_STAGE(PG8_SB(1, 1), (b3) + hstep, voffB); PG8_STAGEA(PG8_SA(1, 0), (a3), voffA); \
            PG8_WAIT_V(8); PG8_WAIT_L(0); PG8_BAR; PG8_MMA(1, 0, At, B0); PG8_MMA(1, 1, At, B1); PG8_BAR; PG8_SCHED; } while (0)
        {
            const char* a1 = cA + kstep; const char* a2 = cA + 2 * kstep; const char* b2 = cB + 2 * kstep; const char* a3 = a2 + kstep; const char* b3 = b2 + kstep;
            PG8_TRIP(a1, a2, b2, a3, b3);
            if (pend >= 0) { dep_done(D, pend, lane); pend = -1; }
        }
        for (int t = 2; t < nt - 2; t += 2) {
            const char* a1 = cA + (size_t)(t + 1) * kstep; const char* a2 = cA + (size_t)(t + 2) * kstep; const char* b2 = cB + (size_t)(t + 2) * kstep; const char* a3 = a2 + kstep; const char* b3 = b2 + kstep;
            PG8_TRIP(a1, a2, b2, a3, b3);
        }
        {
            has_next = S.peek_next(ui, nxt);
            if (has_next) { nA = (const char*)(nxt.seg ? g.A1 : g.A0) + (size_t)nxt.pm * tstep; nB = (const char*)(nxt.seg ? g.B1 : g.B0) + (size_t)nxt.pn * tstep; dep_wait(D, nxt.pm, wid, dflags); }
            const char* a1 = cA + (size_t)(nt - 1) * kstep; const char* a2 = nA; const char* b2 = nB; const char* a3 = a2 + kstep; const char* b3 = b2 + kstep;
            PG8_TRIP(a1, a2, b2, a3, b3);
        }
#undef PG8_TRIP
        if (wr == 0) PG8_BAR;
        S.pull(ui, wid);
        const bool keep = E(acc, cur, wr, wc, fr, fq);
        S.commit(ui, wid);
        if (!keep) pend = cur.pm;
        if (!has_next) break;
        if (!keep) {
#pragma unroll
        for (int a = 0; a < 2; ++a)
#pragma unroll
            for (int b = 0; b < 2; ++b)
#pragma unroll
                for (int m = 0; m < 4; ++m)
#pragma unroll
                    for (int n = 0; n < 2; ++n) acc[a][b][m][n] = (f32x4){0.f, 0.f, 0.f, 0.f};
        }
        cur = nxt; cA = nA; cB = nB; ++ui;
        if (wr == 1) PG8_BAR;
    }
    PG8_WAIT_V(0);
    if (pend >= 0) dep_done(D, pend, lane);
    PG8_BAR;
    if (D.done_tot != nullptr && tid == 0) __hip_atomic_fetch_add(D.done_tot, 1u, __ATOMIC_RELAXED, __HIP_MEMORY_SCOPE_AGENT);
#undef PG8_STAGEA
#undef PG8_SA
#undef PG8_SB
#undef PG8_STAGE
#undef PG8_LDA
#undef PG8_LDB
#undef PG8_MMA
#undef PG8_WAIT_V
#undef PG8_WAIT_L
#undef PG8_BAR
#undef PG8_SCHED
}
}

constexpr int DM = 1024, NB = 16, SEQ = 4096, DECS = 16, NKV = 4, HD = 64, KVW = 256, INW = 5632, DFF = 2816;
constexpr int MP = NB * SEQ, MS = NB * DECS, MT = MP + MS;
constexpr float EPS = 1e-6f, LOG2E = 1.4426950408889634f, QSCALE = 0.125f * LOG2E;
constexpr size_t O_YP = 0, O_YS = (size_t)MP * DM, O_KP = O_YS + (size_t)MS * DM, O_VP = O_KP + 524288, O_KS = O_VP + 524288, O_VS = O_KS + 524288, O_GS = O_VS + 524288, O_END = O_GS + (size_t)MS * DM;

constexpr size_t MiB = 1u << 20;
constexpr size_t WS_CTL = 0, CTL_ZERO_BYTES = 1 * MiB;
constexpr size_t WS_WIN = 1 * MiB, WS_WFI = 12 * MiB, WS_WA = 23 * MiB, WS_WG = 25 * MiB, WS_WO = 27 * MiB, WS_WFO = 29 * MiB;
constexpr size_t WS_WSB = 34 * MiB + 768 * 1024;
constexpr size_t WS_RSTD1 = 35 * MiB, WS_RSTD2 = 36 * MiB, WS_PMIX = 37 * MiB, WS_PF = 42 * MiB;
constexpr size_t ACTB = (size_t)MT * DM * 2;
constexpr size_t WS_R0 = 48 * MiB;
constexpr size_t WS_R1 = 177 * MiB;
constexpr size_t WS_R2 = 306 * MiB;
constexpr size_t WS_KB = 435 * MiB, WS_VB = 468 * MiB;
constexpr size_t WS_R3 = 501 * MiB;
constexpr size_t WS_SA = WS_R3, WS_SB = WS_R3 + ACTB, WS_U = WS_R3 + 2 * ACTB, WS_AO = WS_R3 + 3 * ACTB, WS_END = WS_AO + ACTB;
static_assert(WS_END <= 1024 * MiB && (size_t)MT * DFF * 2 <= 3 * ACTB && WS_R0 + ACTB <= WS_R1 && WS_R1 + ACTB <= WS_R2 && WS_R2 + ACTB <= WS_KB, "d_ws map");
constexpr int CW_BAR = 4096, CW_TMO = 64;
constexpr int CW_CNT = 16384;
constexpr int CW_TOT = CW_CNT + 5 * 264 * 64;
constexpr int CW_C0 = CW_TOT + 8 * 64;
constexpr int CW_Q = CW_C0 + 264 * 64;
constexpr int CW_C1 = CW_Q + 9 * 8 * 64, CW_C2 = CW_C1 + 264 * 64, CW_CS = CW_C2 + 264 * 64;
static_assert((CW_CS + 64) * 4 <= 768 * 1024, "CTL words inside the memset region, below the probe stamps");

constexpr int RING_BYTES = 131072, LDS_BYTES = 147456, LDSCTL_OFF = LDS_BYTES - 512, MISC_OFF = LDSCTL_OFF + 320;
constexpr int NWAVES = 8, BOX_OFF = LDSCTL_OFF + 64;

#define GAS __attribute__((address_space(1)))
#define LAS __attribute__((address_space(3)))
typedef unsigned short bf16;
typedef unsigned v4u __attribute__((ext_vector_type(4)));
typedef unsigned v2u __attribute__((ext_vector_type(2)));
typedef float f32x4 __attribute__((ext_vector_type(4)));
typedef GAS unsigned gu32;
#define RLX_AGENT __ATOMIC_RELAXED, __HIP_MEMORY_SCOPE_AGENT
#define LDS_WAIT() asm volatile("s_waitcnt lgkmcnt(0)" ::: "memory")
typedef float f32x2_t __attribute__((ext_vector_type(2))); typedef __bf16 bf16x2_t __attribute__((ext_vector_type(2)));
__device__ __forceinline__ unsigned pk2(float lo, float hi) { f32x2_t v = {lo, hi}; bf16x2_t b = __builtin_convertvector(v, bf16x2_t); return __builtin_bit_cast(unsigned, b); }
__device__ __forceinline__ float bflo(unsigned w) { return __uint_as_float(w << 16); }
__device__ __forceinline__ float bfhi(unsigned w) { return __uint_as_float(w & 0xffff0000u); }
__device__ __forceinline__ float wave_sum(float v) {
#pragma unroll
    for (int o = 1; o < 64; o <<= 1) v += __shfl_xor(v, o);
    return v;
}
__device__ __forceinline__ float gelu_tanh(float x) {
    const float e = __builtin_amdgcn_exp2f(x * (-2.302208198f - 0.10294324f * x * x));
    return x * __builtin_amdgcn_rcpf(1.0f + e);
}
__device__ __forceinline__ float sigmoidf_(float x) { return __builtin_amdgcn_rcpf(1.0f + __builtin_amdgcn_exp2f(-LOG2E * x)); }

#define XB_TMO      128
#define XB_XCNT(j)  (256  + 64 * (j))
#define XB_XSUB(j)  (1280 + 64 * (j))
#define XB_XGEN(j)  (2304 + 64 * (j))
#define XB_TOP      3328
#define XB_TOPGEN   3392
#define XCD_BAR_WORDS 3456
#define XB_SPIN_CAP (1u << 18)
__device__ __forceinline__ unsigned xb_ld(unsigned* p)              { return __hip_atomic_load(p, __ATOMIC_RELAXED, __HIP_MEMORY_SCOPE_AGENT); }
__device__ __forceinline__ unsigned xb_add(unsigned* p, unsigned v) { return __hip_atomic_fetch_add(p, v, __ATOMIC_RELAXED, __HIP_MEMORY_SCOPE_AGENT); }
__device__ __forceinline__ unsigned xb_xcc_id() { return (unsigned)__builtin_amdgcn_s_getreg((3 << 11) | 20) & 0xFu; }
#define XB_SPIN(cond, bar) do { unsigned _sp = 0; while (cond) { __builtin_amdgcn_s_sleep(1); \
    if ((++_sp & 255u) == 0u) { if (xb_ld(&(bar)[XB_TMO])) break; if (_sp > XB_SPIN_CAP) { atomicAdd(&(bar)[XB_TMO], 1u); break; } } } } while (0)
struct XcdBarrier { unsigned* bar; unsigned x; volatile LAS unsigned* st; };
__device__ __forceinline__ XcdBarrier xcd_barrier_post(unsigned* bar, volatile LAS unsigned* st) {
    XcdBarrier b; b.bar = bar; b.x = xb_xcc_id(); b.st = st;
    if (threadIdx.x == 0) (void)xb_add(&bar[XB_XCNT(b.x)], 1u);
    return b;
}
__device__ __forceinline__ void xcd_barrier_complete(unsigned* bar, unsigned x, unsigned& nloc, unsigned& nx) {
    const unsigned G = gridDim.x * gridDim.y * gridDim.z;
    unsigned sum, cnt, mine, sp = 0u;
    for (;;) {
        sum = 0u; cnt = 0u; mine = 0u;
#pragma unroll
        for (unsigned j = 0; j < 16; ++j) { const unsigned c = xb_ld(&bar[XB_XCNT(j)]); sum += c; cnt += (c > 0u) ? 1u : 0u; mine = (j == x) ? c : mine; }
        if (sum == G) break;
        __builtin_amdgcn_s_sleep(1);
        if ((++sp & 255u) == 0u) { if (xb_ld(&bar[XB_TMO])) break; if (sp > XB_SPIN_CAP) { atomicAdd(&bar[XB_TMO], 1u); break; } }
    }
    nloc = mine > 0u ? mine : 1u; nx = cnt > 0u ? cnt : 1u;
}
__device__ __forceinline__ void xcd_barrier(const XcdBarrier& b) {
    asm volatile("s_waitcnt vmcnt(0)" ::: "memory");
    __syncthreads();
    if (threadIdx.x == 0) {
        unsigned* bar = b.bar;
        __builtin_amdgcn_s_waitcnt(0);
        unsigned nloc = b.st[0], nx = b.st[1];
        if (nloc == 0u) { xcd_barrier_complete(bar, b.x, nloc, nx); b.st[0] = nloc; b.st[1] = nx; }
        const unsigned old = xb_add(&bar[XB_XSUB(b.x)], 1u);
        const unsigned gen = old / nloc;
        if (old + 1u == (gen + 1u) * nloc) {
            __builtin_amdgcn_fence(__ATOMIC_RELEASE, "agent");
            asm volatile("s_waitcnt vmcnt(0)" ::: "memory");
            const unsigned og = xb_add(&bar[XB_TOP], 1u);
            const unsigned tg = og / nx;
            if (og + 1u == (tg + 1u) * nx) xb_add(&bar[XB_TOPGEN], 1u);
            else XB_SPIN(xb_ld(&bar[XB_TOPGEN]) == tg, bar);
            __builtin_amdgcn_fence(__ATOMIC_ACQUIRE, "agent");
            xb_add(&bar[XB_XGEN(b.x)], 1u);
            asm volatile("s_waitcnt vmcnt(0)" ::: "memory");
        } else {
            XB_SPIN(xb_ld(&bar[XB_XGEN(b.x)]) == gen, bar);
            __builtin_amdgcn_fence(__ATOMIC_ACQUIRE, "agent");
            asm volatile("s_waitcnt vmcnt(0)" ::: "memory");
        }
    }
    __syncthreads();
}

typedef __amdgpu_buffer_rsrc_t rsrc_t;
__device__ __forceinline__ rsrc_t mk_rsrc(const void* p) { return __builtin_amdgcn_make_buffer_rsrc((void*)p, 0, 0x7fffffff, 0x00020000); }
__device__ __forceinline__ void st16_wt(rsrc_t r, size_t byte_off, v4u v) { __builtin_amdgcn_raw_buffer_store_b128(v, r, (int)byte_off, 0, 16); }
__device__ __forceinline__ v4u ld16_nc(rsrc_t r, size_t byte_off) { return __builtin_amdgcn_raw_buffer_load_b128(r, (int)byte_off, 0, 16); }
__device__ __forceinline__ void stf_wt(float* p, float v) { __hip_atomic_store((unsigned*)p, __float_as_uint(v), __ATOMIC_RELAXED, __HIP_MEMORY_SCOPE_AGENT); }
__device__ __forceinline__ float ldf_nc(const float* p) { return __uint_as_float(__hip_atomic_load((const unsigned*)p, __ATOMIC_RELAXED, __HIP_MEMORY_SCOPE_AGENT)); }

using pg8::Unit;
struct EpiIn {
    static constexpr bool PERM = true;
    const float* rstd; bf16 *Q, *Kb, *Vb, *U, *GV, *SA, *SB; float* out; float *PG1, *PG2;
    __device__ __forceinline__ bool operator()(f32x4 (&acc)[2][2][4][2], const Unit& u, int wr, int wc, int fr, int fq) const {
        const int pn = u.pn; int mode, ld, colt; bf16* dst; float* side = nullptr; size_t side_s = 0;
        if (pn < 4)       { mode = 0; dst = Q;  ld = DM;  colt = pn * 256; }
        else if (pn == 4) { mode = 1; dst = Kb; ld = KVW; colt = 0; side = out + O_KP; side_s = O_KS - O_KP; }
        else if (pn == 5) { mode = 1; dst = Vb; ld = KVW; colt = 0; side = out + O_VP; side_s = O_VS - O_VP; }
        else if (pn < 10) { mode = 2; dst = U;  ld = DM;  colt = (pn - 6) * 256; }
        else if (pn < 14) { mode = 2; dst = GV; ld = DM;  colt = (pn - 10) * 256; }
        else if (pn < 18) { mode = 3; dst = SA; ld = DM;  colt = (pn - 14) * 256; }
        else              { mode = 3; dst = SB; ld = DM;  colt = (pn - 18) * 256; }
        const int row0 = u.pm * 256 + wr * 64 + fr, col0 = colt + wc * 32 + 8 * fq; const rsrc_t rdst = mk_rsrc(dst);
        float rsv[2][4];
#pragma unroll
        for (int ai = 0; ai < 2; ++ai)
#pragma unroll
            for (int m = 0; m < 4; ++m) rsv[ai][m] = rstd[row0 + ai * 128 + m * 16];
#pragma unroll
        for (int ai = 0; ai < 2; ++ai)
#pragma unroll
            for (int m = 0; m < 4; ++m) {
                const int row = row0 + ai * 128 + m * 16; const float rs = rsv[ai][m]; float s1 = 0.f, s2 = 0.f;
#pragma unroll
                for (int bj = 0; bj < 2; ++bj) {
                    float v[8];
#pragma unroll
                    for (int j = 0; j < 4; ++j) { v[j] = acc[ai][bj][m][0][j] * rs; v[4 + j] = acc[ai][bj][m][1][j] * rs; }
                    if (mode == 0) {
#pragma unroll
                        for (int j = 0; j < 8; ++j) v[j] *= QSCALE;
                    } else if (mode == 2) {
#pragma unroll
                        for (int j = 0; j < 8; ++j) { v[j] = gelu_tanh(v[j]); s1 += v[j]; s2 += v[j] * v[j]; }
                    } else if (mode == 3) {
#pragma unroll
                        for (int j = 0; j < 8; ++j) v[j] = sigmoidf_(v[j]);
                    }
                    const int col = col0 + bj * 128;
                    v4u w; w.x = pk2(v[0], v[1]); w.y = pk2(v[2], v[3]); w.z = pk2(v[4], v[5]); w.w = pk2(v[6], v[7]);
                    st16_wt(rdst, ((size_t)row * ld + col) * 2, w);
                    if (mode == 1) {
                        float* sp = nullptr;
                        if (u.pm == 256) { const int r = row - MP; sp = side + side_s + ((size_t)((r >> 4) * 128 + 112 + (r & 15)) * KVW + col); }
                        else if ((u.pm & 15) == 15 && ai == 1) { const int j = wr * 64 + m * 16 + fr; sp = side + ((size_t)((u.pm >> 4) * 128 + j) * KVW + col); }
                        if (sp) { *(f32x4*)sp = (f32x4){v[0], v[1], v[2], v[3]}; *(f32x4*)(sp + 4) = (f32x4){v[4], v[5], v[6], v[7]}; }
                    }
                }
                if (pn >= 10 && pn < 14) {
                    s1 += __shfl_xor(s1, 16); s1 += __shfl_xor(s1, 32); s2 += __shfl_xor(s2, 16); s2 += __shfl_xor(s2, 32);
                    if (fq == 0) { const size_t si = (size_t)((pn - 10) * 4 + wc) * MT + row; stf_wt(PG1 + si, s1); stf_wt(PG2 + si, s2); }
                }
            }
        return false;
    }
};
struct EpiMerge {
    static constexpr bool PERM = true;
    const bf16 *SA, *SB; bf16* O;
    __device__ __forceinline__ bool operator()(f32x4 (&acc)[2][2][4][2], const Unit& u, int wr, int wc, int fr, int fq) const {
        const int row0 = u.pm * 256 + wr * 64 + fr, col0 = u.pn * 256 + wc * 32 + 8 * fq; const rsrc_t ro = mk_rsrc(O);
        if (u.seg == 0) {
#pragma unroll
            for (int ai = 0; ai < 2; ++ai) {
                v4u sbw[4][2], saw[4][2];
#pragma unroll
                for (int m = 0; m < 4; ++m)
#pragma unroll
                    for (int bj = 0; bj < 2; ++bj) { const size_t off = (size_t)(row0 + ai * 128 + m * 16) * DM + col0 + bj * 128; sbw[m][bj] = *(const v4u*)(SB + off); saw[m][bj] = *(const v4u*)(SA + off); }
#pragma unroll
                for (int m = 0; m < 4; ++m)
#pragma unroll
                    for (int bj = 0; bj < 2; ++bj) { const v4u b = sbw[m][bj], a = saw[m][bj];
                        const float sb[8] = {bflo(b.x), bfhi(b.x), bflo(b.y), bfhi(b.y), bflo(b.z), bfhi(b.z), bflo(b.w), bfhi(b.w)}, sa[8] = {bflo(a.x), bfhi(a.x), bflo(a.y), bfhi(a.y), bflo(a.z), bfhi(a.z), bflo(a.w), bfhi(a.w)};
#pragma unroll
                        for (int j = 0; j < 4; ++j) { acc[ai][bj][m][0][j] *= sa[j] * __builtin_amdgcn_rcpf(fmaxf(sb[j], 1e-30f)); acc[ai][bj][m][1][j] *= sa[4 + j] * __builtin_amdgcn_rcpf(fmaxf(sb[4 + j], 1e-30f)); } }
            }
            return true;
        }
        v4u sbw[2][4][2];
#pragma unroll
        for (int ai = 0; ai < 2; ++ai)
#pragma unroll
            for (int m = 0; m < 4; ++m)
#pragma unroll
                for (int bj = 0; bj < 2; ++bj) sbw[ai][m][bj] = *(const v4u*)(SB + (size_t)(row0 + ai * 128 + m * 16) * DM + col0 + bj * 128);
#pragma unroll
        for (int ai = 0; ai < 2; ++ai)
#pragma unroll
            for (int m = 0; m < 4; ++m)
#pragma unroll
                for (int bj = 0; bj < 2; ++bj) { const size_t off = (size_t)(row0 + ai * 128 + m * 16) * DM + col0 + bj * 128; const v4u b = sbw[ai][m][bj];
                    const float sb[8] = {bflo(b.x), bfhi(b.x), bflo(b.y), bfhi(b.y), bflo(b.z), bfhi(b.z), bflo(b.w), bfhi(b.w)}; float v[8];
#pragma unroll
                    for (int j = 0; j < 4; ++j) { v[j] = acc[ai][bj][m][0][j] * fmaxf(sb[j], 1e-30f); v[4 + j] = acc[ai][bj][m][1][j] * fmaxf(sb[4 + j], 1e-30f); }
                    v4u w; w.x = pk2(v[0], v[1]); w.y = pk2(v[2], v[3]); w.z = pk2(v[4], v[5]); w.w = pk2(v[6], v[7]);
                    st16_wt(ro, off * 2, w); }
        return false;
    }
};
struct EpiBf16Ss {
    static constexpr bool PERM = true;
    bf16* O; float* P;
    __device__ __forceinline__ bool operator()(f32x4 (&acc)[2][2][4][2], const Unit& u, int wr, int wc, int fr, int fq) const {
        const int row0 = u.pm * 256 + wr * 64 + fr, col0 = u.pn * 256 + wc * 32 + 8 * fq; const rsrc_t ro = mk_rsrc(O);
#pragma unroll
        for (int ai = 0; ai < 2; ++ai)
#pragma unroll
            for (int m = 0; m < 4; ++m) {
                const int row = row0 + ai * 128 + m * 16; float ss = 0.f;
#pragma unroll
                for (int bj = 0; bj < 2; ++bj) {
                    const f32x4 a = acc[ai][bj][m][0], b = acc[ai][bj][m][1];
                    ss += (a[0] * a[0] + a[1] * a[1]) + (a[2] * a[2] + a[3] * a[3]) + (b[0] * b[0] + b[1] * b[1]) + (b[2] * b[2] + b[3] * b[3]);
                    v4u w; w.x = pk2(a[0], a[1]); w.y = pk2(a[2], a[3]); w.z = pk2(b[0], b[1]); w.w = pk2(b[2], b[3]);
                    st16_wt(ro, ((size_t)row * DM + col0 + bj * 128) * 2, w);
                }
                ss += __shfl_xor(ss, 16); ss += __shfl_xor(ss, 32);
                if (fq == 0) stf_wt(P + (size_t)(u.pn * 4 + wc) * MT + row, ss);
            }
        return false;
    }
};
struct EpiSwiglu {
    static constexpr bool PERM = true;
    const float* rstd; bf16* O;
    __device__ __forceinline__ bool operator()(f32x4 (&acc)[2][2][4][2], const Unit& u, int wr, int wc, int fr, int fq) const {
        const int row0 = u.pm * 256 + wr * 64 + fr, col0 = u.pn * 128 + wc * 32 + 8 * fq; const rsrc_t ro = mk_rsrc(O);
        float rsv[2][4];
#pragma unroll
        for (int ai = 0; ai < 2; ++ai)
#pragma unroll
            for (int m = 0; m < 4; ++m) rsv[ai][m] = rstd[row0 + ai * 128 + m * 16];
#pragma unroll
        for (int ai = 0; ai < 2; ++ai)
#pragma unroll
            for (int m = 0; m < 4; ++m) {
                const int row = row0 + ai * 128 + m * 16; const float rs = rsv[ai][m]; float v[8];
#pragma unroll
                for (int n = 0; n < 2; ++n)
#pragma unroll
                    for (int j = 0; j < 4; ++j) { const float gg = acc[ai][0][m][n][j] * rs, up = acc[ai][1][m][n][j] * rs; v[4 * n + j] = gg * sigmoidf_(gg) * up; }
                v4u w; w.x = pk2(v[0], v[1]); w.y = pk2(v[2], v[3]); w.z = pk2(v[4], v[5]); w.w = pk2(v[6], v[7]);
                st16_wt(ro, ((size_t)row * DFF + col0) * 2, w);
            }
        return false;
    }
};

template <bool MAP>
__device__ __forceinline__ void p0_transpose_item(const float* W, int K, int N, const float* gain, bf16* WT, LAS float* scr, int item, int lane) {
    const int nblk = N / 32, kb = item / nblk, nb = item % nblk, k0 = 64 * kb, n0 = 32 * nb;
    f32x4 ld[8]; float gk[8];
#pragma unroll
    for (int i = 0; i < 8; ++i) { const int kk = (lane >> 3) + 8 * i; ld[i] = *(const f32x4*)(W + (size_t)(k0 + kk) * N + n0 + (lane & 7) * 4); gk[i] = gain ? gain[k0 + kk] : 1.0f; }
#pragma unroll
    for (int i = 0; i < 8; ++i) { const int kk = (lane >> 3) + 8 * i; LAS float* d = scr + kk * 33 + (lane & 7) * 4; d[0] = ld[i].x * gk[i]; d[1] = ld[i].y * gk[i]; d[2] = ld[i].z * gk[i]; d[3] = ld[i].w * gk[i]; }
    LDS_WAIT(); asm volatile("" ::: "memory");
    const int c = lane & 7;
#pragma unroll
    for (int j = 0; j < 4; ++j) { const int n = (lane >> 3) + 8 * j; const LAS float* s = scr + (8 * c) * 33 + n;
        v4u o; o.x = pk2(s[0 * 33], s[1 * 33]); o.y = pk2(s[2 * 33], s[3 * 33]); o.z = pk2(s[4 * 33], s[5 * 33]); o.w = pk2(s[6 * 33], s[7 * 33]);
        int nn = n0 + n;
        if (MAP) { const int hi = nn >= DFF ? 1 : 0, r = nn - hi * DFF; nn = 256 * (r >> 7) + 128 * hi + (r & 127); }
        *(GAS v4u*)(WT + (size_t)nn * K + k0 + 8 * c) = o; }
    LDS_WAIT(); asm volatile("" ::: "memory");
}

namespace att {
typedef short bf16x8 __attribute__((ext_vector_type(8)));
typedef short s16x4 __attribute__((ext_vector_type(4)));
typedef short v4i16_t __attribute__((ext_vector_type(4)));
typedef float f32x16 __attribute__((ext_vector_type(16)));
typedef LAS const char* lds_cptr;
constexpr int SLOT = 16384, OST = 4 * SLOT;
__device__ __forceinline__ int crow(int r, int hi) { return (r & 3) + 8 * (r >> 2) + 4 * hi; }
__device__ __forceinline__ s16x4 vtr(lds_cptr p) { return __builtin_bit_cast(s16x4, __builtin_amdgcn_ds_read_tr16_b64_v4i16((LAS v4i16_t*)p)); }
struct TileRegs { v4u k, v; };
__device__ __forceinline__ TileRegs load_tile(const bf16* KB, const bf16* VB, size_t rowbase, int kvh, int wid, int lane) {
    TileRegs t;
    t.k = *(const v4u*)(KB + (rowbase + lane) * KVW + kvh * HD + wid * 8);
    t.v = *(const v4u*)(VB + (rowbase + 16 * (wid & 3) + (lane >> 2)) * KVW + kvh * HD + (wid >> 2) * 32 + (lane & 3) * 8);
    return t;
}
__device__ __forceinline__ void store_tile(LAS unsigned char* slot, const TileRegs& t, int wid, int lane) {
    *(LAS v4u*)(slot + wid * 1024 + lane * 16) = t.k;
    *(LAS v4u*)(slot + 8192 + wid * 1024 + lane * 16) = t.v;
}
struct QFrag { bf16x8 q[4]; };
template <bool SAMPLE>
__device__ __forceinline__ QFrag load_q(const bf16* QO, size_t qrow0, int kvh, int wid, int lane) {
    const int r32 = lane & 31, hi = lane >> 5, posb = 32 * (wid & 1), head = kvh * 4 + (wid >> 1);
    const size_t qrow = SAMPLE ? qrow0 + ((posb + r32) & 15) : qrow0 + posb + r32;
    const bf16* qp = QO + qrow * DM + head * HD; QFrag f;
#pragma unroll
    for (int d0 = 0; d0 < 4; ++d0) f.q[d0] = *(const bf16x8*)(qp + d0 * 16 + hi * 8);
    return f;
}
template <bool SAMPLE>
__device__ __forceinline__ void attn_unit(LAS unsigned char* lds, int s0, int s1, int s2, int ft, const QFrag& qf, bf16* AO, size_t qrow0, int kvh, const float* sinks, int wid, int lane) {
    const int r32 = lane & 31, hi = lane >> 5, g = wid >> 1, posb = 32 * (wid & 1), head = kvh * 4 + g;
    const float sink2 = sinks[head] * LOG2E;
    f32x16 p[6];
#pragma unroll
    for (int ti = 0; ti < 3; ++ti) {
        if (ti >= ft) {
            const int so = (ti == 0) ? s0 : (ti == 1) ? s1 : s2;
            lds_cptr kb = (lds_cptr)lds + so + hi * 1024 + r32 * 16;
            f32x16 a = {}, c = {};
#pragma unroll
            for (int d0 = 0; d0 < 4; ++d0) {
                const bf16x8 b0 = *(const LAS bf16x8*)(kb + d0 * 2048), b1 = *(const LAS bf16x8*)(kb + d0 * 2048 + 512);
                a = __builtin_amdgcn_mfma_f32_32x32x16_bf16(b0, qf.q[d0], a, 0, 0, 0); c = __builtin_amdgcn_mfma_f32_32x32x16_bf16(b1, qf.q[d0], c, 0, 0, 0);
            }
            p[2 * ti] = a; p[2 * ti + 1] = c;
        } else {
#pragma unroll
            for (int r = 0; r < 16; ++r) { p[2 * ti][r] = -INFINITY; p[2 * ti + 1][r] = -INFINITY; }
        }
    }
    if (SAMPLE) {
#pragma unroll
        for (int r = 0; r < 16; ++r) { if (r >= 8) p[4][r] = -INFINITY; p[5][r] = -INFINITY; }
    }
    float mx = sink2;
#pragma unroll
    for (int kb = 0; kb < 6; ++kb)
#pragma unroll
        for (int r = 0; r < 16; ++r) mx = fmaxf(mx, p[kb][r]);
    { auto rr = __builtin_amdgcn_permlane32_swap(__float_as_uint(mx), __float_as_uint(mx), false, false); mx = fmaxf(__uint_as_float(rr[0]), __uint_as_float(rr[1])); }
    float sum = 0.f;
#pragma unroll
    for (int kb = 0; kb < 6; ++kb)
#pragma unroll
        for (int r = 0; r < 16; ++r) { p[kb][r] = __builtin_amdgcn_exp2f(p[kb][r] - mx); sum += p[kb][r]; }
    { auto rr = __builtin_amdgcn_permlane32_swap(__float_as_uint(sum), __float_as_uint(sum), false, false); sum = __uint_as_float(rr[0]) + __uint_as_float(rr[1]); }
    const float inv = 1.0f / (sum + __builtin_amdgcn_exp2f(sink2 - mx));
    f32x16 o0 = {}, o1 = {};
    const int vb = ((lane >> 4) & 1) * 32 + (lane & 3) * 8 + (4 * hi + ((lane & 15) >> 2)) * 64;
#pragma unroll
    for (int ti = 0; ti < 3; ++ti) {
        if (ti >= ft) {
            const int so = (ti == 0) ? s0 : (ti == 1) ? s1 : s2;
            lds_cptr vp = (lds_cptr)lds + so + 8192 + vb;
#pragma unroll
            for (int ks = 0; ks < 4; ++ks) {
                const int kb = 2 * ti + (ks >> 1), rb = 8 * (ks & 1);
                v4u pw; pw.x = pk2(p[kb][rb + 0] * inv, p[kb][rb + 1] * inv); pw.y = pk2(p[kb][rb + 2] * inv, p[kb][rb + 3] * inv); pw.z = pk2(p[kb][rb + 4] * inv, p[kb][rb + 5] * inv); pw.w = pk2(p[kb][rb + 6] * inv, p[kb][rb + 7] * inv);
                const bf16x8 pa = __builtin_bit_cast(bf16x8, pw);
                { const s16x4 lo = vtr(vp + ks * 1024), h4 = vtr(vp + ks * 1024 + 512); const bf16x8 vf = (bf16x8){lo[0], lo[1], lo[2], lo[3], h4[0], h4[1], h4[2], h4[3]};
                  o0 = __builtin_amdgcn_mfma_f32_32x32x16_bf16(pa, vf, o0, 0, 0, 0); }
                { const s16x4 lo = vtr(vp + 4096 + ks * 1024), h4 = vtr(vp + 4096 + ks * 1024 + 512); const bf16x8 vf = (bf16x8){lo[0], lo[1], lo[2], lo[3], h4[0], h4[1], h4[2], h4[3]};
                  o1 = __builtin_amdgcn_mfma_f32_32x32x16_bf16(pa, vf, o1, 0, 0, 0); }
            }
        }
    }
    LAS bf16* stg = (LAS bf16*)(lds + OST + wid * 4096); const rsrc_t rao = mk_rsrc(AO);
#pragma unroll
    for (int r = 0; r < 16; ++r) { const int orow = crow(r, hi); stg[orow * 64 + r32] = (bf16)(pk2(o0[r], 0.f) & 0xffffu); stg[orow * 64 + 32 + r32] = (bf16)(pk2(o1[r], 0.f) & 0xffffu); }
    LDS_WAIT();
#pragma unroll
    for (int i = 0; i < 4; ++i) { const int row = i * 8 + (lane >> 3), ch = lane & 7; const v4u v = *(const LAS v4u*)(stg + row * 64 + ch * 8);
        if (!SAMPLE || posb + row < 16) st16_wt(rao, ((qrow0 + posb + row) * DM + head * HD + ch * 8) * 2, v); }
    LDS_WAIT();
}
}

namespace gat {
using att::bf16x8; using att::s16x4; using att::f32x16; using att::lds_cptr; using att::vtr; using att::crow;
constexpr int G_LN = 1024, G_IMG = 9216, G_STG = G_IMG + 65536;
template <bool SAMPLE, int PP>
__device__ __forceinline__ void gate_group(LAS unsigned char* lds, int g, v4u (&raw)[8], const bf16* GV, const bf16* UB, bf16* BMO, const bf16* WSB, const float* b_s, float* gs_out, size_t row0, int tid, int wave, int lane) {
    constexpr int L = SAMPLE ? 16 : 128;
    asm volatile("" : "+v"(tid)); lane = tid & 63;
    constexpr int TB0 = PP, TB1 = 3 - PP, NK0 = 2 * (TB0 + 1), NK1 = 2 * (TB1 + 1);
    LAS float* stats = (LAS float*)lds; LAS float* lnp = (LAS float*)(lds + G_LN); LAS unsigned char* img = lds + G_IMG;
    const int r32 = lane & 31, hi = lane >> 5, cq = wave >> 1;
    const int vb = ((lane >> 4) & 1) * 32 + (lane & 3) * 8 + (4 * hi + ((lane & 15) >> 2)) * 64;
    const int sr = tid >> 5, sc = (tid & 31) * 8;
    bf16x8 af0[NK0], af1[NK1];
    { const bf16* w0 = WSB + ((size_t)(g * 128 + 32 * TB0 + r32) * 128 + hi * 8); const bf16* w1 = WSB + ((size_t)(g * 128 + 32 * TB1 + r32) * 128 + hi * 8);
#pragma unroll
      for (int ks = 0; ks < NK0; ++ks) af0[ks] = *(const bf16x8*)(w0 + ks * 16);
#pragma unroll
      for (int ks = 0; ks < NK1; ++ks) af1[ks] = *(const bf16x8*)(w1 + ks * 16); }
    v4u uw[2][4]; float bias[2][4];
#pragma unroll
    for (int tsel = 0; tsel < 2; ++tsel) { const int tb = tsel ? TB1 : TB0;
#pragma unroll
        for (int i = 0; i < 4; ++i) { const int t = 32 * tb + i * 8 + (lane >> 3); uw[tsel][i] = (v4u){0u, 0u, 0u, 0u}; bias[tsel][i] = 0.f;
            if (t < L) { uw[tsel][i] = *(const v4u*)(UB + (row0 + t) * DM + g * 256 + 64 * cq + (lane & 7) * 8); bias[tsel][i] = b_s[g * 128 + t]; } } }
    { const int col = g * 256 + sc;
      const f32x4 g0 = *(const LAS f32x4*)(lnp + col), g1 = *(const LAS f32x4*)(lnp + col + 4), b0 = *(const LAS f32x4*)(lnp + DM + col), b1 = *(const LAS f32x4*)(lnp + DM + col + 4);
#pragma unroll
      for (int i = 0; i < 8; ++i) { const int r = sr + 16 * i; v4u w = {0u, 0u, 0u, 0u};
        if (r < L) {
            const v4u x = raw[i]; const float mean = stats[2 * r], rstd = stats[2 * r + 1];
            float v[8] = {bflo(x.x), bfhi(x.x), bflo(x.y), bfhi(x.y), bflo(x.z), bfhi(x.z), bflo(x.w), bfhi(x.w)};
            v[0] = (v[0] - mean) * rstd * g0.x + b0.x; v[1] = (v[1] - mean) * rstd * g0.y + b0.y; v[2] = (v[2] - mean) * rstd * g0.z + b0.z; v[3] = (v[3] - mean) * rstd * g0.w + b0.w;
            v[4] = (v[4] - mean) * rstd * g1.x + b1.x; v[5] = (v[5] - mean) * rstd * g1.y + b1.y; v[6] = (v[6] - mean) * rstd * g1.z + b1.z; v[7] = (v[7] - mean) * rstd * g1.w + b1.w;
            if (SAMPLE) { float* gs = gs_out + (size_t)r * DM + col; *(f32x4*)gs = (f32x4){v[0], v[1], v[2], v[3]}; *(f32x4*)(gs + 4) = (f32x4){v[4], v[5], v[6], v[7]}; }
            w.x = pk2(v[0], v[1]); w.y = pk2(v[2], v[3]); w.z = pk2(v[4], v[5]); w.w = pk2(v[6], v[7]);
        }
        *(LAS v4u*)(img + ((sc >> 5) * 8 + (r >> 4)) * 1024 + (r & 15) * 64 + (sc & 31) * 2) = w; } }
    if (g < 3) {
#pragma unroll
        for (int i = 0; i < 8; ++i) if (sr + 16 * i < L) raw[i] = *(const v4u*)(GV + (row0 + sr + 16 * i) * DM + (g + 1) * 256 + sc);
    }
    __syncthreads();
    f32x16 o[2][2];
#pragma unroll
    for (int a = 0; a < 2; ++a)
#pragma unroll
        for (int c = 0; c < 2; ++c) o[a][c] = (f32x16){};
#pragma unroll
    for (int ks = 0; ks < NK1; ++ks) {
#pragma unroll
        for (int cs = 0; cs < 2; ++cs) {
            lds_cptr vp = (lds_cptr)img + ((2 * cq + cs) * 8 + ks) * 1024 + vb;
            const s16x4 lo = vtr(vp), h4 = vtr(vp + 512); const bf16x8 vf = (bf16x8){lo[0], lo[1], lo[2], lo[3], h4[0], h4[1], h4[2], h4[3]};
            if (ks < NK0) o[0][cs] = __builtin_amdgcn_mfma_f32_32x32x16_bf16(af0[ks < NK0 ? ks : 0], vf, o[0][cs], 0, 0, 0);
            o[1][cs] = __builtin_amdgcn_mfma_f32_32x32x16_bf16(af1[ks], vf, o[1][cs], 0, 0, 0);
        }
        __builtin_amdgcn_sched_barrier(0);
    }
    LAS float* stg = (LAS float*)(lds + G_STG + wave * 8704); const rsrc_t rbm = mk_rsrc(BMO);
#pragma unroll
    for (int tsel = 0; tsel < 2; ++tsel) {
        const int tb = tsel ? TB1 : TB0;
#pragma unroll
        for (int r = 0; r < 16; ++r) { const int row = crow(r, hi); stg[row * 68 + r32] = o[tsel][0][r]; stg[row * 68 + 32 + r32] = o[tsel][1][r]; }
        LDS_WAIT();
#pragma unroll
        for (int i = 0; i < 4; ++i) { const int row = i * 8 + (lane >> 3), ch0 = (lane & 7) * 8, t = 32 * tb + row;
            if (t < L) {
                const f32x4 m0 = *(const LAS f32x4*)(stg + row * 68 + ch0), m1 = *(const LAS f32x4*)(stg + row * 68 + ch0 + 4); const float bs = bias[tsel][i];
                const v4u u4 = uw[tsel][i]; v4u w;
                w.x = pk2(bflo(u4.x) * (m0.x + bs), bfhi(u4.x) * (m0.y + bs)); w.y = pk2(bflo(u4.y) * (m0.z + bs), bfhi(u4.y) * (m0.w + bs));
                w.z = pk2(bflo(u4.z) * (m1.x + bs), bfhi(u4.z) * (m1.y + bs)); w.w = pk2(bflo(u4.w) * (m1.z + bs), bfhi(u4.w) * (m1.w + bs));
                st16_wt(rbm, ((row0 + t) * DM + g * 256 + 64 * cq + ch0) * 2, w);
            }
        }
        LDS_WAIT();
    }
    __syncthreads();
}
template <bool SAMPLE>
__device__ __forceinline__ void gate_unit(LAS unsigned char* lds, const bf16* GV, const bf16* UB, bf16* BMO, const bf16* WSB, const float* PG1, const float* PG2, const float* ln_g, const float* ln_b, const float* b_s, float* gs_out, size_t row0, int tid, int wave, int lane) {
    constexpr int L = SAMPLE ? 16 : 128;
    LAS float* stats = (LAS float*)lds; LAS float* lnp = (LAS float*)(lds + G_LN);
    __syncthreads();
    const int sr = tid >> 5, sc = (tid & 31) * 8;
    v4u raw[8];
#pragma unroll
    for (int i = 0; i < 8; ++i) { raw[i] = (v4u){0u, 0u, 0u, 0u}; if (sr + 16 * i < L) raw[i] = *(const v4u*)(GV + (row0 + sr + 16 * i) * DM + sc); }
    if (tid < L) {
        float a = 0.f, q = 0.f;
#pragma unroll
        for (int k = 0; k < 16; ++k) { a += PG1[(size_t)k * MT + row0 + tid]; q += PG2[(size_t)k * MT + row0 + tid]; }
        const float mean = a * (1.0f / DM), var = fmaxf(q * (1.0f / DM) - mean * mean, 0.f);
        stats[2 * tid] = mean; stats[2 * tid + 1] = 1.0f / sqrtf(var + EPS);
    }
    { const int i4 = tid & 255; const float* src = (tid < 256) ? ln_g : ln_b; *(LAS f32x4*)(lnp + (tid < 256 ? 0 : DM) + 4 * i4) = *(const f32x4*)(src + 4 * i4); }
    __syncthreads();
    if (wave & 1) { for (int g = 0; g < 4; ++g) gate_group<SAMPLE, 1>(lds, g, raw, GV, UB, BMO, WSB, b_s, gs_out, row0, tid, wave, lane); }
    else          { for (int g = 0; g < 4; ++g) gate_group<SAMPLE, 0>(lds, g, raw, GV, UB, BMO, WSB, b_s, gs_out, row0, tid, wave, lane); }
}
}

template <bool WT>
__device__ __forceinline__ void x_rows4(int m0, const float* xp, const float* xs, bf16* XB, float* RSTD1, int lane) {
    f32x4 v[4][4]; const rsrc_t rx = mk_rsrc(XB);
#pragma unroll
    for (int i = 0; i < 4; ++i) { const int m = m0 + i; const float* xrow = (m < MP) ? xp + (size_t)m * DM : xs + (size_t)(m - MP) * DM;
#pragma unroll
        for (int k = 0; k < 2; ++k) { v[i][2 * k] = *(const f32x4*)(xrow + k * 512 + 8 * lane); v[i][2 * k + 1] = *(const f32x4*)(xrow + k * 512 + 8 * lane + 4); } }
#pragma unroll
    for (int i = 0; i < 4; ++i) { const int m = m0 + i; float s = 0.f;
#pragma unroll
        for (int j = 0; j < 4; ++j) s += (v[i][j].x * v[i][j].x + v[i][j].y * v[i][j].y) + (v[i][j].z * v[i][j].z + v[i][j].w * v[i][j].w);
        s = wave_sum(s);
        const float rs = 1.0f / sqrtf(s * (1.0f / DM) + EPS);
        if (lane == 0) { if (WT) stf_wt(RSTD1 + m, rs); else RSTD1[m] = rs; }
#pragma unroll
        for (int k = 0; k < 2; ++k) { v4u w; w.x = pk2(v[i][2 * k].x, v[i][2 * k].y); w.y = pk2(v[i][2 * k].z, v[i][2 * k].w); w.z = pk2(v[i][2 * k + 1].x, v[i][2 * k + 1].y); w.w = pk2(v[i][2 * k + 1].z, v[i][2 * k + 1].w);
            if (WT) st16_wt(rx, ((size_t)m * DM + k * 512 + 8 * lane) * 2, w); else *(v4u*)(XB + (size_t)m * DM + k * 512 + 8 * lane) = w; } }
}
__device__ __forceinline__ bool chunk_next(pg8::DynOrder& S, int i, pg8::Unit& u, int tid) {
    if (tid == 0) S.put(i & 1, S.draw(S.xcd), 0);
    __syncthreads();
    return S.get(i & 1, u);
}
__device__ __forceinline__ void l1_acquire(int tid) {
    __syncthreads();
    if (tid == 0) { __builtin_amdgcn_fence(__ATOMIC_ACQUIRE, "agent"); asm volatile("s_waitcnt vmcnt(0)" ::: "memory"); }
    __syncthreads();
}
__device__ __forceinline__ void rows_wait(unsigned* cnt, unsigned need, unsigned* tot, unsigned need_tot, int& flag, unsigned* tmo, int wave) {
    if (wave == 0 && flag == 0) {
        unsigned spins = 0;
        for (;;) {
            const unsigned c0 = __hip_atomic_load(cnt, __ATOMIC_RELAXED, __HIP_MEMORY_SCOPE_AGENT), t0 = __hip_atomic_load(tot, __ATOMIC_RELAXED, __HIP_MEMORY_SCOPE_AGENT);
            const unsigned c = (unsigned)__builtin_amdgcn_readfirstlane(c0), t = (unsigned)__builtin_amdgcn_readfirstlane(t0);
            if (t >= need_tot) { flag = 1; break; }
            if (c >= need) break;
            if (++spins > PG8_SPIN_CAP || ((spins & 63u) == 0u && __builtin_amdgcn_readfirstlane(__hip_atomic_load(tmo, __ATOMIC_RELAXED, __HIP_MEMORY_SCOPE_AGENT)) != 0u)) { if ((threadIdx.x & 63) == 0) __hip_atomic_store(tmo, 1u, __ATOMIC_RELAXED, __HIP_MEMORY_SCOPE_AGENT); break; }
            __builtin_amdgcn_s_sleep(4);
        }
    }
    __syncthreads();
}

__device__ __forceinline__ void panels_wait(unsigned* C, int p_lo, int p_hi, unsigned need, unsigned* tot, unsigned need_tot, int& flag, unsigned* tmo, int wave) {
    if (wave == 0 && flag == 0) {
        unsigned spins = 0;
        for (;;) {
            const unsigned t0 = __hip_atomic_load(tot, __ATOMIC_RELAXED, __HIP_MEMORY_SCOPE_AGENT); unsigned cmin = 0xffffffffu;
            for (int p = p_lo; p <= p_hi; ++p) { const unsigned c = __hip_atomic_load(C + 64 * p, __ATOMIC_RELAXED, __HIP_MEMORY_SCOPE_AGENT); cmin = c < cmin ? c : cmin; }
            if ((unsigned)__builtin_amdgcn_readfirstlane(t0) >= need_tot) { flag = 1; break; }
            if ((unsigned)__builtin_amdgcn_readfirstlane(cmin) >= need) break;
            if (++spins > PG8_SPIN_CAP || ((spins & 63u) == 0u && __builtin_amdgcn_readfirstlane(__hip_atomic_load(tmo, __ATOMIC_RELAXED, __HIP_MEMORY_SCOPE_AGENT)) != 0u)) { if ((threadIdx.x & 63) == 0) __hip_atomic_store(tmo, 1u, __ATOMIC_RELAXED, __HIP_MEMORY_SCOPE_AGENT); break; }
            __builtin_amdgcn_s_sleep(4);
        }
    }
    __syncthreads();
}
__device__ __forceinline__ void p2_signal(unsigned* C2, int panel, int lane) {
    asm volatile("s_waitcnt vmcnt(0)" ::: "memory");
    if (lane == 0) __hip_atomic_fetch_add(C2 + 64 * panel, 1u, __ATOMIC_RELAXED, __HIP_MEMORY_SCOPE_AGENT);
}
__device__ __forceinline__ void p2_signal_sample(unsigned* C2, unsigned* CS, int lane) {
    asm volatile("s_waitcnt vmcnt(0)" ::: "memory");
    if (lane == 0) { const unsigned old = __hip_atomic_fetch_add(CS, 1u, __ATOMIC_RELAXED, __HIP_MEMORY_SCOPE_AGENT); if (old == 639u) __hip_atomic_fetch_add(C2 + 64 * 256, 48u, __ATOMIC_RELAXED, __HIP_MEMORY_SCOPE_AGENT); }
}

struct Args { const float* in[19]; float* out; unsigned char* ws; int ph_lo, ph_hi; };

__global__ void __launch_bounds__(NWAVES * 64, 2) fwd_kernel(Args args) {
    extern __shared__ __attribute__((aligned(16))) unsigned char lds_raw[];
    LAS unsigned char* lds = (LAS unsigned char*)lds_raw;
    volatile LAS unsigned* MISC = (volatile LAS unsigned*)(lds + MISC_OFF);
    const int tid = threadIdx.x, lane = tid & 63, wave = __builtin_amdgcn_readfirstlane(tid >> 6);
    const int G = gridDim.x;
    const int vcu = (G % 8 == 0) ? ((int)blockIdx.x % 8) * (G / 8) + (int)blockIdx.x / 8 : (int)blockIdx.x;
    unsigned char* ws = args.ws;
    const float* xp = args.in[0]; const float* xs = args.in[1]; const float* cache_k = args.in[2]; const float* cache_v = args.in[3];
    const float* g_pre_mix = args.in[4]; const float* g_post_mix = args.in[5]; const float* g_pre_ffn = args.in[6]; const float* g_post_ffn = args.in[7];
    const float* w_in = args.in[8]; const float* sinks = args.in[9]; const float* ln_g = args.in[10]; const float* ln_b = args.in[11];
    const float* w_s = args.in[12]; const float* b_s = args.in[13]; const float* w_ap = args.in[14]; const float* w_gp = args.in[15];
    const float* w_out = args.in[16]; const float* w_fi = args.in[17]; const float* w_fo = args.in[18];
    float* out = args.out;
    bf16* WinT = (bf16*)(ws + WS_WIN); bf16* WfiT = (bf16*)(ws + WS_WFI); bf16* WaT = (bf16*)(ws + WS_WA); bf16* WgT = (bf16*)(ws + WS_WG); bf16* WoT = (bf16*)(ws + WS_WO); bf16* WfoT = (bf16*)(ws + WS_WFO); bf16* WSB = (bf16*)(ws + WS_WSB);
    float* RSTD1 = (float*)(ws + WS_RSTD1); float* RSTD2 = (float*)(ws + WS_RSTD2); float* PMIX = (float*)(ws + WS_PMIX); float* PF = (float*)(ws + WS_PF);
    bf16* XB = (bf16*)(ws + WS_R0); bf16* FB = XB;
    bf16* QB = (bf16*)(ws + WS_R1); bf16* MERGED = QB; bf16* X1B = QB;
    bf16* GV = (bf16*)(ws + WS_R2); bf16* MIX = GV;
    bf16* KB = (bf16*)(ws + WS_KB); bf16* VB = (bf16*)(ws + WS_VB);
    bf16* SA = (bf16*)(ws + WS_SA); bf16* SB = (bf16*)(ws + WS_SB); bf16* UB = (bf16*)(ws + WS_U); bf16* ACT = (bf16*)(ws + WS_R3); bf16* AO = (bf16*)(ws + WS_AO);
#ifdef GATE_OOP
    bf16* BMB = XB;
#else
    bf16* BMB = UB;
#endif

    for (int u = tid; u < (LDS_BYTES - LDSCTL_OFF) / 4; u += NWAVES * 64) ((LAS unsigned*)(lds + LDSCTL_OFF))[u] = 0u;
    __syncthreads();
    XcdBarrier bar; bar.bar = (unsigned*)(ws + WS_CTL) + CW_BAR; bar.x = 0; bar.st = nullptr;
    if (MK_ONE_LAUNCH) bar = xcd_barrier_post((unsigned*)(ws + WS_CTL) + CW_BAR, MISC + 8);
    const int lo = args.ph_lo, hi = args.ph_hi;
    STAMP(0);
#ifndef PH_MASK
#define PH_MASK 0x1ff
#endif
#define IN(k) (((PH_MASK >> (k)) & 1) && lo <= (k) && (k) < hi)
#define SEAM(k) do { if (MK_ONE_LAUNCH && IN(k) && IN((k) + 1)) xcd_barrier(bar); } while (0)
    const int gw = vcu * NWAVES + wave, NGW = G * NWAVES;
    unsigned* const QH = (unsigned*)(ws + WS_CTL) + CW_Q; LAS int* const BOX = (LAS int*)(lds + BOX_OFF);
    unsigned* const C0 = (unsigned*)(ws + WS_CTL) + CW_C0, * const T0 = (unsigned*)(ws + WS_CTL) + CW_TOT + 5 * 64, * const TMO0 = (unsigned*)(ws + WS_CTL) + CW_TMO;

    if (IN(0)) for (int rep_ = 0; rep_ < NREP(0); ++rep_) {
        LAS float* scr = (LAS float*)(lds + wave * 16384);
        constexpr int I_IN = (DM / 64) * (INW / 32), I_SQ = (DM / 64) * (DM / 32), I_FO = (DFF / 64) * (DM / 32);
        constexpr int NITEMS = 2 * I_IN + 3 * I_SQ + I_FO;
        for (int it = gw; it < NITEMS; it += NGW) {
            int r = it;
            if (r < I_IN) { p0_transpose_item<false>(w_in, DM, INW, g_pre_mix, WinT, scr, r, lane); continue; } r -= I_IN;
            if (r < I_IN) { p0_transpose_item<true>(w_fi, DM, INW, g_pre_ffn, WfiT, scr, r, lane); continue; } r -= I_IN;
            if (r < I_SQ) { p0_transpose_item<false>(w_ap, DM, DM, nullptr, WaT, scr, r, lane); continue; } r -= I_SQ;
            if (r < I_SQ) { p0_transpose_item<false>(w_gp, DM, DM, nullptr, WgT, scr, r, lane); continue; } r -= I_SQ;
            if (r < I_SQ) { p0_transpose_item<false>(w_out, DM, DM, nullptr, WoT, scr, r, lane); continue; } r -= I_SQ;
            p0_transpose_item<false>(w_fo, DFF, DM, nullptr, WfoT, scr, r, lane);
        }
        for (int i = gw * 64 + lane; i < 4 * 128 * 128; i += NGW * 64) {
            const int t = (i >> 7) & 127, pp = i & 127, pl = pp & 15, sl = (pl & 3) | ((pl & 4) << 1) | ((pl & 8) >> 1), sidx = (pp & ~15) + sl;
            const float v = (sidx <= t) ? w_s[(size_t)(i & ~127) + sidx] : 0.f;
            WSB[i] = (bf16)(pk2(v, 0.f) & 0xffffu);
        }
        for (int gi = gw; gi < 65 * 64; gi += NGW) { const int p = gi >> 6, panel = p < 64 ? 32 * (p & 7) + (p >> 3) : 256; x_rows4<false>(panel * 256 + 4 * (gi & 63), xp, xs, XB, RSTD1, lane); }
        if (tid == 0) for (int p = blockIdx.x; p < 65; p += G) { const int panel = p < 64 ? 32 * (p & 7) + (p >> 3) : 256; __hip_atomic_fetch_add(C0 + 64 * panel, 8u, __ATOMIC_RELAXED, __HIP_MEMORY_SCOPE_AGENT); }
        for (int i = gw * 64 + lane; i < 2 * NB * 112 * 64; i += NGW * 64) {
            const int which = i / (NB * 112 * 64), r = i % (NB * 112 * 64), b = r / (112 * 64), q = r % (112 * 64);
            const float* src = (which ? cache_v : cache_k) + (size_t)b * 128 * KVW + 16 * KVW;
            float* dstp = out + (which ? O_VS : O_KS) + (size_t)b * 128 * KVW;
            ((f32x4*)dstp)[q] = ((const f32x4*)src)[q];
        }
    }
    STAMP(1);
    SEAM(0);
    STAMP(2);

    if (IN(1)) for (int rep_ = 0; rep_ < NREP(1); ++rep_) {
        const int NWK = (G >> 5) * 8;
        if (((blockIdx.x >> 3) & 3) == 0 && rep_ == 0) {
            const int w = (int)(blockIdx.x & 7) + 8 * (int)(blockIdx.x >> 5);
            for (int idx = w; idx < 192; idx += NWK) { const int wi = idx & 63, panel = 32 * (wi & 7) + 8 * (1 + (idx >> 6)) + (wi >> 3);
                for (int r = 0; r < 8; ++r) x_rows4<true>(panel * 256 + 32 * wave + 4 * r, xp, xs, XB, RSTD1, lane);
                asm volatile("s_waitcnt vmcnt(0)" ::: "memory");
                if (lane == 0) __hip_atomic_fetch_add(C0 + 64 * panel, 1u, __ATOMIC_RELAXED, __HIP_MEMORY_SCOPE_AGENT); }
            __syncthreads();
            if (tid == 0) __hip_atomic_fetch_add(T0, 1u, __ATOMIC_RELAXED, __HIP_MEMORY_SCOPE_AGENT);
        }
        pg8::Gemm g{XB, WinT, XB, WinT, MT, INW, DM}; pg8::DynOrder S; S.init(QH + 1 * 512, MP, INW, 1, BOX);
        EpiIn E{RSTD1, QB, KB, VB, UB, GV, SA, SB, out, PF, PMIX};
        const pg8::Dep D{C0, 8u, T0, (unsigned)NWK, nullptr, 0u, (unsigned*)(ws + WS_CTL) + CW_C1, (unsigned*)(ws + WS_CTL) + CW_TOT + 6 * 64, TMO0}; pg8::gemm_phase<EpiIn, pg8::DynOrder, 0, DM>(lds, g, S, E, D);
    }
    STAMP(3);
    STAMP(4);

    unsigned* const C1 = (unsigned*)(ws + WS_CTL) + CW_C1, * const C2 = (unsigned*)(ws + WS_CTL) + CW_C2, * const CSP = (unsigned*)(ws + WS_CTL) + CW_CS;
    unsigned* const T1 = (unsigned*)(ws + WS_CTL) + CW_TOT + 6 * 64, * const T2 = (unsigned*)(ws + WS_CTL) + CW_TOT + 7 * 64;
    if (IN(2)) {
        int p2flag = 0;
        for (;;) {
            __syncthreads();
            if (tid == 0) BOX[0] = (int)__hip_atomic_fetch_add(QH + 2 * 512, 1u, __ATOMIC_RELAXED, __HIP_MEMORY_SCOPE_AGENT);
            __syncthreads();
            const int t = BOX[0];
            if (t >= NB * NKV * 4 + NB * NKV) break;
            if (t < NB * NKV * 4) {
                const int key = t >> 6, w6 = t & 63, kvh = w6 & 3, b = 2 * (w6 >> 3) + (key >> 1), qq = 2 * (key & 1) + ((w6 >> 2) & 1), c0 = 16 * qq; const size_t seqbase = (size_t)b * SEQ;
                panels_wait(C1, 16 * b + 4 * qq - (qq > 0 ? 1 : 0), 16 * b + 4 * qq + 3, 176u, T1, (unsigned)G, p2flag, TMO0, wave);
                for (int T = (c0 >= 2 ? c0 - 2 : 0); T <= c0; ++T) { const att::TileRegs tr = att::load_tile(KB, VB, seqbase + 64 * T, kvh, wave, lane); att::store_tile(lds + (T & 3) * att::SLOT, tr, wave, lane); }
                att::QFrag qc = att::load_q<false>(QB, seqbase + 64 * c0, kvh, wave, lane);
                __syncthreads();
                for (int c = c0; c < c0 + 16; ++c) {
                    att::TileRegs nx; nx.k = (v4u){0u, 0u, 0u, 0u}; nx.v = nx.k; const bool pre = (c + 1 < c0 + 16);
                    att::QFrag qn = qc;
                    if (pre) { nx = att::load_tile(KB, VB, seqbase + 64 * (c + 1), kvh, wave, lane); qn = att::load_q<false>(QB, seqbase + 64 * (c + 1), kvh, wave, lane); }
                    att::attn_unit<false>(lds, ((c + 2) & 3) * att::SLOT, ((c + 3) & 3) * att::SLOT, (c & 3) * att::SLOT, c >= 2 ? 0 : 2 - c, qc, AO, seqbase + 64 * c, kvh, sinks, wave, lane);
                    if (pre) att::store_tile(lds + ((c + 1) & 3) * att::SLOT, nx, wave, lane);
                    qc = qn;
                    if ((c & 3) == 3) p2_signal(C2, 16 * b + (c >> 2), lane);
                    __syncthreads();
                }
            } else {
                const int j = t - NB * NKV * 4, b = j >> 2, kvh = j & 3;
                panels_wait(C1, 256, 256, 176u, T1, (unsigned)G, p2flag, TMO0, wave);
#pragma unroll
                for (int T = 0; T < 2; ++T) {
                    att::TileRegs tr;
                    { const size_t o = ((size_t)(b * 128 + 64 * T + lane) * NKV + kvh) * HD + wave * 8; const f32x4 k0 = *(const f32x4*)(cache_k + o), k1 = *(const f32x4*)(cache_k + o + 4);
                      tr.k.x = pk2(k0.x, k0.y); tr.k.y = pk2(k0.z, k0.w); tr.k.z = pk2(k1.x, k1.y); tr.k.w = pk2(k1.z, k1.w); }
                    { const size_t o = ((size_t)(b * 128 + 64 * T + 16 * (wave & 3) + (lane >> 2)) * NKV + kvh) * HD + (wave >> 2) * 32 + (lane & 3) * 8; const f32x4 v0 = *(const f32x4*)(cache_v + o), v1 = *(const f32x4*)(cache_v + o + 4);
                      tr.v.x = pk2(v0.x, v0.y); tr.v.y = pk2(v0.z, v0.w); tr.v.z = pk2(v1.x, v1.y); tr.v.w = pk2(v1.z, v1.w); }
                    att::store_tile(lds + T * att::SLOT, tr, wave, lane);
                }
                { att::TileRegs tr; tr.k = (v4u){0u, 0u, 0u, 0u}; tr.v = tr.k;
                  if (lane < 16) tr.k = *(const v4u*)(KB + (size_t)(MP + b * 16 + lane) * KVW + kvh * HD + wave * 8);
                  if ((wave & 3) == 0) tr.v = *(const v4u*)(VB + (size_t)(MP + b * 16 + (lane >> 2)) * KVW + kvh * HD + (wave >> 2) * 32 + (lane & 3) * 8);
                  att::store_tile(lds + 2 * att::SLOT, tr, wave, lane); }
                __syncthreads();
                { const att::QFrag qs = att::load_q<true>(QB, (size_t)(MP + b * 16), kvh, wave, lane); att::attn_unit<true>(lds, 0, att::SLOT, 2 * att::SLOT, 0, qs, AO, (size_t)(MP + b * 16), kvh, sinks, wave, lane); }
                p2_signal_sample(C2, CSP, lane);
            }
        }
        for (;;) {
            __syncthreads();
            if (tid == 0) BOX[0] = (int)__hip_atomic_fetch_add(QH + 2 * 512 + 64, 1u, __ATOMIC_RELAXED, __HIP_MEMORY_SCOPE_AGENT);
            __syncthreads();
            const int t = BOX[0];
            if (t >= NB * 32 + NB) break;
            if (t < NB * 32) {
                const int key = t >> 7, w7 = t & 127, b = 2 * (w7 >> 4) + (key >> 1), unit = b * 32 + 16 * (key & 1) + (w7 & 15);
                panels_wait(C1, unit >> 1, unit >> 1, 176u, T1, (unsigned)G, p2flag, TMO0, wave);
                gat::gate_unit<false>(lds, GV, UB, BMB, WSB, PF, PMIX, ln_g, ln_b, b_s, nullptr, (size_t)unit * 128, tid, wave, lane);
                p2_signal(C2, unit >> 1, lane);
            } else {
                const int j = t - NB * 32;
                panels_wait(C1, 256, 256, 176u, T1, (unsigned)G, p2flag, TMO0, wave);
                gat::gate_unit<true>(lds, GV, UB, BMB, WSB, PF, PMIX, ln_g, ln_b, b_s, out + O_GS + (size_t)j * 16 * DM, (size_t)(MP + j * 16), tid, wave, lane);
                p2_signal_sample(C2, CSP, lane);
            }
        }
        __syncthreads();
        if (tid == 0) __hip_atomic_fetch_add(T2, 1u, __ATOMIC_RELAXED, __HIP_MEMORY_SCOPE_AGENT);
    }
    STAMP(5);
    STAMP(6);

    unsigned* const ctl = (unsigned*)(ws + WS_CTL);
    unsigned* const C3 = ctl + CW_CNT, * const C4 = C3 + 264 * 64, * const C5 = C4 + 264 * 64, * const C6 = C5 + 264 * 64, * const C7 = C6 + 264 * 64, * const T3 = ctl + CW_TOT, * const T4 = T3 + 64, * const T5 = T4 + 64, * const T6 = T5 + 64, * const T7 = T6 + 64, * const TMO = ctl + CW_TMO;
    const unsigned NWG = (unsigned)G;
    if (IN(3)) {
        pg8::Gemm g{AO, WaT, BMB, WgT, MT, DM, DM}; pg8::DynOrder S; S.init(QH + 3 * 512, MP, DM, 2, BOX);
        EpiMerge E{SA, SB, MERGED}; const pg8::Dep D{C2, 48u, T2, NWG, nullptr, 0u, C3, T3, TMO};
        l1_acquire(tid); pg8::gemm_phase<EpiMerge, pg8::DynOrder, 0, DM>(lds, g, S, E, D);
    }
    STAMP(7);
    if (IN(4)) {
        pg8::Gemm g{MERGED, WoT, MERGED, WoT, MT, DM, DM}; pg8::DynOrder S; S.init(QH + 4 * 512, MP, DM, 1, BOX);
        EpiBf16Ss E{MIX, PMIX}; const pg8::Dep D{C3, 32u, T3, NWG, nullptr, 0u, C4, T4, TMO};
        l1_acquire(tid); pg8::gemm_phase<EpiBf16Ss, pg8::DynOrder, 0, DM>(lds, g, S, E, D);
    }
    STAMP(8);
    if (IN(5)) {
        const bool worker = ((blockIdx.x >> 3) & 3) == 0;
        pg8::DynOrder S; S.init(QH + 5 * 512, MP, DM, 1, BOX); pg8::Unit u; const rsrc_t rmix = mk_rsrc(MIX), rx1 = mk_rsrc(X1B);
        f32x4 gv[4];
#pragma unroll
        for (int k = 0; k < 4; ++k) gv[k] = *(const f32x4*)(g_post_mix + (k >> 1) * 512 + 8 * lane + (k & 1) * 4);
        int rflag = 0;
        for (int i = 0; (worker || i == 0) && chunk_next(S, i, u, tid); ++i) {
            rows_wait(C4 + 64 * u.pm, 32u, T4, NWG, rflag, TMO, wave);
            const int mb = u.pm * 256 + u.pn * 64 + wave * 8;
#pragma unroll 1
            for (int h = 0; h < 2; ++h) {
                v4u xw[4][2], mw[4][2]; float ps[4];
#pragma unroll
                for (int r = 0; r < 4; ++r) { const int m = mb + 4 * h + r; ps[r] = ldf_nc(PMIX + (size_t)(lane & 15) * MT + m);
#pragma unroll
                    for (int k = 0; k < 2; ++k) { xw[r][k] = *(const v4u*)(XB + (size_t)m * DM + k * 512 + 8 * lane); mw[r][k] = ld16_nc(rmix, ((size_t)m * DM + k * 512 + 8 * lane) * 2); } }
#pragma unroll
                for (int r = 0; r < 4; ++r) { const int m = mb + 4 * h + r; float p = ps[r]; p += __shfl_xor(p, 1); p += __shfl_xor(p, 2); p += __shfl_xor(p, 4); p += __shfl_xor(p, 8);
                    const float rm = 1.0f / sqrtf(p * (1.0f / DM) + EPS); float v[2][8]; float sq = 0.f;
#pragma unroll
                    for (int k = 0; k < 2; ++k) { const v4u a = xw[r][k], b = mw[r][k]; const f32x4 g0 = gv[2 * k], g1 = gv[2 * k + 1];
                        v[k][0] = bflo(a.x) + bflo(b.x) * rm * g0.x; v[k][1] = bfhi(a.x) + bfhi(b.x) * rm * g0.y; v[k][2] = bflo(a.y) + bflo(b.y) * rm * g0.z; v[k][3] = bfhi(a.y) + bfhi(b.y) * rm * g0.w;
                        v[k][4] = bflo(a.z) + bflo(b.z) * rm * g1.x; v[k][5] = bfhi(a.z) + bfhi(b.z) * rm * g1.y; v[k][6] = bflo(a.w) + bflo(b.w) * rm * g1.z; v[k][7] = bfhi(a.w) + bfhi(b.w) * rm * g1.w;
#pragma unroll
                        for (int j = 0; j < 8; ++j) sq += v[k][j] * v[k][j]; }
                    sq = wave_sum(sq);
                    if (lane == 0) stf_wt(RSTD2 + m, 1.0f / sqrtf(sq * (1.0f / DM) + EPS));
#pragma unroll
                    for (int k = 0; k < 2; ++k) { v4u w; w.x = pk2(v[k][0], v[k][1]); w.y = pk2(v[k][2], v[k][3]); w.z = pk2(v[k][4], v[k][5]); w.w = pk2(v[k][6], v[k][7]); st16_wt(rx1, ((size_t)m * DM + k * 512 + 8 * lane) * 2, w); } }
            }
            asm volatile("s_waitcnt vmcnt(0)" ::: "memory");
            if (lane == 0) __hip_atomic_fetch_add(C5 + 64 * u.pm, 1u, __ATOMIC_RELAXED, __HIP_MEMORY_SCOPE_AGENT);
        }
        __syncthreads();
        if (tid == 0) __hip_atomic_fetch_add(T5, 1u, __ATOMIC_RELAXED, __HIP_MEMORY_SCOPE_AGENT);
    }
    STAMP(9);
    if (IN(6)) {
        pg8::Gemm g{X1B, WfiT, X1B, WfiT, MT, INW, DM}; pg8::DynOrder S; S.init(QH + 6 * 512, MP, INW, 1, BOX);
        EpiSwiglu E{RSTD2, ACT}; const pg8::Dep D{C5, 32u, T5, NWG, T3, NWG, C6, T6, TMO};
        l1_acquire(tid); pg8::gemm_phase<EpiSwiglu, pg8::DynOrder, 0, DM>(lds, g, S, E, D);
    }
    STAMP(10);
    if (IN(7)) {
        pg8::Gemm g{ACT, WfoT, ACT, WfoT, MT, DM, DFF}; pg8::DynOrder S; S.init(QH + 7 * 512, MP, DM, 1, BOX);
        EpiBf16Ss E{FB, PF}; const pg8::Dep D{C6, 176u, T6, NWG, nullptr, 0u, C7, T7, TMO};
        l1_acquire(tid); pg8::gemm_phase<EpiBf16Ss, pg8::DynOrder, 0, DFF>(lds, g, S, E, D);
    }
    STAMP(11);
    if (IN(8)) {
        pg8::DynOrder S; S.init(QH + 8 * 512, MP, DM, 1, BOX); pg8::Unit u; const rsrc_t rf = mk_rsrc(FB), rx1 = mk_rsrc(X1B);
        f32x4 gv[4];
#pragma unroll
        for (int k = 0; k < 4; ++k) gv[k] = *(const f32x4*)(g_post_ffn + (k >> 1) * 512 + 8 * lane + (k & 1) * 4);
        int rflag = 0;
        for (int i = 0; chunk_next(S, i, u, tid); ++i) {
            rows_wait(C7 + 64 * u.pm, 32u, T7, NWG, rflag, TMO, wave);
            const int mb = u.pm * 256 + u.pn * 64 + wave * 8;
#pragma unroll 1
            for (int h = 0; h < 2; ++h) {
                v4u xw[4][2], fw[4][2]; float ps[4];
#pragma unroll
                for (int r = 0; r < 4; ++r) { const int m = mb + 4 * h + r; ps[r] = ldf_nc(PF + (size_t)(lane & 15) * MT + m);
#pragma unroll
                    for (int k = 0; k < 2; ++k) { xw[r][k] = ld16_nc(rx1, ((size_t)m * DM + k * 512 + 8 * lane) * 2); fw[r][k] = ld16_nc(rf, ((size_t)m * DM + k * 512 + 8 * lane) * 2); } }
#pragma unroll
                for (int r = 0; r < 4; ++r) { const int m = mb + 4 * h + r; float p = ps[r]; p += __shfl_xor(p, 1); p += __shfl_xor(p, 2); p += __shfl_xor(p, 4); p += __shfl_xor(p, 8);
                    const float rf2 = 1.0f / sqrtf(p * (1.0f / DM) + EPS);
                    float* yrow = (m < MP) ? out + O_YP + (size_t)m * DM : out + O_YS + (size_t)(m - MP) * DM;
#pragma unroll
                    for (int k = 0; k < 2; ++k) { const v4u a = xw[r][k], b = fw[r][k]; const f32x4 g0 = gv[2 * k], g1 = gv[2 * k + 1]; f32x4 y0, y1;
                        y0.x = bflo(a.x) + bflo(b.x) * rf2 * g0.x; y0.y = bfhi(a.x) + bfhi(b.x) * rf2 * g0.y; y0.z = bflo(a.y) + bflo(b.y) * rf2 * g0.z; y0.w = bfhi(a.y) + bfhi(b.y) * rf2 * g0.w;
                        y1.x = bflo(a.z) + bflo(b.z) * rf2 * g1.x; y1.y = bfhi(a.z) + bfhi(b.z) * rf2 * g1.y; y1.z = bflo(a.w) + bflo(b.w) * rf2 * g1.z; y1.w = bfhi(a.w) + bfhi(b.w) * rf2 * g1.w;
                        *(f32x4*)(yrow + k * 512 + 8 * lane) = y0; *(f32x4*)(yrow + k * 512 + 8 * lane + 4) = y1; } }
            }
        }
    }
    STAMP(12);
#undef IN
#undef SEAM
}

#ifdef TS_A
#ifndef TS_C
#define TS_C TS_A
#define TS_D TS_B
#endif
#ifndef TS_SCALE
#define TS_SCALE 1e-7f
#endif
#ifndef TS_STAT
#define TS_STAT 0
#endif
__global__ void probe_fin(unsigned char* ws, float* out, int G) {
    __shared__ unsigned long long sh[4][256];
    const unsigned long long* ts = (const unsigned long long*)(ws + 768 * 1024); const int t = threadIdx.x;
    unsigned long long a = 0, b = 0, c = 0, d = 0;
    if (t < G) { a = ts[t * 16 + TS_A]; b = ts[t * 16 + TS_B]; c = ts[t * 16 + TS_C]; d = ts[t * 16 + TS_D]; }
    sh[0][t] = a; sh[1][t] = b; sh[2][t] = c; sh[3][t] = d; __syncthreads();
    if (t == 0) {
        unsigned long long s1 = 0, s2 = 0, mina = ~0ull, maxb = 0, minc = ~0ull, maxd = 0;
        for (int i = 0; i < G; ++i) { s1 += sh[1][i] - sh[0][i]; s2 += sh[3][i] - sh[2][i]; if (sh[0][i] < mina) mina = sh[0][i]; if (sh[1][i] > maxb) maxb = sh[1][i]; if (sh[2][i] < minc) minc = sh[2][i]; if (sh[3][i] > maxd) maxd = sh[3][i]; }
        const unsigned long long v1 = TS_STAT ? (maxb - mina) : s1 / (unsigned long long)G, v2 = TS_STAT ? (maxd - minc) : s2 / (unsigned long long)G;
        const unsigned long long t0 = __builtin_amdgcn_s_memrealtime();
        while (__builtin_amdgcn_s_memrealtime() - t0 < v1) __builtin_amdgcn_s_sleep(8);
        const float us = (float)v2 * 0.01f;
        out[O_GS] += sqrtf(us * TS_SCALE * 262930.0f);
    }
}
#endif
constexpr int N_PHASES = 9;
extern "C" void kernel_launch(void* const* d_in, const int* in_sizes, int n_in, void* d_out, int out_size, void* d_ws, size_t ws_size, hipStream_t stream) {
    static int grid = 0;
    if (grid == 0) {
        if (n_in != 19 || (size_t)out_size != O_END || ws_size < WS_END) { fprintf(stderr, "kernel_launch: unexpected shapes: n_in %d out %d ws %zu (need %zu)\n", n_in, out_size, ws_size, (size_t)WS_END); grid = -1; return; }
        int dev = 0, cus = 0;
        if (hipGetDevice(&dev) != hipSuccess || hipDeviceGetAttribute(&cus, hipDeviceAttributeMultiprocessorCount, dev) != hipSuccess) { grid = -1; return; }
        if (hipFuncSetAttribute((const void*)fwd_kernel, hipFuncAttributeMaxDynamicSharedMemorySize, LDS_BYTES) != hipSuccess) { fprintf(stderr, "kernel_launch: hipFuncSetAttribute failed\n"); grid = -1; return; }
        int per_cu = 0;
        (void)hipOccupancyMaxActiveBlocksPerMultiprocessor(&per_cu, (const void*)fwd_kernel, NWAVES * 64, LDS_BYTES);
        (void)hipGetLastError();
        grid = cus;
    }
    if (grid < 0) return;
    (void)hipMemsetAsync((char*)d_ws + WS_CTL, 0, CTL_ZERO_BYTES, stream);
    Args a{};
    for (int i = 0; i < 19; ++i) a.in[i] = (const float*)d_in[i];
    a.out = (float*)d_out; a.ws = (unsigned char*)d_ws;
#if MK_ONE_LAUNCH
    a.ph_lo = 0; a.ph_hi = N_PHASES;
    hipLaunchKernelGGL(fwd_kernel, dim3(grid), dim3(NWAVES * 64), LDS_BYTES, stream, a);
#ifdef TS_A
    hipLaunchKernelGGL(probe_fin, dim3(1), dim3(256), 0, stream, (unsigned char*)d_ws, (float*)d_out, grid);
#endif
#else
    for (int p = 0; p < N_PHASES; ++p) { a.ph_lo = p; a.ph_hi = p + 1; hipLaunchKernelGGL(fwd_kernel, dim3(grid), dim3(NWAVES * 64), LDS_BYTES, stream, a); }
#endif
}
```

```cpp
#include <hip/hip_runtime.h>
#include <cstdio>
#include <cstdint>

#ifndef MK_ONE_LAUNCH
#define MK_ONE_LAUNCH 1
#endif
#ifndef REP_MASK
#define REP_MASK 0
#endif
#define NREP(k) (((REP_MASK >> (k)) & 1) ? 2 : 1)
#ifdef TS_A
#define STAMP(j) do { if (threadIdx.x == 0) ((unsigned long long*)(args.ws + 768 * 1024))[blockIdx.x * 16 + (j)] = __builtin_amdgcn_s_memrealtime(); } while (0)
#else
#define STAMP(j) do { } while (0)
#endif

namespace pg8 {
#define PG8_LAS __attribute__((address_space(3)))
typedef unsigned short bf16_t;
typedef short bf16x8 __attribute__((ext_vector_type(8)));
typedef float f32x4 __attribute__((ext_vector_type(4)));
typedef unsigned u32x4 __attribute__((ext_vector_type(4)));
constexpr int BM = 256, BK = 64, HALF = 128, HTB = HALF * BK * 2  , STAGE_BYTES = 8 * HTB, NXCD = 8, WGM = 8;

__host__ __device__ __forceinline__ int lds_byte(int r, int c) { const int st = (r >> 4) * 2 + (c >> 5), rr = r & 15, cc = c & 31, ob = rr * 64 + cc * 2; return st * 1024 + (ob ^ (((ob >> 9) & 1) << 5)); }
__host__ __device__ __forceinline__ void stage_rc(int b, int& R, int& C) { const int st = b / 1024, sb = b % 1024, swz = sb ^ (((sb >> 9) & 1) << 5); R = (st >> 1) * 16 + swz / 64; C = (st & 1) * 32 + (swz % 64) / 2; }
__host__ __device__ __forceinline__ int perm32(int rho) { const int n = rho >> 4, i = rho & 15; return 8 * (i >> 2) + 4 * n + (i & 3); }

struct Unit { int pm, pn, seg; };
struct Gemm { const bf16_t* A0; const bf16_t* B0; const bf16_t* A1; const bf16_t* B1; int M, N, K; };

struct StaticOrder {
    int nM, nN, nwg, G, c, nseg;
    __host__ __device__ void init(int M, int N, int G_, int c_, int nseg_) { nM = M / BM; nN = N / BM; nwg = nM * nN; G = G_; c = c_; nseg = nseg_; }
    __host__ __device__ bool next(int i, Unit& u) const {
        const int ti = (nseg == 2) ? (i >> 1) : i; u.seg = (nseg == 2) ? (i & 1) : 0;
        const long L = (long)ti * G + c; if (L >= nwg) return false;
        int wgid = (int)L; { const int q = nwg / NXCD, r = nwg % NXCD, xcd = wgid % NXCD, off = wgid / NXCD; wgid = (xcd < r ? xcd * (q + 1) : r * (q + 1) + (xcd - r) * q) + off; }
        const int nig = WGM * nN, gid = wgid / nig, fm = gid * WGM, gsz = (nM - fm) < WGM ? (nM - fm) : WGM;
        u.pm = fm + ((wgid % nig) % gsz); u.pn = (wgid % nig) / gsz; return true;
    }
};

struct DfOrder {
    StaticOrder P; int nNs, cs, nseg;
    __host__ __device__ void init(int Mp, int N, int G, int c, int shift, int nseg_) { P.init(Mp, N, G, c, 1); nNs = N / BM; cs = (c + G - shift % G) % G; nseg = nseg_; }
    __host__ __device__ bool next(int i, Unit& u) const {
        int ti = (nseg == 2) ? (i >> 1) : i; u.seg = (nseg == 2) ? (i & 1) : 0;
        if (cs < nNs) { if (ti == 1) { u.pm = P.nM; u.pn = cs; return true; } if (ti > 1) --ti; }
        Unit t; if (!P.next(ti, t)) return false; u.pm = t.pm; u.pn = t.pn; return true;
    }
};
struct DynOrder {
    unsigned* q8; int nMp, nN, xcd, nseg; PG8_LAS int* box; unsigned tk;
    __device__ __forceinline__ void init(unsigned* q8_, int Mp, int N, int nseg_, PG8_LAS int* box_) { xcd = (int)(__builtin_amdgcn_s_getreg((3 << 11) | 20) & 7u); q8 = q8_; nMp = Mp / BM; nN = N / BM; nseg = nseg_; box = box_; tk = 0u; }
    __device__ __forceinline__ unsigned draw(int cls) const { return __hip_atomic_fetch_add(q8 + 64 * cls, 1u, __ATOMIC_RELAXED, __HIP_MEMORY_SCOPE_AGENT); }
    __device__ __forceinline__ bool map(int cls, unsigned t, int& pm, int& pn) const {
        const int ns = (nN - cls + 7) >> 3, q = nMp * nN / NXCD, ti = (int)t;
        if (ti < ns) { pm = nMp; pn = cls + 8 * ti; return true; }
        if (ti - ns < q) { const int wgid = cls * q + (ti - ns), nig = WGM * nN, gid = wgid / nig, fm = gid * WGM, gsz = (nMp - fm) < WGM ? (nMp - fm) : WGM; pm = fm + ((wgid % nig) % gsz); pn = (wgid % nig) / gsz; return true; }
        return false;
    }
    __device__ __forceinline__ void put(int slot, unsigned t, int seg) const {
        int pm = 0, pn = 0; bool valid = map(xcd, t, pm, pn);
        for (int k = 1; k < NXCD && !valid; ++k) { const int cls = (xcd + k) & 7; valid = map(cls, draw(cls), pm, pn); }
        box[4 * slot + 0] = pm; box[4 * slot + 1] = pn; box[4 * slot + 2] = seg; box[4 * slot + 3] = valid ? 1 : 0;
    }
    __device__ __forceinline__ bool get(int slot, Unit& u) const { u.pm = box[4 * slot]; u.pn = box[4 * slot + 1]; u.seg = box[4 * slot + 2]; return box[4 * slot + 3] != 0; }
    __device__ __forceinline__ bool first(Unit& u) {
        __syncthreads();
        if (threadIdx.x == 0) {
            put(0, draw(xcd), 0);
            if (nseg == 2) { box[4] = box[0]; box[5] = box[1]; box[6] = 1; box[7] = box[3]; } else put(1, draw(xcd), 0);
        }
        __syncthreads();
        return get(0, u);
    }
    __device__ __forceinline__ bool peek_next(int ui, Unit& u) const { return get((ui + 1) & 1, u); }
    __device__ __forceinline__ void pull(int ui, int wid) {
        if (wid == 0 && (threadIdx.x & 63) == 0 && (nseg == 1 || (ui & 1) == 0)) tk = draw(xcd);
    }
    __device__ __forceinline__ void commit(int ui, int wid) {
        if (wid == 0 && (threadIdx.x & 63) == 0) {
            if (nseg == 1 || (ui & 1) == 0) put(ui & 1, tk, 0);
            else { const int o = (ui + 1) & 1, d = ui & 1; box[4 * d] = box[4 * o]; box[4 * d + 1] = box[4 * o + 1]; box[4 * d + 2] = 1; box[4 * d + 3] = box[4 * o + 3]; }
        }
    }
};
struct Dep {
    unsigned* wait_cnt; unsigned need;
    unsigned* wait_tot; unsigned need_tot;
    unsigned* guard; unsigned need_guard;
    unsigned* done_cnt; unsigned* done_tot;
    unsigned* tmo;
};
#define PG8_SPIN_CAP (1u << 16)
__device__ __forceinline__ void dep_wait(const Dep& D, int pm, int wid, int& flags) {
    if (D.wait_cnt == nullptr) return;
    if (wid == 0 && (flags & 1) == 0) {
        unsigned spins = 0;
        for (;;) {
            const unsigned c0 = __hip_atomic_load(D.wait_cnt + 64 * pm, __ATOMIC_RELAXED, __HIP_MEMORY_SCOPE_AGENT);
            const unsigned t0 = __hip_atomic_load(D.wait_tot, __ATOMIC_RELAXED, __HIP_MEMORY_SCOPE_AGENT);
            const unsigned g0 = (D.guard != nullptr && (flags & 2) == 0) ? __hip_atomic_load(D.guard, __ATOMIC_RELAXED, __HIP_MEMORY_SCOPE_AGENT) : D.need_guard;
            const unsigned c = (unsigned)__builtin_amdgcn_readfirstlane(c0), t = (unsigned)__builtin_amdgcn_readfirstlane(t0), gg = (unsigned)__builtin_amdgcn_readfirstlane(g0);
            if (gg >= D.need_guard) flags |= 2;
            if (t >= D.need_tot && (flags & 2)) { flags |= 1; break; }
            if (c >= D.need && (flags & 2)) break;
            if (++spins > PG8_SPIN_CAP || ((spins & 63u) == 0u && __builtin_amdgcn_readfirstlane(__hip_atomic_load(D.tmo, __ATOMIC_RELAXED, __HIP_MEMORY_SCOPE_AGENT)) != 0u)) { if ((threadIdx.x & 63) == 0) __hip_atomic_store(D.tmo, 1u, __ATOMIC_RELAXED, __HIP_MEMORY_SCOPE_AGENT); break; }
            __builtin_amdgcn_s_sleep(4);
        }
    }
    asm volatile("" ::: "memory"); __builtin_amdgcn_s_barrier(); asm volatile("" ::: "memory");
}
__device__ __forceinline__ void dep_done(const Dep& D, int pm, int lane) {
    if (D.done_cnt != nullptr && lane == 0) __hip_atomic_fetch_add(D.done_cnt + 64 * pm, 1u, __ATOMIC_RELAXED, __HIP_MEMORY_SCOPE_AGENT);
}

template <class Epi, class Sched, int AUXA>
__device__ __forceinline__ void gemm_phase(PG8_LAS unsigned char* lds, const Gemm g, Sched& S, const Epi& E, const Dep D) {
    const int tid = threadIdx.x, wid = __builtin_amdgcn_readfirstlane(tid >> 6), lane = tid & 63, wr = wid >> 2, wc = wid & 3, fr = lane & 15, fq = lane >> 4;
    const int K = g.K, nt = K / BK;
    unsigned voffA[2], voffB[2];
#pragma unroll
    for (int i = 0; i < 2; ++i) { int R, C; stage_rc(tid * 16 + i * 8192, R, C); const int Rb = Epi::PERM ? ((R & ~31) + perm32(R & 31)) : R;
        voffA[i] = (unsigned)(R * K + C) * 2u; voffB[i] = (unsigned)(Rb * K + C) * 2u; }
    const size_t kstep = (size_t)(BK * 2);
    const size_t hstep = (size_t)HALF * K * 2;
    const size_t tstep = 2 * hstep;
    const unsigned ldsw = (unsigned)wid * 1024u;
    const int aoff = lds_byte(wr * 64 + fr, fq * 8), boff = lds_byte(wc * 32 + fr, fq * 8);
#define PG8_SA(b, h) (((b) * 2 + (h)) * HTB)
#define PG8_SB(b, h) ((4 + (b) * 2 + (h)) * HTB)
#define PG8_STAGE(bufoff, gbase, voff) do { _Pragma("unroll") for (int _i = 0; _i < 2; ++_i) \
        __builtin_amdgcn_global_load_lds((const unsigned*)((const char*)(gbase) + (voff)[_i]), (PG8_LAS unsigned*)(lds + (bufoff) + ldsw + _i * 8192), 16, 0, 0); } while (0)
#define PG8_STAGEA(bufoff, gbase, voff) do { _Pragma("unroll") for (int _i = 0; _i < 2; ++_i) \
        __builtin_amdgcn_global_load_lds((const unsigned*)((const char*)(gbase) + (voff)[_i]), (PG8_LAS unsigned*)(lds + (bufoff) + ldsw + _i * 8192), 16, 0, AUXA); } while (0)
#define PG8_LDA(dst, b, h) do { _Pragma("unroll") for (int m = 0; m < 4; ++m) _Pragma("unroll") for (int k = 0; k < 2; ++k) dst[m][k] = *(const PG8_LAS bf16x8*)(lds + PG8_SA(b, h) + aoff + m * 2048 + k * 1024); } while (0)
#define PG8_LDB(dst, b, h) do { _Pragma("unroll") for (int n = 0; n < 2; ++n) _Pragma("unroll") for (int k = 0; k < 2; ++k) dst[n][k] = *(const PG8_LAS bf16x8*)(lds + PG8_SB(b, h) + boff + n * 2048 + k * 1024); } while (0)
#define PG8_MMA(ai, bj, At, Bt) do { __builtin_amdgcn_s_setprio(1); _Pragma("unroll") for (int m = 0; m < 4; ++m) _Pragma("unroll") for (int n = 0; n < 2; ++n) _Pragma("unroll") for (int k = 0; k < 2; ++k) \
        acc[ai][bj][m][n] = __builtin_amdgcn_mfma_f32_16x16x32_bf16(Bt[n][k], At[m][k], acc[ai][bj][m][n], 0, 0, 0); __builtin_amdgcn_s_setprio(0); } while (0)
#define PG8_WAIT_V(n) asm volatile("s_waitcnt vmcnt(" #n ")" ::: "memory")
#define PG8_WAIT_L(n) asm volatile("s_waitcnt lgkmcnt(" #n ")" ::: "memory")
#define PG8_BAR __builtin_amdgcn_s_barrier()
#define PG8_SCHED __builtin_amdgcn_sched_barrier(0)
    Unit cur, nxt; int ui = 0;
    if (!S.first(cur)) { if (D.done_tot != nullptr && tid == 0) __hip_atomic_fetch_add(D.done_tot, 1u, __ATOMIC_RELAXED, __HIP_MEMORY_SCOPE_AGENT); return; }
    f32x4 acc[2][2][4][2];
#pragma unroll
    for (int a = 0; a < 2; ++a)
#pragma unroll
        for (int b = 0; b < 2; ++b)
#pragma unroll
            for (int m = 0; m < 4; ++m)
#pragma unroll
                for (int n = 0; n < 2; ++n) acc[a][b][m][n] = (f32x4){0.f, 0.f, 0.f, 0.f};
    bf16x8 At[4][2], B0[2][2], B1[2][2];
    const char* cA = (const char*)(cur.seg ? g.A1 : g.A0) + (size_t)cur.pm * tstep; const char* cB = (const char*)(cur.seg ? g.B1 : g.B0) + (size_t)cur.pn * tstep;
    int dflags = 0, pend = -1;
    dep_wait(D, cur.pm, wid, dflags);
    PG8_STAGE(PG8_SB(0, 0), cB, voffB); PG8_STAGE(PG8_SB(0, 1), cB + hstep, voffB); PG8_STAGEA(PG8_SA(0, 0), cA, voffA); PG8_STAGEA(PG8_SA(0, 1), cA + hstep, voffA);
    if (wr == 1) PG8_BAR;
    PG8_WAIT_V(2); PG8_BAR;
    PG8_STAGE(PG8_SB(1, 0), cB + kstep, voffB); PG8_STAGEA(PG8_SA(1, 0), cA + kstep, voffA); PG8_STAGE(PG8_SB(1, 1), cB + hstep + kstep, voffB);
    PG8_WAIT_V(6); PG8_BAR;
    for (;;) {
        bool has_next = false; const char* nA = cA; const char* nB = cB;
#define PG8_TRIP(a1, a2, b2, a3, b3) do { asm volatile("" : "+v"(voffA[0]), "+v"(voffA[1]), "+v"(voffB[0]), "+v"(voffB[1])); \
            PG8_LDB(B0, 0, 0); PG8_LDB(B1, 0, 1); PG8_SCHED; PG8_LDA(At, 0, 0); PG8_STAGEA(PG8_SA(1, 1), (a1) + hstep, voffA); \
            PG8_WAIT_V(8); PG8_WAIT_L(0); PG8_BAR; PG8_MMA(0, 0, At, B0); PG8_MMA(0, 1, At, B1); PG8_BAR; PG8_SCHED; \
            PG8_LDA(At, 0, 1); PG8_STAGE(PG8_SB(0, 0), (b2), voffB); PG8_STAGE(PG8_SB(0, 1), (b2) + hstep, voffB); PG8_STAGEA(PG8_SA(0, 0), (a2), voffA); \
            PG8_WAIT_V(8); PG8_WAIT_L(0); PG8_BAR; PG8_MMA(1, 0, At, B0); PG8_MMA(1, 1, At, B1); PG8_BAR; PG8_SCHED; \
            PG8_LDB(B0, 1, 0); PG8_LDB(B1, 1, 1); PG8_SCHED; PG8_LDA(At, 1, 0); PG8_STAGEA(PG8_SA(0, 1), (a2) + hstep, voffA); \
            PG8_WAIT_V(8); PG8_WAIT_L(0); PG8_BAR; PG8_MMA(0, 0, At, B0); PG8_MMA(0, 1, At, B1); PG8_BAR; PG8_SCHED; \
            PG8_LDA(At, 1, 1); PG8_STAGE(PG8_SB(1, 0), (b3), voffB); PG8_STAGE(PG8_SB(1, 1), (b3) + hstep, voffB); PG8_STAGEA(PG8_SA(1, 0), (a3), voffA); \
            PG8_WAIT_V(8); PG8_WAIT_L(0); PG8_BAR; PG8_MMA(1, 0, At, B0); PG8_MMA(1, 1, At, B1); PG8_BAR; PG8_SCHED; } while (0)
        {
            const char* a1 = cA + kstep; const char* a2 = cA + 2 * kstep; const char* b2 = cB + 2 * kstep; const char* a3 = a2 + kstep; const char* b3 = b2 + kstep;
            PG8_TRIP(a1, a2, b2, a3, b3);
            if (pend >= 0) { dep_done(D, pend, lane); pend = -1; }
        }
        for (int t = 2; t < nt - 2; t += 2) {
            const char* a1 = cA + (size_t)(t + 1) * kstep; const char* a2 = cA + (size_t)(t + 2) * kstep; const char* b2 = cB + (size_t)(t + 2) * kstep; const char* a3 = a2 + kstep; const char* b3 = b2 + kstep;
            PG8_TRIP(a1, a2, b2, a3, b3);
        }
        {
            has_next = S.peek_next(ui, nxt);
            if (has_next) { nA = (const char*)(nxt.seg ? g.A1 : g.A0) + (size_t)nxt.pm * tstep; nB = (const char*)(nxt.seg ? g.B1 : g.B0) + (size_t)nxt.pn * tstep; dep_wait(D, nxt.pm, wid, dflags); }
            const char* a1 = cA + (size_t)(nt - 1) * kstep; const char* a2 = nA; const char* b2 = nB; const char* a3 = a2 + kstep; const char* b3 = b2 + kstep;
            PG8_TRIP(a1, a2, b2, a3, b3);
        }
#undef PG8_TRIP
        if (wr == 0) PG8_BAR;
        S.pull(ui, wid);
        const bool keep = E(acc, cur, wr, wc, fr, fq);
        S.commit(ui, wid);
        if (!keep) pend = cur.pm;
        if (!has_next) break;
        if (!keep) {
#pragma unroll
        for (int a = 0; a < 2; ++a)
#pragma unroll
            for (int b = 0; b < 2; ++b)
#pragma unroll
                for (int m = 0; m < 4; ++m)
#pragma unroll
                    for (int n = 0; n < 2; ++n) acc[a][b][m][n] = (f32x4){0.f, 0.f, 0.f, 0.f};
        }
        cur = nxt; cA = nA; cB = nB; ++ui;
        if (wr == 1) PG8_BAR;
    }
    PG8_WAIT_V(0);
    if (pend >= 0) dep_done(D, pend, lane);
    PG8_BAR;
    if (D.done_tot != nullptr && tid == 0) __hip_atomic_fetch_add(D.done_tot, 1u, __ATOMIC_RELAXED, __HIP_MEMORY_SCOPE_AGENT);
#undef PG8_STAGEA
#undef PG8_SA
#undef PG8_SB
#undef PG8_STAGE
#undef PG8_LDA
#undef PG8_LDB
#undef PG8_MMA
#undef PG8_WAIT_V
#undef PG8_WAIT_L
#undef PG8_BAR
#undef PG8_SCHED
}
}

constexpr int DM = 1024, NB = 16, SEQ = 4096, DECS = 16, NKV = 4, HD = 64, KVW = 256, INW = 5632, DFF = 2816;
constexpr int MP = NB * SEQ, MS = NB * DECS, MT = MP + MS;
constexpr float EPS = 1e-6f, LOG2E = 1.4426950408889634f, QSCALE = 0.125f * LOG2E;
constexpr size_t O_YP = 0, O_YS = (size_t)MP * DM, O_KP = O_YS + (size_t)MS * DM, O_VP = O_KP + 524288, O_KS = O_VP + 524288, O_VS = O_KS + 524288, O_GS = O_VS + 524288, O_END = O_GS + (size_t)MS * DM;

constexpr size_t MiB = 1u << 20;
constexpr size_t WS_CTL = 0, CTL_ZERO_BYTES = 1 * MiB;
constexpr size_t WS_WIN = 1 * MiB, WS_WFI = 12 * MiB, WS_WA = 23 * MiB, WS_WG = 25 * MiB, WS_WO = 27 * MiB, WS_WFO = 29 * MiB;
constexpr size_t WS_WSB = 34 * MiB + 768 * 1024;
constexpr size_t WS_RSTD1 = 35 * MiB, WS_RSTD2 = 36 * MiB, WS_PMIX = 37 * MiB, WS_PF = 42 * MiB;
constexpr size_t ACTB = (size_t)MT * DM * 2;
constexpr size_t WS_R0 = 48 * MiB;
constexpr size_t WS_R1 = 177 * MiB;
constexpr size_t WS_R2 = 306 * MiB;
constexpr size_t WS_KB = 435 * MiB, WS_VB = 468 * MiB;
constexpr size_t WS_R3 = 501 * MiB;
constexpr size_t WS_SA = WS_R3, WS_SB = WS_R3 + ACTB, WS_U = WS_R3 + 2 * ACTB, WS_AO = WS_R3 + 3 * ACTB, WS_END = WS_AO + ACTB;
static_assert(WS_END <= 1024 * MiB && (size_t)MT * DFF * 2 <= 3 * ACTB && WS_R0 + ACTB <= WS_R1 && WS_R1 + ACTB <= WS_R2 && WS_R2 + ACTB <= WS_KB, "d_ws map");
constexpr int CW_BAR = 4096, CW_TMO = 64;
constexpr int CW_CNT = 16384;
constexpr int CW_TOT = CW_CNT + 5 * 264 * 64;
constexpr int CW_C0 = CW_TOT + 8 * 64;
constexpr int CW_Q = CW_C0 + 264 * 64;
constexpr int CW_C1 = CW_Q + 9 * 8 * 64, CW_C2 = CW_C1 + 264 * 64, CW_CS = CW_C2 + 264 * 64;
static_assert((CW_CS + 64) * 4 <= 768 * 1024, "CTL words inside the memset region, below the probe stamps");

constexpr int RING_BYTES = 131072, LDS_BYTES = 147456, LDSCTL_OFF = LDS_BYTES - 512, MISC_OFF = LDSCTL_OFF + 320;
constexpr int NWAVES = 8, BOX_OFF = LDSCTL_OFF + 64;

#define GAS __attribute__((address_space(1)))
#define LAS __attribute__((address_space(3)))
typedef unsigned short bf16;
typedef unsigned v4u __attribute__((ext_vector_type(4)));
typedef unsigned v2u __attribute__((ext_vector_type(2)));
typedef float f32x4 __attribute__((ext_vector_type(4)));
typedef GAS unsigned gu32;
#define RLX_AGENT __ATOMIC_RELAXED, __HIP_MEMORY_SCOPE_AGENT
#define LDS_WAIT() asm volatile("s_waitcnt lgkmcnt(0)" ::: "memory")
typedef float f32x2_t __attribute__((ext_vector_type(2))); typedef __bf16 bf16x2_t __attribute__((ext_vector_type(2)));
__device__ __forceinline__ unsigned pk2(float lo, float hi) { f32x2_t v = {lo, hi}; bf16x2_t b = __builtin_convertvector(v, bf16x2_t); return __builtin_bit_cast(unsigned, b); }
__device__ __forceinline__ float bflo(unsigned w) { return __uint_as_float(w << 16); }
__device__ __forceinline__ float bfhi(unsigned w) { return __uint_as_float(w & 0xffff0000u); }
__device__ __forceinline__ float wave_sum(float v) {
#pragma unroll
    for (int o = 1; o < 64; o <<= 1) v += __shfl_xor(v, o);
    return v;
}
__device__ __forceinline__ float gelu_tanh(float x) {
    const float e = __builtin_amdgcn_exp2f(x * (-2.302208198f - 0.10294324f * x * x));
    return x * __builtin_amdgcn_rcpf(1.0f + e);
}
__device__ __forceinline__ float sigmoidf_(float x) { return __builtin_amdgcn_rcpf(1.0f + __builtin_amdgcn_exp2f(-LOG2E * x)); }

#define XB_TMO      128
#define XB_XCNT(j)  (256  + 64 * (j))
#define XB_XSUB(j)  (1280 + 64 * (j))
#define XB_XGEN(j)  (2304 + 64 * (j))
#define XB_TOP      3328
#define XB_TOPGEN   3392
#define XCD_BAR_WORDS 3456
#define XB_SPIN_CAP (1u << 18)
__device__ __forceinline__ unsigned xb_ld(unsigned* p)              { return __hip_atomic_load(p, __ATOMIC_RELAXED, __HIP_MEMORY_SCOPE_AGENT); }
__device__ __forceinline__ unsigned xb_add(unsigned* p, unsigned v) { return __hip_atomic_fetch_add(p, v, __ATOMIC_RELAXED, __HIP_MEMORY_SCOPE_AGENT); }
__device__ __forceinline__ unsigned xb_xcc_id() { return (unsigned)__builtin_amdgcn_s_getreg((3 << 11) | 20) & 0xFu; }
#define XB_SPIN(cond, bar) do { unsigned _sp = 0; while (cond) { __builtin_amdgcn_s_sleep(1); \
    if ((++_sp & 255u) == 0u) { if (xb_ld(&(bar)[XB_TMO])) break; if (_sp > XB_SPIN_CAP) { atomicAdd(&(bar)[XB_TMO], 1u); break; } } } } while (0)
struct XcdBarrier { unsigned* bar; unsigned x; volatile LAS unsigned* st; };
__device__ __forceinline__ XcdBarrier xcd_barrier_post(unsigned* bar, volatile LAS unsigned* st) {
    XcdBarrier b; b.bar = bar; b.x = xb_xcc_id(); b.st = st;
    if (threadIdx.x == 0) (void)xb_add(&bar[XB_XCNT(b.x)], 1u);
    return b;
}
__device__ __forceinline__ void xcd_barrier_complete(unsigned* bar, unsigned x, unsigned& nloc, unsigned& nx) {
    const unsigned G = gridDim.x * gridDim.y * gridDim.z;
    unsigned sum, cnt, mine, sp = 0u;
    for (;;) {
        sum = 0u; cnt = 0u; mine = 0u;
#pragma unroll
        for (unsigned j = 0; j < 16; ++j) { const unsigned c = xb_ld(&bar[XB_XCNT(j)]); sum += c; cnt += (c > 0u) ? 1u : 0u; mine = (j == x) ? c : mine; }
        if (sum == G) break;
        __builtin_amdgcn_s_sleep(1);
        if ((++sp & 255u) == 0u) { if (xb_ld(&bar[XB_TMO])) break; if (sp > XB_SPIN_CAP) { atomicAdd(&bar[XB_TMO], 1u); break; } }
    }
    nloc = mine > 0u ? mine : 1u; nx = cnt > 0u ? cnt : 1u;
}
__device__ __forceinline__ void xcd_barrier(const XcdBarrier& b) {
    asm volatile("s_waitcnt vmcnt(0)" ::: "memory");
    __syncthreads();
    if (threadIdx.x == 0) {
        unsigned* bar = b.bar;
        __builtin_amdgcn_s_waitcnt(0);
        unsigned nloc = b.st[0], nx = b.st[1];
        if (nloc == 0u) { xcd_barrier_complete(bar, b.x, nloc, nx); b.st[0] = nloc; b.st[1] = nx; }
        const unsigned old = xb_add(&bar[XB_XSUB(b.x)], 1u);
        const unsigned gen = old / nloc;
        if (old + 1u == (gen + 1u) * nloc) {
            __builtin_amdgcn_fence(__ATOMIC_RELEASE, "agent");
            asm volatile("s_waitcnt vmcnt(0)" ::: "memory");
            const unsigned og = xb_add(&bar[XB_TOP], 1u);
            const unsigned tg = og / nx;
            if (og + 1u == (tg + 1u) * nx) xb_add(&bar[XB_TOPGEN], 1u);
            else XB_SPIN(xb_ld(&bar[XB_TOPGEN]) == tg, bar);
            __builtin_amdgcn_fence(__ATOMIC_ACQUIRE, "agent");
            xb_add(&bar[XB_XGEN(b.x)], 1u);
            asm volatile("s_waitcnt vmcnt(0)" ::: "memory");
        } else {
            XB_SPIN(xb_ld(&bar[XB_XGEN(b.x)]) == gen, bar);
            __builtin_amdgcn_fence(__ATOMIC_ACQUIRE, "agent");
            asm volatile("s_waitcnt vmcnt(0)" ::: "memory");
        }
    }
    __syncthreads();
}

typedef __amdgpu_buffer_rsrc_t rsrc_t;
__device__ __forceinline__ rsrc_t mk_rsrc(const void* p) { return __builtin_amdgcn_make_buffer_rsrc((void*)p, 0, 0x7fffffff, 0x00020000); }
__device__ __forceinline__ void st16_wt(rsrc_t r, size_t byte_off, v4u v) { __builtin_amdgcn_raw_buffer_store_b128(v, r, (int)byte_off, 0, 16); }
__device__ __forceinline__ v4u ld16_nc(rsrc_t r, size_t byte_off) { return __builtin_amdgcn_raw_buffer_load_b128(r, (int)byte_off, 0, 16); }
__device__ __forceinline__ void stf_wt(float* p, float v) { __hip_atomic_store((unsigned*)p, __float_as_uint(v), __ATOMIC_RELAXED, __HIP_MEMORY_SCOPE_AGENT); }
__device__ __forceinline__ float ldf_nc(const float* p) { return __uint_as_float(__hip_atomic_load((const unsigned*)p, __ATOMIC_RELAXED, __HIP_MEMORY_SCOPE_AGENT)); }

using pg8::Unit;
struct EpiIn {
    static constexpr bool PERM = true;
    const float* rstd; bf16 *Q, *Kb, *Vb, *U, *GV, *SA, *SB; float* out; float *PG1, *PG2;
    __device__ __forceinline__ bool operator()(f32x4 (&acc)[2][2][4][2], const Unit& u, int wr, int wc, int fr, int fq) const {
        const int pn = u.pn; int mode, ld, colt; bf16* dst; float* side = nullptr; size_t side_s = 0;
        if (pn < 4)       { mode = 0; dst = Q;  ld = DM;  colt = pn * 256; }
        else if (pn == 4) { mode = 1; dst = Kb; ld = KVW; colt = 0; side = out + O_KP; side_s = O_KS - O_KP; }
        else if (pn == 5) { mode = 1; dst = Vb; ld = KVW; colt = 0; side = out + O_VP; side_s = O_VS - O_VP; }
        else if (pn < 10) { mode = 2; dst = U;  ld = DM;  colt = (pn - 6) * 256; }
        else if (pn < 14) { mode = 2; dst = GV; ld = DM;  colt = (pn - 10) * 256; }
        else if (pn < 18) { mode = 3; dst = SA; ld = DM;  colt = (pn - 14) * 256; }
        else              { mode = 3; dst = SB; ld = DM;  colt = (pn - 18) * 256; }
        const int row0 = u.pm * 256 + wr * 64 + fr, col0 = colt + wc * 32 + 8 * fq; const rsrc_t rdst = mk_rsrc(dst);
        float rsv[2][4];
#pragma unroll
        for (int ai = 0; ai < 2; ++ai)
#pragma unroll
            for (int m = 0; m < 4; ++m) rsv[ai][m] = rstd[row0 + ai * 128 + m * 16];
#pragma unroll
        for (int ai = 0; ai < 2; ++ai)
#pragma unroll
            for (int m = 0; m < 4; ++m) {
                const int row = row0 + ai * 128 + m * 16; const float rs = rsv[ai][m]; float s1 = 0.f, s2 = 0.f;
#pragma unroll
                for (int bj = 0; bj < 2; ++bj) {
                    float v[8];
#pragma unroll
                    for (int j = 0; j < 4; ++j) { v[j] = acc[ai][bj][m][0][j] * rs; v[4 + j] = acc[ai][bj][m][1][j] * rs; }
                    if (mode == 0) {
#pragma unroll
                        for (int j = 0; j < 8; ++j) v[j] *= QSCALE;
                    } else if (mode == 2) {
#pragma unroll
                        for (int j = 0; j < 8; ++j) { v[j] = gelu_tanh(v[j]); s1 += v[j]; s2 += v[j] * v[j]; }
                    } else if (mode == 3) {
#pragma unroll
                        for (int j = 0; j < 8; ++j) v[j] = sigmoidf_(v[j]);
                    }
                    const int col = col0 + bj * 128;
                    v4u w; w.x = pk2(v[0], v[1]); w.y = pk2(v[2], v[3]); w.z = pk2(v[4], v[5]); w.w = pk2(v[6], v[7]);
                    st16_wt(rdst, ((size_t)row * ld + col) * 2, w);
                    if (mode == 1) {
                        float* sp = nullptr;
                        if (u.pm == 256) { const int r = row - MP; sp = side + side_s + ((size_t)((r >> 4) * 128 + 112 + (r & 15)) * KVW + col); }
                        else if ((u.pm & 15) == 15 && ai == 1) { const int j = wr * 64 + m * 16 + fr; sp = side + ((size_t)((u.pm >> 4) * 128 + j) * KVW + col); }
                        if (sp) { *(f32x4*)sp = (f32x4){v[0], v[1], v[2], v[3]}; *(f32x4*)(sp + 4) = (f32x4){v[4], v[5], v[6], v[7]}; }
                    }
                }
                if (pn >= 10 && pn < 14) {
                    s1 += __shfl_xor(s1, 16); s1 += __shfl_xor(s1, 32); s2 += __shfl_xor(s2, 16); s2 += __shfl_xor(s2, 32);
                    if (fq == 0) { const size_t si = (size_t)((pn - 10) * 4 + wc) * MT + row; stf_wt(PG1 + si, s1); stf_wt(PG2 + si, s2); }
                }
            }
        return false;
    }
};
struct EpiMerge {
    static constexpr bool PERM = true;
    const bf16 *SA, *SB; bf16* O;
    __device__ __forceinline__ bool operator()(f32x4 (&acc)[2][2][4][2], const Unit& u, int wr, int wc, int fr, int fq) const {
        const int row0 = u.pm * 256 + wr * 64 + fr, col0 = u.pn * 256 + wc * 32 + 8 * fq; const rsrc_t ro = mk_rsrc(O);
        if (u.seg == 0) {
#pragma unroll
            for (int ai = 0; ai < 2; ++ai) {
                v4u sbw[4][2], saw[4][2];
#pragma unroll
                for (int m = 0; m < 4; ++m)
#pragma unroll
                    for (int bj = 0; bj < 2; ++bj) { const size_t off = (size_t)(row0 + ai * 128 + m * 16) * DM + col0 + bj * 128; sbw[m][bj] = *(const v4u*)(SB + off); saw[m][bj] = *(const v4u*)(SA + off); }
#pragma unroll
                for (int m = 0; m < 4; ++m)
#pragma unroll
                    for (int bj = 0; bj < 2; ++bj) { const v4u b = sbw[m][bj], a = saw[m][bj];
                        const float sb[8] = {bflo(b.x), bfhi(b.x), bflo(b.y), bfhi(b.y), bflo(b.z), bfhi(b.z), bflo(b.w), bfhi(b.w)}, sa[8] = {bflo(a.x), bfhi(a.x), bflo(a.y), bfhi(a.y), bflo(a.z), bfhi(a.z), bflo(a.w), bfhi(a.w)};
#pragma unroll
                        for (int j = 0; j < 4; ++j) { acc[ai][bj][m][0][j] *= sa[j] * __builtin_amdgcn_rcpf(fmaxf(sb[j], 1e-30f)); acc[ai][bj][m][1][j] *= sa[4 + j] * __builtin_amdgcn_rcpf(fmaxf(sb[4 + j], 1e-30f)); } }
            }
            return true;
        }
        v4u sbw[2][4][2];
#pragma unroll
        for (int ai = 0; ai < 2; ++ai)
#pragma unroll
            for (int m = 0; m < 4; ++m)
#pragma unroll
                for (int bj = 0; bj < 2; ++bj) sbw[ai][m][bj] = *(const v4u*)(SB + (size_t)(row0 + ai * 128 + m * 16) * DM + col0 + bj * 128);
#pragma unroll
        for (int ai = 0; ai < 2; ++ai)
#pragma unroll
            for (int m = 0; m < 4; ++m)
#pragma unroll
                for (int bj = 0; bj < 2; ++bj) { const size_t off = (size_t)(row0 + ai * 128 + m * 16) * DM + col0 + bj * 128; const v4u b = sbw[ai][m][bj];
                    const float sb[8] = {bflo(b.x), bfhi(b.x), bflo(b.y), bfhi(b.y), bflo(b.z), bfhi(b.z), bflo(b.w), bfhi(b.w)}; float v[8];
#pragma unroll
                    for (int j = 0; j < 4; ++j) { v[j] = acc[ai][bj][m][0][j] * fmaxf(sb[j], 1e-30f); v[4 + j] = acc[ai][bj][m][1][j] * fmaxf(sb[4 + j], 1e-30f); }
                    v4u w; w.x = pk2(v[0], v[1]); w.y = pk2(v[2], v[3]); w.z = pk2(v[4], v[5]); w.w = pk2(v[6], v[7]);
                    st16_wt(ro, off * 2, w); }
        return false;
    }
};
struct EpiBf16Ss {
    static constexpr bool PERM = true;
    bf16* O; float* P;
    __device__ __forceinline__ bool operator()(f32x4 (&acc)[2][2][4][2], const Unit& u, int wr, int wc, int fr, int fq) const {
        const int row0 = u.pm * 256 + wr * 64 + fr, col0 = u.pn * 256 + wc * 32 + 8 * fq; const rsrc_t ro = mk_rsrc(O);
#pragma unroll
        for (int ai = 0; ai < 2; ++ai)
#pragma unroll
            for (int m = 0; m < 4; ++m) {
                const int row = row0 + ai * 128 + m * 16; float ss = 0.f;
#pragma unroll
                for (int bj = 0; bj < 2; ++bj) {
                    const f32x4 a = acc[ai][bj][m][0], b = acc[ai][bj][m][1];
                    ss += (a[0] * a[0] + a[1] * a[1]) + (a[2] * a[2] + a[3] * a[3]) + (b[0] * b[0] + b[1] * b[1]) + (b[2] * b[2] + b[3] * b[3]);
                    v4u w; w.x = pk2(a[0], a[1]); w.y = pk2(a[2], a[3]); w.z = pk2(b[0], b[1]); w.w = pk2(b[2], b[3]);
                    st16_wt(ro, ((size_t)row * DM + col0 + bj * 128) * 2, w);
                }
                ss += __shfl_xor(ss, 16); ss += __shfl_xor(ss, 32);
                if (fq == 0) stf_wt(P + (size_t)(u.pn * 4 + wc) * MT + row, ss);
            }
        return false;
    }
};
struct EpiSwiglu {
    static constexpr bool PERM = true;
    const float* rstd; bf16* O;
    __device__ __forceinline__ bool operator()(f32x4 (&acc)[2][2][4][2], const Unit& u, int wr, int wc, int fr, int fq) const {
        const int row0 = u.pm * 256 + wr * 64 + fr, col0 = u.pn * 128 + wc * 32 + 8 * fq; const rsrc_t ro = mk_rsrc(O);
        float rsv[2][4];
#pragma unroll
        for (int ai = 0; ai < 2; ++ai)
#pragma unroll
            for (int m = 0; m < 4; ++m) rsv[ai][m] = rstd[row0 + ai * 128 + m * 16];
#pragma unroll
        for (int ai = 0; ai < 2; ++ai)
#pragma unroll
            for (int m = 0; m < 4; ++m) {
                const int row = row0 + ai * 128 + m * 16; const float rs = rsv[ai][m]; float v[8];
#pragma unroll
                for (int n = 0; n < 2; ++n)
#pragma unroll
                    for (int j = 0; j < 4; ++j) { const float gg = acc[ai][0][m][n][j] * rs, up = acc[ai][1][m][n][j] * rs; v[4 * n + j] = gg * sigmoidf_(gg) * up; }
                v4u w; w.x = pk2(v[0], v[1]); w.y = pk2(v[2], v[3]); w.z = pk2(v[4], v[5]); w.w = pk2(v[6], v[7]);
                st16_wt(ro, ((size_t)row * DFF + col0) * 2, w);
            }
        return false;
    }
};

template <bool MAP>
__device__ __forceinline__ void p0_transpose_item(const float* W, int K, int N, const float* gain, bf16* WT, LAS float* scr, int item, int lane) {
    const int nblk = N / 32, kb = item / nblk, nb = item % nblk, k0 = 64 * kb, n0 = 32 * nb;
    f32x4 ld[8]; float gk[8];
#pragma unroll
    for (int i = 0; i < 8; ++i) { const int kk = (lane >> 3) + 8 * i; ld[i] = *(const f32x4*)(W + (size_t)(k0 + kk) * N + n0 + (lane & 7) * 4); gk[i] = gain ? gain[k0 + kk] : 1.0f; }
#pragma unroll
    for (int i = 0; i < 8; ++i) { const int kk = (lane >> 3) + 8 * i; LAS float* d = scr + kk * 33 + (lane & 7) * 4; d[0] = ld[i].x * gk[i]; d[1] = ld[i].y * gk[i]; d[2] = ld[i].z * gk[i]; d[3] = ld[i].w * gk[i]; }
    LDS_WAIT(); asm volatile("" ::: "memory");
    const int c = lane & 7;
#pragma unroll
    for (int j = 0; j < 4; ++j) { const int n = (lane >> 3) + 8 * j; const LAS float* s = scr + (8 * c) * 33 + n;
        v4u o; o.x = pk2(s[0 * 33], s[1 * 33]); o.y = pk2(s[2 * 33], s[3 * 33]); o.z = pk2(s[4 * 33], s[5 * 33]); o.w = pk2(s[6 * 33], s[7 * 33]);
        int nn = n0 + n;
        if (MAP) { const int hi = nn >= DFF ? 1 : 0, r = nn - hi * DFF; nn = 256 * (r >> 7) + 128 * hi + (r & 127); }
        *(GAS v4u*)(WT + (size_t)nn * K + k0 + 8 * c) = o; }
    LDS_WAIT(); asm volatile("" ::: "memory");
}

namespace att {
typedef short bf16x8 __attribute__((ext_vector_type(8)));
typedef short s16x4 __attribute__((ext_vector_type(4)));
typedef short v4i16_t __attribute__((ext_vector_type(4)));
typedef float f32x16 __attribute__((ext_vector_type(16)));
typedef LAS const char* lds_cptr;
constexpr int SLOT = 16384, OST = 4 * SLOT;
__device__ __forceinline__ int crow(int r, int hi) { return (r & 3) + 8 * (r >> 2) + 4 * hi; }
__device__ __forceinline__ s16x4 vtr(lds_cptr p) { return __builtin_bit_cast(s16x4, __builtin_amdgcn_ds_read_tr16_b64_v4i16((LAS v4i16_t*)p)); }
struct TileRegs { v4u k, v; };
__device__ __forceinline__ TileRegs load_tile(const bf16* KB, const bf16* VB, size_t rowbase, int kvh, int wid, int lane) {
    TileRegs t;
    t.k = *(const v4u*)(KB + (rowbase + lane) * KVW + kvh * HD + wid * 8);
    t.v = *(const v4u*)(VB + (rowbase + 16 * (wid & 3) + (lane >> 2)) * KVW + kvh * HD + (wid >> 2) * 32 + (lane & 3) * 8);
    return t;
}
__device__ __forceinline__ void store_tile(LAS unsigned char* slot, const TileRegs& t, int wid, int lane) {
    *(LAS v4u*)(slot + wid * 1024 + lane * 16) = t.k;
    *(LAS v4u*)(slot + 8192 + wid * 1024 + lane * 16) = t.v;
}
struct QFrag { bf16x8 q[4]; };
template <bool SAMPLE>
__device__ __forceinline__ QFrag load_q(const bf16* QO, size_t qrow0, int kvh, int wid, int lane) {
    const int r32 = lane & 31, hi = lane >> 5, posb = 32 * (wid & 1), head = kvh * 4 + (wid >> 1);
    const size_t qrow = SAMPLE ? qrow0 + ((posb + r32) & 15) : qrow0 + posb + r32;
    const bf16* qp = QO + qrow * DM + head * HD; QFrag f;
#pragma unroll
    for (int d0 = 0; d0 < 4; ++d0) f.q[d0] = *(const bf16x8*)(qp + d0 * 16 + hi * 8);
    return f;
}
template <bool SAMPLE>
__device__ __forceinline__ void attn_unit(LAS unsigned char* lds, int s0, int s1, int s2, int ft, const QFrag& qf, bf16* AO, size_t qrow0, int kvh, const float sink2, int wid, int lane) {
    const int r32 = lane & 31, hi = lane >> 5, g = wid >> 1, posb = 32 * (wid & 1), head = kvh * 4 + g;
    f32x16 p[6];
#pragma unroll
    for (int ti = 0; ti < 3; ++ti) {
        if (ti >= ft) {
            const int so = (ti == 0) ? s0 : (ti == 1) ? s1 : s2;
            lds_cptr kb = (lds_cptr)lds + so + hi * 1024 + r32 * 16;
            f32x16 a = {}, c = {};
#pragma unroll
            for (int d0 = 0; d0 < 4; ++d0) {
                const bf16x8 b0 = *(const LAS bf16x8*)(kb + d0 * 2048), b1 = *(const LAS bf16x8*)(kb + d0 * 2048 + 512);
                a = __builtin_amdgcn_mfma_f32_32x32x16_bf16(b0, qf.q[d0], a, 0, 0, 0); c = __builtin_amdgcn_mfma_f32_32x32x16_bf16(b1, qf.q[d0], c, 0, 0, 0);
            }
            p[2 * ti] = a; p[2 * ti + 1] = c;
        } else {
#pragma unroll
            for (int r = 0; r < 16; ++r) { p[2 * ti][r] = -INFINITY; p[2 * ti + 1][r] = -INFINITY; }
        }
    }
    if (SAMPLE) {
#pragma unroll
        for (int r = 0; r < 16; ++r) { if (r >= 8) p[4][r] = -INFINITY; p[5][r] = -INFINITY; }
    }
    float mx = sink2;
#pragma unroll
    for (int kb = 0; kb < 6; ++kb)
#pragma unroll
        for (int r = 0; r < 16; ++r) mx = fmaxf(mx, p[kb][r]);
    { auto rr = __builtin_amdgcn_permlane32_swap(__float_as_uint(mx), __float_as_uint(mx), false, false); mx = fmaxf(__uint_as_float(rr[0]), __uint_as_float(rr[1])); }
    float sum = 0.f;
#pragma unroll
    for (int kb = 0; kb < 6; ++kb)
#pragma unroll
        for (int r = 0; r < 16; ++r) { p[kb][r] = __builtin_amdgcn_exp2f(p[kb][r] - mx); sum += p[kb][r]; }
    { auto rr = __builtin_amdgcn_permlane32_swap(__float_as_uint(sum), __float_as_uint(sum), false, false); sum = __uint_as_float(rr[0]) + __uint_as_float(rr[1]); }
    const float inv = 1.0f / (sum + __builtin_amdgcn_exp2f(sink2 - mx));
    f32x16 o0 = {}, o1 = {};
    const int vb = ((lane >> 4) & 1) * 32 + (lane & 3) * 8 + (4 * hi + ((lane & 15) >> 2)) * 64;
#pragma unroll
    for (int ti = 0; ti < 3; ++ti) {
        if (ti >= ft) {
            const int so = (ti == 0) ? s0 : (ti == 1) ? s1 : s2;
            lds_cptr vp = (lds_cptr)lds + so + 8192 + vb;
#pragma unroll
            for (int ks = 0; ks < 4; ++ks) {
                const int kb = 2 * ti + (ks >> 1), rb = 8 * (ks & 1);
                v4u pw; pw.x = pk2(p[kb][rb + 0] * inv, p[kb][rb + 1] * inv); pw.y = pk2(p[kb][rb + 2] * inv, p[kb][rb + 3] * inv); pw.z = pk2(p[kb][rb + 4] * inv, p[kb][rb + 5] * inv); pw.w = pk2(p[kb][rb + 6] * inv, p[kb][rb + 7] * inv);
                const bf16x8 pa = __builtin_bit_cast(bf16x8, pw);
                { const s16x4 lo = vtr(vp + ks * 1024), h4 = vtr(vp + ks * 1024 + 512); const bf16x8 vf = (bf16x8){lo[0], lo[1], lo[2], lo[3], h4[0], h4[1], h4[2], h4[3]};
                  o0 = __builtin_amdgcn_mfma_f32_32x32x16_bf16(pa, vf, o0, 0, 0, 0); }
                { const s16x4 lo = vtr(vp + 4096 + ks * 1024), h4 = vtr(vp + 4096 + ks * 1024 + 512); const bf16x8 vf = (bf16x8){lo[0], lo[1], lo[2], lo[3], h4[0], h4[1], h4[2], h4[3]};
                  o1 = __builtin_amdgcn_mfma_f32_32x32x16_bf16(pa, vf, o1, 0, 0, 0); }
            }
        }
    }
    LAS bf16* stg = (LAS bf16*)(lds + OST + wid * 4096); const rsrc_t rao = mk_rsrc(AO);
#pragma unroll
    for (int r = 0; r < 16; ++r) { const int orow = crow(r, hi); stg[orow * 64 + r32] = (bf16)(pk2(o0[r], 0.f) & 0xffffu); stg[orow * 64 + 32 + r32] = (bf16)(pk2(o1[r], 0.f) & 0xffffu); }
    LDS_WAIT();
#pragma unroll
    for (int i = 0; i < 4; ++i) { const int row = i * 8 + (lane >> 3), ch = lane & 7; const v4u v = *(const LAS v4u*)(stg + row * 64 + ch * 8);
        if (!SAMPLE || posb + row < 16) st16_wt(rao, ((qrow0 + posb + row) * DM + head * HD + ch * 8) * 2, v); }
    LDS_WAIT();
}
}

namespace gat {
using att::bf16x8; using att::s16x4; using att::f32x16; using att::lds_cptr; using att::vtr; using att::crow;
constexpr int G_LN = 1024, G_IMG = 9216, G_STG = G_IMG + 65536;
template <bool SAMPLE, int PP>
__device__ __forceinline__ void gate_group(LAS unsigned char* lds, int g, v4u (&raw)[8], const bf16* GV, const bf16* UB, bf16* BMO, const bf16* WSB, const float* b_s, float* gs_out, size_t row0, int tid, int wave, int lane) {
    constexpr int L = SAMPLE ? 16 : 128;
    asm volatile("" : "+v"(tid)); lane = tid & 63;
    constexpr int TB0 = PP, TB1 = 3 - PP, NK0 = 2 * (TB0 + 1), NK1 = 2 * (TB1 + 1);
    LAS float* stats = (LAS float*)lds; LAS float* lnp = (LAS float*)(lds + G_LN); LAS unsigned char* img = lds + G_IMG;
    const int r32 = lane & 31, hi = lane >> 5, cq = wave >> 1;
    const int vb = ((lane >> 4) & 1) * 32 + (lane & 3) * 8 + (4 * hi + ((lane & 15) >> 2)) * 64;
    const int sr = tid >> 5, sc = (tid & 31) * 8;
    bf16x8 af0[NK0], af1[NK1];
    { const bf16* w0 = WSB + ((size_t)(g * 128 + 32 * TB0 + r32) * 128 + hi * 8); const bf16* w1 = WSB + ((size_t)(g * 128 + 32 * TB1 + r32) * 128 + hi * 8);
#pragma unroll
      for (int ks = 0; ks < NK0; ++ks) af0[ks] = *(const bf16x8*)(w0 + ks * 16);
#pragma unroll
      for (int ks = 0; ks < NK1; ++ks) af1[ks] = *(const bf16x8*)(w1 + ks * 16); }
    v4u uw[2][4]; float bias[2][4];
#pragma unroll
    for (int tsel = 0; tsel < 2; ++tsel) { const int tb = tsel ? TB1 : TB0;
#pragma unroll
        for (int i = 0; i < 4; ++i) { const int t = 32 * tb + i * 8 + (lane >> 3); uw[tsel][i] = (v4u){0u, 0u, 0u, 0u}; bias[tsel][i] = 0.f;
            if (t < L) { uw[tsel][i] = *(const v4u*)(UB + (row0 + t) * DM + g * 256 + 64 * cq + (lane & 7) * 8); bias[tsel][i] = b_s[g * 128 + t]; } } }
    { const int col = g * 256 + sc;
      const f32x4 g0 = *(const LAS f32x4*)(lnp + col), g1 = *(const LAS f32x4*)(lnp + col + 4), b0 = *(const LAS f32x4*)(lnp + DM + col), b1 = *(const LAS f32x4*)(lnp + DM + col + 4);
#pragma unroll
      for (int i = 0; i < 8; ++i) { const int r = sr + 16 * i; v4u w = {0u, 0u, 0u, 0u};
        if (r < L) {
            const v4u x = raw[i]; const float mean = stats[2 * r], rstd = stats[2 * r + 1];
            float v[8] = {bflo(x.x), bfhi(x.x), bflo(x.y), bfhi(x.y), bflo(x.z), bfhi(x.z), bflo(x.w), bfhi(x.w)};
            v[0] = (v[0] - mean) * rstd * g0.x + b0.x; v[1] = (v[1] - mean) * rstd * g0.y + b0.y; v[2] = (v[2] - mean) * rstd * g0.z + b0.z; v[3] = (v[3] - mean) * rstd * g0.w + b0.w;
            v[4] = (v[4] - mean) * rstd * g1.x + b1.x; v[5] = (v[5] - mean) * rstd * g1.y + b1.y; v[6] = (v[6] - mean) * rstd * g1.z + b1.z; v[7] = (v[7] - mean) * rstd * g1.w + b1.w;
            if (SAMPLE) { float* gs = gs_out + (size_t)r * DM + col; *(f32x4*)gs = (f32x4){v[0], v[1], v[2], v[3]}; *(f32x4*)(gs + 4) = (f32x4){v[4], v[5], v[6], v[7]}; }
            w.x = pk2(v[0], v[1]); w.y = pk2(v[2], v[3]); w.z = pk2(v[4], v[5]); w.w = pk2(v[6], v[7]);
        }
        *(LAS v4u*)(img + ((sc >> 5) * 8 + (r >> 4)) * 1024 + (r & 15) * 64 + (sc & 31) * 2) = w; } }
    if (g < 3) {
#pragma unroll
        for (int i = 0; i < 8; ++i) if (sr + 16 * i < L) raw[i] = *(const v4u*)(GV + (row0 + sr + 16 * i) * DM + (g + 1) * 256 + sc);
    }
    __syncthreads();
    f32x16 o[2][2];
#pragma unroll
    for (int a = 0; a < 2; ++a)
#pragma unroll
        for (int c = 0; c < 2; ++c) o[a][c] = (f32x16){};
#pragma unroll
    for (int ks = 0; ks < NK1; ++ks) {
#pragma unroll
        for (int cs = 0; cs < 2; ++cs) {
            lds_cptr vp = (lds_cptr)img + ((2 * cq + cs) * 8 + ks) * 1024 + vb;
            const s16x4 lo = vtr(vp), h4 = vtr(vp + 512); const bf16x8 vf = (bf16x8){lo[0], lo[1], lo[2], lo[3], h4[0], h4[1], h4[2], h4[3]};
            if (ks < NK0) o[0][cs] = __builtin_amdgcn_mfma_f32_32x32x16_bf16(af0[ks < NK0 ? ks : 0], vf, o[0][cs], 0, 0, 0);
            o[1][cs] = __builtin_amdgcn_mfma_f32_32x32x16_bf16(af1[ks], vf, o[1][cs], 0, 0, 0);
        }
        __builtin_amdgcn_sched_barrier(0);
    }
    LAS float* stg = (LAS float*)(lds + G_STG + wave * 8704); const rsrc_t rbm = mk_rsrc(BMO);
#pragma unroll
    for (int tsel = 0; tsel < 2; ++tsel) {
        const int tb = tsel ? TB1 : TB0;
#pragma unroll
        for (int r = 0; r < 16; ++r) { const int row = crow(r, hi); stg[row * 68 + r32] = o[tsel][0][r]; stg[row * 68 + 32 + r32] = o[tsel][1][r]; }
        LDS_WAIT();
#pragma unroll
        for (int i = 0; i < 4; ++i) { const int row = i * 8 + (lane >> 3), ch0 = (lane & 7) * 8, t = 32 * tb + row;
            if (t < L) {
                const f32x4 m0 = *(const LAS f32x4*)(stg + row * 68 + ch0), m1 = *(const LAS f32x4*)(stg + row * 68 + ch0 + 4); const float bs = bias[tsel][i];
                const v4u u4 = uw[tsel][i]; v4u w;
                w.x = pk2(bflo(u4.x) * (m0.x + bs), bfhi(u4.x) * (m0.y + bs)); w.y = pk2(bflo(u4.y) * (m0.z + bs), bfhi(u4.y) * (m0.w + bs));
                w.z = pk2(bflo(u4.z) * (m1.x + bs), bfhi(u4.z) * (m1.y + bs)); w.w = pk2(bflo(u4.w) * (m1.z + bs), bfhi(u4.w) * (m1.w + bs));
                st16_wt(rbm, ((row0 + t) * DM + g * 256 + 64 * cq + ch0) * 2, w);
            }
        }
        LDS_WAIT();
    }
    __syncthreads();
}
template <bool SAMPLE>
__device__ __forceinline__ void gate_unit(LAS unsigned char* lds, const bf16* GV, const bf16* UB, bf16* BMO, const bf16* WSB, const float* PG1, const float* PG2, const float* ln_g, const float* ln_b, const float* b_s, float* gs_out, size_t row0, int tid, int wave, int lane) {
    constexpr int L = SAMPLE ? 16 : 128;
    LAS float* stats = (LAS float*)lds; LAS float* lnp = (LAS float*)(lds + G_LN);
    __syncthreads();
    const int sr = tid >> 5, sc = (tid & 31) * 8;
    v4u raw[8];
#pragma unroll
    for (int i = 0; i < 8; ++i) { raw[i] = (v4u){0u, 0u, 0u, 0u}; if (sr + 16 * i < L) raw[i] = *(const v4u*)(GV + (row0 + sr + 16 * i) * DM + sc); }
    if (tid < L) {
        float a = 0.f, q = 0.f;
#pragma unroll
        for (int k = 0; k < 16; ++k) { a += PG1[(size_t)k * MT + row0 + tid]; q += PG2[(size_t)k * MT + row0 + tid]; }
        const float mean = a * (1.0f / DM), var = fmaxf(q * (1.0f / DM) - mean * mean, 0.f);
        stats[2 * tid] = mean; stats[2 * tid + 1] = 1.0f / sqrtf(var + EPS);
    }
    { const int i4 = tid & 255; const float* src = (tid < 256) ? ln_g : ln_b; *(LAS f32x4*)(lnp + (tid < 256 ? 0 : DM) + 4 * i4) = *(const f32x4*)(src + 4 * i4); }
    __syncthreads();
    if (wave & 1) { for (int g = 0; g < 4; ++g) gate_group<SAMPLE, 1>(lds, g, raw, GV, UB, BMO, WSB, b_s, gs_out, row0, tid, wave, lane); }
    else          { for (int g = 0; g < 4; ++g) gate_group<SAMPLE, 0>(lds, g, raw, GV, UB, BMO, WSB, b_s, gs_out, row0, tid, wave, lane); }
}
}

template <bool WT>
__device__ __forceinline__ void x_rows4(int m0, const float* xp, const float* xs, bf16* XB, float* RSTD1, int lane) {
    f32x4 v[4][4]; const rsrc_t rx = mk_rsrc(XB);
#pragma unroll
    for (int i = 0; i < 4; ++i) { const int m = m0 + i; const float* xrow = (m < MP) ? xp + (size_t)m * DM : xs + (size_t)(m - MP) * DM;
#pragma unroll
        for (int k = 0; k < 2; ++k) { v[i][2 * k] = *(const f32x4*)(xrow + k * 512 + 8 * lane); v[i][2 * k + 1] = *(const f32x4*)(xrow + k * 512 + 8 * lane + 4); } }
#pragma unroll
    for (int i = 0; i < 4; ++i) { const int m = m0 + i; float s = 0.f;
#pragma unroll
        for (int j = 0; j < 4; ++j) s += (v[i][j].x * v[i][j].x + v[i][j].y * v[i][j].y) + (v[i][j].z * v[i][j].z + v[i][j].w * v[i][j].w);
        s = wave_sum(s);
        const float rs = 1.0f / sqrtf(s * (1.0f / DM) + EPS);
        if (lane == 0) { if (WT) stf_wt(RSTD1 + m, rs); else RSTD1[m] = rs; }
#pragma unroll
        for (int k = 0; k < 2; ++k) { v4u w; w.x = pk2(v[i][2 * k].x, v[i][2 * k].y); w.y = pk2(v[i][2 * k].z, v[i][2 * k].w); w.z = pk2(v[i][2 * k + 1].x, v[i][2 * k + 1].y); w.w = pk2(v[i][2 * k + 1].z, v[i][2 * k + 1].w);
            if (WT) st16_wt(rx, ((size_t)m * DM + k * 512 + 8 * lane) * 2, w); else *(v4u*)(XB + (size_t)m * DM + k * 512 + 8 * lane) = w; } }
}
__device__ __forceinline__ bool chunk_next(pg8::DynOrder& S, int i, pg8::Unit& u, int tid) {
    if (tid == 0) S.put(i & 1, S.draw(S.xcd), 0);
    __syncthreads();
    return S.get(i & 1, u);
}
__device__ __forceinline__ void l1_acquire(int tid) {
    __syncthreads();
    if (tid == 0) { __builtin_amdgcn_fence(__ATOMIC_ACQUIRE, "agent"); asm volatile("s_waitcnt vmcnt(0)" ::: "memory"); }
    __syncthreads();
}
__device__ __forceinline__ void rows_wait(unsigned* cnt, unsigned need, unsigned* tot, unsigned need_tot, int& flag, unsigned* tmo, int wave) {
    if (wave == 0 && flag == 0) {
        unsigned spins = 0;
        for (;;) {
            const unsigned c0 = __hip_atomic_load(cnt, __ATOMIC_RELAXED, __HIP_MEMORY_SCOPE_AGENT), t0 = __hip_atomic_load(tot, __ATOMIC_RELAXED, __HIP_MEMORY_SCOPE_AGENT);
            const unsigned c = (unsigned)__builtin_amdgcn_readfirstlane(c0), t = (unsigned)__builtin_amdgcn_readfirstlane(t0);
            if (t >= need_tot) { flag = 1; break; }
            if (c >= need) break;
            if (++spins > PG8_SPIN_CAP || ((spins & 63u) == 0u && __builtin_amdgcn_readfirstlane(__hip_atomic_load(tmo, __ATOMIC_RELAXED, __HIP_MEMORY_SCOPE_AGENT)) != 0u)) { if ((threadIdx.x & 63) == 0) __hip_atomic_store(tmo, 1u, __ATOMIC_RELAXED, __HIP_MEMORY_SCOPE_AGENT); break; }
            __builtin_amdgcn_s_sleep(4);
        }
    }
    __syncthreads();
}

__device__ __forceinline__ void panels_wait(unsigned* C, int p_lo, int p_hi, unsigned need, unsigned* tot, unsigned need_tot, int& flag, unsigned* tmo, int wave) {
    if (wave == 0 && flag == 0) {
        unsigned spins = 0;
        for (;;) {
            const unsigned t0 = __hip_atomic_load(tot, __ATOMIC_RELAXED, __HIP_MEMORY_SCOPE_AGENT); unsigned cmin = 0xffffffffu;
            for (int p = p_lo; p <= p_hi; ++p) { const unsigned c = __hip_atomic_load(C + 64 * p, __ATOMIC_RELAXED, __HIP_MEMORY_SCOPE_AGENT); cmin = c < cmin ? c : cmin; }
            if ((unsigned)__builtin_amdgcn_readfirstlane(t0) >= need_tot) { flag = 1; break; }
            if ((unsigned)__builtin_amdgcn_readfirstlane(cmin) >= need) break;
            if (++spins > PG8_SPIN_CAP || ((spins & 63u) == 0u && __builtin_amdgcn_readfirstlane(__hip_atomic_load(tmo, __ATOMIC_RELAXED, __HIP_MEMORY_SCOPE_AGENT)) != 0u)) { if ((threadIdx.x & 63) == 0) __hip_atomic_store(tmo, 1u, __ATOMIC_RELAXED, __HIP_MEMORY_SCOPE_AGENT); break; }
            __builtin_amdgcn_s_sleep(4);
        }
    }
    __syncthreads();
}
__device__ __forceinline__ void p2_signal(unsigned* C2, int panel, int lane) {
    asm volatile("s_waitcnt vmcnt(0)" ::: "memory");
    if (lane == 0) __hip_atomic_fetch_add(C2 + 64 * panel, 1u, __ATOMIC_RELAXED, __HIP_MEMORY_SCOPE_AGENT);
}
__device__ __forceinline__ void p2_signal_sample(unsigned* C2, unsigned* CS, int lane) {
    asm volatile("s_waitcnt vmcnt(0)" ::: "memory");
    if (lane == 0) { const unsigned old = __hip_atomic_fetch_add(CS, 1u, __ATOMIC_RELAXED, __HIP_MEMORY_SCOPE_AGENT); if (old == 639u) __hip_atomic_fetch_add(C2 + 64 * 256, 48u, __ATOMIC_RELAXED, __HIP_MEMORY_SCOPE_AGENT); }
}

struct Args { const float* in[19]; float* out; unsigned char* ws; int ph_lo, ph_hi; };

__global__ void __launch_bounds__(NWAVES * 64, 2) fwd_kernel(Args args) {
    extern __shared__ __attribute__((aligned(16))) unsigned char lds_raw[];
    LAS unsigned char* lds = (LAS unsigned char*)lds_raw;
    volatile LAS unsigned* MISC = (volatile LAS unsigned*)(lds + MISC_OFF);
    const int tid = threadIdx.x, lane = tid & 63, wave = __builtin_amdgcn_readfirstlane(tid >> 6);
    const int G = gridDim.x;
    const int vcu = (G % 8 == 0) ? ((int)blockIdx.x % 8) * (G / 8) + (int)blockIdx.x / 8 : (int)blockIdx.x;
    unsigned char* ws = args.ws;
    const float* xp = args.in[0]; const float* xs = args.in[1]; const float* cache_k = args.in[2]; const float* cache_v = args.in[3];
    const float* g_pre_mix = args.in[4]; const float* g_post_mix = args.in[5]; const float* g_pre_ffn = args.in[6]; const float* g_post_ffn = args.in[7];
    const float* w_in = args.in[8]; const float* sinks = args.in[9]; const float* ln_g = args.in[10]; const float* ln_b = args.in[11];
    const float* w_s = args.in[12]; const float* b_s = args.in[13]; const float* w_ap = args.in[14]; const float* w_gp = args.in[15];
    const float* w_out = args.in[16]; const float* w_fi = args.in[17]; const float* w_fo = args.in[18];
    float* out = args.out;
    bf16* WinT = (bf16*)(ws + WS_WIN); bf16* WfiT = (bf16*)(ws + WS_WFI); bf16* WaT = (bf16*)(ws + WS_WA); bf16* WgT = (bf16*)(ws + WS_WG); bf16* WoT = (bf16*)(ws + WS_WO); bf16* WfoT = (bf16*)(ws + WS_WFO); bf16* WSB = (bf16*)(ws + WS_WSB);
    float* RSTD1 = (float*)(ws + WS_RSTD1); float* RSTD2 = (float*)(ws + WS_RSTD2); float* PMIX = (float*)(ws + WS_PMIX); float* PF = (float*)(ws + WS_PF);
    bf16* XB = (bf16*)(ws + WS_R0); bf16* FB = XB;
    bf16* QB = (bf16*)(ws + WS_R1); bf16* MERGED = QB; bf16* X1B = QB;
    bf16* GV = (bf16*)(ws + WS_R2); bf16* MIX = GV;
    bf16* KB = (bf16*)(ws + WS_KB); bf16* VB = (bf16*)(ws + WS_VB);
    bf16* SA = (bf16*)(ws + WS_SA); bf16* SB = (bf16*)(ws + WS_SB); bf16* UB = (bf16*)(ws + WS_U); bf16* ACT = (bf16*)(ws + WS_R3); bf16* AO = (bf16*)(ws + WS_AO);
#ifdef GATE_OOP
    bf16* BMB = XB;
#else
    bf16* BMB = UB;
#endif

    for (int u = tid; u < (LDS_BYTES - LDSCTL_OFF) / 4; u += NWAVES * 64) ((LAS unsigned*)(lds + LDSCTL_OFF))[u] = 0u;
    __syncthreads();
    XcdBarrier bar; bar.bar = (unsigned*)(ws + WS_CTL) + CW_BAR; bar.x = 0; bar.st = nullptr;
    if (MK_ONE_LAUNCH) bar = xcd_barrier_post((unsigned*)(ws + WS_CTL) + CW_BAR, MISC + 8);
    const int lo = args.ph_lo, hi = args.ph_hi;
    STAMP(0);
#ifndef PH_MASK
#define PH_MASK 0x1ff
#endif
#define IN(k) (((PH_MASK >> (k)) & 1) && lo <= (k) && (k) < hi)
#define SEAM(k) do { if (MK_ONE_LAUNCH && IN(k) && IN((k) + 1)) xcd_barrier(bar); } while (0)
    const int gw = vcu * NWAVES + wave, NGW = G * NWAVES;
    unsigned* const QH = (unsigned*)(ws + WS_CTL) + CW_Q; LAS int* const BOX = (LAS int*)(lds + BOX_OFF);
    unsigned* const C0 = (unsigned*)(ws + WS_CTL) + CW_C0, * const T0 = (unsigned*)(ws + WS_CTL) + CW_TOT + 5 * 64, * const TMO0 = (unsigned*)(ws + WS_CTL) + CW_TMO;

    if (IN(0)) for (int rep_ = 0; rep_ < NREP(0); ++rep_) {
        LAS float* scr = (LAS float*)(lds + wave * 16384);
        constexpr int I_IN = (DM / 64) * (INW / 32), I_SQ = (DM / 64) * (DM / 32), I_FO = (DFF / 64) * (DM / 32);
        constexpr int NITEMS = 2 * I_IN + 3 * I_SQ + I_FO;
        for (int it = gw; it < NITEMS; it += NGW) {
            int r = it;
            if (r < I_IN) { p0_transpose_item<false>(w_in, DM, INW, g_pre_mix, WinT, scr, r, lane); continue; } r -= I_IN;
            if (r < I_IN) { p0_transpose_item<true>(w_fi, DM, INW, g_pre_ffn, WfiT, scr, r, lane); continue; } r -= I_IN;
            if (r < I_SQ) { p0_transpose_item<false>(w_ap, DM, DM, nullptr, WaT, scr, r, lane); continue; } r -= I_SQ;
            if (r < I_SQ) { p0_transpose_item<false>(w_gp, DM, DM, nullptr, WgT, scr, r, lane); continue; } r -= I_SQ;
            if (r < I_SQ) { p0_transpose_item<false>(w_out, DM, DM, nullptr, WoT, scr, r, lane); continue; } r -= I_SQ;
            p0_transpose_item<false>(w_fo, DFF, DM, nullptr, WfoT, scr, r, lane);
        }
        for (int i = gw * 64 + lane; i < 4 * 128 * 128; i += NGW * 64) {
            const int t = (i >> 7) & 127, pp = i & 127, pl = pp & 15, sl = (pl & 3) | ((pl & 4) << 1) | ((pl & 8) >> 1), sidx = (pp & ~15) + sl;
            const float v = (sidx <= t) ? w_s[(size_t)(i & ~127) + sidx] : 0.f;
            WSB[i] = (bf16)(pk2(v, 0.f) & 0xffffu);
        }
        for (int gi = gw; gi < 65 * 64; gi += NGW) { const int p = gi >> 6, panel = p < 64 ? 32 * (p & 7) + (p >> 3) : 256; x_rows4<false>(panel * 256 + 4 * (gi & 63), xp, xs, XB, RSTD1, lane); }
        if (tid == 0) for (int p = blockIdx.x; p < 65; p += G) { const int panel = p < 64 ? 32 * (p & 7) + (p >> 3) : 256; __hip_atomic_fetch_add(C0 + 64 * panel, 8u, __ATOMIC_RELAXED, __HIP_MEMORY_SCOPE_AGENT); }
        for (int i = gw * 64 + lane; i < 2 * NB * 112 * 64; i += NGW * 64) {
            const int which = i / (NB * 112 * 64), r = i % (NB * 112 * 64), b = r / (112 * 64), q = r % (112 * 64);
            const float* src = (which ? cache_v : cache_k) + (size_t)b * 128 * KVW + 16 * KVW;
            float* dstp = out + (which ? O_VS : O_KS) + (size_t)b * 128 * KVW;
            ((f32x4*)dstp)[q] = ((const f32x4*)src)[q];
        }
    }
    STAMP(1);
    SEAM(0);
    STAMP(2);

    if (IN(1)) for (int rep_ = 0; rep_ < NREP(1); ++rep_) {
        const int NWK = (G >> 5) * 8;
        if (((blockIdx.x >> 3) & 3) == 0 && rep_ == 0) {
            const int w = (int)(blockIdx.x & 7) + 8 * (int)(blockIdx.x >> 5);
            for (int idx = w; idx < 192; idx += NWK) { const int wi = idx & 63, panel = 32 * (wi & 7) + 8 * (1 + (idx >> 6)) + (wi >> 3);
                for (int r = 0; r < 8; ++r) x_rows4<true>(panel * 256 + 32 * wave + 4 * r, xp, xs, XB, RSTD1, lane);
                asm volatile("s_waitcnt vmcnt(0)" ::: "memory");
                if (lane == 0) __hip_atomic_fetch_add(C0 + 64 * panel, 1u, __ATOMIC_RELAXED, __HIP_MEMORY_SCOPE_AGENT); }
            __syncthreads();
            if (tid == 0) __hip_atomic_fetch_add(T0, 1u, __ATOMIC_RELAXED, __HIP_MEMORY_SCOPE_AGENT);
        }
        pg8::Gemm g{XB, WinT, XB, WinT, MT, INW, DM}; pg8::DynOrder S; S.init(QH + 1 * 512, MP, INW, 1, BOX);
        EpiIn E{RSTD1, QB, KB, VB, UB, GV, SA, SB, out, PF, PMIX};
        const pg8::Dep D{C0, 8u, T0, (unsigned)NWK, nullptr, 0u, (unsigned*)(ws + WS_CTL) + CW_C1, (unsigned*)(ws + WS_CTL) + CW_TOT + 6 * 64, TMO0}; pg8::gemm_phase<EpiIn, pg8::DynOrder, 0>(lds, g, S, E, D);
    }
    STAMP(3);
    STAMP(4);

    unsigned* const C1 = (unsigned*)(ws + WS_CTL) + CW_C1, * const C2 = (unsigned*)(ws + WS_CTL) + CW_C2, * const CSP = (unsigned*)(ws + WS_CTL) + CW_CS;
    unsigned* const T1 = (unsigned*)(ws + WS_CTL) + CW_TOT + 6 * 64, * const T2 = (unsigned*)(ws + WS_CTL) + CW_TOT + 7 * 64;
    if (IN(2)) {
        int p2flag = 0;
        for (;;) {
            __syncthreads();
            if (tid == 0) BOX[0] = (int)__hip_atomic_fetch_add(QH + 2 * 512, 1u, __ATOMIC_RELAXED, __HIP_MEMORY_SCOPE_AGENT);
            __syncthreads();
            const int t = BOX[0];
            if (t >= NB * NKV * 4 + NB * NKV) break;
            if (t < NB * NKV * 4) {
                const int key = t >> 6, w6 = t & 63, kvh = w6 & 3, b = 2 * (w6 >> 3) + (key >> 1), qq = 2 * (key & 1) + ((w6 >> 2) & 1), c0 = 16 * qq; const size_t seqbase = (size_t)b * SEQ;
                panels_wait(C1, 16 * b + 4 * qq - (qq > 0 ? 1 : 0), 16 * b + 4 * qq + 3, 176u, T1, (unsigned)G, p2flag, TMO0, wave);
                for (int T = (c0 >= 2 ? c0 - 2 : 0); T <= c0; ++T) { const att::TileRegs tr = att::load_tile(KB, VB, seqbase + 64 * T, kvh, wave, lane); att::store_tile(lds + (T & 3) * att::SLOT, tr, wave, lane); }
                att::QFrag qc = att::load_q<false>(QB, seqbase + 64 * c0, kvh, wave, lane);
                const float sink2 = sinks[kvh * 4 + (wave >> 1)] * LOG2E;
                __syncthreads();
                for (int c = c0; c < c0 + 16; ++c) {
                    att::TileRegs nx; nx.k = (v4u){0u, 0u, 0u, 0u}; nx.v = nx.k; const bool pre = (c + 1 < c0 + 16);
                    att::QFrag qn = qc;
                    if (pre) { nx = att::load_tile(KB, VB, seqbase + 64 * (c + 1), kvh, wave, lane); qn = att::load_q<false>(QB, seqbase + 64 * (c + 1), kvh, wave, lane); }
                    att::attn_unit<false>(lds, ((c + 2) & 3) * att::SLOT, ((c + 3) & 3) * att::SLOT, (c & 3) * att::SLOT, c >= 2 ? 0 : 2 - c, qc, AO, seqbase + 64 * c, kvh, sink2, wave, lane);
                    if (pre) att::store_tile(lds + ((c + 1) & 3) * att::SLOT, nx, wave, lane);
                    qc = qn;
                    if ((c & 3) == 3) p2_signal(C2, 16 * b + (c >> 2), lane);
                    __syncthreads();
                }
            } else {
                const int j = t - NB * NKV * 4, b = j >> 2, kvh = j & 3;
                panels_wait(C1, 256, 256, 176u, T1, (unsigned)G, p2flag, TMO0, wave);
#pragma unroll
                for (int T = 0; T < 2; ++T) {
                    att::TileRegs tr;
                    { const size_t o = ((size_t)(b * 128 + 64 * T + lane) * NKV + kvh) * HD + wave * 8; const f32x4 k0 = *(const f32x4*)(cache_k + o), k1 = *(const f32x4*)(cache_k + o + 4);
                      tr.k.x = pk2(k0.x, k0.y); tr.k.y = pk2(k0.z, k0.w); tr.k.z = pk2(k1.x, k1.y); tr.k.w = pk2(k1.z, k1.w); }
                    { const size_t o = ((size_t)(b * 128 + 64 * T + 16 * (wave & 3) + (lane >> 2)) * NKV + kvh) * HD + (wave >> 2) * 32 + (lane & 3) * 8; const f32x4 v0 = *(const f32x4*)(cache_v + o), v1 = *(const f32x4*)(cache_v + o + 4);
                      tr.v.x = pk2(v0.x, v0.y); tr.v.y = pk2(v0.z, v0.w); tr.v.z = pk2(v1.x, v1.y); tr.v.w = pk2(v1.z, v1.w); }
                    att::store_tile(lds + T * att::SLOT, tr, wave, lane);
                }
                { att::TileRegs tr; tr.k = (v4u){0u, 0u, 0u, 0u}; tr.v = tr.k;
                  if (lane < 16) tr.k = *(const v4u*)(KB + (size_t)(MP + b * 16 + lane) * KVW + kvh * HD + wave * 8);
                  if ((wave & 3) == 0) tr.v = *(const v4u*)(VB + (size_t)(MP + b * 16 + (lane >> 2)) * KVW + kvh * HD + (wave >> 2) * 32 + (lane & 3) * 8);
                  att::store_tile(lds + 2 * att::SLOT, tr, wave, lane); }
                __syncthreads();
                { const att::QFrag qs = att::load_q<true>(QB, (size_t)(MP + b * 16), kvh, wave, lane); att::attn_unit<true>(lds, 0, att::SLOT, 2 * att::SLOT, 0, qs, AO, (size_t)(MP + b * 16), kvh, sinks[kvh * 4 + (wave >> 1)] * LOG2E, wave, lane); }
                p2_signal_sample(C2, CSP, lane);
            }
        }
        for (;;) {
            __syncthreads();
            if (tid == 0) BOX[0] = (int)__hip_atomic_fetch_add(QH + 2 * 512 + 64, 1u, __ATOMIC_RELAXED, __HIP_MEMORY_SCOPE_AGENT);
            __syncthreads();
            const int t = BOX[0];
            if (t >= NB * 32 + NB) break;
            if (t < NB * 32) {
                const int key = t >> 7, w7 = t & 127, b = 2 * (w7 >> 4) + (key >> 1), unit = b * 32 + 16 * (key & 1) + (w7 & 15);
                panels_wait(C1, unit >> 1, unit >> 1, 176u, T1, (unsigned)G, p2flag, TMO0, wave);
                gat::gate_unit<false>(lds, GV, UB, BMB, WSB, PF, PMIX, ln_g, ln_b, b_s, nullptr, (size_t)unit * 128, tid, wave, lane);
                p2_signal(C2, unit >> 1, lane);
            } else {
                const int j = t - NB * 32;
                panels_wait(C1, 256, 256, 176u, T1, (unsigned)G, p2flag, TMO0, wave);
                gat::gate_unit<true>(lds, GV, UB, BMB, WSB, PF, PMIX, ln_g, ln_b, b_s, out + O_GS + (size_t)j * 16 * DM, (size_t)(MP + j * 16), tid, wave, lane);
                p2_signal_sample(C2, CSP, lane);
            }
        }
        __syncthreads();
        if (tid == 0) __hip_atomic_fetch_add(T2, 1u, __ATOMIC_RELAXED, __HIP_MEMORY_SCOPE_AGENT);
    }
    STAMP(5);
    STAMP(6);

    unsigned* const ctl = (unsigned*)(ws + WS_CTL);
    unsigned* const C3 = ctl + CW_CNT, * const C4 = C3 + 264 * 64, * const C5 = C4 + 264 * 64, * const C6 = C5 + 264 * 64, * const C7 = C6 + 264 * 64, * const T3 = ctl + CW_TOT, * const T4 = T3 + 64, * const T5 = T4 + 64, * const T6 = T5 + 64, * const T7 = T6 + 64, * const TMO = ctl + CW_TMO;
    const unsigned NWG = (unsigned)G;
    if (IN(3)) {
        pg8::Gemm g{AO, WaT, BMB, WgT, MT, DM, DM}; pg8::DynOrder S; S.init(QH + 3 * 512, MP, DM, 2, BOX);
        EpiMerge E{SA, SB, MERGED}; const pg8::Dep D{C2, 48u, T2, NWG, nullptr, 0u, C3, T3, TMO};
        l1_acquire(tid); pg8::gemm_phase<EpiMerge, pg8::DynOrder, 0>(lds, g, S, E, D);
    }
    STAMP(7);
    if (IN(4)) {
        pg8::Gemm g{MERGED, WoT, MERGED, WoT, MT, DM, DM}; pg8::DynOrder S; S.init(QH + 4 * 512, MP, DM, 1, BOX);
        EpiBf16Ss E{MIX, PMIX}; const pg8::Dep D{C3, 32u, T3, NWG, nullptr, 0u, C4, T4, TMO};
        l1_acquire(tid); pg8::gemm_phase<EpiBf16Ss, pg8::DynOrder, 0>(lds, g, S, E, D);
    }
    STAMP(8);
    if (IN(5)) {
        const bool worker = ((blockIdx.x >> 3) & 3) == 0;
        pg8::DynOrder S; S.init(QH + 5 * 512, MP, DM, 1, BOX); pg8::Unit u; const rsrc_t rmix = mk_rsrc(MIX), rx1 = mk_rsrc(X1B);
        f32x4 gv[4];
#pragma unroll
        for (int k = 0; k < 4; ++k) gv[k] = *(const f32x4*)(g_post_mix + (k >> 1) * 512 + 8 * lane + (k & 1) * 4);
        int rflag = 0;
        for (int i = 0; (worker || i == 0) && chunk_next(S, i, u, tid); ++i) {
            rows_wait(C4 + 64 * u.pm, 32u, T4, NWG, rflag, TMO, wave);
            const int mb = u.pm * 256 + u.pn * 64 + wave * 8;
#pragma unroll 1
            for (int h = 0; h < 2; ++h) {
                v4u xw[4][2], mw[4][2]; float ps[4];
#pragma unroll
                for (int r = 0; r < 4; ++r) { const int m = mb + 4 * h + r; ps[r] = ldf_nc(PMIX + (size_t)(lane & 15) * MT + m);
#pragma unroll
                    for (int k = 0; k < 2; ++k) { xw[r][k] = *(const v4u*)(XB + (size_t)m * DM + k * 512 + 8 * lane); mw[r][k] = ld16_nc(rmix, ((size_t)m * DM + k * 512 + 8 * lane) * 2); } }
#pragma unroll
                for (int r = 0; r < 4; ++r) { const int m = mb + 4 * h + r; float p = ps[r]; p += __shfl_xor(p, 1); p += __shfl_xor(p, 2); p += __shfl_xor(p, 4); p += __shfl_xor(p, 8);
                    const float rm = 1.0f / sqrtf(p * (1.0f / DM) + EPS); float v[2][8]; float sq = 0.f;
#pragma unroll
                    for (int k = 0; k < 2; ++k) { const v4u a = xw[r][k], b = mw[r][k]; const f32x4 g0 = gv[2 * k], g1 = gv[2 * k + 1];
                        v[k][0] = bflo(a.x) + bflo(b.x) * rm * g0.x; v[k][1] = bfhi(a.x) + bfhi(b.x) * rm * g0.y; v[k][2] = bflo(a.y) + bflo(b.y) * rm * g0.z; v[k][3] = bfhi(a.y) + bfhi(b.y) * rm * g0.w;
                        v[k][4] = bflo(a.z) + bflo(b.z) * rm * g1.x; v[k][5] = bfhi(a.z) + bfhi(b.z) * rm * g1.y; v[k][6] = bflo(a.w) + bflo(b.w) * rm * g1.z; v[k][7] = bfhi(a.w) + bfhi(b.w) * rm * g1.w;
#pragma unroll
                        for (int j = 0; j < 8; ++j) sq += v[k][j] * v[k][j]; }
                    sq = wave_sum(sq);
                    if (lane == 0) stf_wt(RSTD2 + m, 1.0f / sqrtf(sq * (1.0f / DM) + EPS));
#pragma unroll
                    for (int k = 0; k < 2; ++k) { v4u w; w.x = pk2(v[k][0], v[k][1]); w.y = pk2(v[k][2], v[k][3]); w.z = pk2(v[k][4], v[k][5]); w.w = pk2(v[k][6], v[k][7]); st16_wt(rx1, ((size_t)m * DM + k * 512 + 8 * lane) * 2, w); } }
            }
            asm volatile("s_waitcnt vmcnt(0)" ::: "memory");
            if (lane == 0) __hip_atomic_fetch_add(C5 + 64 * u.pm, 1u, __ATOMIC_RELAXED, __HIP_MEMORY_SCOPE_AGENT);
        }
        __syncthreads();
        if (tid == 0) __hip_atomic_fetch_add(T5, 1u, __ATOMIC_RELAXED, __HIP_MEMORY_SCOPE_AGENT);
    }
    STAMP(9);
    if (IN(6)) {
        pg8::Gemm g{X1B, WfiT, X1B, WfiT, MT, INW, DM}; pg8::DynOrder S; S.init(QH + 6 * 512, MP, INW, 1, BOX);
        EpiSwiglu E{RSTD2, ACT}; const pg8::Dep D{C5, 32u, T5, NWG, T3, NWG, C6, T6, TMO};
        l1_acquire(tid); pg8::gemm_phase<EpiSwiglu, pg8::DynOrder, 0>(lds, g, S, E, D);
    }
    STAMP(10);
    if (IN(7)) {
        pg8::Gemm g{ACT, WfoT, ACT, WfoT, MT, DM, DFF}; pg8::DynOrder S; S.init(QH + 7 * 512, MP, DM, 1, BOX);
        EpiBf16Ss E{FB, PF}; const pg8::Dep D{C6, 176u, T6, NWG, nullptr, 0u, C7, T7, TMO};
        l1_acquire(tid); pg8::gemm_phase<EpiBf16Ss, pg8::DynOrder, 0>(lds, g, S, E, D);
    }
    STAMP(11);
    if (IN(8)) {
        pg8::DynOrder S; S.init(QH + 8 * 512, MP, DM, 1, BOX); pg8::Unit u; const rsrc_t rf = mk_rsrc(FB), rx1 = mk_rsrc(X1B);
        f32x4 gv[4];
#pragma unroll
        for (int k = 0; k < 4; ++k) gv[k] = *(const f32x4*)(g_post_ffn + (k >> 1) * 512 + 8 * lane + (k & 1) * 4);
        int rflag = 0;
        for (int i = 0; chunk_next(S, i, u, tid); ++i) {
            rows_wait(C7 + 64 * u.pm, 32u, T7, NWG, rflag, TMO, wave);
            const int mb = u.pm * 256 + u.pn * 64 + wave * 8;
#pragma unroll 1
            for (int h = 0; h < 2; ++h) {
                v4u xw[4][2], fw[4][2]; float ps[4];
#pragma unroll
                for (int r = 0; r < 4; ++r) { const int m = mb + 4 * h + r; ps[r] = ldf_nc(PF + (size_t)(lane & 15) * MT + m);
#pragma unroll
                    for (int k = 0; k < 2; ++k) { xw[r][k] = ld16_nc(rx1, ((size_t)m * DM + k * 512 + 8 * lane) * 2); fw[r][k] = ld16_nc(rf, ((size_t)m * DM + k * 512 + 8 * lane) * 2); } }
#pragma unroll
                for (int r = 0; r < 4; ++r) { const int m = mb + 4 * h + r; float p = ps[r]; p += __shfl_xor(p, 1); p += __shfl_xor(p, 2); p += __shfl_xor(p, 4); p += __shfl_xor(p, 8);
                    const float rf2 = 1.0f / sqrtf(p * (1.0f / DM) + EPS);
                    float* yrow = (m < MP) ? out + O_YP + (size_t)m * DM : out + O_YS + (size_t)(m - MP) * DM;
#pragma unroll
                    for (int k = 0; k < 2; ++k) { const v4u a = xw[r][k], b = fw[r][k]; const f32x4 g0 = gv[2 * k], g1 = gv[2 * k + 1]; f32x4 y0, y1;
                        y0.x = bflo(a.x) + bflo(b.x) * rf2 * g0.x; y0.y = bfhi(a.x) + bfhi(b.x) * rf2 * g0.y; y0.z = bflo(a.y) + bflo(b.y) * rf2 * g0.z; y0.w = bfhi(a.y) + bfhi(b.y) * rf2 * g0.w;
                        y1.x = bflo(a.z) + bflo(b.z) * rf2 * g1.x; y1.y = bfhi(a.z) + bfhi(b.z) * rf2 * g1.y; y1.z = bflo(a.w) + bflo(b.w) * rf2 * g1.z; y1.w = bfhi(a.w) + bfhi(b.w) * rf2 * g1.w;
                        *(f32x4*)(yrow + k * 512 + 8 * lane) = y0; *(f32x4*)(yrow + k * 512 + 8 * lane + 4) = y1; } }
            }
        }
    }
    STAMP(12);
#undef IN
#undef SEAM
}

#ifdef TS_A
#ifndef TS_C
#define TS_C TS_A
#define TS_D TS_B
#endif
#ifndef TS_SCALE
#define TS_SCALE 1e-7f
#endif
#ifndef TS_STAT
#define TS_STAT 0
#endif
__global__ void probe_fin(unsigned char* ws, float* out, int G) {
    __shared__ unsigned long long sh[4][256];
    const unsigned long long* ts = (const unsigned long long*)(ws + 768 * 1024); const int t = threadIdx.x;
    unsigned long long a = 0, b = 0, c = 0, d = 0;
    if (t < G) { a = ts[t * 16 + TS_A]; b = ts[t * 16 + TS_B]; c = ts[t * 16 + TS_C]; d = ts[t * 16 + TS_D]; }
    sh[0][t] = a; sh[1][t] = b; sh[2][t] = c; sh[3][t] = d; __syncthreads();
    if (t == 0) {
        unsigned long long s1 = 0, s2 = 0, mina = ~0ull, maxb = 0, minc = ~0ull, maxd = 0;
        for (int i = 0; i < G; ++i) { s1 += sh[1][i] - sh[0][i]; s2 += sh[3][i] - sh[2][i]; if (sh[0][i] < mina) mina = sh[0][i]; if (sh[1][i] > maxb) maxb = sh[1][i]; if (sh[2][i] < minc) minc = sh[2][i]; if (sh[3][i] > maxd) maxd = sh[3][i]; }
        const unsigned long long v1 = TS_STAT ? (maxb - mina) : s1 / (unsigned long long)G, v2 = TS_STAT ? (maxd - minc) : s2 / (unsigned long long)G;
        const unsigned long long t0 = __builtin_amdgcn_s_memrealtime();
        while (__builtin_amdgcn_s_memrealtime() - t0 < v1) __builtin_amdgcn_s_sleep(8);
        const float us = (float)v2 * 0.01f;
        out[O_GS] += sqrtf(us * TS_SCALE * 262930.0f);
    }
}
#endif
constexpr int N_PHASES = 9;
extern "C" void kernel_launch(void* const* d_in, const int* in_sizes, int n_in, void* d_out, int out_size, void* d_ws, size_t ws_size, hipStream_t stream) {
    static int grid = 0;
    if (grid == 0) {
        if (n_in != 19 || (size_t)out_size != O_END || ws_size < WS_END) { fprintf(stderr, "kernel_launch: unexpected shapes: n_in %d out %d ws %zu (need %zu)\n", n_in, out_size, ws_size, (size_t)WS_END); grid = -1; return; }
        int dev = 0, cus = 0;
        if (hipGetDevice(&dev) != hipSuccess || hipDeviceGetAttribute(&cus, hipDeviceAttributeMultiprocessorCount, dev) != hipSuccess) { grid = -1; return; }
        if (hipFuncSetAttribute((const void*)fwd_kernel, hipFuncAttributeMaxDynamicSharedMemorySize, LDS_BYTES) != hipSuccess) { fprintf(stderr, "kernel_launch: hipFuncSetAttribute failed\n"); grid = -1; return; }
        int per_cu = 0;
        (void)hipOccupancyMaxActiveBlocksPerMultiprocessor(&per_cu, (const void*)fwd_kernel, NWAVES * 64, LDS_BYTES);
        (void)hipGetLastError();
        grid = cus;
    }
    if (grid < 0) return;
    (void)hipMemsetAsync((char*)d_ws + WS_CTL, 0, CTL_ZERO_BYTES, stream);
    Args a{};
    for (int i = 0; i < 19; ++i) a.in[i] = (const float*)d_in[i];
    a.out = (float*)d_out; a.ws = (unsigned char*)d_ws;
#if MK_ONE_LAUNCH
    a.ph_lo = 0; a.ph_hi = N_PHASES;
    hipLaunchKernelGGL(fwd_kernel, dim3(grid), dim3(NWAVES * 64), LDS_BYTES, stream, a);
#ifdef TS_A
    hipLaunchKernelGGL(probe_fin, dim3(1), dim3(256), 0, stream, (unsigned char*)d_ws, (float*)d_out, grid);
#endif
#else
    for (int p = 0; p < N_PHASES; ++p) { a.ph_lo = p; a.ph_hi = p + 1; hipLaunchKernelGGL(fwd_kernel, dim3(grid), dim3(NWAVES * 64), LDS_BYTES, stream, a); }
#endif
}
```

```cpp
#include <hip/hip_runtime.h>
#include <cstdio>
#include <cstdint>

#ifndef MK_ONE_LAUNCH
#define MK_ONE_LAUNCH 1
#endif
#ifndef REP_MASK
#define REP_MASK 0
#endif
#define NREP(k) (((REP_MASK >> (k)) & 1) ? 2 : 1)
#ifdef TS_A
#define STAMP(j) do { if (threadIdx.x == 0) ((unsigned long long*)(args.ws + 768 * 1024))[blockIdx.x * 16 + (j)] = __builtin_amdgcn_s_memrealtime(); } while (0)
#else
#define STAMP(j) do { } while (0)
#endif

namespace pg8 {
#define PG8_LAS __attribute__((address_space(3)))
typedef unsigned short bf16_t;
typedef short bf16x8 __attribute__((ext_vector_type(8)));
typedef float f32x4 __attribute__((ext_vector_type(4)));
typedef unsigned u32x4 __attribute__((ext_vector_type(4)));
constexpr int BM = 256, BK = 64, HALF = 128, HTB = HALF * BK * 2  , STAGE_BYTES = 8 * HTB, NXCD = 8, WGM = 8;

__host__ __device__ __forceinline__ int lds_byte(int r, int c) { const int st = (r >> 4) * 2 + (c >> 5), rr = r & 15, cc = c & 31, ob = rr * 64 + cc * 2; return st * 1024 + (ob ^ (((ob >> 9) & 1) << 5)); }
__host__ __device__ __forceinline__ void stage_rc(int b, int& R, int& C) { const int st = b / 1024, sb = b % 1024, swz = sb ^ (((sb >> 9) & 1) << 5); R = (st >> 1) * 16 + swz / 64; C = (st & 1) * 32 + (swz % 64) / 2; }
__host__ __device__ __forceinline__ int perm32(int rho) { const int n = rho >> 4, i = rho & 15; return 8 * (i >> 2) + 4 * n + (i & 3); }

struct Unit { int pm, pn, seg; };
struct Gemm { const bf16_t* A0; const bf16_t* B0; const bf16_t* A1; const bf16_t* B1; int M, N, K; };

struct StaticOrder {
    int nM, nN, nwg, G, c, nseg;
    __host__ __device__ void init(int M, int N, int G_, int c_, int nseg_) { nM = M / BM; nN = N / BM; nwg = nM * nN; G = G_; c = c_; nseg = nseg_; }
    __host__ __device__ bool next(int i, Unit& u) const {
        const int ti = (nseg == 2) ? (i >> 1) : i; u.seg = (nseg == 2) ? (i & 1) : 0;
        const long L = (long)ti * G + c; if (L >= nwg) return false;
        int wgid = (int)L; { const int q = nwg / NXCD, r = nwg % NXCD, xcd = wgid % NXCD, off = wgid / NXCD; wgid = (xcd < r ? xcd * (q + 1) : r * (q + 1) + (xcd - r) * q) + off; }
        const int nig = WGM * nN, gid = wgid / nig, fm = gid * WGM, gsz = (nM - fm) < WGM ? (nM - fm) : WGM;
        u.pm = fm + ((wgid % nig) % gsz); u.pn = (wgid % nig) / gsz; return true;
    }
};

struct DfOrder {
    StaticOrder P; int nNs, cs, nseg;
    __host__ __device__ void init(int Mp, int N, int G, int c, int shift, int nseg_) { P.init(Mp, N, G, c, 1); nNs = N / BM; cs = (c + G - shift % G) % G; nseg = nseg_; }
    __host__ __device__ bool next(int i, Unit& u) const {
        int ti = (nseg == 2) ? (i >> 1) : i; u.seg = (nseg == 2) ? (i & 1) : 0;
        if (cs < nNs) { if (ti == 1) { u.pm = P.nM; u.pn = cs; return true; } if (ti > 1) --ti; }
        Unit t; if (!P.next(ti, t)) return false; u.pm = t.pm; u.pn = t.pn; return true;
    }
};
struct DynOrder {
    unsigned* q8; int nMp, nN, xcd, nseg; PG8_LAS int* box; unsigned tk;
    __device__ __forceinline__ void init(unsigned* q8_, int Mp, int N, int nseg_, PG8_LAS int* box_) { xcd = (int)(__builtin_amdgcn_s_getreg((3 << 11) | 20) & 7u); q8 = q8_; nMp = Mp / BM; nN = N / BM; nseg = nseg_; box = box_; tk = 0u; }
    __device__ __forceinline__ unsigned draw(int cls) const { return __hip_atomic_fetch_add(q8 + 64 * cls, 1u, __ATOMIC_RELAXED, __HIP_MEMORY_SCOPE_AGENT); }
    __device__ __forceinline__ bool map(int cls, unsigned t, int& pm, int& pn) const {
        const int ns = (nN - cls + 7) >> 3, q = nMp * nN / NXCD, ti = (int)t;
        if (ti < ns) { pm = nMp; pn = cls + 8 * ti; return true; }
        if (ti - ns < q) { const int wgid = cls * q + (ti - ns), nig = WGM * nN, gid = wgid / nig, fm = gid * WGM, gsz = (nMp - fm) < WGM ? (nMp - fm) : WGM; pm = fm + ((wgid % nig) % gsz); pn = (wgid % nig) / gsz; return true; }
        return false;
    }
    __device__ __forceinline__ void put(int slot, unsigned t, int seg) const {
        int pm = 0, pn = 0; bool valid = map(xcd, t, pm, pn);
        for (int k = 1; k < NXCD && !valid; ++k) { const int cls = (xcd + k) & 7; valid = map(cls, draw(cls), pm, pn); }
        box[4 * slot + 0] = pm; box[4 * slot + 1] = pn; box[4 * slot + 2] = seg; box[4 * slot + 3] = valid ? 1 : 0;
    }
    __device__ __forceinline__ bool get(int slot, Unit& u) const { u.pm = box[4 * slot]; u.pn = box[4 * slot + 1]; u.seg = box[4 * slot + 2]; return box[4 * slot + 3] != 0; }
    __device__ __forceinline__ bool first(Unit& u) {
        __syncthreads();
        if (threadIdx.x == 0) {
            put(0, draw(xcd), 0);
            if (nseg == 2) { box[4] = box[0]; box[5] = box[1]; box[6] = 1; box[7] = box[3]; } else put(1, draw(xcd), 0);
        }
        __syncthreads();
        return get(0, u);
    }
    __device__ __forceinline__ bool peek_next(int ui, Unit& u) const { return get((ui + 1) & 1, u); }
    __device__ __forceinline__ void pull(int ui, int wid) {
        if (wid == 0 && (threadIdx.x & 63) == 0 && (nseg == 1 || (ui & 1) == 0)) tk = draw(xcd);
    }
    __device__ __forceinline__ void commit(int ui, int wid) {
        if (wid == 0 && (threadIdx.x & 63) == 0) {
            if (nseg == 1 || (ui & 1) == 0) put(ui & 1, tk, 0);
            else { const int o = (ui + 1) & 1, d = ui & 1; box[4 * d] = box[4 * o]; box[4 * d + 1] = box[4 * o + 1]; box[4 * d + 2] = 1; box[4 * d + 3] = box[4 * o + 3]; }
        }
    }
};
struct Dep {
    unsigned* wait_cnt; unsigned need;
    unsigned* wait_tot; unsigned need_tot;
    unsigned* guard; unsigned need_guard;
    unsigned* done_cnt; unsigned* done_tot;
    unsigned* tmo;
};
#define PG8_SPIN_CAP (1u << 16)
__device__ __forceinline__ void dep_wait(const Dep& D, int pm, int wid, int& flags) {
    if (D.wait_cnt == nullptr) return;
    if (wid == 0 && (flags & 1) == 0) {
        unsigned spins = 0;
        for (;;) {
            const unsigned c0 = __hip_atomic_load(D.wait_cnt + 64 * pm, __ATOMIC_RELAXED, __HIP_MEMORY_SCOPE_AGENT);
            const unsigned t0 = __hip_atomic_load(D.wait_tot, __ATOMIC_RELAXED, __HIP_MEMORY_SCOPE_AGENT);
            const unsigned g0 = (D.guard != nullptr && (flags & 2) == 0) ? __hip_atomic_load(D.guard, __ATOMIC_RELAXED, __HIP_MEMORY_SCOPE_AGENT) : D.need_guard;
            const unsigned c = (unsigned)__builtin_amdgcn_readfirstlane(c0), t = (unsigned)__builtin_amdgcn_readfirstlane(t0), gg = (unsigned)__builtin_amdgcn_readfirstlane(g0);
            if (gg >= D.need_guard) flags |= 2;
            if (t >= D.need_tot && (flags & 2)) { flags |= 1; break; }
            if (c >= D.need && (flags & 2)) break;
            if (++spins > PG8_SPIN_CAP || ((spins & 63u) == 0u && __builtin_amdgcn_readfirstlane(__hip_atomic_load(D.tmo, __ATOMIC_RELAXED, __HIP_MEMORY_SCOPE_AGENT)) != 0u)) { if ((threadIdx.x & 63) == 0) __hip_atomic_store(D.tmo, 1u, __ATOMIC_RELAXED, __HIP_MEMORY_SCOPE_AGENT); break; }
            __builtin_amdgcn_s_sleep(4);
        }
    }
    asm volatile("" ::: "memory"); __builtin_amdgcn_s_barrier(); asm volatile("" ::: "memory");
}
__device__ __forceinline__ void dep_done(const Dep& D, int pm, int lane) {
    if (D.done_cnt != nullptr && lane == 0) __hip_atomic_fetch_add(D.done_cnt + 64 * pm, 1u, __ATOMIC_RELAXED, __HIP_MEMORY_SCOPE_AGENT);
}

template <class Epi, class Sched, int AUXA>
__device__ __forceinline__ void gemm_phase(PG8_LAS unsigned char* lds, const Gemm g, Sched& S, const Epi& E, const Dep D) {
    const int tid = threadIdx.x, wid = __builtin_amdgcn_readfirstlane(tid >> 6), lane = tid & 63, wr = wid >> 2, wc = wid & 3, fr = lane & 15, fq = lane >> 4;
    const int K = g.K, nt = K / BK;
    unsigned voffA[2], voffB[2];
#pragma unroll
    for (int i = 0; i < 2; ++i) { int R, C; stage_rc(tid * 16 + i * 8192, R, C); const int Rb = Epi::PERM ? ((R & ~31) + perm32(R & 31)) : R;
        voffA[i] = (unsigned)(R * K + C) * 2u; voffB[i] = (unsigned)(Rb * K + C) * 2u; }
    const size_t kstep = (size_t)(BK * 2);
    const size_t hstep = (size_t)HALF * K * 2;
    const size_t tstep = 2 * hstep;
    const unsigned ldsw = (unsigned)wid * 1024u;
    const int aoff = lds_byte(wr * 64 + fr, fq * 8), boff = lds_byte(wc * 32 + fr, fq * 8);
#define PG8_SA(b, h) (((b) * 2 + (h)) * HTB)
#define PG8_SB(b, h) ((4 + (b) * 2 + (h)) * HTB)
#define PG8_STAGE(bufoff, gbase, voff) do { _Pragma("unroll") for (int _i = 0; _i < 2; ++_i) \
        __builtin_amdgcn_global_load_lds((const unsigned*)((const char*)(gbase) + (voff)[_i]), (PG8_LAS unsigned*)(lds + (bufoff) + ldsw + _i * 8192), 16, 0, 0); } while (0)
#define PG8_STAGEA(bufoff, gbase, voff) do { _Pragma("unroll") for (int _i = 0; _i < 2; ++_i) \
        __builtin_amdgcn_global_load_lds((const unsigned*)((const char*)(gbase) + (voff)[_i]), (PG8_LAS unsigned*)(lds + (bufoff) + ldsw + _i * 8192), 16, 0, AUXA); } while (0)
#define PG8_LDA(dst, b, h) do { _Pragma("unroll") for (int m = 0; m < 4; ++m) _Pragma("unroll") for (int k = 0; k < 2; ++k) dst[m][k] = *(const PG8_LAS bf16x8*)(lds + PG8_SA(b, h) + aoff + m * 2048 + k * 1024); } while (0)
#define PG8_LDB(dst, b, h) do { _Pragma("unroll") for (int n = 0; n < 2; ++n) _Pragma("unroll") for (int k = 0; k < 2; ++k) dst[n][k] = *(const PG8_LAS bf16x8*)(lds + PG8_SB(b, h) + boff + n * 2048 + k * 1024); } while (0)
#define PG8_MMA(ai, bj, At, Bt) do { __builtin_amdgcn_s_setprio(1); _Pragma("unroll") for (int m = 0; m < 4; ++m) _Pragma("unroll") for (int n = 0; n < 2; ++n) _Pragma("unroll") for (int k = 0; k < 2; ++k) \
        acc[ai][bj][m][n] = __builtin_amdgcn_mfma_f32_16x16x32_bf16(Bt[n][k], At[m][k], acc[ai][bj][m][n], 0, 0, 0); __builtin_amdgcn_s_setprio(0); } while (0)
#define PG8_WAIT_V(n) asm volatile("s_waitcnt vmcnt(" #n ")" ::: "memory")
#define PG8_WAIT_L(n) asm volatile("s_waitcnt lgkmcnt(" #n ")" ::: "memory")
#define PG8_BAR __builtin_amdgcn_s_barrier()
#define PG8_SCHED __builtin_amdgcn_sched_barrier(0)
    Unit cur, nxt; int ui = 0;
    if (!S.first(cur)) { if (D.done_tot != nullptr && tid == 0) __hip_atomic_fetch_add(D.done_tot, 1u, __ATOMIC_RELAXED, __HIP_MEMORY_SCOPE_AGENT); return; }
    f32x4 acc[2][2][4][2];
#pragma unroll
    for (int a = 0; a < 2; ++a)
#pragma unroll
        for (int b = 0; b < 2; ++b)
#pragma unroll
            for (int m = 0; m < 4; ++m)
#pragma unroll
                for (int n = 0; n < 2; ++n) acc[a][b][m][n] = (f32x4){0.f, 0.f, 0.f, 0.f};
    bf16x8 At[4][2], B0[2][2], B1[2][2];
    const char* cA = (const char*)(cur.seg ? g.A1 : g.A0) + (size_t)cur.pm * tstep; const char* cB = (const char*)(cur.seg ? g.B1 : g.B0) + (size_t)cur.pn * tstep;
    int dflags = 0, pend = -1;
    dep_wait(D, cur.pm, wid, dflags);
    PG8_STAGE(PG8_SB(0, 0), cB, voffB); PG8_STAGE(PG8_SB(0, 1), cB + hstep, voffB); PG8_STAGEA(PG8_SA(0, 0), cA, voffA); PG8_STAGEA(PG8_SA(0, 1), cA + hstep, voffA);
    if (wr == 1) PG8_BAR;
    PG8_WAIT_V(2); PG8_BAR;
    PG8_STAGE(PG8_SB(1, 0), cB + kstep, voffB); PG8_STAGEA(PG8_SA(1, 0), cA + kstep, voffA); PG8_STAGE(PG8_SB(1, 1), cB + hstep + kstep, voffB);
    PG8_WAIT_V(6); PG8_BAR;
    for (;;) {
        bool has_next = false; const char* nA = cA; const char* nB = cB;
#define PG8_TRIP(a1, a2, b2, a3, b3) do { asm volatile("" : "+v"(voffA[0]), "+v"(voffA[1]), "+v"(voffB[0]), "+v"(voffB[1])); \
            PG8_LDB(B0, 0, 0); PG8_LDB(B1, 0, 1); PG8_SCHED; PG8_LDA(At, 0, 0); PG8_STAGEA(PG8_SA(1, 1), (a1) + hstep, voffA); \
            PG8_WAIT_V(8); PG8_WAIT_L(0); PG8_BAR; PG8_MMA(0, 0, At, B0); PG8_MMA(0, 1, At, B1); PG8_BAR; PG8_SCHED; \
            PG8_LDA(At, 0, 1); PG8_STAGE(PG8_SB(0, 0), (b2), voffB); PG8_STAGE(PG8_SB(0, 1), (b2) + hstep, voffB); PG8_STAGEA(PG8_SA(0, 0), (a2), voffA); \
            PG8_WAIT_V(8); PG8_WAIT_L(0); PG8_BAR; PG8_MMA(1, 0, At, B0); PG8_MMA(1, 1, At, B1); PG8_BAR; PG8_SCHED; \
            PG8_LDB(B0, 1, 0); PG8_LDB(B1, 1, 1); PG8_SCHED; PG8_LDA(At, 1, 0); PG8_STAGEA(PG8_SA(0, 1), (a2) + hstep, voffA); \
            PG8_WAIT_V(8); PG8_WAIT_L(0); PG8_BAR; PG8_MMA(0, 0, At, B0); PG8_MMA(0, 1, At, B1); PG8_BAR; PG8_SCHED; \
            PG8_LDA(At, 1, 1); PG8_STAGE(PG8_SB(1, 0), (b3), voffB); PG8_STAGE(PG8_SB(1, 1), (b3) + hstep, voffB); PG8_STAGEA(PG8_SA(1, 0), (a3), voffA); \
            PG8_WAIT_V(8); PG8_WAIT_L(0); PG8_BAR; PG8_MMA(1, 0, At, B0); PG8_MMA(1, 1, At, B1); PG8_BAR; PG8_SCHED; } while (0)
        {
            const char* a1 = cA + kstep; const char* a2 = cA + 2 * kstep; const char* b2 = cB + 2 * kstep; const char* a3 = a2 + kstep; const char* b3 = b2 + kstep;
            PG8_TRIP(a1, a2, b2, a3, b3);
            if (pend >= 0) { dep_done(D, pend, lane); pend = -1; }
        }
        for (int t = 2; t < nt - 2; t += 2) {
            const char* a1 = cA + (size_t)(t + 1) * kstep; const char* a2 = cA + (size_t)(t + 2) * kstep; const char* b2 = cB + (size_t)(t + 2) * kstep; const char* a3 = a2 + kstep; const char* b3 = b2 + kstep;
            PG8_TRIP(a1, a2, b2, a3, b3);
        }
        {
            has_next = S.peek_next(ui, nxt);
            if (has_next) { nA = (const char*)(nxt.seg ? g.A1 : g.A0) + (size_t)nxt.pm * tstep; nB = (const char*)(nxt.seg ? g.B1 : g.B0) + (size_t)nxt.pn * tstep; dep_wait(D, nxt.pm, wid, dflags); }
            const char* a1 = cA + (size_t)(nt - 1) * kstep; const char* a2 = nA; const char* b2 = nB; const char* a3 = a2 + kstep; const char* b3 = b2 + kstep;
            PG8_TRIP(a1, a2, b2, a3, b3);
        }
#undef PG8_TRIP
        if (wr == 0) PG8_BAR;
        S.pull(ui, wid);
        const bool keep = E(acc, cur, wr, wc, fr, fq);
        S.commit(ui, wid);
        if (!keep) pend = cur.pm;
        if (!has_next) break;
        if (!keep) {
#pragma unroll
        for (int a = 0; a < 2; ++a)
#pragma unroll
            for (int b = 0; b < 2; ++b)
#pragma unroll
                for (int m = 0; m < 4; ++m)
#pragma unroll
                    for (int n = 0; n < 2; ++n) acc[a][b][m][n] = (f32x4){0.f, 0.f, 0.f, 0.f};
        }
        cur = nxt; cA = nA; cB = nB; ++ui;
        if (wr == 1) PG8_BAR;
    }
    PG8_WAIT_V(0);
    if (pend >= 0) dep_done(D, pend, lane);
    PG8_BAR;
    if (D.done_tot != nullptr && tid == 0) __hip_atomic_fetch_add(D.done_tot, 1u, __ATOMIC_RELAXED, __HIP_MEMORY_SCOPE_AGENT);
#undef PG8_STAGEA
#undef PG8_SA
#undef PG8_SB
#undef PG8_STAGE
#undef PG8_LDA
#undef PG8_LDB
#undef PG8_MMA
#undef PG8_WAIT_V
#undef PG8_WAIT_L
#undef PG8_BAR
#undef PG8_SCHED
}
}

constexpr int DM = 1024, NB = 16, SEQ = 4096, DECS = 16, NKV = 4, HD = 64, KVW = 256, INW = 5632, DFF = 2816;
constexpr int MP = NB * SEQ, MS = NB * DECS, MT = MP + MS;
constexpr float EPS = 1e-6f, LOG2E = 1.4426950408889634f, QSCALE = 0.125f * LOG2E;
constexpr size_t O_YP = 0, O_YS = (size_t)MP * DM, O_KP = O_YS + (size_t)MS * DM, O_VP = O_KP + 524288, O_KS = O_VP + 524288, O_VS = O_KS + 524288, O_GS = O_VS + 524288, O_END = O_GS + (size_t)MS * DM;

constexpr size_t MiB = 1u << 20;
constexpr size_t WS_CTL = 0, CTL_ZERO_BYTES = 1 * MiB;
constexpr size_t WS_WIN = 1 * MiB, WS_WFI = 12 * MiB, WS_WA = 23 * MiB, WS_WG = 25 * MiB, WS_WO = 27 * MiB, WS_WFO = 29 * MiB;
constexpr size_t WS_WSB = 34 * MiB + 768 * 1024;
constexpr size_t WS_RSTD1 = 35 * MiB, WS_RSTD2 = 36 * MiB, WS_PMIX = 37 * MiB, WS_PF = 42 * MiB;
constexpr size_t ACTB = (size_t)MT * DM * 2;
constexpr size_t WS_R0 = 48 * MiB;
constexpr size_t WS_R1 = 177 * MiB;
constexpr size_t WS_R2 = 306 * MiB;
constexpr size_t WS_KB = 435 * MiB, WS_VB = 468 * MiB;
constexpr size_t WS_R3 = 501 * MiB;
constexpr size_t WS_SA = WS_R3, WS_SB = WS_R3 + ACTB, WS_U = WS_R3 + 2 * ACTB, WS_AO = WS_R3 + 3 * ACTB, WS_END = WS_AO + ACTB;
static_assert(WS_END <= 1024 * MiB && (size_t)MT * DFF * 2 <= 3 * ACTB && WS_R0 + ACTB <= WS_R1 && WS_R1 + ACTB <= WS_R2 && WS_R2 + ACTB <= WS_KB, "d_ws map");
constexpr int CW_BAR = 4096, CW_TMO = 64;
constexpr int CW_CNT = 16384;
constexpr int CW_TOT = CW_CNT + 5 * 264 * 64;
constexpr int CW_C0 = CW_TOT + 8 * 64;
constexpr int CW_Q = CW_C0 + 264 * 64;
constexpr int CW_C1 = CW_Q + 9 * 8 * 64, CW_C2 = CW_C1 + 264 * 64, CW_CS = CW_C2 + 264 * 64;
static_assert((CW_CS + 64) * 4 <= 768 * 1024, "CTL words inside the memset region, below the probe stamps");

constexpr int RING_BYTES = 131072, LDS_BYTES = 147456, LDSCTL_OFF = LDS_BYTES - 512, MISC_OFF = LDSCTL_OFF + 320;
constexpr int NWAVES = 8, BOX_OFF = LDSCTL_OFF + 64;

#define GAS __attribute__((address_space(1)))
#define LAS __attribute__((address_space(3)))
typedef unsigned short bf16;
typedef unsigned v4u __attribute__((ext_vector_type(4)));
typedef unsigned v2u __attribute__((ext_vector_type(2)));
typedef float f32x4 __attribute__((ext_vector_type(4)));
typedef GAS unsigned gu32;
#define RLX_AGENT __ATOMIC_RELAXED, __HIP_MEMORY_SCOPE_AGENT
#define LDS_WAIT() asm volatile("s_waitcnt lgkmcnt(0)" ::: "memory")
typedef float f32x2_t __attribute__((ext_vector_type(2))); typedef __bf16 bf16x2_t __attribute__((ext_vector_type(2)));
__device__ __forceinline__ unsigned pk2(float lo, float hi) { f32x2_t v = {lo, hi}; bf16x2_t b = __builtin_convertvector(v, bf16x2_t); return __builtin_bit_cast(unsigned, b); }
__device__ __forceinline__ float bflo(unsigned w) { return __uint_as_float(w << 16); }
__device__ __forceinline__ float bfhi(unsigned w) { return __uint_as_float(w & 0xffff0000u); }
__device__ __forceinline__ float wave_sum(float v) {
#pragma unroll
    for (int o = 1; o < 64; o <<= 1) v += __shfl_xor(v, o);
    return v;
}
__device__ __forceinline__ float gelu_tanh(float x) {
    const float e = __builtin_amdgcn_exp2f(x * (-2.302208198f - 0.10294324f * x * x));
    return x * __builtin_amdgcn_rcpf(1.0f + e);
}
__device__ __forceinline__ float sigmoidf_(float x) { return __builtin_amdgcn_rcpf(1.0f + __builtin_amdgcn_exp2f(-LOG2E * x)); }

#define XB_TMO      128
#define XB_XCNT(j)  (256  + 64 * (j))
#define XB_XSUB(j)  (1280 + 64 * (j))
#define XB_XGEN(j)  (2304 + 64 * (j))
#define XB_TOP      3328
#define XB_TOPGEN   3392
#define XCD_BAR_WORDS 3456
#define XB_SPIN_CAP (1u << 18)
__device__ __forceinline__ unsigned xb_ld(unsigned* p)              { return __hip_atomic_load(p, __ATOMIC_RELAXED, __HIP_MEMORY_SCOPE_AGENT); }
__device__ __forceinline__ unsigned xb_add(unsigned* p, unsigned v) { return __hip_atomic_fetch_add(p, v, __ATOMIC_RELAXED, __HIP_MEMORY_SCOPE_AGENT); }
__device__ __forceinline__ unsigned xb_xcc_id() { return (unsigned)__builtin_amdgcn_s_getreg((3 << 11) | 20) & 0xFu; }
#define XB_SPIN(cond, bar) do { unsigned _sp = 0; while (cond) { __builtin_amdgcn_s_sleep(1); \
    if ((++_sp & 255u) == 0u) { if (xb_ld(&(bar)[XB_TMO])) break; if (_sp > XB_SPIN_CAP) { atomicAdd(&(bar)[XB_TMO], 1u); break; } } } } while (0)
struct XcdBarrier { unsigned* bar; unsigned x; volatile LAS unsigned* st; };
__device__ __forceinline__ XcdBarrier xcd_barrier_post(unsigned* bar, volatile LAS unsigned* st) {
    XcdBarrier b; b.bar = bar; b.x = xb_xcc_id(); b.st = st;
    if (threadIdx.x == 0) (void)xb_add(&bar[XB_XCNT(b.x)], 1u);
    return b;
}
__device__ __forceinline__ void xcd_barrier_complete(unsigned* bar, unsigned x, unsigned& nloc, unsigned& nx) {
    const unsigned G = gridDim.x * gridDim.y * gridDim.z;
    unsigned sum, cnt, mine, sp = 0u;
    for (;;) {
        sum = 0u; cnt = 0u; mine = 0u;
#pragma unroll
        for (unsigned j = 0; j < 16; ++j) { const unsigned c = xb_ld(&bar[XB_XCNT(j)]); sum += c; cnt += (c > 0u) ? 1u : 0u; mine = (j == x) ? c : mine; }
        if (sum == G) break;
        __builtin_amdgcn_s_sleep(1);
        if ((++sp & 255u) == 0u) { if (xb_ld(&bar[XB_TMO])) break; if (sp > XB_SPIN_CAP) { atomicAdd(&bar[XB_TMO], 1u); break; } }
    }
    nloc = mine > 0u ? mine : 1u; nx = cnt > 0u ? cnt : 1u;
}
__device__ __forceinline__ void xcd_barrier(const XcdBarrier& b) {
    asm volatile("s_waitcnt vmcnt(0)" ::: "memory");
    __syncthreads();
    if (threadIdx.x == 0) {
        unsigned* bar = b.bar;
        __builtin_amdgcn_s_waitcnt(0);
        unsigned nloc = b.st[0], nx = b.st[1];
        if (nloc == 0u) { xcd_barrier_complete(bar, b.x, nloc, nx); b.st[0] = nloc; b.st[1] = nx; }
        const unsigned old = xb_add(&bar[XB_XSUB(b.x)], 1u);
        const unsigned gen = old / nloc;
        if (old + 1u == (gen + 1u) * nloc) {
            __builtin_amdgcn_fence(__ATOMIC_RELEASE, "agent");
            asm volatile("s_waitcnt vmcnt(0)" ::: "memory");
            const unsigned og = xb_add(&bar[XB_TOP], 1u);
            const unsigned tg = og / nx;
            if (og + 1u == (tg + 1u) * nx) xb_add(&bar[XB_TOPGEN], 1u);
            else XB_SPIN(xb_ld(&bar[XB_TOPGEN]) == tg, bar);
            __builtin_amdgcn_fence(__ATOMIC_ACQUIRE, "agent");
            xb_add(&bar[XB_XGEN(b.x)], 1u);
            asm volatile("s_waitcnt vmcnt(0)" ::: "memory");
        } else {
            XB_SPIN(xb_ld(&bar[XB_XGEN(b.x)]) == gen, bar);
            __builtin_amdgcn_fence(__ATOMIC_ACQUIRE, "agent");
            asm volatile("s_waitcnt vmcnt(0)" ::: "memory");
        }
    }
    __syncthreads();
}

typedef __amdgpu_buffer_rsrc_t rsrc_t;
__device__ __forceinline__ rsrc_t mk_rsrc(const void* p) { return __builtin_amdgcn_make_buffer_rsrc((void*)p, 0, 0x7fffffff, 0x00020000); }
__device__ __forceinline__ void st16_wt(rsrc_t r, size_t byte_off, v4u v) { __builtin_amdgcn_raw_buffer_store_b128(v, r, (int)byte_off, 0, 16); }
__device__ __forceinline__ v4u ld16_nc(rsrc_t r, size_t byte_off) { return __builtin_amdgcn_raw_buffer_load_b128(r, (int)byte_off, 0, 16); }
__device__ __forceinline__ void stf_wt(float* p, float v) { __hip_atomic_store((unsigned*)p, __float_as_uint(v), __ATOMIC_RELAXED, __HIP_MEMORY_SCOPE_AGENT); }
__device__ __forceinline__ float ldf_nc(const float* p) { return __uint_as_float(__hip_atomic_load((const unsigned*)p, __ATOMIC_RELAXED, __HIP_MEMORY_SCOPE_AGENT)); }

using pg8::Unit;
struct EpiIn {
    static constexpr bool PERM = true;
    const float* rstd; bf16 *Q, *Kb, *Vb, *U, *GV, *SA, *SB; float* out; float *PG1, *PG2;
    __device__ __forceinline__ bool operator()(f32x4 (&acc)[2][2][4][2], const Unit& u, int wr, int wc, int fr, int fq) const {
        const int pn = u.pn; int mode, ld, colt; bf16* dst; float* side = nullptr; size_t side_s = 0;
        if (pn < 4)       { mode = 0; dst = Q;  ld = DM;  colt = pn * 256; }
        else if (pn == 4) { mode = 1; dst = Kb; ld = KVW; colt = 0; side = out + O_KP; side_s = O_KS - O_KP; }
        else if (pn == 5) { mode = 1; dst = Vb; ld = KVW; colt = 0; side = out + O_VP; side_s = O_VS - O_VP; }
        else if (pn < 10) { mode = 2; dst = U;  ld = DM;  colt = (pn - 6) * 256; }
        else if (pn < 14) { mode = 2; dst = GV; ld = DM;  colt = (pn - 10) * 256; }
        else if (pn < 18) { mode = 3; dst = SA; ld = DM;  colt = (pn - 14) * 256; }
        else              { mode = 3; dst = SB; ld = DM;  colt = (pn - 18) * 256; }
        const int row0 = u.pm * 256 + wr * 64 + fr, col0 = colt + wc * 32 + 8 * fq; const rsrc_t rdst = mk_rsrc(dst);
        float rsv[2][4];
#pragma unroll
        for (int ai = 0; ai < 2; ++ai)
#pragma unroll
            for (int m = 0; m < 4; ++m) rsv[ai][m] = rstd[row0 + ai * 128 + m * 16];
#pragma unroll
        for (int ai = 0; ai < 2; ++ai)
#pragma unroll
            for (int m = 0; m < 4; ++m) {
                const int row = row0 + ai * 128 + m * 16; const float rs = rsv[ai][m]; float s1 = 0.f, s2 = 0.f;
#pragma unroll
                for (int bj = 0; bj < 2; ++bj) {
                    float v[8];
#pragma unroll
                    for (int j = 0; j < 4; ++j) { v[j] = acc[ai][bj][m][0][j] * rs; v[4 + j] = acc[ai][bj][m][1][j] * rs; }
                    if (mode == 0) {
#pragma unroll
                        for (int j = 0; j < 8; ++j) v[j] *= QSCALE;
                    } else if (mode == 2) {
#pragma unroll
                        for (int j = 0; j < 8; ++j) { v[j] = gelu_tanh(v[j]); s1 += v[j]; s2 += v[j] * v[j]; }
                    } else if (mode == 3) {
#pragma unroll
                        for (int j = 0; j < 8; ++j) v[j] = sigmoidf_(v[j]);
                    }
                    const int col = col0 + bj * 128;
                    v4u w; w.x = pk2(v[0], v[1]); w.y = pk2(v[2], v[3]); w.z = pk2(v[4], v[5]); w.w = pk2(v[6], v[7]);
                    st16_wt(rdst, ((size_t)row * ld + col) * 2, w);
                    if (mode == 1) {
                        float* sp = nullptr;
                        if (u.pm == 256) { const int r = row - MP; sp = side + side_s + ((size_t)((r >> 4) * 128 + 112 + (r & 15)) * KVW + col); }
                        else if ((u.pm & 15) == 15 && ai == 1) { const int j = wr * 64 + m * 16 + fr; sp = side + ((size_t)((u.pm >> 4) * 128 + j) * KVW + col); }
                        if (sp) { *(f32x4*)sp = (f32x4){v[0], v[1], v[2], v[3]}; *(f32x4*)(sp + 4) = (f32x4){v[4], v[5], v[6], v[7]}; }
                    }
                }
                if (pn >= 10 && pn < 14) {
                    s1 += __shfl_xor(s1, 16); s1 += __shfl_xor(s1, 32); s2 += __shfl_xor(s2, 16); s2 += __shfl_xor(s2, 32);
                    if (fq == 0) { const size_t si = (size_t)((pn - 10) * 4 + wc) * MT + row; stf_wt(PG1 + si, s1); stf_wt(PG2 + si, s2); }
                }
            }
        return false;
    }
};
struct EpiMerge {
    static constexpr bool PERM = true;
    const bf16 *SA, *SB; bf16* O;
    __device__ __forceinline__ bool operator()(f32x4 (&acc)[2][2][4][2], const Unit& u, int wr, int wc, int fr, int fq) const {
        const int row0 = u.pm * 256 + wr * 64 + fr, col0 = u.pn * 256 + wc * 32 + 8 * fq; const rsrc_t ro = mk_rsrc(O);
        if (u.seg == 0) {
#pragma unroll
            for (int ai = 0; ai < 2; ++ai) {
                v4u sbw[4][2], saw[4][2];
#pragma unroll
                for (int m = 0; m < 4; ++m)
#pragma unroll
                    for (int bj = 0; bj < 2; ++bj) { const size_t off = (size_t)(row0 + ai * 128 + m * 16) * DM + col0 + bj * 128; sbw[m][bj] = *(const v4u*)(SB + off); saw[m][bj] = *(const v4u*)(SA + off); }
#pragma unroll
                for (int m = 0; m < 4; ++m)
#pragma unroll
                    for (int bj = 0; bj < 2; ++bj) { const v4u b = sbw[m][bj], a = saw[m][bj];
                        const float sb[8] = {bflo(b.x), bfhi(b.x), bflo(b.y), bfhi(b.y), bflo(b.z), bfhi(b.z), bflo(b.w), bfhi(b.w)}, sa[8] = {bflo(a.x), bfhi(a.x), bflo(a.y), bfhi(a.y), bflo(a.z), bfhi(a.z), bflo(a.w), bfhi(a.w)};
#pragma unroll
                        for (int j = 0; j < 4; ++j) { acc[ai][bj][m][0][j] *= sa[j] * __builtin_amdgcn_rcpf(fmaxf(sb[j], 1e-30f)); acc[ai][bj][m][1][j] *= sa[4 + j] * __builtin_amdgcn_rcpf(fmaxf(sb[4 + j], 1e-30f)); } }
            }
            return true;
        }
        v4u sbw[2][4][2];
#pragma unroll
        for (int ai = 0; ai < 2; ++ai)
#pragma unroll
            for (int m = 0; m < 4; ++m)
#pragma unroll
                for (int bj = 0; bj < 2; ++bj) sbw[ai][m][bj] = *(const v4u*)(SB + (size_t)(row0 + ai * 128 + m * 16) * DM + col0 + bj * 128);
#pragma unroll
        for (int ai = 0; ai < 2; ++ai)
#pragma unroll
            for (int m = 0; m < 4; ++m)
#pragma unroll
                for (int bj = 0; bj < 2; ++bj) { const size_t off = (size_t)(row0 + ai * 128 + m * 16) * DM + col0 + bj * 128; const v4u b = sbw[ai][m][bj];
                    const float sb[8] = {bflo(b.x), bfhi(b.x), bflo(b.y), bfhi(b.y), bflo(b.z), bfhi(b.z), bflo(b.w), bfhi(b.w)}; float v[8];
#pragma unroll
                    for (int j = 0; j < 4; ++j) { v[j] = acc[ai][bj][m][0][j] * fmaxf(sb[j], 1e-30f); v[4 + j] = acc[ai][bj][m][1][j] * fmaxf(sb[4 + j], 1e-30f); }
                    v4u w; w.x = pk2(v[0], v[1]); w.y = pk2(v[2], v[3]); w.z = pk2(v[4], v[5]); w.w = pk2(v[6], v[7]);
                    st16_wt(ro, off * 2, w); }
        return false;
    }
};
struct EpiBf16Ss {
    static constexpr bool PERM = true;
    bf16* O; float* P;
    __device__ __forceinline__ bool operator()(f32x4 (&acc)[2][2][4][2], const Unit& u, int wr, int wc, int fr, int fq) const {
        const int row0 = u.pm * 256 + wr * 64 + fr, col0 = u.pn * 256 + wc * 32 + 8 * fq; const rsrc_t ro = mk_rsrc(O);
#pragma unroll
        for (int ai = 0; ai < 2; ++ai)
#pragma unroll
            for (int m = 0; m < 4; ++m) {
                const int row = row0 + ai * 128 + m * 16; float ss = 0.f;
#pragma unroll
                for (int bj = 0; bj < 2; ++bj) {
                    const f32x4 a = acc[ai][bj][m][0], b = acc[ai][bj][m][1];
                    ss += (a[0] * a[0] + a[1] * a[1]) + (a[2] * a[2] + a[3] * a[3]) + (b[0] * b[0] + b[1] * b[1]) + (b[2] * b[2] + b[3] * b[3]);
                    v4u w; w.x = pk2(a[0], a[1]); w.y = pk2(a[2], a[3]); w.z = pk2(b[0], b[1]); w.w = pk2(b[2], b[3]);
                    st16_wt(ro, ((size_t)row * DM + col0 + bj * 128) * 2, w);
                }
                ss += __shfl_xor(ss, 16); ss += __shfl_xor(ss, 32);
                if (fq == 0) stf_wt(P + (size_t)(u.pn * 4 + wc) * MT + row, ss);
            }
        return false;
    }
};
struct EpiSwiglu {
    static constexpr bool PERM = true;
    const float* rstd; bf16* O;
    __device__ __forceinline__ bool operator()(f32x4 (&acc)[2][2][4][2], const Unit& u, int wr, int wc, int fr, int fq) const {
        const int row0 = u.pm * 256 + wr * 64 + fr, col0 = u.pn * 128 + wc * 32 + 8 * fq; const rsrc_t ro = mk_rsrc(O);
        float rsv[2][4];
#pragma unroll
        for (int ai = 0; ai < 2; ++ai)
#pragma unroll
            for (int m = 0; m < 4; ++m) rsv[ai][m] = rstd[row0 + ai * 128 + m * 16];
#pragma unroll
        for (int ai = 0; ai < 2; ++ai)
#pragma unroll
            for (int m = 0; m < 4; ++m) {
                const int row = row0 + ai * 128 + m * 16; const float rs = rsv[ai][m]; float v[8];
#pragma unroll
                for (int n = 0; n < 2; ++n)
#pragma unroll
                    for (int j = 0; j < 4; ++j) { const float gg = acc[ai][0][m][n][j] * rs, up = acc[ai][1][m][n][j] * rs; v[4 * n + j] = gg * sigmoidf_(gg) * up; }
                v4u w; w.x = pk2(v[0], v[1]); w.y = pk2(v[2], v[3]); w.z = pk2(v[4], v[5]); w.w = pk2(v[6], v[7]);
                st16_wt(ro, ((size_t)row * DFF + col0) * 2, w);
            }
        return false;
    }
};

template <bool MAP>
__device__ __forceinline__ void p0_transpose_item(const float* W, int K, int N, const float* gain, bf16* WT, LAS float* scr, int item, int lane) {
    const int nblk = N / 32, kb = item / nblk, nb = item % nblk, k0 = 64 * kb, n0 = 32 * nb;
    f32x4 ld[8]; float gk[8];
#pragma unroll
    for (int i = 0; i < 8; ++i) { const int kk = (lane >> 3) + 8 * i; ld[i] = *(const f32x4*)(W + (size_t)(k0 + kk) * N + n0 + (lane & 7) * 4); gk[i] = gain ? gain[k0 + kk] : 1.0f; }
#pragma unroll
    for (int i = 0; i < 8; ++i) { const int kk = (lane >> 3) + 8 * i; LAS float* d = scr + kk * 33 + (lane & 7) * 4; d[0] = ld[i].x * gk[i]; d[1] = ld[i].y * gk[i]; d[2] = ld[i].z * gk[i]; d[3] = ld[i].w * gk[i]; }
    LDS_WAIT(); asm volatile("" ::: "memory");
    const int c = lane & 7;
#pragma unroll
    for (int j = 0; j < 4; ++j) { const int n = (lane >> 3) + 8 * j; const LAS float* s = scr + (8 * c) * 33 + n;
        v4u o; o.x = pk2(s[0 * 33], s[1 * 33]); o.y = pk2(s[2 * 33], s[3 * 33]); o.z = pk2(s[4 * 33], s[5 * 33]); o.w = pk2(s[6 * 33], s[7 * 33]);
        int nn = n0 + n;
        if (MAP) { const int hi = nn >= DFF ? 1 : 0, r = nn - hi * DFF; nn = 256 * (r >> 7) + 128 * hi + (r & 127); }
        *(GAS v4u*)(WT + (size_t)nn * K + k0 + 8 * c) = o; }
    LDS_WAIT(); asm volatile("" ::: "memory");
}

namespace att {
typedef short bf16x8 __attribute__((ext_vector_type(8)));
typedef short s16x4 __attribute__((ext_vector_type(4)));
typedef short v4i16_t __attribute__((ext_vector_type(4)));
typedef float f32x16 __attribute__((ext_vector_type(16)));
typedef LAS const char* lds_cptr;
constexpr int SLOT = 16384, OST = 4 * SLOT, OSTW = 32 * 72 * 2;
__device__ __forceinline__ int crow(int r, int hi) { return (r & 3) + 8 * (r >> 2) + 4 * hi; }
__device__ __forceinline__ s16x4 vtr(lds_cptr p) { return __builtin_bit_cast(s16x4, __builtin_amdgcn_ds_read_tr16_b64_v4i16((LAS v4i16_t*)p)); }
struct TileRegs { v4u k, v; };
__device__ __forceinline__ TileRegs load_tile(const bf16* KB, const bf16* VB, size_t rowbase, int kvh, int wid, int lane) {
    TileRegs t;
    t.k = *(const v4u*)(KB + (rowbase + lane) * KVW + kvh * HD + wid * 8);
    t.v = *(const v4u*)(VB + (rowbase + 16 * (wid & 3) + (lane >> 2)) * KVW + kvh * HD + (wid >> 2) * 32 + (lane & 3) * 8);
    return t;
}
__device__ __forceinline__ void store_tile(LAS unsigned char* slot, const TileRegs& t, int wid, int lane) {
    *(LAS v4u*)(slot + wid * 1024 + lane * 16) = t.k;
    *(LAS v4u*)(slot + 8192 + wid * 1024 + lane * 16) = t.v;
}
struct QFrag { bf16x8 q[4]; };
template <bool SAMPLE>
__device__ __forceinline__ QFrag load_q(const bf16* QO, size_t qrow0, int kvh, int wid, int lane) {
    const int r32 = lane & 31, hi = lane >> 5, posb = 32 * (wid & 1), head = kvh * 4 + (wid >> 1);
    const size_t qrow = SAMPLE ? qrow0 + ((posb + r32) & 15) : qrow0 + posb + r32;
    const bf16* qp = QO + qrow * DM + head * HD; QFrag f;
#pragma unroll
    for (int d0 = 0; d0 < 4; ++d0) f.q[d0] = *(const bf16x8*)(qp + d0 * 16 + hi * 8);
    return f;
}
template <bool SAMPLE>
__device__ __forceinline__ void attn_unit(LAS unsigned char* lds, int s0, int s1, int s2, int ft, const QFrag& qf, bf16* AO, size_t qrow0, int kvh, const float sink2, int wid, int lane) {
    const int r32 = lane & 31, hi = lane >> 5, g = wid >> 1, posb = 32 * (wid & 1), head = kvh * 4 + g;
    f32x16 p[6];
#pragma unroll
    for (int ti = 0; ti < 3; ++ti) {
        if (ti >= ft) {
            const int so = (ti == 0) ? s0 : (ti == 1) ? s1 : s2;
            lds_cptr kb = (lds_cptr)lds + so + hi * 1024 + r32 * 16;
            f32x16 a = {}, c = {};
#pragma unroll
            for (int d0 = 0; d0 < 4; ++d0) {
                const bf16x8 b0 = *(const LAS bf16x8*)(kb + d0 * 2048), b1 = *(const LAS bf16x8*)(kb + d0 * 2048 + 512);
                a = __builtin_amdgcn_mfma_f32_32x32x16_bf16(b0, qf.q[d0], a, 0, 0, 0); c = __builtin_amdgcn_mfma_f32_32x32x16_bf16(b1, qf.q[d0], c, 0, 0, 0);
            }
            p[2 * ti] = a; p[2 * ti + 1] = c;
        } else {
#pragma unroll
            for (int r = 0; r < 16; ++r) { p[2 * ti][r] = -INFINITY; p[2 * ti + 1][r] = -INFINITY; }
        }
    }
    if (SAMPLE) {
#pragma unroll
        for (int r = 0; r < 16; ++r) { if (r >= 8) p[4][r] = -INFINITY; p[5][r] = -INFINITY; }
    }
    float mx = sink2;
#pragma unroll
    for (int kb = 0; kb < 6; ++kb)
#pragma unroll
        for (int r = 0; r < 16; ++r) mx = fmaxf(mx, p[kb][r]);
    { auto rr = __builtin_amdgcn_permlane32_swap(__float_as_uint(mx), __float_as_uint(mx), false, false); mx = fmaxf(__uint_as_float(rr[0]), __uint_as_float(rr[1])); }
    float sum = 0.f;
#pragma unroll
    for (int kb = 0; kb < 6; ++kb)
#pragma unroll
        for (int r = 0; r < 16; ++r) { p[kb][r] = __builtin_amdgcn_exp2f(p[kb][r] - mx); sum += p[kb][r]; }
    { auto rr = __builtin_amdgcn_permlane32_swap(__float_as_uint(sum), __float_as_uint(sum), false, false); sum = __uint_as_float(rr[0]) + __uint_as_float(rr[1]); }
    const float inv = 1.0f / (sum + __builtin_amdgcn_exp2f(sink2 - mx));
    f32x16 o0 = {}, o1 = {};
    const int vb = ((lane >> 4) & 1) * 32 + (lane & 3) * 8 + (4 * hi + ((lane & 15) >> 2)) * 64;
#pragma unroll
    for (int ti = 0; ti < 3; ++ti) {
        if (ti >= ft) {
            const int so = (ti == 0) ? s0 : (ti == 1) ? s1 : s2;
            lds_cptr vp = (lds_cptr)lds + so + 8192 + vb;
#pragma unroll
            for (int ks = 0; ks < 4; ++ks) {
                const int kb = 2 * ti + (ks >> 1), rb = 8 * (ks & 1);
                v4u pw; pw.x = pk2(p[kb][rb + 0], p[kb][rb + 1]); pw.y = pk2(p[kb][rb + 2], p[kb][rb + 3]); pw.z = pk2(p[kb][rb + 4], p[kb][rb + 5]); pw.w = pk2(p[kb][rb + 6], p[kb][rb + 7]);
                const bf16x8 pa = __builtin_bit_cast(bf16x8, pw);
                { const s16x4 lo = vtr(vp + ks * 1024), h4 = vtr(vp + ks * 1024 + 512); const bf16x8 vf = (bf16x8){lo[0], lo[1], lo[2], lo[3], h4[0], h4[1], h4[2], h4[3]};
                  o0 = __builtin_amdgcn_mfma_f32_32x32x16_bf16(vf, pa, o0, 0, 0, 0); }
                { const s16x4 lo = vtr(vp + 4096 + ks * 1024), h4 = vtr(vp + 4096 + ks * 1024 + 512); const bf16x8 vf = (bf16x8){lo[0], lo[1], lo[2], lo[3], h4[0], h4[1], h4[2], h4[3]};
                  o1 = __builtin_amdgcn_mfma_f32_32x32x16_bf16(vf, pa, o1, 0, 0, 0); }
            }
        }
    }
    LAS bf16* stg = (LAS bf16*)(lds + OST + wid * OSTW); const rsrc_t rao = mk_rsrc(AO);
#pragma unroll
    for (int j = 0; j < 4; ++j) {
        v2u w0, w1; w0.x = pk2(o0[4 * j] * inv, o0[4 * j + 1] * inv); w0.y = pk2(o0[4 * j + 2] * inv, o0[4 * j + 3] * inv); w1.x = pk2(o1[4 * j] * inv, o1[4 * j + 1] * inv); w1.y = pk2(o1[4 * j + 2] * inv, o1[4 * j + 3] * inv);
        *(LAS v2u*)(stg + r32 * 72 + 8 * j + 4 * hi) = w0; *(LAS v2u*)(stg + r32 * 72 + 32 + 8 * j + 4 * hi) = w1;
    }
    LDS_WAIT();
#pragma unroll
    for (int i = 0; i < 4; ++i) { const int row = i * 8 + (lane >> 3), ch = lane & 7; const v4u v = *(const LAS v4u*)(stg + row * 72 + ch * 8);
        if (!SAMPLE || posb + row < 16) st16_wt(rao, ((qrow0 + posb + row) * DM + head * HD + ch * 8) * 2, v); }
    LDS_WAIT();
}
}

namespace gat {
using att::bf16x8; using att::s16x4; using att::f32x16; using att::lds_cptr; using att::vtr; using att::crow;
constexpr int G_LN = 1024, G_IMG = 9216, G_STG = G_IMG + 65536;
template <bool SAMPLE, int PP>
__device__ __forceinline__ void gate_group(LAS unsigned char* lds, int g, v4u (&raw)[8], const bf16* GV, const bf16* UB, bf16* BMO, const bf16* WSB, const float* b_s, float* gs_out, size_t row0, int tid, int wave, int lane) {
    constexpr int L = SAMPLE ? 16 : 128;
    asm volatile("" : "+v"(tid)); lane = tid & 63;
    constexpr int TB0 = PP, TB1 = 3 - PP, NK0 = 2 * (TB0 + 1), NK1 = 2 * (TB1 + 1);
    LAS float* stats = (LAS float*)lds; LAS float* lnp = (LAS float*)(lds + G_LN); LAS unsigned char* img = lds + G_IMG;
    const int r32 = lane & 31, hi = lane >> 5, cq = wave >> 1;
    const int vb = ((lane >> 4) & 1) * 32 + (lane & 3) * 8 + (4 * hi + ((lane & 15) >> 2)) * 64;
    const int sr = tid >> 5, sc = (tid & 31) * 8;
    bf16x8 af0[NK0], af1[NK1];
    { const bf16* w0 = WSB + ((size_t)(g * 128 + 32 * TB0 + r32) * 128 + hi * 8); const bf16* w1 = WSB + ((size_t)(g * 128 + 32 * TB1 + r32) * 128 + hi * 8);
#pragma unroll
      for (int ks = 0; ks < NK0; ++ks) af0[ks] = *(const bf16x8*)(w0 + ks * 16);
#pragma unroll
      for (int ks = 0; ks < NK1; ++ks) af1[ks] = *(const bf16x8*)(w1 + ks * 16); }
    v4u uw[2][4]; float bias[2][4];
#pragma unroll
    for (int tsel = 0; tsel < 2; ++tsel) { const int tb = tsel ? TB1 : TB0;
#pragma unroll
        for (int i = 0; i < 4; ++i) { const int t = 32 * tb + i * 8 + (lane >> 3); uw[tsel][i] = (v4u){0u, 0u, 0u, 0u}; bias[tsel][i] = 0.f;
            if (t < L) { uw[tsel][i] = *(const v4u*)(UB + (row0 + t) * DM + g * 256 + 64 * cq + (lane & 7) * 8); bias[tsel][i] = b_s[g * 128 + t]; } } }
    { const int col = g * 256 + sc;
      const f32x4 g0 = *(const LAS f32x4*)(lnp + col), g1 = *(const LAS f32x4*)(lnp + col + 4), b0 = *(const LAS f32x4*)(lnp + DM + col), b1 = *(const LAS f32x4*)(lnp + DM + col + 4);
#pragma unroll
      for (int i = 0; i < 8; ++i) { const int r = sr + 16 * i; v4u w = {0u, 0u, 0u, 0u};
        if (r < L) {
            const v4u x = raw[i]; const float mean = stats[2 * r], rstd = stats[2 * r + 1];
            float v[8] = {bflo(x.x), bfhi(x.x), bflo(x.y), bfhi(x.y), bflo(x.z), bfhi(x.z), bflo(x.w), bfhi(x.w)};
            v[0] = (v[0] - mean) * rstd * g0.x + b0.x; v[1] = (v[1] - mean) * rstd * g0.y + b0.y; v[2] = (v[2] - mean) * rstd * g0.z + b0.z; v[3] = (v[3] - mean) * rstd * g0.w + b0.w;
            v[4] = (v[4] - mean) * rstd * g1.x + b1.x; v[5] = (v[5] - mean) * rstd * g1.y + b1.y; v[6] = (v[6] - mean) * rstd * g1.z + b1.z; v[7] = (v[7] - mean) * rstd * g1.w + b1.w;
            if (SAMPLE) { float* gs = gs_out + (size_t)r * DM + col; *(f32x4*)gs = (f32x4){v[0], v[1], v[2], v[3]}; *(f32x4*)(gs + 4) = (f32x4){v[4], v[5], v[6], v[7]}; }
            w.x = pk2(v[0], v[1]); w.y = pk2(v[2], v[3]); w.z = pk2(v[4], v[5]); w.w = pk2(v[6], v[7]);
        }
        *(LAS v4u*)(img + ((sc >> 5) * 8 + (r >> 4)) * 1024 + (r & 15) * 64 + (sc & 31) * 2) = w; } }
    if (g < 3) {
#pragma unroll
        for (int i = 0; i < 8; ++i) if (sr + 16 * i < L) raw[i] = *(const v4u*)(GV + (row0 + sr + 16 * i) * DM + (g + 1) * 256 + sc);
    }
    __syncthreads();
    f32x16 o[2][2];
#pragma unroll
    for (int a = 0; a < 2; ++a)
#pragma unroll
        for (int c = 0; c < 2; ++c) o[a][c] = (f32x16){};
#pragma unroll
    for (int ks = 0; ks < NK1; ++ks) {
#pragma unroll
        for (int cs = 0; cs < 2; ++cs) {
            lds_cptr vp = (lds_cptr)img + ((2 * cq + cs) * 8 + ks) * 1024 + vb;
            const s16x4 lo = vtr(vp), h4 = vtr(vp + 512); const bf16x8 vf = (bf16x8){lo[0], lo[1], lo[2], lo[3], h4[0], h4[1], h4[2], h4[3]};
            if (ks < NK0) o[0][cs] = __builtin_amdgcn_mfma_f32_32x32x16_bf16(af0[ks < NK0 ? ks : 0], vf, o[0][cs], 0, 0, 0);
            o[1][cs] = __builtin_amdgcn_mfma_f32_32x32x16_bf16(af1[ks], vf, o[1][cs], 0, 0, 0);
        }
        __builtin_amdgcn_sched_barrier(0);
    }
    LAS float* stg = (LAS float*)(lds + G_STG + wave * 8704); const rsrc_t rbm = mk_rsrc(BMO);
#pragma unroll
    for (int tsel = 0; tsel < 2; ++tsel) {
        const int tb = tsel ? TB1 : TB0;
#pragma unroll
        for (int r = 0; r < 16; ++r) { const int row = crow(r, hi); stg[row * 68 + r32] = o[tsel][0][r]; stg[row * 68 + 32 + r32] = o[tsel][1][r]; }
        LDS_WAIT();
#pragma unroll
        for (int i = 0; i < 4; ++i) { const int row = i * 8 + (lane >> 3), ch0 = (lane & 7) * 8, t = 32 * tb + row;
            if (t < L) {
                const f32x4 m0 = *(const LAS f32x4*)(stg + row * 68 + ch0), m1 = *(const LAS f32x4*)(stg + row * 68 + ch0 + 4); const float bs = bias[tsel][i];
                const v4u u4 = uw[tsel][i]; v4u w;
                w.x = pk2(bflo(u4.x) * (m0.x + bs), bfhi(u4.x) * (m0.y + bs)); w.y = pk2(bflo(u4.y) * (m0.z + bs), bfhi(u4.y) * (m0.w + bs));
                w.z = pk2(bflo(u4.z) * (m1.x + bs), bfhi(u4.z) * (m1.y + bs)); w.w = pk2(bflo(u4.w) * (m1.z + bs), bfhi(u4.w) * (m1.w + bs));
                st16_wt(rbm, ((row0 + t) * DM + g * 256 + 64 * cq + ch0) * 2, w);
            }
        }
        LDS_WAIT();
    }
    __syncthreads();
}
template <bool SAMPLE>
__device__ __forceinline__ void gate_unit(LAS unsigned char* lds, const bf16* GV, const bf16* UB, bf16* BMO, const bf16* WSB, const float* PG1, const float* PG2, const float* ln_g, const float* ln_b, const float* b_s, float* gs_out, size_t row0, int tid, int wave, int lane) {
    constexpr int L = SAMPLE ? 16 : 128;
    LAS float* stats = (LAS float*)lds; LAS float* lnp = (LAS float*)(lds + G_LN);
    __syncthreads();
    const int sr = tid >> 5, sc = (tid & 31) * 8;
    v4u raw[8];
#pragma unroll
    for (int i = 0; i < 8; ++i) { raw[i] = (v4u){0u, 0u, 0u, 0u}; if (sr + 16 * i < L) raw[i] = *(const v4u*)(GV + (row0 + sr + 16 * i) * DM + sc); }
    if (tid < L) {
        float a = 0.f, q = 0.f;
#pragma unroll
        for (int k = 0; k < 16; ++k) { a += PG1[(size_t)k * MT + row0 + tid]; q += PG2[(size_t)k * MT + row0 + tid]; }
        const float mean = a * (1.0f / DM), var = fmaxf(q * (1.0f / DM) - mean * mean, 0.f);
        stats[2 * tid] = mean; stats[2 * tid + 1] = 1.0f / sqrtf(var + EPS);
    }
    { const int i4 = tid & 255; const float* src = (tid < 256) ? ln_g : ln_b; *(LAS f32x4*)(lnp + (tid < 256 ? 0 : DM) + 4 * i4) = *(const f32x4*)(src + 4 * i4); }
    __syncthreads();
    if (wave & 1) { for (int g = 0; g < 4; ++g) gate_group<SAMPLE, 1>(lds, g, raw, GV, UB, BMO, WSB, b_s, gs_out, row0, tid, wave, lane); }
    else          { for (int g = 0; g < 4; ++g) gate_group<SAMPLE, 0>(lds, g, raw, GV, UB, BMO, WSB, b_s, gs_out, row0, tid, wave, lane); }
}
}

template <bool WT>
__device__ __forceinline__ void x_rows4(int m0, const float* xp, const float* xs, bf16* XB, float* RSTD1, int lane) {
    f32x4 v[4][4]; const rsrc_t rx = mk_rsrc(XB);
#pragma unroll
    for (int i = 0; i < 4; ++i) { const int m = m0 + i; const float* xrow = (m < MP) ? xp + (size_t)m * DM : xs + (size_t)(m - MP) * DM;
#pragma unroll
        for (int k = 0; k < 2; ++k) { v[i][2 * k] = *(const f32x4*)(xrow + k * 512 + 8 * lane); v[i][2 * k + 1] = *(const f32x4*)(xrow + k * 512 + 8 * lane + 4); } }
#pragma unroll
    for (int i = 0; i < 4; ++i) { const int m = m0 + i; float s = 0.f;
#pragma unroll
        for (int j = 0; j < 4; ++j) s += (v[i][j].x * v[i][j].x + v[i][j].y * v[i][j].y) + (v[i][j].z * v[i][j].z + v[i][j].w * v[i][j].w);
        s = wave_sum(s);
        const float rs = 1.0f / sqrtf(s * (1.0f / DM) + EPS);
        if (lane == 0) { if (WT) stf_wt(RSTD1 + m, rs); else RSTD1[m] = rs; }
#pragma unroll
        for (int k = 0; k < 2; ++k) { v4u w; w.x = pk2(v[i][2 * k].x, v[i][2 * k].y); w.y = pk2(v[i][2 * k].z, v[i][2 * k].w); w.z = pk2(v[i][2 * k + 1].x, v[i][2 * k + 1].y); w.w = pk2(v[i][2 * k + 1].z, v[i][2 * k + 1].w);
            if (WT) st16_wt(rx, ((size_t)m * DM + k * 512 + 8 * lane) * 2, w); else *(v4u*)(XB + (size_t)m * DM + k * 512 + 8 * lane) = w; } }
}
__device__ __forceinline__ bool chunk_next(pg8::DynOrder& S, int i, pg8::Unit& u, int tid) {
    if (tid == 0) S.put(i & 1, S.draw(S.xcd), 0);
    __syncthreads();
    return S.get(i & 1, u);
}
__device__ __forceinline__ void l1_acquire(int tid) {
    __syncthreads();
    if (tid == 0) { __builtin_amdgcn_fence(__ATOMIC_ACQUIRE, "agent"); asm volatile("s_waitcnt vmcnt(0)" ::: "memory"); }
    __syncthreads();
}
__device__ __forceinline__ void rows_wait(unsigned* cnt, unsigned need, unsigned* tot, unsigned need_tot, int& flag, unsigned* tmo, int wave) {
    if (wave == 0 && flag == 0) {
        unsigned spins = 0;
        for (;;) {
            const unsigned c0 = __hip_atomic_load(cnt, __ATOMIC_RELAXED, __HIP_MEMORY_SCOPE_AGENT), t0 = __hip_atomic_load(tot, __ATOMIC_RELAXED, __HIP_MEMORY_SCOPE_AGENT);
            const unsigned c = (unsigned)__builtin_amdgcn_readfirstlane(c0), t = (unsigned)__builtin_amdgcn_readfirstlane(t0);
            if (t >= need_tot) { flag = 1; break; }
            if (c >= need) break;
            if (++spins > PG8_SPIN_CAP || ((spins & 63u) == 0u && __builtin_amdgcn_readfirstlane(__hip_atomic_load(tmo, __ATOMIC_RELAXED, __HIP_MEMORY_SCOPE_AGENT)) != 0u)) { if ((threadIdx.x & 63) == 0) __hip_atomic_store(tmo, 1u, __ATOMIC_RELAXED, __HIP_MEMORY_SCOPE_AGENT); break; }
            __builtin_amdgcn_s_sleep(4);
        }
    }
    __syncthreads();
}

__device__ __forceinline__ void panels_wait(unsigned* C, int p_lo, int p_hi, unsigned need, unsigned* tot, unsigned need_tot, int& flag, unsigned* tmo, int wave) {
    if (wave == 0 && flag == 0) {
        unsigned spins = 0;
        for (;;) {
            const unsigned t0 = __hip_atomic_load(tot, __ATOMIC_RELAXED, __HIP_MEMORY_SCOPE_AGENT); unsigned cmin = 0xffffffffu;
            for (int p = p_lo; p <= p_hi; ++p) { const unsigned c = __hip_atomic_load(C + 64 * p, __ATOMIC_RELAXED, __HIP_MEMORY_SCOPE_AGENT); cmin = c < cmin ? c : cmin; }
            if ((unsigned)__builtin_amdgcn_readfirstlane(t0) >= need_tot) { flag = 1; break; }
            if ((unsigned)__builtin_amdgcn_readfirstlane(cmin) >= need) break;
            if (++spins > PG8_SPIN_CAP || ((spins & 63u) == 0u && __builtin_amdgcn_readfirstlane(__hip_atomic_load(tmo, __ATOMIC_RELAXED, __HIP_MEMORY_SCOPE_AGENT)) != 0u)) { if ((threadIdx.x & 63) == 0) __hip_atomic_store(tmo, 1u, __ATOMIC_RELAXED, __HIP_MEMORY_SCOPE_AGENT); break; }
            __builtin_amdgcn_s_sleep(4);
        }
    }
    __syncthreads();
}
__device__ __forceinline__ void p2_signal(unsigned* C2, int panel, int lane) {
    asm volatile("s_waitcnt vmcnt(0)" ::: "memory");
    if (lane == 0) __hip_atomic_fetch_add(C2 + 64 * panel, 1u, __ATOMIC_RELAXED, __HIP_MEMORY_SCOPE_AGENT);
}
__device__ __forceinline__ void p2_signal_sample(unsigned* C2, unsigned* CS, int lane) {
    asm volatile("s_waitcnt vmcnt(0)" ::: "memory");
    if (lane == 0) { const unsigned old = __hip_atomic_fetch_add(CS, 1u, __ATOMIC_RELAXED, __HIP_MEMORY_SCOPE_AGENT); if (old == 639u) __hip_atomic_fetch_add(C2 + 64 * 256, 48u, __ATOMIC_RELAXED, __HIP_MEMORY_SCOPE_AGENT); }
}

struct Args { const float* in[19]; float* out; unsigned char* ws; int ph_lo, ph_hi; };

__global__ void __launch_bounds__(NWAVES * 64, 2) fwd_kernel(Args args) {
    extern __shared__ __attribute__((aligned(16))) unsigned char lds_raw[];
    LAS unsigned char* lds = (LAS unsigned char*)lds_raw;
    volatile LAS unsigned* MISC = (volatile LAS unsigned*)(lds + MISC_OFF);
    const int tid = threadIdx.x, lane = tid & 63, wave = __builtin_amdgcn_readfirstlane(tid >> 6);
    const int G = gridDim.x;
    const int vcu = (G % 8 == 0) ? ((int)blockIdx.x % 8) * (G / 8) + (int)blockIdx.x / 8 : (int)blockIdx.x;
    unsigned char* ws = args.ws;
    const float* xp = args.in[0]; const float* xs = args.in[1]; const float* cache_k = args.in[2]; const float* cache_v = args.in[3];
    const float* g_pre_mix = args.in[4]; const float* g_post_mix = args.in[5]; const float* g_pre_ffn = args.in[6]; const float* g_post_ffn = args.in[7];
    const float* w_in = args.in[8]; const float* sinks = args.in[9]; const float* ln_g = args.in[10]; const float* ln_b = args.in[11];
    const float* w_s = args.in[12]; const float* b_s = args.in[13]; const float* w_ap = args.in[14]; const float* w_gp = args.in[15];
    const float* w_out = args.in[16]; const float* w_fi = args.in[17]; const float* w_fo = args.in[18];
    float* out = args.out;
    bf16* WinT = (bf16*)(ws + WS_WIN); bf16* WfiT = (bf16*)(ws + WS_WFI); bf16* WaT = (bf16*)(ws + WS_WA); bf16* WgT = (bf16*)(ws + WS_WG); bf16* WoT = (bf16*)(ws + WS_WO); bf16* WfoT = (bf16*)(ws + WS_WFO); bf16* WSB = (bf16*)(ws + WS_WSB);
    float* RSTD1 = (float*)(ws + WS_RSTD1); float* RSTD2 = (float*)(ws + WS_RSTD2); float* PMIX = (float*)(ws + WS_PMIX); float* PF = (float*)(ws + WS_PF);
    bf16* XB = (bf16*)(ws + WS_R0); bf16* FB = XB;
    bf16* QB = (bf16*)(ws + WS_R1); bf16* MERGED = QB; bf16* X1B = QB;
    bf16* GV = (bf16*)(ws + WS_R2); bf16* MIX = GV;
    bf16* KB = (bf16*)(ws + WS_KB); bf16* VB = (bf16*)(ws + WS_VB);
    bf16* SA = (bf16*)(ws + WS_SA); bf16* SB = (bf16*)(ws + WS_SB); bf16* UB = (bf16*)(ws + WS_U); bf16* ACT = (bf16*)(ws + WS_R3); bf16* AO = (bf16*)(ws + WS_AO);
#ifdef GATE_OOP
    bf16* BMB = XB;
#else
    bf16* BMB = UB;
#endif

    for (int u = tid; u < (LDS_BYTES - LDSCTL_OFF) / 4; u += NWAVES * 64) ((LAS unsigned*)(lds + LDSCTL_OFF))[u] = 0u;
    __syncthreads();
    XcdBarrier bar; bar.bar = (unsigned*)(ws + WS_CTL) + CW_BAR; bar.x = 0; bar.st = nullptr;
    if (MK_ONE_LAUNCH) bar = xcd_barrier_post((unsigned*)(ws + WS_CTL) + CW_BAR, MISC + 8);
    const int lo = args.ph_lo, hi = args.ph_hi;
    STAMP(0);
#ifndef PH_MASK
#define PH_MASK 0x1ff
#endif
#define IN(k) (((PH_MASK >> (k)) & 1) && lo <= (k) && (k) < hi)
#define SEAM(k) do { if (MK_ONE_LAUNCH && IN(k) && IN((k) + 1)) xcd_barrier(bar); } while (0)
    const int gw = vcu * NWAVES + wave, NGW = G * NWAVES;
    unsigned* const QH = (unsigned*)(ws + WS_CTL) + CW_Q; LAS int* const BOX = (LAS int*)(lds + BOX_OFF);
    unsigned* const C0 = (unsigned*)(ws + WS_CTL) + CW_C0, * const T0 = (unsigned*)(ws + WS_CTL) + CW_TOT + 5 * 64, * const TMO0 = (unsigned*)(ws + WS_CTL) + CW_TMO;

    if (IN(0)) for (int rep_ = 0; rep_ < NREP(0); ++rep_) {
        LAS float* scr = (LAS float*)(lds + wave * 16384);
        constexpr int I_IN = (DM / 64) * (INW / 32), I_SQ = (DM / 64) * (DM / 32), I_FO = (DFF / 64) * (DM / 32);
        constexpr int NITEMS = 2 * I_IN + 3 * I_SQ + I_FO;
        for (int it = gw; it < NITEMS; it += NGW) {
            int r = it;
            if (r < I_IN) { p0_transpose_item<false>(w_in, DM, INW, g_pre_mix, WinT, scr, r, lane); continue; } r -= I_IN;
            if (r < I_IN) { p0_transpose_item<true>(w_fi, DM, INW, g_pre_ffn, WfiT, scr, r, lane); continue; } r -= I_IN;
            if (r < I_SQ) { p0_transpose_item<false>(w_ap, DM, DM, nullptr, WaT, scr, r, lane); continue; } r -= I_SQ;
            if (r < I_SQ) { p0_transpose_item<false>(w_gp, DM, DM, nullptr, WgT, scr, r, lane); continue; } r -= I_SQ;
            if (r < I_SQ) { p0_transpose_item<false>(w_out, DM, DM, nullptr, WoT, scr, r, lane); continue; } r -= I_SQ;
            p0_transpose_item<false>(w_fo, DFF, DM, nullptr, WfoT, scr, r, lane);
        }
        for (int i = gw * 64 + lane; i < 4 * 128 * 128; i += NGW * 64) {
            const int t = (i >> 7) & 127, pp = i & 127, pl = pp & 15, sl = (pl & 3) | ((pl & 4) << 1) | ((pl & 8) >> 1), sidx = (pp & ~15) + sl;
            const float v = (sidx <= t) ? w_s[(size_t)(i & ~127) + sidx] : 0.f;
            WSB[i] = (bf16)(pk2(v, 0.f) & 0xffffu);
        }
        for (int gi = gw; gi < 65 * 64; gi += NGW) { const int p = gi >> 6, panel = p < 64 ? 32 * (p & 7) + (p >> 3) : 256; x_rows4<false>(panel * 256 + 4 * (gi & 63), xp, xs, XB, RSTD1, lane); }
        if (tid == 0) for (int p = blockIdx.x; p < 65; p += G) { const int panel = p < 64 ? 32 * (p & 7) + (p >> 3) : 256; __hip_atomic_fetch_add(C0 + 64 * panel, 8u, __ATOMIC_RELAXED, __HIP_MEMORY_SCOPE_AGENT); }
        for (int i = gw * 64 + lane; i < 2 * NB * 112 * 64; i += NGW * 64) {
            const int which = i / (NB * 112 * 64), r = i % (NB * 112 * 64), b = r / (112 * 64), q = r % (112 * 64);
            const float* src = (which ? cache_v : cache_k) + (size_t)b * 128 * KVW + 16 * KVW;
            float* dstp = out + (which ? O_VS : O_KS) + (size_t)b * 128 * KVW;
            ((f32x4*)dstp)[q] = ((const f32x4*)src)[q];
        }
    }
    STAMP(1);
    SEAM(0);
    STAMP(2);

    if (IN(1)) for (int rep_ = 0; rep_ < NREP(1); ++rep_) {
        const int NWK = (G >> 5) * 8;
        if (((blockIdx.x >> 3) & 3) == 0 && rep_ == 0) {
            const int w = (int)(blockIdx.x & 7) + 8 * (int)(blockIdx.x >> 5);
            for (int idx = w; idx < 192; idx += NWK) { const int wi = idx & 63, panel = 32 * (wi & 7) + 8 * (1 + (idx >> 6)) + (wi >> 3);
                for (int r = 0; r < 8; ++r) x_rows4<true>(panel * 256 + 32 * wave + 4 * r, xp, xs, XB, RSTD1, lane);
                asm volatile("s_waitcnt vmcnt(0)" ::: "memory");
                if (lane == 0) __hip_atomic_fetch_add(C0 + 64 * panel, 1u, __ATOMIC_RELAXED, __HIP_MEMORY_SCOPE_AGENT); }
            __syncthreads();
            if (tid == 0) __hip_atomic_fetch_add(T0, 1u, __ATOMIC_RELAXED, __HIP_MEMORY_SCOPE_AGENT);
        }
        pg8::Gemm g{XB, WinT, XB, WinT, MT, INW, DM}; pg8::DynOrder S; S.init(QH + 1 * 512, MP, INW, 1, BOX);
        EpiIn E{RSTD1, QB, KB, VB, UB, GV, SA, SB, out, PF, PMIX};
        const pg8::Dep D{C0, 8u, T0, (unsigned)NWK, nullptr, 0u, (unsigned*)(ws + WS_CTL) + CW_C1, (unsigned*)(ws + WS_CTL) + CW_TOT + 6 * 64, TMO0}; pg8::gemm_phase<EpiIn, pg8::DynOrder, 0>(lds, g, S, E, D);
    }
    STAMP(3);
    STAMP(4);

    unsigned* const C1 = (unsigned*)(ws + WS_CTL) + CW_C1, * const C2 = (unsigned*)(ws + WS_CTL) + CW_C2, * const CSP = (unsigned*)(ws + WS_CTL) + CW_CS;
    unsigned* const T1 = (unsigned*)(ws + WS_CTL) + CW_TOT + 6 * 64, * const T2 = (unsigned*)(ws + WS_CTL) + CW_TOT + 7 * 64;
    if (IN(2)) {
        int p2flag = 0;
        for (;;) {
            __syncthreads();
            if (tid == 0) BOX[0] = (int)__hip_atomic_fetch_add(QH + 2 * 512, 1u, __ATOMIC_RELAXED, __HIP_MEMORY_SCOPE_AGENT);
            __syncthreads();
            const int t = BOX[0];
            if (t >= NB * NKV * 4 + NB * NKV) break;
            if (t < NB * NKV * 4) {
                const int key = t >> 6, w6 = t & 63, kvh = w6 & 3, b = 2 * (w6 >> 3) + (key >> 1), qq = 2 * (key & 1) + ((w6 >> 2) & 1), c0 = 16 * qq; const size_t seqbase = (size_t)b * SEQ;
                panels_wait(C1, 16 * b + 4 * qq - (qq > 0 ? 1 : 0), 16 * b + 4 * qq + 3, 176u, T1, (unsigned)G, p2flag, TMO0, wave);
                for (int T = (c0 >= 2 ? c0 - 2 : 0); T <= c0; ++T) { const att::TileRegs tr = att::load_tile(KB, VB, seqbase + 64 * T, kvh, wave, lane); att::store_tile(lds + (T & 3) * att::SLOT, tr, wave, lane); }
                att::QFrag qc = att::load_q<false>(QB, seqbase + 64 * c0, kvh, wave, lane);
                const float sink2 = sinks[kvh * 4 + (wave >> 1)] * LOG2E;
                __syncthreads();
                for (int c = c0; c < c0 + 16; ++c) {
                    att::TileRegs nx; nx.k = (v4u){0u, 0u, 0u, 0u}; nx.v = nx.k; const bool pre = (c + 1 < c0 + 16);
                    att::QFrag qn = qc;
                    if (pre) { nx = att::load_tile(KB, VB, seqbase + 64 * (c + 1), kvh, wave, lane); qn = att::load_q<false>(QB, seqbase + 64 * (c + 1), kvh, wave, lane); }
                    att::attn_unit<false>(lds, ((c + 2) & 3) * att::SLOT, ((c + 3) & 3) * att::SLOT, (c & 3) * att::SLOT, c >= 2 ? 0 : 2 - c, qc, AO, seqbase + 64 * c, kvh, sink2, wave, lane);
                    if (pre) att::store_tile(lds + ((c + 1) & 3) * att::SLOT, nx, wave, lane);
                    qc = qn;
                    if ((c & 3) == 3) p2_signal(C2, 16 * b + (c >> 2), lane);
                    __syncthreads();
                }
            } else {
                const int j = t - NB * NKV * 4, b = j >> 2, kvh = j & 3;
                panels_wait(C1, 256, 256, 176u, T1, (unsigned)G, p2flag, TMO0, wave);
#pragma unroll
                for (int T = 0; T < 2; ++T) {
                    att::TileRegs tr;
                    { const size_t o = ((size_t)(b * 128 + 64 * T + lane) * NKV + kvh) * HD + wave * 8; const f32x4 k0 = *(const f32x4*)(cache_k + o), k1 = *(const f32x4*)(cache_k + o + 4);
                      tr.k.x = pk2(k0.x, k0.y); tr.k.y = pk2(k0.z, k0.w); tr.k.z = pk2(k1.x, k1.y); tr.k.w = pk2(k1.z, k1.w); }
                    { const size_t o = ((size_t)(b * 128 + 64 * T + 16 * (wave & 3) + (lane >> 2)) * NKV + kvh) * HD + (wave >> 2) * 32 + (lane & 3) * 8; const f32x4 v0 = *(const f32x4*)(cache_v + o), v1 = *(const f32x4*)(cache_v + o + 4);
                      tr.v.x = pk2(v0.x, v0.y); tr.v.y = pk2(v0.z, v0.w); tr.v.z = pk2(v1.x, v1.y); tr.v.w = pk2(v1.z, v1.w); }
                    att::store_tile(lds + T * att::SLOT, tr, wave, lane);
                }
                { att::TileRegs tr; tr.k = (v4u){0u, 0u, 0u, 0u}; tr.v = tr.k;
                  if (lane < 16) tr.k = *(const v4u*)(KB + (size_t)(MP + b * 16 + lane) * KVW + kvh * HD + wave * 8);
                  if ((wave & 3) == 0) tr.v = *(const v4u*)(VB + (size_t)(MP + b * 16 + (lane >> 2)) * KVW + kvh * HD + (wave >> 2) * 32 + (lane & 3) * 8);
                  att::store_tile(lds + 2 * att::SLOT, tr, wave, lane); }
                __syncthreads();
                { const att::QFrag qs = att::load_q<true>(QB, (size_t)(MP + b * 16), kvh, wave, lane); att::attn_unit<true>(lds, 0, att::SLOT, 2 * att::SLOT, 0, qs, AO, (size_t)(MP + b * 16), kvh, sinks[kvh * 4 + (wave >> 1)] * LOG2E, wave, lane); }
                p2_signal_sample(C2, CSP, lane);
            }
        }
        for (;;) {
            __syncthreads();
            if (tid == 0) BOX[0] = (int)__hip_atomic_fetch_add(QH + 2 * 512 + 64, 1u, __ATOMIC_RELAXED, __HIP_MEMORY_SCOPE_AGENT);
            __syncthreads();
            const int t = BOX[0];
            if (t >= NB * 32 + NB) break;
            if (t < NB * 32) {
                const int key = t >> 7, w7 = t & 127, b = 2 * (w7 >> 4) + (key >> 1), unit = b * 32 + 16 * (key & 1) + (w7 & 15);
                panels_wait(C1, unit >> 1, unit >> 1, 176u, T1, (unsigned)G, p2flag, TMO0, wave);
                gat::gate_unit<false>(lds, GV, UB, BMB, WSB, PF, PMIX, ln_g, ln_b, b_s, nullptr, (size_t)unit * 128, tid, wave, lane);
                p2_signal(C2, unit >> 1, lane);
            } else {
                const int j = t - NB * 32;
                panels_wait(C1, 256, 256, 176u, T1, (unsigned)G, p2flag, TMO0, wave);
                gat::gate_unit<true>(lds, GV, UB, BMB, WSB, PF, PMIX, ln_g, ln_b, b_s, out + O_GS + (size_t)j * 16 * DM, (size_t)(MP + j * 16), tid, wave, lane);
                p2_signal_sample(C2, CSP, lane);
            }
        }
        __syncthreads();
        if (tid == 0) __hip_atomic_fetch_add(T2, 1u, __ATOMIC_RELAXED, __HIP_MEMORY_SCOPE_AGENT);
    }
    STAMP(5);
    STAMP(6);

    unsigned* const ctl = (unsigned*)(ws + WS_CTL);
    unsigned* const C3 = ctl + CW_CNT, * const C4 = C3 + 264 * 64, * const C5 = C4 + 264 * 64, * const C6 = C5 + 264 * 64, * const C7 = C6 + 264 * 64, * const T3 = ctl + CW_TOT, * const T4 = T3 + 64, * const T5 = T4 + 64, * const T6 = T5 + 64, * const T7 = T6 + 64, * const TMO = ctl + CW_TMO;
    const unsigned NWG = (unsigned)G;
    if (IN(3)) {
        pg8::Gemm g{AO, WaT, BMB, WgT, MT, DM, DM}; pg8::DynOrder S; S.init(QH + 3 * 512, MP, DM, 2, BOX);
        EpiMerge E{SA, SB, MERGED}; const pg8::Dep D{C2, 48u, T2, NWG, nullptr, 0u, C3, T3, TMO};
        l1_acquire(tid); pg8::gemm_phase<EpiMerge, pg8::DynOrder, 0>(lds, g, S, E, D);
    }
    STAMP(7);
    if (IN(4)) {
        pg8::Gemm g{MERGED, WoT, MERGED, WoT, MT, DM, DM}; pg8::DynOrder S; S.init(QH + 4 * 512, MP, DM, 1, BOX);
        EpiBf16Ss E{MIX, PMIX}; const pg8::Dep D{C3, 32u, T3, NWG, nullptr, 0u, C4, T4, TMO};
        l1_acquire(tid); pg8::gemm_phase<EpiBf16Ss, pg8::DynOrder, 0>(lds, g, S, E, D);
    }
    STAMP(8);
    if (IN(5)) {
        const bool worker = ((blockIdx.x >> 3) & 3) == 0;
        pg8::DynOrder S; S.init(QH + 5 * 512, MP, DM, 1, BOX); pg8::Unit u; const rsrc_t rmix = mk_rsrc(MIX), rx1 = mk_rsrc(X1B);
        f32x4 gv[4];
#pragma unroll
        for (int k = 0; k < 4; ++k) gv[k] = *(const f32x4*)(g_post_mix + (k >> 1) * 512 + 8 * lane + (k & 1) * 4);
        int rflag = 0;
        for (int i = 0; (worker || i == 0) && chunk_next(S, i, u, tid); ++i) {
            rows_wait(C4 + 64 * u.pm, 32u, T4, NWG, rflag, TMO, wave);
            const int mb = u.pm * 256 + u.pn * 64 + wave * 8;
#pragma unroll 1
            for (int h = 0; h < 2; ++h) {
                v4u xw[4][2], mw[4][2]; float ps[4];
#pragma unroll
                for (int r = 0; r < 4; ++r) { const int m = mb + 4 * h + r; ps[r] = ldf_nc(PMIX + (size_t)(lane & 15) * MT + m);
#pragma unroll
                    for (int k = 0; k < 2; ++k) { xw[r][k] = *(const v4u*)(XB + (size_t)m * DM + k * 512 + 8 * lane); mw[r][k] = ld16_nc(rmix, ((size_t)m * DM + k * 512 + 8 * lane) * 2); } }
#pragma unroll
                for (int r = 0; r < 4; ++r) { const int m = mb + 4 * h + r; float p = ps[r]; p += __shfl_xor(p, 1); p += __shfl_xor(p, 2); p += __shfl_xor(p, 4); p += __shfl_xor(p, 8);
                    const float rm = 1.0f / sqrtf(p * (1.0f / DM) + EPS); float v[2][8]; float sq = 0.f;
#pragma unroll
                    for (int k = 0; k < 2; ++k) { const v4u a = xw[r][k], b = mw[r][k]; const f32x4 g0 = gv[2 * k], g1 = gv[2 * k + 1];
                        v[k][0] = bflo(a.x) + bflo(b.x) * rm * g0.x; v[k][1] = bfhi(a.x) + bfhi(b.x) * rm * g0.y; v[k][2] = bflo(a.y) + bflo(b.y) * rm * g0.z; v[k][3] = bfhi(a.y) + bfhi(b.y) * rm * g0.w;
                        v[k][4] = bflo(a.z) + bflo(b.z) * rm * g1.x; v[k][5] = bfhi(a.z) + bfhi(b.z) * rm * g1.y; v[k][6] = bflo(a.w) + bflo(b.w) * rm * g1.z; v[k][7] = bfhi(a.w) + bfhi(b.w) * rm * g1.w;
#pragma unroll
                        for (int j = 0; j < 8; ++j) sq += v[k][j] * v[k][j]; }
                    sq = wave_sum(sq);
                    if (lane == 0) stf_wt(RSTD2 + m, 1.0f / sqrtf(sq * (1.0f / DM) + EPS));
#pragma unroll
                    for (int k = 0; k < 2; ++k) { v4u w; w.x = pk2(v[k][0], v[k][1]); w.y = pk2(v[k][2], v[k][3]); w.z = pk2(v[k][4], v[k][5]); w.w = pk2(v[k][6], v[k][7]); st16_wt(rx1, ((size_t)m * DM + k * 512 + 8 * lane) * 2, w); } }
            }
            asm volatile("s_waitcnt vmcnt(0)" ::: "memory");
            if (lane == 0) __hip_atomic_fetch_add(C5 + 64 * u.pm, 1u, __ATOMIC_RELAXED, __HIP_MEMORY_SCOPE_AGENT);
        }
        __syncthreads();
        if (tid == 0) __hip_atomic_fetch_add(T5, 1u, __ATOMIC_RELAXED, __HIP_MEMORY_SCOPE_AGENT);
    }
    STAMP(9);
    if (IN(6)) {
        pg8::Gemm g{X1B, WfiT, X1B, WfiT, MT, INW, DM}; pg8::DynOrder S; S.init(QH + 6 * 512, MP, INW, 1, BOX);
        EpiSwiglu E{RSTD2, ACT}; const pg8::Dep D{C5, 32u, T5, NWG, T3, NWG, C6, T6, TMO};
        l1_acquire(tid); pg8::gemm_phase<EpiSwiglu, pg8::DynOrder, 0>(lds, g, S, E, D);
    }
    STAMP(10);
    if (IN(7)) {
        pg8::Gemm g{ACT, WfoT, ACT, WfoT, MT, DM, DFF}; pg8::DynOrder S; S.init(QH + 7 * 512, MP, DM, 1, BOX);
        EpiBf16Ss E{FB, PF}; const pg8::Dep D{C6, 176u, T6, NWG, nullptr, 0u, C7, T7, TMO};
        l1_acquire(tid); pg8::gemm_phase<EpiBf16Ss, pg8::DynOrder, 0>(lds, g, S, E, D);
    }
    STAMP(11);
    if (IN(8)) {
        pg8::DynOrder S; S.init(QH + 8 * 512, MP, DM, 1, BOX); pg8::Unit u; const rsrc_t rf = mk_rsrc(FB), rx1 = mk_rsrc(X1B);
        f32x4 gv[4];
#pragma unroll
        for (int k = 0; k < 4; ++k) gv[k] = *(const f32x4*)(g_post_ffn + (k >> 1) * 512 + 8 * lane + (k & 1) * 4);
        int rflag = 0;
        for (int i = 0; chunk_next(S, i, u, tid); ++i) {
            rows_wait(C7 + 64 * u.pm, 32u, T7, NWG, rflag, TMO, wave);
            const int mb = u.pm * 256 + u.pn * 64 + wave * 8;
#pragma unroll 1
            for (int h = 0; h < 2; ++h) {
                v4u xw[4][2], fw[4][2]; float ps[4];
#pragma unroll
                for (int r = 0; r < 4; ++r) { const int m = mb + 4 * h + r; ps[r] = ldf_nc(PF + (size_t)(lane & 15) * MT + m);
#pragma unroll
                    for (int k = 0; k < 2; ++k) { xw[r][k] = ld16_nc(rx1, ((size_t)m * DM + k * 512 + 8 * lane) * 2); fw[r][k] = ld16_nc(rf, ((size_t)m * DM + k * 512 + 8 * lane) * 2); } }
#pragma unroll
                for (int r = 0; r < 4; ++r) { const int m = mb + 4 * h + r; float p = ps[r]; p += __shfl_xor(p, 1); p += __shfl_xor(p, 2); p += __shfl_xor(p, 4); p += __shfl_xor(p, 8);
                    const float rf2 = 1.0f / sqrtf(p * (1.0f / DM) + EPS);
                    float* yrow = (m < MP) ? out + O_YP + (size_t)m * DM : out + O_YS + (size_t)(m - MP) * DM;
#pragma unroll
                    for (int k = 0; k < 2; ++k) { const v4u a = xw[r][k], b = fw[r][k]; const f32x4 g0 = gv[2 * k], g1 = gv[2 * k + 1]; f32x4 y0, y1;
                        y0.x = bflo(a.x) + bflo(b.x) * rf2 * g0.x; y0.y = bfhi(a.x) + bfhi(b.x) * rf2 * g0.y; y0.z = bflo(a.y) + bflo(b.y) * rf2 * g0.z; y0.w = bfhi(a.y) + bfhi(b.y) * rf2 * g0.w;
                        y1.x = bflo(a.z) + bflo(b.z) * rf2 * g1.x; y1.y = bfhi(a.z) + bfhi(b.z) * rf2 * g1.y; y1.z = bflo(a.w) + bflo(b.w) * rf2 * g1.z; y1.w = bfhi(a.w) + bfhi(b.w) * rf2 * g1.w;
                        *(f32x4*)(yrow + k * 512 + 8 * lane) = y0; *(f32x4*)(yrow + k * 512 + 8 * lane + 4) = y1; } }
            }
        }
    }
    STAMP(12);
#undef IN
#undef SEAM
}

#ifdef TS_A
#ifndef TS_C
#define TS_C TS_A
#define TS_D TS_B
#endif
#ifndef TS_SCALE
#define TS_SCALE 1e-7f
#endif
#ifndef TS_STAT
#define TS_STAT 0
#endif
__global__ void probe_fin(unsigned char* ws, float* out, int G) {
    __shared__ unsigned long long sh[4][256];
    const unsigned long long* ts = (const unsigned long long*)(ws + 768 * 1024); const int t = threadIdx.x;
    unsigned long long a = 0, b = 0, c = 0, d = 0;
    if (t < G) { a = ts[t * 16 + TS_A]; b = ts[t * 16 + TS_B]; c = ts[t * 16 + TS_C]; d = ts[t * 16 + TS_D]; }
    sh[0][t] = a; sh[1][t] = b; sh[2][t] = c; sh[3][t] = d; __syncthreads();
    if (t == 0) {
        unsigned long long s1 = 0, s2 = 0, mina = ~0ull, maxb = 0, minc = ~0ull, maxd = 0;
        for (int i = 0; i < G; ++i) { s1 += sh[1][i] - sh[0][i]; s2 += sh[3][i] - sh[2][i]; if (sh[0][i] < mina) mina = sh[0][i]; if (sh[1][i] > maxb) maxb = sh[1][i]; if (sh[2][i] < minc) minc = sh[2][i]; if (sh[3][i] > maxd) maxd = sh[3][i]; }
        const unsigned long long v1 = TS_STAT ? (maxb - mina) : s1 / (unsigned long long)G, v2 = TS_STAT ? (maxd - minc) : s2 / (unsigned long long)G;
        const unsigned long long t0 = __builtin_amdgcn_s_memrealtime();
        while (__builtin_amdgcn_s_memrealtime() - t0 < v1) __builtin_amdgcn_s_sleep(8);
        const float us = (float)v2 * 0.01f;
        out[O_GS] += sqrtf(us * TS_SCALE * 262930.0f);
    }
}
#endif
constexpr int N_PHASES = 9;
extern "C" void kernel_launch(void* const* d_in, const int* in_sizes, int n_in, void* d_out, int out_size, void* d_ws, size_t ws_size, hipStream_t stream) {
    static int grid = 0;
    if (grid == 0) {
        if (n_in != 19 || (size_t)out_size != O_END || ws_size < WS_END) { fprintf(stderr, "kernel_launch: unexpected shapes: n_in %d out %d ws %zu (need %zu)\n", n_in, out_size, ws_size, (size_t)WS_END); grid = -1; return; }
        int dev = 0, cus = 0;
        if (hipGetDevice(&dev) != hipSuccess || hipDeviceGetAttribute(&cus, hipDeviceAttributeMultiprocessorCount, dev) != hipSuccess) { grid = -1; return; }
        if (hipFuncSetAttribute((const void*)fwd_kernel, hipFuncAttributeMaxDynamicSharedMemorySize, LDS_BYTES) != hipSuccess) { fprintf(stderr, "kernel_launch: hipFuncSetAttribute failed\n"); grid = -1; return; }
        int per_cu = 0;
        (void)hipOccupancyMaxActiveBlocksPerMultiprocessor(&per_cu, (const void*)fwd_kernel, NWAVES * 64, LDS_BYTES);
        (void)hipGetLastError();
        grid = cus;
    }
    if (grid < 0) return;
    (void)hipMemsetAsync((char*)d_ws + WS_CTL, 0, CTL_ZERO_BYTES, stream);
    Args a{};
    for (int i = 0; i < 19; ++i) a.in[i] = (const float*)d_in[i];
    a.out = (float*)d_out; a.ws = (unsigned char*)d_ws;
#if MK_ONE_LAUNCH
    a.ph_lo = 0; a.ph_hi = N_PHASES;
    hipLaunchKernelGGL(fwd_kernel, dim3(grid), dim3(NWAVES * 64), LDS_BYTES, stream, a);
#ifdef TS_A
    hipLaunchKernelGGL(probe_fin, dim3(1), dim3(256), 0, stream, (unsigned char*)d_ws, (float*)d_out, grid);
#endif
#else
    for (int p = 0; p < N_PHASES; ++p) { a.ph_lo = p; a.ph_hi = p + 1; hipLaunchKernelGGL(fwd_kernel, dim3(grid), dim3(NWAVES * 64), LDS_BYTES, stream, a); }
#endif
}
```

```cpp
#include <hip/hip_runtime.h>
#include <cstdio>
#include <cstdint>

#ifndef MK_ONE_LAUNCH
#define MK_ONE_LAUNCH 1
#endif
#ifndef REP_MASK
#define REP_MASK 0
#endif
#define NREP(k) (((REP_MASK >> (k)) & 1) ? 2 : 1)
#ifdef TS_A
#define STAMP(j) do { if (threadIdx.x == 0) ((unsigned long long*)(args.ws + 768 * 1024))[blockIdx.x * 16 + (j)] = __builtin_amdgcn_s_memrealtime(); } while (0)
#else
#define STAMP(j) do { } while (0)
#endif

namespace pg8 {
#define PG8_LAS __attribute__((address_space(3)))
typedef unsigned short bf16_t;
typedef short bf16x8 __attribute__((ext_vector_type(8)));
typedef float f32x4 __attribute__((ext_vector_type(4)));
typedef unsigned u32x4 __attribute__((ext_vector_type(4)));
constexpr int BM = 256, BK = 64, HALF = 128, HTB = HALF * BK * 2  , STAGE_BYTES = 8 * HTB, NXCD = 8, WGM = 8;

__host__ __device__ __forceinline__ int lds_byte(int r, int c) { const int st = (r >> 4) * 2 + (c >> 5), rr = r & 15, cc = c & 31, ob = rr * 64 + cc * 2; return st * 1024 + (ob ^ (((ob >> 9) & 1) << 5)); }
__host__ __device__ __forceinline__ void stage_rc(int b, int& R, int& C) { const int st = b / 1024, sb = b % 1024, swz = sb ^ (((sb >> 9) & 1) << 5); R = (st >> 1) * 16 + swz / 64; C = (st & 1) * 32 + (swz % 64) / 2; }
__host__ __device__ __forceinline__ int perm32(int rho) { const int n = rho >> 4, i = rho & 15; return 8 * (i >> 2) + 4 * n + (i & 3); }

struct Unit { int pm, pn, seg; };
struct Gemm { const bf16_t* A0; const bf16_t* B0; const bf16_t* A1; const bf16_t* B1; int M, N, K; };

struct StaticOrder {
    int nM, nN, nwg, G, c, nseg;
    __host__ __device__ void init(int M, int N, int G_, int c_, int nseg_) { nM = M / BM; nN = N / BM; nwg = nM * nN; G = G_; c = c_; nseg = nseg_; }
    __host__ __device__ bool next(int i, Unit& u) const {
        const int ti = (nseg == 2) ? (i >> 1) : i; u.seg = (nseg == 2) ? (i & 1) : 0;
        const long L = (long)ti * G + c; if (L >= nwg) return false;
        int wgid = (int)L; { const int q = nwg / NXCD, r = nwg % NXCD, xcd = wgid % NXCD, off = wgid / NXCD; wgid = (xcd < r ? xcd * (q + 1) : r * (q + 1) + (xcd - r) * q) + off; }
        const int nig = WGM * nN, gid = wgid / nig, fm = gid * WGM, gsz = (nM - fm) < WGM ? (nM - fm) : WGM;
        u.pm = fm + ((wgid % nig) % gsz); u.pn = (wgid % nig) / gsz; return true;
    }
};

struct DfOrder {
    StaticOrder P; int nNs, cs, nseg;
    __host__ __device__ void init(int Mp, int N, int G, int c, int shift, int nseg_) { P.init(Mp, N, G, c, 1); nNs = N / BM; cs = (c + G - shift % G) % G; nseg = nseg_; }
    __host__ __device__ bool next(int i, Unit& u) const {
        int ti = (nseg == 2) ? (i >> 1) : i; u.seg = (nseg == 2) ? (i & 1) : 0;
        if (cs < nNs) { if (ti == 1) { u.pm = P.nM; u.pn = cs; return true; } if (ti > 1) --ti; }
        Unit t; if (!P.next(ti, t)) return false; u.pm = t.pm; u.pn = t.pn; return true;
    }
};
struct DynOrder {
    unsigned* q8; int nMp, nN, xcd, nseg; PG8_LAS int* box; unsigned tk;
    __device__ __forceinline__ void init(unsigned* q8_, int Mp, int N, int nseg_, PG8_LAS int* box_) { xcd = (int)(__builtin_amdgcn_s_getreg((3 << 11) | 20) & 7u); q8 = q8_; nMp = Mp / BM; nN = N / BM; nseg = nseg_; box = box_; tk = 0u; }
    __device__ __forceinline__ unsigned draw(int cls) const { return __hip_atomic_fetch_add(q8 + 64 * cls, 1u, __ATOMIC_RELAXED, __HIP_MEMORY_SCOPE_AGENT); }
    __device__ __forceinline__ bool map(int cls, unsigned t, int& pm, int& pn) const {
        const int ns = (nN - cls + 7) >> 3, q = nMp * nN / NXCD, ti = (int)t;
        if (ti < ns) { pm = nMp; pn = cls + 8 * ti; return true; }
        if (ti - ns < q) { const int wgid = cls * q + (ti - ns), nig = WGM * nN, gid = wgid / nig, fm = gid * WGM, gsz = (nMp - fm) < WGM ? (nMp - fm) : WGM; pm = fm + ((wgid % nig) % gsz); pn = (wgid % nig) / gsz; return true; }
        return false;
    }
    __device__ __forceinline__ void put(int slot, unsigned t, int seg) const {
        int pm = 0, pn = 0; bool valid = map(xcd, t, pm, pn);
        for (int k = 1; k < NXCD && !valid; ++k) { const int cls = (xcd + k) & 7; valid = map(cls, draw(cls), pm, pn); }
        box[4 * slot + 0] = pm; box[4 * slot + 1] = pn; box[4 * slot + 2] = seg; box[4 * slot + 3] = valid ? 1 : 0;
    }
    __device__ __forceinline__ bool get(int slot, Unit& u) const { u.pm = box[4 * slot]; u.pn = box[4 * slot + 1]; u.seg = box[4 * slot + 2]; return box[4 * slot + 3] != 0; }
    __device__ __forceinline__ bool first(Unit& u) {
        __syncthreads();
        if (threadIdx.x == 0) {
            put(0, draw(xcd), 0);
            if (nseg == 2) { box[4] = box[0]; box[5] = box[1]; box[6] = 1; box[7] = box[3]; } else put(1, draw(xcd), 0);
        }
        __syncthreads();
        return get(0, u);
    }
    __device__ __forceinline__ bool peek_next(int ui, Unit& u) const { return get((ui + 1) & 1, u); }
    __device__ __forceinline__ void pull(int ui, int wid) {
        if (wid == 0 && (threadIdx.x & 63) == 0 && (nseg == 1 || (ui & 1) == 0)) tk = draw(xcd);
    }
    __device__ __forceinline__ void commit(int ui, int wid) {
        if (wid == 0 && (threadIdx.x & 63) == 0) {
            if (nseg == 1 || (ui & 1) == 0) put(ui & 1, tk, 0);
            else { const int o = (ui + 1) & 1, d = ui & 1; box[4 * d] = box[4 * o]; box[4 * d + 1] = box[4 * o + 1]; box[4 * d + 2] = 1; box[4 * d + 3] = box[4 * o + 3]; }
        }
    }
};
struct Dep {
    unsigned* wait_cnt; unsigned need;
    unsigned* wait_tot; unsigned need_tot;
    unsigned* guard; unsigned need_guard;
    unsigned* done_cnt; unsigned* done_tot;
    unsigned* tmo;
};
#define PG8_SPIN_CAP (1u << 16)
__device__ __forceinline__ void dep_wait(const Dep& D, int pm, int wid, int& flags) {
    if (D.wait_cnt == nullptr) return;
    if (wid == 0 && (flags & 1) == 0) {
        unsigned spins = 0;
        for (;;) {
            const unsigned c0 = __hip_atomic_load(D.wait_cnt + 64 * pm, __ATOMIC_RELAXED, __HIP_MEMORY_SCOPE_AGENT);
            const unsigned t0 = __hip_atomic_load(D.wait_tot, __ATOMIC_RELAXED, __HIP_MEMORY_SCOPE_AGENT);
            const unsigned g0 = (D.guard != nullptr && (flags & 2) == 0) ? __hip_atomic_load(D.guard, __ATOMIC_RELAXED, __HIP_MEMORY_SCOPE_AGENT) : D.need_guard;
            const unsigned c = (unsigned)__builtin_amdgcn_readfirstlane(c0), t = (unsigned)__builtin_amdgcn_readfirstlane(t0), gg = (unsigned)__builtin_amdgcn_readfirstlane(g0);
            if (gg >= D.need_guard) flags |= 2;
            if (t >= D.need_tot && (flags & 2)) { flags |= 1; break; }
            if (c >= D.need && (flags & 2)) break;
            if (++spins > PG8_SPIN_CAP || ((spins & 63u) == 0u && __builtin_amdgcn_readfirstlane(__hip_atomic_load(D.tmo, __ATOMIC_RELAXED, __HIP_MEMORY_SCOPE_AGENT)) != 0u)) { if ((threadIdx.x & 63) == 0) __hip_atomic_store(D.tmo, 1u, __ATOMIC_RELAXED, __HIP_MEMORY_SCOPE_AGENT); break; }
            __builtin_amdgcn_s_sleep(4);
        }
    }
    asm volatile("" ::: "memory"); __builtin_amdgcn_s_barrier(); asm volatile("" ::: "memory");
}
__device__ __forceinline__ void dep_done(const Dep& D, int pm, int lane) {
    if (D.done_cnt != nullptr && lane == 0) __hip_atomic_fetch_add(D.done_cnt + 64 * pm, 1u, __ATOMIC_RELAXED, __HIP_MEMORY_SCOPE_AGENT);
}

template <class Epi, class Sched, int AUXA>
__device__ __forceinline__ void gemm_phase(PG8_LAS unsigned char* lds, const Gemm g, Sched& S, const Epi& E, const Dep D) {
    const int tid = threadIdx.x, wid = __builtin_amdgcn_readfirstlane(tid >> 6), lane = tid & 63, wr = wid >> 2, wc = wid & 3, fr = lane & 15, fq = lane >> 4;
    const int K = g.K, nt = K / BK;
    unsigned voffA[2], voffB[2];
#pragma unroll
    for (int i = 0; i < 2; ++i) { int R, C; stage_rc(tid * 16 + i * 8192, R, C); const int Rb = Epi::PERM ? ((R & ~31) + perm32(R & 31)) : R;
        voffA[i] = (unsigned)(R * K + C) * 2u; voffB[i] = (unsigned)(Rb * K + C) * 2u; }
    const size_t kstep = (size_t)(BK * 2);
    const size_t hstep = (size_t)HALF * K * 2;
    const size_t tstep = 2 * hstep;
    const unsigned ldsw = (unsigned)wid * 1024u;
    const int aoff = lds_byte(wr * 64 + fr, fq * 8), boff = lds_byte(wc * 32 + fr, fq * 8);
#define PG8_SA(b, h) (((b) * 2 + (h)) * HTB)
#define PG8_SB(b, h) ((4 + (b) * 2 + (h)) * HTB)
#define PG8_STAGE(bufoff, gbase, voff) do { _Pragma("unroll") for (int _i = 0; _i < 2; ++_i) \
        __builtin_amdgcn_global_load_lds((const unsigned*)((const char*)(gbase) + (voff)[_i]), (PG8_LAS unsigned*)(lds + (bufoff) + ldsw + _i * 8192), 16, 0, 0); } while (0)
#define PG8_STAGEA(bufoff, gbase, voff) do { _Pragma("unroll") for (int _i = 0; _i < 2; ++_i) \
        __builtin_amdgcn_global_load_lds((const unsigned*)((const char*)(gbase) + (voff)[_i]), (PG8_LAS unsigned*)(lds + (bufoff) + ldsw + _i * 8192), 16, 0, AUXA); } while (0)
#define PG8_LDA(dst, b, h) do { _Pragma("unroll") for (int m = 0; m < 4; ++m) _Pragma("unroll") for (int k = 0; k < 2; ++k) dst[m][k] = *(const PG8_LAS bf16x8*)(lds + PG8_SA(b, h) + aoff + m * 2048 + k * 1024); } while (0)
#define PG8_LDB(dst, b, h) do { _Pragma("unroll") for (int n = 0; n < 2; ++n) _Pragma("unroll") for (int k = 0; k < 2; ++k) dst[n][k] = *(const PG8_LAS bf16x8*)(lds + PG8_SB(b, h) + boff + n * 2048 + k * 1024); } while (0)
#define PG8_MMA(ai, bj, At, Bt) do { __builtin_amdgcn_s_setprio(1); _Pragma("unroll") for (int m = 0; m < 4; ++m) _Pragma("unroll") for (int n = 0; n < 2; ++n) _Pragma("unroll") for (int k = 0; k < 2; ++k) \
        acc[ai][bj][m][n] = __builtin_amdgcn_mfma_f32_16x16x32_bf16(Bt[n][k], At[m][k], acc[ai][bj][m][n], 0, 0, 0); __builtin_amdgcn_s_setprio(0); } while (0)
#define PG8_WAIT_V(n) asm volatile("s_waitcnt vmcnt(" #n ")" ::: "memory")
#define PG8_WAIT_L(n) asm volatile("s_waitcnt lgkmcnt(" #n ")" ::: "memory")
#define PG8_BAR __builtin_amdgcn_s_barrier()
#define PG8_SCHED __builtin_amdgcn_sched_barrier(0)
    Unit cur, nxt; int ui = 0;
    if (!S.first(cur)) { if (D.done_tot != nullptr && tid == 0) __hip_atomic_fetch_add(D.done_tot, 1u, __ATOMIC_RELAXED, __HIP_MEMORY_SCOPE_AGENT); return; }
    f32x4 acc[2][2][4][2];
#pragma unroll
    for (int a = 0; a < 2; ++a)
#pragma unroll
        for (int b = 0; b < 2; ++b)
#pragma unroll
            for (int m = 0; m < 4; ++m)
#pragma unroll
                for (int n = 0; n < 2; ++n) acc[a][b][m][n] = (f32x4){0.f, 0.f, 0.f, 0.f};
    bf16x8 At[4][2], B0[2][2], B1[2][2];
    const char* cA = (const char*)(cur.seg ? g.A1 : g.A0) + (size_t)cur.pm * tstep; const char* cB = (const char*)(cur.seg ? g.B1 : g.B0) + (size_t)cur.pn * tstep;
    int dflags = 0, pend = -1;
    dep_wait(D, cur.pm, wid, dflags);
    PG8_STAGE(PG8_SB(0, 0), cB, voffB); PG8_STAGE(PG8_SB(0, 1), cB + hstep, voffB); PG8_STAGEA(PG8_SA(0, 0), cA, voffA); PG8_STAGEA(PG8_SA(0, 1), cA + hstep, voffA);
    if (wr == 1) PG8_BAR;
    PG8_WAIT_V(2); PG8_BAR;
    PG8_STAGE(PG8_SB(1, 0), cB + kstep, voffB); PG8_STAGEA(PG8_SA(1, 0), cA + kstep, voffA); PG8_STAGE(PG8_SB(1, 1), cB + hstep + kstep, voffB);
    PG8_WAIT_V(6); PG8_BAR;
    for (;;) {
        bool has_next = false; const char* nA = cA; const char* nB = cB;
#define PG8_TRIP(a1, a2, b2, a3, b3) do { asm volatile("" : "+v"(voffA[0]), "+v"(voffA[1]), "+v"(voffB[0]), "+v"(voffB[1])); \
            PG8_LDB(B0, 0, 0); PG8_LDB(B1, 0, 1); PG8_SCHED; PG8_LDA(At, 0, 0); PG8_STAGEA(PG8_SA(1, 1), (a1) + hstep, voffA); \
            PG8_WAIT_V(8); PG8_WAIT_L(0); PG8_BAR; PG8_MMA(0, 0, At, B0); PG8_MMA(0, 1, At, B1); PG8_BAR; PG8_SCHED; \
            PG8_LDA(At, 0, 1); PG8_STAGE(PG8_SB(0, 0), (b2), voffB); PG8_STAGE(PG8_SB(0, 1), (b2) + hstep, voffB); PG8_STAGEA(PG8_SA(0, 0), (a2), voffA); \
            PG8_WAIT_V(8); PG8_WAIT_L(0); PG8_BAR; PG8_MMA(1, 0, At, B0); PG8_MMA(1, 1, At, B1); PG8_BAR; PG8_SCHED; \
            PG8_LDB(B0, 1, 0); PG8_LDB(B1, 1, 1); PG8_SCHED; PG8_LDA(At, 1, 0); PG8_STAGEA(PG8_SA(0, 1), (a2) + hstep, voffA); \
            PG8_WAIT_V(8); PG8_WAIT_L(0); PG8_BAR; PG8_MMA(0, 0, At, B0); PG8_MMA(0, 1, At, B1); PG8_BAR; PG8_SCHED; \
            PG8_LDA(At, 1, 1); PG8_STAGE(PG8_SB(1, 0), (b3), voffB); PG8_STAGE(PG8_SB(1, 1), (b3) + hstep, voffB); PG8_STAGEA(PG8_SA(1, 0), (a3), voffA); \
            PG8_WAIT_V(8); PG8_WAIT_L(0); PG8_BAR; PG8_MMA(1, 0, At, B0); PG8_MMA(1, 1, At, B1); PG8_BAR; PG8_SCHED; } while (0)
        {
            const char* a1 = cA + kstep; const char* a2 = cA + 2 * kstep; const char* b2 = cB + 2 * kstep; const char* a3 = a2 + kstep; const char* b3 = b2 + kstep;
            PG8_TRIP(a1, a2, b2, a3, b3);
            if (pend >= 0) { dep_done(D, pend, lane); pend = -1; }
        }
        for (int t = 2; t < nt - 2; t += 2) {
            const char* a1 = cA + (size_t)(t + 1) * kstep; const char* a2 = cA + (size_t)(t + 2) * kstep; const char* b2 = cB + (size_t)(t + 2) * kstep; const char* a3 = a2 + kstep; const char* b3 = b2 + kstep;
            PG8_TRIP(a1, a2, b2, a3, b3);
        }
        {
            has_next = S.peek_next(ui, nxt);
            if (has_next) { nA = (const char*)(nxt.seg ? g.A1 : g.A0) + (size_t)nxt.pm * tstep; nB = (const char*)(nxt.seg ? g.B1 : g.B0) + (size_t)nxt.pn * tstep; dep_wait(D, nxt.pm, wid, dflags); }
            const char* a1 = cA + (size_t)(nt - 1) * kstep; const char* a2 = nA; const char* b2 = nB; const char* a3 = a2 + kstep; const char* b3 = b2 + kstep;
            PG8_TRIP(a1, a2, b2, a3, b3);
        }
#undef PG8_TRIP
        if (wr == 0) PG8_BAR;
        S.pull(ui, wid);
        const bool keep = E(acc, cur, wr, wc, fr, fq);
        S.commit(ui, wid);
        if (!keep) pend = cur.pm;
        if (!has_next) break;
        if (!keep) {
#pragma unroll
        for (int a = 0; a < 2; ++a)
#pragma unroll
            for (int b = 0; b < 2; ++b)
#pragma unroll
                for (int m = 0; m < 4; ++m)
#pragma unroll
                    for (int n = 0; n < 2; ++n) acc[a][b][m][n] = (f32x4){0.f, 0.f, 0.f, 0.f};
        }
        cur = nxt; cA = nA; cB = nB; ++ui;
        if (wr == 1) PG8_BAR;
    }
    PG8_WAIT_V(0);
    if (pend >= 0) dep_done(D, pend, lane);
    PG8_BAR;
    if (D.done_tot != nullptr && tid == 0) __hip_atomic_fetch_add(D.done_tot, 1u, __ATOMIC_RELAXED, __HIP_MEMORY_SCOPE_AGENT);
#undef PG8_STAGEA
#undef PG8_SA
#undef PG8_SB
#undef PG8_STAGE
#undef PG8_LDA
#undef PG8_LDB
#undef PG8_MMA
#undef PG8_WAIT_V
#undef PG8_WAIT_L
#undef PG8_BAR
#undef PG8_SCHED
}
}

constexpr int DM = 1024, NB = 16, SEQ = 4096, DECS = 16, NKV = 4, HD = 64, KVW = 256, INW = 5632, DFF = 2816;
constexpr int MP = NB * SEQ, MS = NB * DECS, MT = MP + MS;
constexpr float EPS = 1e-6f, LOG2E = 1.4426950408889634f, QSCALE = 0.125f * LOG2E;
constexpr size_t O_YP = 0, O_YS = (size_t)MP * DM, O_KP = O_YS + (size_t)MS * DM, O_VP = O_KP + 524288, O_KS = O_VP + 524288, O_VS = O_KS + 524288, O_GS = O_VS + 524288, O_END = O_GS + (size_t)MS * DM;

constexpr size_t MiB = 1u << 20;
constexpr size_t WS_CTL = 0, CTL_ZERO_BYTES = 1 * MiB;
constexpr size_t WS_WIN = 1 * MiB, WS_WFI = 12 * MiB, WS_WA = 23 * MiB, WS_WG = 25 * MiB, WS_WO = 27 * MiB, WS_WFO = 29 * MiB;
constexpr size_t WS_WSB = 34 * MiB + 768 * 1024;
constexpr size_t WS_RSTD1 = 35 * MiB, WS_RSTD2 = 36 * MiB, WS_PMIX = 37 * MiB, WS_PF = 42 * MiB;
constexpr size_t ACTB = (size_t)MT * DM * 2;
constexpr size_t WS_R0 = 48 * MiB;
constexpr size_t WS_R1 = 177 * MiB;
constexpr size_t WS_R2 = 306 * MiB;
constexpr size_t WS_KB = 435 * MiB, WS_VB = 468 * MiB;
constexpr size_t WS_R3 = 501 * MiB;
constexpr size_t WS_SA = WS_R3, WS_SB = WS_R3 + ACTB, WS_U = WS_R3 + 2 * ACTB, WS_AO = WS_R3 + 3 * ACTB, WS_END = WS_AO + ACTB;
static_assert(WS_END <= 1024 * MiB && (size_t)MT * DFF * 2 <= 3 * ACTB && WS_R0 + ACTB <= WS_R1 && WS_R1 + ACTB <= WS_R2 && WS_R2 + ACTB <= WS_KB, "d_ws map");
constexpr int CW_BAR = 4096, CW_TMO = 64;
constexpr int CW_CNT = 16384;
constexpr int CW_TOT = CW_CNT + 5 * 264 * 64;
constexpr int CW_C0 = CW_TOT + 8 * 64;
constexpr int CW_Q = CW_C0 + 264 * 64;
constexpr int CW_C1 = CW_Q + 9 * 8 * 64, CW_C2 = CW_C1 + 264 * 64, CW_CS = CW_C2 + 264 * 64;
static_assert((CW_CS + 64) * 4 <= 768 * 1024, "CTL words inside the memset region, below the probe stamps");

constexpr int RING_BYTES = 131072, LDS_BYTES = 147456, LDSCTL_OFF = LDS_BYTES - 512, MISC_OFF = LDSCTL_OFF + 320;
constexpr int NWAVES = 8, BOX_OFF = LDSCTL_OFF + 64;

#define GAS __attribute__((address_space(1)))
#define LAS __attribute__((address_space(3)))
typedef unsigned short bf16;
typedef unsigned v4u __attribute__((ext_vector_type(4)));
typedef unsigned v2u __attribute__((ext_vector_type(2)));
typedef float f32x4 __attribute__((ext_vector_type(4)));
typedef GAS unsigned gu32;
#define RLX_AGENT __ATOMIC_RELAXED, __HIP_MEMORY_SCOPE_AGENT
#define LDS_WAIT() asm volatile("s_waitcnt lgkmcnt(0)" ::: "memory")
typedef float f32x2_t __attribute__((ext_vector_type(2))); typedef __bf16 bf16x2_t __attribute__((ext_vector_type(2)));
__device__ __forceinline__ unsigned pk2(float lo, float hi) { f32x2_t v = {lo, hi}; bf16x2_t b = __builtin_convertvector(v, bf16x2_t); return __builtin_bit_cast(unsigned, b); }
__device__ __forceinline__ float bflo(unsigned w) { return __uint_as_float(w << 16); }
__device__ __forceinline__ float bfhi(unsigned w) { return __uint_as_float(w & 0xffff0000u); }
__device__ __forceinline__ float wave_sum(float v) {
#pragma unroll
    for (int o = 1; o < 64; o <<= 1) v += __shfl_xor(v, o);
    return v;
}
__device__ __forceinline__ float gelu_tanh(float x) {
    const float e = __builtin_amdgcn_exp2f(x * (-2.302208198f - 0.10294324f * x * x));
    return x * __builtin_amdgcn_rcpf(1.0f + e);
}
__device__ __forceinline__ float sigmoidf_(float x) { return __builtin_amdgcn_rcpf(1.0f + __builtin_amdgcn_exp2f(-LOG2E * x)); }

#define XB_TMO      128
#define XB_XCNT(j)  (256  + 64 * (j))
#define XB_XSUB(j)  (1280 + 64 * (j))
#define XB_XGEN(j)  (2304 + 64 * (j))
#define XB_TOP      3328
#define XB_TOPGEN   3392
#define XCD_BAR_WORDS 3456
#define XB_SPIN_CAP (1u << 18)
__device__ __forceinline__ unsigned xb_ld(unsigned* p)              { return __hip_atomic_load(p, __ATOMIC_RELAXED, __HIP_MEMORY_SCOPE_AGENT); }
__device__ __forceinline__ unsigned xb_add(unsigned* p, unsigned v) { return __hip_atomic_fetch_add(p, v, __ATOMIC_RELAXED, __HIP_MEMORY_SCOPE_AGENT); }
__device__ __forceinline__ unsigned xb_xcc_id() { return (unsigned)__builtin_amdgcn_s_getreg((3 << 11) | 20) & 0xFu; }
#define XB_SPIN(cond, bar) do { unsigned _sp = 0; while (cond) { __builtin_amdgcn_s_sleep(1); \
    if ((++_sp & 255u) == 0u) { if (xb_ld(&(bar)[XB_TMO])) break; if (_sp > XB_SPIN_CAP) { atomicAdd(&(bar)[XB_TMO], 1u); break; } } } } while (0)
struct XcdBarrier { unsigned* bar; unsigned x; volatile LAS unsigned* st; };
__device__ __forceinline__ XcdBarrier xcd_barrier_post(unsigned* bar, volatile LAS unsigned* st) {
    XcdBarrier b; b.bar = bar; b.x = xb_xcc_id(); b.st = st;
    if (threadIdx.x == 0) (void)xb_add(&bar[XB_XCNT(b.x)], 1u);
    return b;
}
__device__ __forceinline__ void xcd_barrier_complete(unsigned* bar, unsigned x, unsigned& nloc, unsigned& nx) {
    const unsigned G = gridDim.x * gridDim.y * gridDim.z;
    unsigned sum, cnt, mine, sp = 0u;
    for (;;) {
        sum = 0u; cnt = 0u; mine = 0u;
#pragma unroll
        for (unsigned j = 0; j < 16; ++j) { const unsigned c = xb_ld(&bar[XB_XCNT(j)]); sum += c; cnt += (c > 0u) ? 1u : 0u; mine = (j == x) ? c : mine; }
        if (sum == G) break;
        __builtin_amdgcn_s_sleep(1);
        if ((++sp & 255u) == 0u) { if (xb_ld(&bar[XB_TMO])) break; if (sp > XB_SPIN_CAP) { atomicAdd(&bar[XB_TMO], 1u); break; } }
    }
    nloc = mine > 0u ? mine : 1u; nx = cnt > 0u ? cnt : 1u;
}
__device__ __forceinline__ void xcd_barrier(const XcdBarrier& b) {
    asm volatile("s_waitcnt vmcnt(0)" ::: "memory");
    __syncthreads();
    if (threadIdx.x == 0) {
        unsigned* bar = b.bar;
        __builtin_amdgcn_s_waitcnt(0);
        unsigned nloc = b.st[0], nx = b.st[1];
        if (nloc == 0u) { xcd_barrier_complete(bar, b.x, nloc, nx); b.st[0] = nloc; b.st[1] = nx; }
        const unsigned old = xb_add(&bar[XB_XSUB(b.x)], 1u);
        const unsigned gen = old / nloc;
        if (old + 1u == (gen + 1u) * nloc) {
            __builtin_amdgcn_fence(__ATOMIC_RELEASE, "agent");
            asm volatile("s_waitcnt vmcnt(0)" ::: "memory");
            const unsigned og = xb_add(&bar[XB_TOP], 1u);
            const unsigned tg = og / nx;
            if (og + 1u == (tg + 1u) * nx) xb_add(&bar[XB_TOPGEN], 1u);
            else XB_SPIN(xb_ld(&bar[XB_TOPGEN]) == tg, bar);
            __builtin_amdgcn_fence(__ATOMIC_ACQUIRE, "agent");
            xb_add(&bar[XB_XGEN(b.x)], 1u);
            asm volatile("s_waitcnt vmcnt(0)" ::: "memory");
        } else {
            XB_SPIN(xb_ld(&bar[XB_XGEN(b.x)]) == gen, bar);
            __builtin_amdgcn_fence(__ATOMIC_ACQUIRE, "agent");
            asm volatile("s_waitcnt vmcnt(0)" ::: "memory");
        }
    }
    __syncthreads();
}

typedef __amdgpu_buffer_rsrc_t rsrc_t;
__device__ __forceinline__ rsrc_t mk_rsrc(const void* p) { return __builtin_amdgcn_make_buffer_rsrc((void*)p, 0, 0x7fffffff, 0x00020000); }
__device__ __forceinline__ void st16_wt(rsrc_t r, size_t byte_off, v4u v) { __builtin_amdgcn_raw_buffer_store_b128(v, r, (int)byte_off, 0, 16); }
__device__ __forceinline__ v4u ld16_nc(rsrc_t r, size_t byte_off) { return __builtin_amdgcn_raw_buffer_load_b128(r, (int)byte_off, 0, 16); }
__device__ __forceinline__ void stf_wt(float* p, float v) { __hip_atomic_store((unsigned*)p, __float_as_uint(v), __ATOMIC_RELAXED, __HIP_MEMORY_SCOPE_AGENT); }
__device__ __forceinline__ float ldf_nc(const float* p) { return __uint_as_float(__hip_atomic_load((const unsigned*)p, __ATOMIC_RELAXED, __HIP_MEMORY_SCOPE_AGENT)); }

using pg8::Unit;
struct EpiIn {
    static constexpr bool PERM = true;
    const float* rstd; bf16 *Q, *Kb, *Vb, *U, *GV, *SA, *SB; float* out; float *PG1, *PG2;
    __device__ __forceinline__ bool operator()(f32x4 (&acc)[2][2][4][2], const Unit& u, int wr, int wc, int fr, int fq) const {
        const int pn = u.pn; int mode, ld, colt; bf16* dst; float* side = nullptr; size_t side_s = 0;
        if (pn < 4)       { mode = 0; dst = Q;  ld = DM;  colt = pn * 256; }
        else if (pn == 4) { mode = 1; dst = Kb; ld = KVW; colt = 0; side = out + O_KP; side_s = O_KS - O_KP; }
        else if (pn == 5) { mode = 1; dst = Vb; ld = KVW; colt = 0; side = out + O_VP; side_s = O_VS - O_VP; }
        else if (pn < 10) { mode = 2; dst = U;  ld = DM;  colt = (pn - 6) * 256; }
        else if (pn < 14) { mode = 2; dst = GV; ld = DM;  colt = (pn - 10) * 256; }
        else if (pn < 18) { mode = 3; dst = SA; ld = DM;  colt = (pn - 14) * 256; }
        else              { mode = 3; dst = SB; ld = DM;  colt = (pn - 18) * 256; }
        const int row0 = u.pm * 256 + wr * 64 + fr, col0 = colt + wc * 32 + 8 * fq; const rsrc_t rdst = mk_rsrc(dst);
        float rsv[2][4];
#pragma unroll
        for (int ai = 0; ai < 2; ++ai)
#pragma unroll
            for (int m = 0; m < 4; ++m) rsv[ai][m] = rstd[row0 + ai * 128 + m * 16];
#pragma unroll
        for (int ai = 0; ai < 2; ++ai)
#pragma unroll
            for (int m = 0; m < 4; ++m) {
                const int row = row0 + ai * 128 + m * 16; const float rs = rsv[ai][m]; float s1 = 0.f, s2 = 0.f;
#pragma unroll
                for (int bj = 0; bj < 2; ++bj) {
                    float v[8];
#pragma unroll
                    for (int j = 0; j < 4; ++j) { v[j] = acc[ai][bj][m][0][j] * rs; v[4 + j] = acc[ai][bj][m][1][j] * rs; }
                    if (mode == 0) {
#pragma unroll
                        for (int j = 0; j < 8; ++j) v[j] *= QSCALE;
                    } else if (mode == 2) {
#pragma unroll
                        for (int j = 0; j < 8; ++j) { v[j] = gelu_tanh(v[j]); s1 += v[j]; s2 += v[j] * v[j]; }
                    } else if (mode == 3) {
#pragma unroll
                        for (int j = 0; j < 8; ++j) v[j] = sigmoidf_(v[j]);
                    }
                    const int col = col0 + bj * 128;
                    v4u w; w.x = pk2(v[0], v[1]); w.y = pk2(v[2], v[3]); w.z = pk2(v[4], v[5]); w.w = pk2(v[6], v[7]);
                    st16_wt(rdst, ((size_t)row * ld + col) * 2, w);
                    if (mode == 1) {
                        float* sp = nullptr;
                        if (u.pm == 256) { const int r = row - MP; sp = side + side_s + ((size_t)((r >> 4) * 128 + 112 + (r & 15)) * KVW + col); }
                        else if ((u.pm & 15) == 15 && ai == 1) { const int j = wr * 64 + m * 16 + fr; sp = side + ((size_t)((u.pm >> 4) * 128 + j) * KVW + col); }
                        if (sp) { *(f32x4*)sp = (f32x4){v[0], v[1], v[2], v[3]}; *(f32x4*)(sp + 4) = (f32x4){v[4], v[5], v[6], v[7]}; }
                    }
                }
                if (pn >= 10 && pn < 14) {
                    s1 += __shfl_xor(s1, 16); s1 += __shfl_xor(s1, 32); s2 += __shfl_xor(s2, 16); s2 += __shfl_xor(s2, 32);
                    if (fq == 0) { const size_t si = (size_t)((pn - 10) * 4 + wc) * MT + row; stf_wt(PG1 + si, s1); stf_wt(PG2 + si, s2); }
                }
            }
        return false;
    }
};
struct EpiMerge {
    static constexpr bool PERM = true;
    const bf16 *SA, *SB; bf16* O;
    __device__ __forceinline__ bool operator()(f32x4 (&acc)[2][2][4][2], const Unit& u, int wr, int wc, int fr, int fq) const {
        const int row0 = u.pm * 256 + wr * 64 + fr, col0 = u.pn * 256 + wc * 32 + 8 * fq; const rsrc_t ro = mk_rsrc(O);
        if (u.seg == 0) {
#pragma unroll
            for (int ai = 0; ai < 2; ++ai) {
                v4u sbw[4][2], saw[4][2];
#pragma unroll
                for (int m = 0; m < 4; ++m)
#pragma unroll
                    for (int bj = 0; bj < 2; ++bj) { const size_t off = (size_t)(row0 + ai * 128 + m * 16) * DM + col0 + bj * 128; sbw[m][bj] = *(const v4u*)(SB + off); saw[m][bj] = *(const v4u*)(SA + off); }
#pragma unroll
                for (int m = 0; m < 4; ++m)
#pragma unroll
                    for (int bj = 0; bj < 2; ++bj) { const v4u b = sbw[m][bj], a = saw[m][bj];
                        const float sb[8] = {bflo(b.x), bfhi(b.x), bflo(b.y), bfhi(b.y), bflo(b.z), bfhi(b.z), bflo(b.w), bfhi(b.w)}, sa[8] = {bflo(a.x), bfhi(a.x), bflo(a.y), bfhi(a.y), bflo(a.z), bfhi(a.z), bflo(a.w), bfhi(a.w)};
#pragma unroll
                        for (int j = 0; j < 4; ++j) { acc[ai][bj][m][0][j] *= sa[j] * __builtin_amdgcn_rcpf(fmaxf(sb[j], 1e-30f)); acc[ai][bj][m][1][j] *= sa[4 + j] * __builtin_amdgcn_rcpf(fmaxf(sb[4 + j], 1e-30f)); } }
            }
            return true;
        }
        v4u sbw[2][4][2];
#pragma unroll
        for (int ai = 0; ai < 2; ++ai)
#pragma unroll
            for (int m = 0; m < 4; ++m)
#pragma unroll
                for (int bj = 0; bj < 2; ++bj) sbw[ai][m][bj] = *(const v4u*)(SB + (size_t)(row0 + ai * 128 + m * 16) * DM + col0 + bj * 128);
#pragma unroll
        for (int ai = 0; ai < 2; ++ai)
#pragma unroll
            for (int m = 0; m < 4; ++m)
#pragma unroll
                for (int bj = 0; bj < 2; ++bj) { const size_t off = (size_t)(row0 + ai * 128 + m * 16) * DM + col0 + bj * 128; const v4u b = sbw[ai][m][bj];
                    const float sb[8] = {bflo(b.x), bfhi(b.x), bflo(b.y), bfhi(b.y), bflo(b.z), bfhi(b.z), bflo(b.w), bfhi(b.w)}; float v[8];
#pragma unroll
                    for (int j = 0; j < 4; ++j) { v[j] = acc[ai][bj][m][0][j] * fmaxf(sb[j], 1e-30f); v[4 + j] = acc[ai][bj][m][1][j] * fmaxf(sb[4 + j], 1e-30f); }
                    v4u w; w.x = pk2(v[0], v[1]); w.y = pk2(v[2], v[3]); w.z = pk2(v[4], v[5]); w.w = pk2(v[6], v[7]);
                    st16_wt(ro, off * 2, w); }
        return false;
    }
};
struct EpiBf16Ss {
    static constexpr bool PERM = true;
    bf16* O; float* P;
    __device__ __forceinline__ bool operator()(f32x4 (&acc)[2][2][4][2], const Unit& u, int wr, int wc, int fr, int fq) const {
        const int row0 = u.pm * 256 + wr * 64 + fr, col0 = u.pn * 256 + wc * 32 + 8 * fq; const rsrc_t ro = mk_rsrc(O);
#pragma unroll
        for (int ai = 0; ai < 2; ++ai)
#pragma unroll
            for (int m = 0; m < 4; ++m) {
                const int row = row0 + ai * 128 + m * 16; float ss = 0.f;
#pragma unroll
                for (int bj = 0; bj < 2; ++bj) {
                    const f32x4 a = acc[ai][bj][m][0], b = acc[ai][bj][m][1];
                    ss += (a[0] * a[0] + a[1] * a[1]) + (a[2] * a[2] + a[3] * a[3]) + (b[0] * b[0] + b[1] * b[1]) + (b[2] * b[2] + b[3] * b[3]);
                    v4u w; w.x = pk2(a[0], a[1]); w.y = pk2(a[2], a[3]); w.z = pk2(b[0], b[1]); w.w = pk2(b[2], b[3]);
                    st16_wt(ro, ((size_t)row * DM + col0 + bj * 128) * 2, w);
                }
                ss += __shfl_xor(ss, 16); ss += __shfl_xor(ss, 32);
                if (fq == 0) stf_wt(P + (size_t)(u.pn * 4 + wc) * MT + row, ss);
            }
        return false;
    }
};
struct EpiSwiglu {
    static constexpr bool PERM = true;
    const float* rstd; bf16* O;
    __device__ __forceinline__ bool operator()(f32x4 (&acc)[2][2][4][2], const Unit& u, int wr, int wc, int fr, int fq) const {
        const int row0 = u.pm * 256 + wr * 64 + fr, col0 = u.pn * 128 + wc * 32 + 8 * fq; const rsrc_t ro = mk_rsrc(O);
        float rsv[2][4];
#pragma unroll
        for (int ai = 0; ai < 2; ++ai)
#pragma unroll
            for (int m = 0; m < 4; ++m) rsv[ai][m] = rstd[row0 + ai * 128 + m * 16];
#pragma unroll
        for (int ai = 0; ai < 2; ++ai)
#pragma unroll
            for (int m = 0; m < 4; ++m) {
                const int row = row0 + ai * 128 + m * 16; const float rs = rsv[ai][m]; float v[8];
#pragma unroll
                for (int n = 0; n < 2; ++n)
#pragma unroll
                    for (int j = 0; j < 4; ++j) { const float gg = acc[ai][0][m][n][j] * rs, up = acc[ai][1][m][n][j] * rs; v[4 * n + j] = gg * sigmoidf_(gg) * up; }
                v4u w; w.x = pk2(v[0], v[1]); w.y = pk2(v[2], v[3]); w.z = pk2(v[4], v[5]); w.w = pk2(v[6], v[7]);
                st16_wt(ro, ((size_t)row * DFF + col0) * 2, w);
            }
        return false;
    }
};

template <bool MAP>
__device__ __forceinline__ void p0_transpose_item(const float* W, int K, int N, const float* gain, bf16* WT, LAS float* scr, int item, int lane) {
    const int nblk = N / 32, kb = item / nblk, nb = item % nblk, k0 = 64 * kb, n0 = 32 * nb;
    f32x4 ld[8]; float gk[8];
#pragma unroll
    for (int i = 0; i < 8; ++i) { const int kk = (lane >> 3) + 8 * i; ld[i] = *(const f32x4*)(W + (size_t)(k0 + kk) * N + n0 + (lane & 7) * 4); gk[i] = gain ? gain[k0 + kk] : 1.0f; }
#pragma unroll
    for (int i = 0; i < 8; ++i) { const int kk = (lane >> 3) + 8 * i; LAS float* d = scr + kk * 33 + (lane & 7) * 4; d[0] = ld[i].x * gk[i]; d[1] = ld[i].y * gk[i]; d[2] = ld[i].z * gk[i]; d[3] = ld[i].w * gk[i]; }
    LDS_WAIT(); asm volatile("" ::: "memory");
    const int c = lane & 7;
#pragma unroll
    for (int j = 0; j < 4; ++j) { const int n = (lane >> 3) + 8 * j; const LAS float* s = scr + (8 * c) * 33 + n;
        v4u o; o.x = pk2(s[0 * 33], s[1 * 33]); o.y = pk2(s[2 * 33], s[3 * 33]); o.z = pk2(s[4 * 33], s[5 * 33]); o.w = pk2(s[6 * 33], s[7 * 33]);
        int nn = n0 + n;
        if (MAP) { const int hi = nn >= DFF ? 1 : 0, r = nn - hi * DFF; nn = 256 * (r >> 7) + 128 * hi + (r & 127); }
        *(GAS v4u*)(WT + (size_t)nn * K + k0 + 8 * c) = o; }
    LDS_WAIT(); asm volatile("" ::: "memory");
}

namespace att {
typedef short bf16x8 __attribute__((ext_vector_type(8)));
typedef short s16x4 __attribute__((ext_vector_type(4)));
typedef short v4i16_t __attribute__((ext_vector_type(4)));
typedef float f32x16 __attribute__((ext_vector_type(16)));
typedef LAS const char* lds_cptr;
constexpr int SLOT = 16384, OST = 4 * SLOT, OSTW = 32 * 72 * 2;
__device__ __forceinline__ int crow(int r, int hi) { return (r & 3) + 8 * (r >> 2) + 4 * hi; }
__device__ __forceinline__ s16x4 vtr(lds_cptr p) { return __builtin_bit_cast(s16x4, __builtin_amdgcn_ds_read_tr16_b64_v4i16((LAS v4i16_t*)p)); }
struct TileRegs { v4u k, v; };
__device__ __forceinline__ TileRegs load_tile(const bf16* KB, const bf16* VB, size_t rowbase, int kvh, int wid, int lane) {
    TileRegs t;
    t.k = *(const v4u*)(KB + (rowbase + lane) * KVW + kvh * HD + wid * 8);
    t.v = *(const v4u*)(VB + (rowbase + 16 * (wid & 3) + (lane >> 2)) * KVW + kvh * HD + (wid >> 2) * 32 + (lane & 3) * 8);
    return t;
}
__device__ __forceinline__ void store_tile(LAS unsigned char* slot, const TileRegs& t, int wid, int lane) {
    *(LAS v4u*)(slot + wid * 1024 + lane * 16) = t.k;
    *(LAS v4u*)(slot + 8192 + wid * 1024 + lane * 16) = t.v;
}
struct QFrag { bf16x8 q[4]; };
template <bool SAMPLE>
__device__ __forceinline__ QFrag load_q(const bf16* QO, size_t qrow0, int kvh, int wid, int lane) {
    const int r32 = lane & 31, hi = lane >> 5, posb = 32 * (wid & 1), head = kvh * 4 + (wid >> 1);
    const size_t qrow = SAMPLE ? qrow0 + ((posb + r32) & 15) : qrow0 + posb + r32;
    const bf16* qp = QO + qrow * DM + head * HD; QFrag f;
#pragma unroll
    for (int d0 = 0; d0 < 4; ++d0) f.q[d0] = *(const bf16x8*)(qp + d0 * 16 + hi * 8);
    return f;
}
template <bool SAMPLE>
__device__ __forceinline__ void attn_unit(LAS unsigned char* lds, int s0, int s1, int s2, int ft, const QFrag& qf, bf16* AO, size_t qrow0, int kvh, const float sink2, int wid, int lane) {
    const int r32 = lane & 31, hi = lane >> 5, g = wid >> 1, posb = 32 * (wid & 1), head = kvh * 4 + g;
    f32x16 p[6];
    lds_cptr kb0 = (lds_cptr)lds + s0 + hi * 1024 + r32 * 16, kb1 = (lds_cptr)lds + s1 + hi * 1024 + r32 * 16, kb2 = (lds_cptr)lds + s2 + hi * 1024 + r32 * 16;
#define ATT_KLD(i) (*(const LAS bf16x8*)(((i) >> 3) == 0 ? kb0 + (((i) >> 1) & 3) * 2048 + ((i) & 1) * 512 : ((i) >> 3) == 1 ? kb1 + (((i) >> 1) & 3) * 2048 + ((i) & 1) * 512 : kb2 + (((i) >> 1) & 3) * 2048 + ((i) & 1) * 512))
    bf16x8 kw[4];
#pragma unroll
    for (int i = 0; i < 4; ++i) kw[i] = ATT_KLD(i);
    float mt[3] = {-INFINITY, -INFINITY, sink2};
#pragma unroll
    for (int i = 0; i < 24; ++i) {
        const bf16x8 cur = kw[i & 3];
        if (i + 4 < 24) kw[i & 3] = ATT_KLD(i + 4);
        const int pi = 2 * (i >> 3) + (i & 1), d0 = (i >> 1) & 3;
        if (d0 == 0) p[pi] = __builtin_amdgcn_mfma_f32_32x32x16_bf16(cur, qf.q[0], (f32x16){}, 0, 0, 0);
        else         p[pi] = __builtin_amdgcn_mfma_f32_32x32x16_bf16(cur, qf.q[d0], p[pi], 0, 0, 0);
        if (!SAMPLE && i >= 8) { const int t = (i >> 3) - 1, r = 2 * (i & 7);
            mt[t] = fmaxf(fmaxf(mt[t], p[2 * t][r]), p[2 * t][r + 1]); mt[t] = fmaxf(fmaxf(mt[t], p[2 * t + 1][r]), p[2 * t + 1][r + 1]); }
        __builtin_amdgcn_sched_barrier(0);
    }
#undef ATT_KLD
    if (SAMPLE) {
#pragma unroll
        for (int r = 0; r < 16; ++r) { if (r >= 8) p[4][r] = -INFINITY; p[5][r] = -INFINITY; }
#pragma unroll
        for (int t = 0; t < 2; ++t)
#pragma unroll
            for (int r = 0; r < 16; ++r) mt[t] = fmaxf(fmaxf(mt[t], p[2 * t][r]), p[2 * t + 1][r]);
    }
#pragma unroll
    for (int r = 0; r < 16; ++r) mt[2] = fmaxf(fmaxf(mt[2], p[4][r]), p[5][r]);
    float mx = fmaxf(mt[2], fmaxf(ft > 0 ? -INFINITY : mt[0], ft > 1 ? -INFINITY : mt[1]));
    { auto rr = __builtin_amdgcn_permlane32_swap(__float_as_uint(mx), __float_as_uint(mx), false, false); mx = fmaxf(__uint_as_float(rr[0]), __uint_as_float(rr[1])); }
    const float mx0 = ft > 0 ? INFINITY : mx, mx1 = ft > 1 ? INFINITY : mx;
    float sum = 0.f;
    f32x16 o0 = {}, o1 = {};
    const int vb = ((lane >> 4) & 1) * 32 + (lane & 3) * 8 + (4 * hi + ((lane & 15) >> 2)) * 64;
    lds_cptr vp0 = (lds_cptr)lds + s0 + 8192 + vb, vp1 = (lds_cptr)lds + s1 + 8192 + vb, vp2 = (lds_cptr)lds + s2 + 8192 + vb;
#define ATT_VP(s) (((s) >> 2) == 0 ? vp0 : ((s) >> 2) == 1 ? vp1 : vp2)
#define ATT_EXP(s, j0) do { const int kb_ = 2 * ((s) >> 2) + (((s) & 3) >> 1), rb_ = 8 * ((s) & 1) + (j0); const float m_ = ((s) >> 2) == 0 ? mx0 : ((s) >> 2) == 1 ? mx1 : mx; \
        _Pragma("unroll") for (int j_ = 0; j_ < 4; ++j_) { const float e_ = __builtin_amdgcn_exp2f(p[kb_][rb_ + j_] - m_); p[kb_][rb_ + j_] = e_; sum += e_; } } while (0)
    s16x4 vw[2][4];
    { lds_cptr v = ATT_VP(0); vw[0][0] = vtr(v); vw[0][1] = vtr(v + 512); vw[0][2] = vtr(v + 4096); vw[0][3] = vtr(v + 4096 + 512); }
    ATT_EXP(0, 0); ATT_EXP(0, 4);
#pragma unroll
    for (int s = 0; s < 12; ++s) {
        const int kb = 2 * (s >> 2) + ((s & 3) >> 1), rb = 8 * (s & 1);
        v4u pw; pw.x = pk2(p[kb][rb + 0], p[kb][rb + 1]); pw.y = pk2(p[kb][rb + 2], p[kb][rb + 3]); pw.z = pk2(p[kb][rb + 4], p[kb][rb + 5]); pw.w = pk2(p[kb][rb + 6], p[kb][rb + 7]);
        const bf16x8 pa = __builtin_bit_cast(bf16x8, pw);
        const s16x4 a0 = vw[s & 1][0], a1 = vw[s & 1][1], a2 = vw[s & 1][2], a3 = vw[s & 1][3];
        if (s + 1 < 12) { lds_cptr v = ATT_VP(s + 1) + ((s + 1) & 3) * 1024; vw[(s + 1) & 1][0] = vtr(v); vw[(s + 1) & 1][1] = vtr(v + 512); vw[(s + 1) & 1][2] = vtr(v + 4096); vw[(s + 1) & 1][3] = vtr(v + 4096 + 512); }
        o0 = __builtin_amdgcn_mfma_f32_32x32x16_bf16((bf16x8){a0[0], a0[1], a0[2], a0[3], a1[0], a1[1], a1[2], a1[3]}, pa, o0, 0, 0, 0);
        if (s + 1 < 12) ATT_EXP(s + 1, 0);
        __builtin_amdgcn_sched_barrier(0);
        o1 = __builtin_amdgcn_mfma_f32_32x32x16_bf16((bf16x8){a2[0], a2[1], a2[2], a2[3], a3[0], a3[1], a3[2], a3[3]}, pa, o1, 0, 0, 0);
        if (s + 1 < 12) ATT_EXP(s + 1, 4);
        __builtin_amdgcn_sched_barrier(0);
    }
#undef ATT_EXP
#undef ATT_VP
    { auto rr = __builtin_amdgcn_permlane32_swap(__float_as_uint(sum), __float_as_uint(sum), false, false); sum = __uint_as_float(rr[0]) + __uint_as_float(rr[1]); }
    const float inv = 1.0f / (sum + __builtin_amdgcn_exp2f(sink2 - mx));
    LAS bf16* stg = (LAS bf16*)(lds + OST + wid * OSTW); const rsrc_t rao = mk_rsrc(AO);
#pragma unroll
    for (int j = 0; j < 4; ++j) {
        v2u w0, w1; w0.x = pk2(o0[4 * j] * inv, o0[4 * j + 1] * inv); w0.y = pk2(o0[4 * j + 2] * inv, o0[4 * j + 3] * inv); w1.x = pk2(o1[4 * j] * inv, o1[4 * j + 1] * inv); w1.y = pk2(o1[4 * j + 2] * inv, o1[4 * j + 3] * inv);
        *(LAS v2u*)(stg + r32 * 72 + 8 * j + 4 * hi) = w0; *(LAS v2u*)(stg + r32 * 72 + 32 + 8 * j + 4 * hi) = w1;
    }
    LDS_WAIT();
#pragma unroll
    for (int i = 0; i < 4; ++i) { const int row = i * 8 + (lane >> 3), ch = lane & 7; const v4u v = *(const LAS v4u*)(stg + row * 72 + ch * 8);
        if (!SAMPLE || posb + row < 16) st16_wt(rao, ((qrow0 + posb + row) * DM + head * HD + ch * 8) * 2, v); }
    LDS_WAIT();
}
}

namespace gat {
using att::bf16x8; using att::s16x4; using att::f32x16; using att::lds_cptr; using att::vtr; using att::crow;
constexpr int G_LN = 1024, G_IMG = 9216, G_STG = G_IMG + 65536;
template <bool SAMPLE, int PP>
__device__ __forceinline__ void gate_group(LAS unsigned char* lds, int g, v4u (&raw)[8], const bf16* GV, const bf16* UB, bf16* BMO, const bf16* WSB, const float* b_s, float* gs_out, size_t row0, int tid, int wave, int lane) {
    constexpr int L = SAMPLE ? 16 : 128;
    asm volatile("" : "+v"(tid)); lane = tid & 63;
    constexpr int TB0 = PP, TB1 = 3 - PP, NK0 = 2 * (TB0 + 1), NK1 = 2 * (TB1 + 1);
    LAS float* stats = (LAS float*)lds; LAS float* lnp = (LAS float*)(lds + G_LN); LAS unsigned char* img = lds + G_IMG;
    const int r32 = lane & 31, hi = lane >> 5, cq = wave >> 1;
    const int vb = ((lane >> 4) & 1) * 32 + (lane & 3) * 8 + (4 * hi + ((lane & 15) >> 2)) * 64;
    const int sr = tid >> 5, sc = (tid & 31) * 8;
    bf16x8 af0[NK0], af1[NK1];
    { const bf16* w0 = WSB + ((size_t)(g * 128 + 32 * TB0 + r32) * 128 + hi * 8); const bf16* w1 = WSB + ((size_t)(g * 128 + 32 * TB1 + r32) * 128 + hi * 8);
#pragma unroll
      for (int ks = 0; ks < NK0; ++ks) af0[ks] = *(const bf16x8*)(w0 + ks * 16);
#pragma unroll
      for (int ks = 0; ks < NK1; ++ks) af1[ks] = *(const bf16x8*)(w1 + ks * 16); }
    v4u uw[2][4]; float bias[2][4];
#pragma unroll
    for (int tsel = 0; tsel < 2; ++tsel) { const int tb = tsel ? TB1 : TB0;
#pragma unroll
        for (int i = 0; i < 4; ++i) { const int t = 32 * tb + i * 8 + (lane >> 3); uw[tsel][i] = (v4u){0u, 0u, 0u, 0u}; bias[tsel][i] = 0.f;
            if (t < L) { uw[tsel][i] = *(const v4u*)(UB + (row0 + t) * DM + g * 256 + 64 * cq + (lane & 7) * 8); bias[tsel][i] = b_s[g * 128 + t]; } } }
    { const int col = g * 256 + sc;
      const f32x4 g0 = *(const LAS f32x4*)(lnp + col), g1 = *(const LAS f32x4*)(lnp + col + 4), b0 = *(const LAS f32x4*)(lnp + DM + col), b1 = *(const LAS f32x4*)(lnp + DM + col + 4);
#pragma unroll
      for (int i = 0; i < 8; ++i) { const int r = sr + 16 * i; v4u w = {0u, 0u, 0u, 0u};
        if (r < L) {
            const v4u x = raw[i]; const float mean = stats[2 * r], rstd = stats[2 * r + 1];
            float v[8] = {bflo(x.x), bfhi(x.x), bflo(x.y), bfhi(x.y), bflo(x.z), bfhi(x.z), bflo(x.w), bfhi(x.w)};
            v[0] = (v[0] - mean) * rstd * g0.x + b0.x; v[1] = (v[1] - mean) * rstd * g0.y + b0.y; v[2] = (v[2] - mean) * rstd * g0.z + b0.z; v[3] = (v[3] - mean) * rstd * g0.w + b0.w;
            v[4] = (v[4] - mean) * rstd * g1.x + b1.x; v[5] = (v[5] - mean) * rstd * g1.y + b1.y; v[6] = (v[6] - mean) * rstd * g1.z + b1.z; v[7] = (v[7] - mean) * rstd * g1.w + b1.w;
            if (SAMPLE) { float* gs = gs_out + (size_t)r * DM + col; *(f32x4*)gs = (f32x4){v[0], v[1], v[2], v[3]}; *(f32x4*)(gs + 4) = (f32x4){v[4], v[5], v[6], v[7]}; }
            w.x = pk2(v[0], v[1]); w.y = pk2(v[2], v[3]); w.z = pk2(v[4], v[5]); w.w = pk2(v[6], v[7]);
        }
        *(LAS v4u*)(img + ((sc >> 5) * 8 + (r >> 4)) * 1024 + (r & 15) * 64 + (sc & 31) * 2) = w; } }
    if (g < 3) {
#pragma unroll
        for (int i = 0; i < 8; ++i) if (sr + 16 * i < L) raw[i] = *(const v4u*)(GV + (row0 + sr + 16 * i) * DM + (g + 1) * 256 + sc);
    }
    __syncthreads();
    f32x16 o[2][2];
#pragma unroll
    for (int a = 0; a < 2; ++a)
#pragma unroll
        for (int c = 0; c < 2; ++c) o[a][c] = (f32x16){};
#pragma unroll
    for (int ks = 0; ks < NK1; ++ks) {
#pragma unroll
        for (int cs = 0; cs < 2; ++cs) {
            lds_cptr vp = (lds_cptr)img + ((2 * cq + cs) * 8 + ks) * 1024 + vb;
            const s16x4 lo = vtr(vp), h4 = vtr(vp + 512); const bf16x8 vf = (bf16x8){lo[0], lo[1], lo[2], lo[3], h4[0], h4[1], h4[2], h4[3]};
            if (ks < NK0) o[0][cs] = __builtin_amdgcn_mfma_f32_32x32x16_bf16(af0[ks < NK0 ? ks : 0], vf, o[0][cs], 0, 0, 0);
            o[1][cs] = __builtin_amdgcn_mfma_f32_32x32x16_bf16(af1[ks], vf, o[1][cs], 0, 0, 0);
        }
        __builtin_amdgcn_sched_barrier(0);
    }
    LAS float* stg = (LAS float*)(lds + G_STG + wave * 8704); const rsrc_t rbm = mk_rsrc(BMO);
#pragma unroll
    for (int tsel = 0; tsel < 2; ++tsel) {
        const int tb = tsel ? TB1 : TB0;
#pragma unroll
        for (int r = 0; r < 16; ++r) { const int row = crow(r, hi); stg[row * 68 + r32] = o[tsel][0][r]; stg[row * 68 + 32 + r32] = o[tsel][1][r]; }
        LDS_WAIT();
#pragma unroll
        for (int i = 0; i < 4; ++i) { const int row = i * 8 + (lane >> 3), ch0 = (lane & 7) * 8, t = 32 * tb + row;
            if (t < L) {
                const f32x4 m0 = *(const LAS f32x4*)(stg + row * 68 + ch0), m1 = *(const LAS f32x4*)(stg + row * 68 + ch0 + 4); const float bs = bias[tsel][i];
                const v4u u4 = uw[tsel][i]; v4u w;
                w.x = pk2(bflo(u4.x) * (m0.x + bs), bfhi(u4.x) * (m0.y + bs)); w.y = pk2(bflo(u4.y) * (m0.z + bs), bfhi(u4.y) * (m0.w + bs));
                w.z = pk2(bflo(u4.z) * (m1.x + bs), bfhi(u4.z) * (m1.y + bs)); w.w = pk2(bflo(u4.w) * (m1.z + bs), bfhi(u4.w) * (m1.w + bs));
                st16_wt(rbm, ((row0 + t) * DM + g * 256 + 64 * cq + ch0) * 2, w);
            }
        }
        LDS_WAIT();
    }
    __syncthreads();
}
template <bool SAMPLE>
__device__ __forceinline__ void gate_unit(LAS unsigned char* lds, const bf16* GV, const bf16* UB, bf16* BMO, const bf16* WSB, const float* PG1, const float* PG2, const float* ln_g, const float* ln_b, const float* b_s, float* gs_out, size_t row0, int tid, int wave, int lane) {
    constexpr int L = SAMPLE ? 16 : 128;
    LAS float* stats = (LAS float*)lds; LAS float* lnp = (LAS float*)(lds + G_LN);
    __syncthreads();
    const int sr = tid >> 5, sc = (tid & 31) * 8;
    v4u raw[8];
#pragma unroll
    for (int i = 0; i < 8; ++i) { raw[i] = (v4u){0u, 0u, 0u, 0u}; if (sr + 16 * i < L) raw[i] = *(const v4u*)(GV + (row0 + sr + 16 * i) * DM + sc); }
    if (tid < L) {
        float a = 0.f, q = 0.f;
#pragma unroll
        for (int k = 0; k < 16; ++k) { a += PG1[(size_t)k * MT + row0 + tid]; q += PG2[(size_t)k * MT + row0 + tid]; }
        const float mean = a * (1.0f / DM), var = fmaxf(q * (1.0f / DM) - mean * mean, 0.f);
        stats[2 * tid] = mean; stats[2 * tid + 1] = 1.0f / sqrtf(var + EPS);
    }
    { const int i4 = tid & 255; const float* src = (tid < 256) ? ln_g : ln_b; *(LAS f32x4*)(lnp + (tid < 256 ? 0 : DM) + 4 * i4) = *(const f32x4*)(src + 4 * i4); }
    __syncthreads();
    if (wave & 1) { for (int g = 0; g < 4; ++g) gate_group<SAMPLE, 1>(lds, g, raw, GV, UB, BMO, WSB, b_s, gs_out, row0, tid, wave, lane); }
    else          { for (int g = 0; g < 4; ++g) gate_group<SAMPLE, 0>(lds, g, raw, GV, UB, BMO, WSB, b_s, gs_out, row0, tid, wave, lane); }
}
}

template <bool WT>
__device__ __forceinline__ void x_rows4(int m0, const float* xp, const float* xs, bf16* XB, float* RSTD1, int lane) {
    f32x4 v[4][4]; const rsrc_t rx = mk_rsrc(XB);
#pragma unroll
    for (int i = 0; i < 4; ++i) { const int m = m0 + i; const float* xrow = (m < MP) ? xp + (size_t)m * DM : xs + (size_t)(m - MP) * DM;
#pragma unroll
        for (int k = 0; k < 2; ++k) { v[i][2 * k] = *(const f32x4*)(xrow + k * 512 + 8 * lane); v[i][2 * k + 1] = *(const f32x4*)(xrow + k * 512 + 8 * lane + 4); } }
#pragma unroll
    for (int i = 0; i < 4; ++i) { const int m = m0 + i; float s = 0.f;
#pragma unroll
        for (int j = 0; j < 4; ++j) s += (v[i][j].x * v[i][j].x + v[i][j].y * v[i][j].y) + (v[i][j].z * v[i][j].z + v[i][j].w * v[i][j].w);
        s = wave_sum(s);
        const float rs = 1.0f / sqrtf(s * (1.0f / DM) + EPS);
        if (lane == 0) { if (WT) stf_wt(RSTD1 + m, rs); else RSTD1[m] = rs; }
#pragma unroll
        for (int k = 0; k < 2; ++k) { v4u w; w.x = pk2(v[i][2 * k].x, v[i][2 * k].y); w.y = pk2(v[i][2 * k].z, v[i][2 * k].w); w.z = pk2(v[i][2 * k + 1].x, v[i][2 * k + 1].y); w.w = pk2(v[i][2 * k + 1].z, v[i][2 * k + 1].w);
            if (WT) st16_wt(rx, ((size_t)m * DM + k * 512 + 8 * lane) * 2, w); else *(v4u*)(XB + (size_t)m * DM + k * 512 + 8 * lane) = w; } }
}
__device__ __forceinline__ bool chunk_next(pg8::DynOrder& S, int i, pg8::Unit& u, int tid) {
    if (tid == 0) S.put(i & 1, S.draw(S.xcd), 0);
    __syncthreads();
    return S.get(i & 1, u);
}
__device__ __forceinline__ void l1_acquire(int tid) {
    __syncthreads();
    if (tid == 0) { __builtin_amdgcn_fence(__ATOMIC_ACQUIRE, "agent"); asm volatile("s_waitcnt vmcnt(0)" ::: "memory"); }
    __syncthreads();
}
__device__ __forceinline__ void rows_wait(unsigned* cnt, unsigned need, unsigned* tot, unsigned need_tot, int& flag, unsigned* tmo, int wave) {
    if (wave == 0 && flag == 0) {
        unsigned spins = 0;
        for (;;) {
            const unsigned c0 = __hip_atomic_load(cnt, __ATOMIC_RELAXED, __HIP_MEMORY_SCOPE_AGENT), t0 = __hip_atomic_load(tot, __ATOMIC_RELAXED, __HIP_MEMORY_SCOPE_AGENT);
            const unsigned c = (unsigned)__builtin_amdgcn_readfirstlane(c0), t = (unsigned)__builtin_amdgcn_readfirstlane(t0);
            if (t >= need_tot) { flag = 1; break; }
            if (c >= need) break;
            if (++spins > PG8_SPIN_CAP || ((spins & 63u) == 0u && __builtin_amdgcn_readfirstlane(__hip_atomic_load(tmo, __ATOMIC_RELAXED, __HIP_MEMORY_SCOPE_AGENT)) != 0u)) { if ((threadIdx.x & 63) == 0) __hip_atomic_store(tmo, 1u, __ATOMIC_RELAXED, __HIP_MEMORY_SCOPE_AGENT); break; }
            __builtin_amdgcn_s_sleep(4);
        }
    }
    __syncthreads();
}

__device__ __forceinline__ void panels_wait(unsigned* C, int p_lo, int p_hi, unsigned need, unsigned* tot, unsigned need_tot, int& flag, unsigned* tmo, int wave) {
    if (wave == 0 && flag == 0) {
        unsigned spins = 0;
        for (;;) {
            const unsigned t0 = __hip_atomic_load(tot, __ATOMIC_RELAXED, __HIP_MEMORY_SCOPE_AGENT); unsigned cmin = 0xffffffffu;
            for (int p = p_lo; p <= p_hi; ++p) { const unsigned c = __hip_atomic_load(C + 64 * p, __ATOMIC_RELAXED, __HIP_MEMORY_SCOPE_AGENT); cmin = c < cmin ? c : cmin; }
            if ((unsigned)__builtin_amdgcn_readfirstlane(t0) >= need_tot) { flag = 1; break; }
            if ((unsigned)__builtin_amdgcn_readfirstlane(cmin) >= need) break;
            if (++spins > PG8_SPIN_CAP || ((spins & 63u) == 0u && __builtin_amdgcn_readfirstlane(__hip_atomic_load(tmo, __ATOMIC_RELAXED, __HIP_MEMORY_SCOPE_AGENT)) != 0u)) { if ((threadIdx.x & 63) == 0) __hip_atomic_store(tmo, 1u, __ATOMIC_RELAXED, __HIP_MEMORY_SCOPE_AGENT); break; }
            __builtin_amdgcn_s_sleep(4);
        }
    }
    __syncthreads();
}
__device__ __forceinline__ void p2_signal(unsigned* C2, int panel, int lane) {
    asm volatile("s_waitcnt vmcnt(0)" ::: "memory");
    if (lane == 0) __hip_atomic_fetch_add(C2 + 64 * panel, 1u, __ATOMIC_RELAXED, __HIP_MEMORY_SCOPE_AGENT);
}
__device__ __forceinline__ void p2_signal_sample(unsigned* C2, unsigned* CS, int lane) {
    asm volatile("s_waitcnt vmcnt(0)" ::: "memory");
    if (lane == 0) { const unsigned old = __hip_atomic_fetch_add(CS, 1u, __ATOMIC_RELAXED, __HIP_MEMORY_SCOPE_AGENT); if (old == 639u) __hip_atomic_fetch_add(C2 + 64 * 256, 48u, __ATOMIC_RELAXED, __HIP_MEMORY_SCOPE_AGENT); }
}

struct Args { const float* in[19]; float* out; unsigned char* ws; int ph_lo, ph_hi; };

__global__ void __launch_bounds__(NWAVES * 64, 2) fwd_kernel(Args args) {
    extern __shared__ __attribute__((aligned(16))) unsigned char lds_raw[];
    LAS unsigned char* lds = (LAS unsigned char*)lds_raw;
    volatile LAS unsigned* MISC = (volatile LAS unsigned*)(lds + MISC_OFF);
    const int tid = threadIdx.x, lane = tid & 63, wave = __builtin_amdgcn_readfirstlane(tid >> 6);
    const int G = gridDim.x;
    const int vcu = (G % 8 == 0) ? ((int)blockIdx.x % 8) * (G / 8) + (int)blockIdx.x / 8 : (int)blockIdx.x;
    unsigned char* ws = args.ws;
    const float* xp = args.in[0]; const float* xs = args.in[1]; const float* cache_k = args.in[2]; const float* cache_v = args.in[3];
    const float* g_pre_mix = args.in[4]; const float* g_post_mix = args.in[5]; const float* g_pre_ffn = args.in[6]; const float* g_post_ffn = args.in[7];
    const float* w_in = args.in[8]; const float* sinks = args.in[9]; const float* ln_g = args.in[10]; const float* ln_b = args.in[11];
    const float* w_s = args.in[12]; const float* b_s = args.in[13]; const float* w_ap = args.in[14]; const float* w_gp = args.in[15];
    const float* w_out = args.in[16]; const float* w_fi = args.in[17]; const float* w_fo = args.in[18];
    float* out = args.out;
    bf16* WinT = (bf16*)(ws + WS_WIN); bf16* WfiT = (bf16*)(ws + WS_WFI); bf16* WaT = (bf16*)(ws + WS_WA); bf16* WgT = (bf16*)(ws + WS_WG); bf16* WoT = (bf16*)(ws + WS_WO); bf16* WfoT = (bf16*)(ws + WS_WFO); bf16* WSB = (bf16*)(ws + WS_WSB);
    float* RSTD1 = (float*)(ws + WS_RSTD1); float* RSTD2 = (float*)(ws + WS_RSTD2); float* PMIX = (float*)(ws + WS_PMIX); float* PF = (float*)(ws + WS_PF);
    bf16* XB = (bf16*)(ws + WS_R0); bf16* FB = XB;
    bf16* QB = (bf16*)(ws + WS_R1); bf16* MERGED = QB; bf16* X1B = QB;
    bf16* GV = (bf16*)(ws + WS_R2); bf16* MIX = GV;
    bf16* KB = (bf16*)(ws + WS_KB); bf16* VB = (bf16*)(ws + WS_VB);
    bf16* SA = (bf16*)(ws + WS_SA); bf16* SB = (bf16*)(ws + WS_SB); bf16* UB = (bf16*)(ws + WS_U); bf16* ACT = (bf16*)(ws + WS_R3); bf16* AO = (bf16*)(ws + WS_AO);
#ifdef GATE_OOP
    bf16* BMB = XB;
#else
    bf16* BMB = UB;
#endif

    for (int u = tid; u < (LDS_BYTES - LDSCTL_OFF) / 4; u += NWAVES * 64) ((LAS unsigned*)(lds + LDSCTL_OFF))[u] = 0u;
    __syncthreads();
    XcdBarrier bar; bar.bar = (unsigned*)(ws + WS_CTL) + CW_BAR; bar.x = 0; bar.st = nullptr;
    if (MK_ONE_LAUNCH) bar = xcd_barrier_post((unsigned*)(ws + WS_CTL) + CW_BAR, MISC + 8);
    const int lo = args.ph_lo, hi = args.ph_hi;
    STAMP(0);
#ifndef PH_MASK
#define PH_MASK 0x1ff
#endif
#define IN(k) (((PH_MASK >> (k)) & 1) && lo <= (k) && (k) < hi)
#define SEAM(k) do { if (MK_ONE_LAUNCH && IN(k) && IN((k) + 1)) xcd_barrier(bar); } while (0)
    const int gw = vcu * NWAVES + wave, NGW = G * NWAVES;
    unsigned* const QH = (unsigned*)(ws + WS_CTL) + CW_Q; LAS int* const BOX = (LAS int*)(lds + BOX_OFF);
    unsigned* const C0 = (unsigned*)(ws + WS_CTL) + CW_C0, * const T0 = (unsigned*)(ws + WS_CTL) + CW_TOT + 5 * 64, * const TMO0 = (unsigned*)(ws + WS_CTL) + CW_TMO;

    if (IN(0)) for (int rep_ = 0; rep_ < NREP(0); ++rep_) {
        LAS float* scr = (LAS float*)(lds + wave * 16384);
        constexpr int I_IN = (DM / 64) * (INW / 32), I_SQ = (DM / 64) * (DM / 32), I_FO = (DFF / 64) * (DM / 32);
        constexpr int NITEMS = 2 * I_IN + 3 * I_SQ + I_FO;
        for (int it = gw; it < NITEMS; it += NGW) {
            int r = it;
            if (r < I_IN) { p0_transpose_item<false>(w_in, DM, INW, g_pre_mix, WinT, scr, r, lane); continue; } r -= I_IN;
            if (r < I_IN) { p0_transpose_item<true>(w_fi, DM, INW, g_pre_ffn, WfiT, scr, r, lane); continue; } r -= I_IN;
            if (r < I_SQ) { p0_transpose_item<false>(w_ap, DM, DM, nullptr, WaT, scr, r, lane); continue; } r -= I_SQ;
            if (r < I_SQ) { p0_transpose_item<false>(w_gp, DM, DM, nullptr, WgT, scr, r, lane); continue; } r -= I_SQ;
            if (r < I_SQ) { p0_transpose_item<false>(w_out, DM, DM, nullptr, WoT, scr, r, lane); continue; } r -= I_SQ;
            p0_transpose_item<false>(w_fo, DFF, DM, nullptr, WfoT, scr, r, lane);
        }
        for (int i = gw * 64 + lane; i < 4 * 128 * 128; i += NGW * 64) {
            const int t = (i >> 7) & 127, pp = i & 127, pl = pp & 15, sl = (pl & 3) | ((pl & 4) << 1) | ((pl & 8) >> 1), sidx = (pp & ~15) + sl;
            const float v = (sidx <= t) ? w_s[(size_t)(i & ~127) + sidx] : 0.f;
            WSB[i] = (bf16)(pk2(v, 0.f) & 0xffffu);
        }
        for (int gi = gw; gi < 65 * 64; gi += NGW) { const int p = gi >> 6, panel = p < 64 ? 32 * (p & 7) + (p >> 3) : 256; x_rows4<false>(panel * 256 + 4 * (gi & 63), xp, xs, XB, RSTD1, lane); }
        if (tid == 0) for (int p = blockIdx.x; p < 65; p += G) { const int panel = p < 64 ? 32 * (p & 7) + (p >> 3) : 256; __hip_atomic_fetch_add(C0 + 64 * panel, 8u, __ATOMIC_RELAXED, __HIP_MEMORY_SCOPE_AGENT); }
        for (int i = gw * 64 + lane; i < 2 * NB * 112 * 64; i += NGW * 64) {
            const int which = i / (NB * 112 * 64), r = i % (NB * 112 * 64), b = r / (112 * 64), q = r % (112 * 64);
            const float* src = (which ? cache_v : cache_k) + (size_t)b * 128 * KVW + 16 * KVW;
            float* dstp = out + (which ? O_VS : O_KS) + (size_t)b * 128 * KVW;
            ((f32x4*)dstp)[q] = ((const f32x4*)src)[q];
        }
    }
    STAMP(1);
    SEAM(0);
    STAMP(2);

    if (IN(1)) for (int rep_ = 0; rep_ < NREP(1); ++rep_) {
        const int NWK = (G >> 5) * 8;
        if (((blockIdx.x >> 3) & 3) == 0 && rep_ == 0) {
            const int w = (int)(blockIdx.x & 7) + 8 * (int)(blockIdx.x >> 5);
            for (int idx = w; idx < 192; idx += NWK) { const int wi = idx & 63, panel = 32 * (wi & 7) + 8 * (1 + (idx >> 6)) + (wi >> 3);
                for (int r = 0; r < 8; ++r) x_rows4<true>(panel * 256 + 32 * wave + 4 * r, xp, xs, XB, RSTD1, lane);
                asm volatile("s_waitcnt vmcnt(0)" ::: "memory");
                if (lane == 0) __hip_atomic_fetch_add(C0 + 64 * panel, 1u, __ATOMIC_RELAXED, __HIP_MEMORY_SCOPE_AGENT); }
            __syncthreads();
            if (tid == 0) __hip_atomic_fetch_add(T0, 1u, __ATOMIC_RELAXED, __HIP_MEMORY_SCOPE_AGENT);
        }
        pg8::Gemm g{XB, WinT, XB, WinT, MT, INW, DM}; pg8::DynOrder S; S.init(QH + 1 * 512, MP, INW, 1, BOX);
        EpiIn E{RSTD1, QB, KB, VB, UB, GV, SA, SB, out, PF, PMIX};
        const pg8::Dep D{C0, 8u, T0, (unsigned)NWK, nullptr, 0u, (unsigned*)(ws + WS_CTL) + CW_C1, (unsigned*)(ws + WS_CTL) + CW_TOT + 6 * 64, TMO0}; pg8::gemm_phase<EpiIn, pg8::DynOrder, 0>(lds, g, S, E, D);
    }
    STAMP(3);
    STAMP(4);

    unsigned* const C1 = (unsigned*)(ws + WS_CTL) + CW_C1, * const C2 = (unsigned*)(ws + WS_CTL) + CW_C2, * const CSP = (unsigned*)(ws + WS_CTL) + CW_CS;
    unsigned* const T1 = (unsigned*)(ws + WS_CTL) + CW_TOT + 6 * 64, * const T2 = (unsigned*)(ws + WS_CTL) + CW_TOT + 7 * 64;
    if (IN(2)) {
        int p2flag = 0;
        for (;;) {
            __syncthreads();
            if (tid == 0) BOX[0] = (int)__hip_atomic_fetch_add(QH + 2 * 512, 1u, __ATOMIC_RELAXED, __HIP_MEMORY_SCOPE_AGENT);
            __syncthreads();
            const int t = BOX[0];
            if (t >= NB * NKV * 4 + NB * NKV) break;
            if (t < NB * NKV * 4) {
                const int key = t >> 6, w6 = t & 63, kvh = w6 & 3, b = 2 * (w6 >> 3) + (key >> 1), qq = 2 * (key & 1) + ((w6 >> 2) & 1), c0 = 16 * qq; const size_t seqbase = (size_t)b * SEQ;
                panels_wait(C1, 16 * b + 4 * qq - (qq > 0 ? 1 : 0), 16 * b + 4 * qq + 3, 176u, T1, (unsigned)G, p2flag, TMO0, wave);
                for (int T = (c0 >= 2 ? c0 - 2 : 0); T <= c0; ++T) { const att::TileRegs tr = att::load_tile(KB, VB, seqbase + 64 * T, kvh, wave, lane); att::store_tile(lds + (T & 3) * att::SLOT, tr, wave, lane); }
                att::QFrag qc = att::load_q<false>(QB, seqbase + 64 * c0, kvh, wave, lane);
                if (c0 == 0) { const v4u z = {0u, 0u, 0u, 0u};
#pragma unroll
                    for (int i = 0; i < 4; ++i) *(LAS v4u*)(lds + 2 * att::SLOT + i * 8192 + tid * 16) = z; }
                const float sink2 = sinks[kvh * 4 + (wave >> 1)] * LOG2E;
                __syncthreads();
                for (int c = c0; c < c0 + 16; ++c) {
                    att::TileRegs nx; nx.k = (v4u){0u, 0u, 0u, 0u}; nx.v = nx.k; const bool pre = (c + 1 < c0 + 16);
                    att::QFrag qn = qc;
                    if (pre) { nx = att::load_tile(KB, VB, seqbase + 64 * (c + 1), kvh, wave, lane); qn = att::load_q<false>(QB, seqbase + 64 * (c + 1), kvh, wave, lane); }
                    att::attn_unit<false>(lds, ((c + 2) & 3) * att::SLOT, ((c + 3) & 3) * att::SLOT, (c & 3) * att::SLOT, c >= 2 ? 0 : 2 - c, qc, AO, seqbase + 64 * c, kvh, sink2, wave, lane);
                    if (pre) att::store_tile(lds + ((c + 1) & 3) * att::SLOT, nx, wave, lane);
                    qc = qn;
                    if ((c & 3) == 3) p2_signal(C2, 16 * b + (c >> 2), lane);
                    __syncthreads();
                }
            } else {
                const int j = t - NB * NKV * 4, b = j >> 2, kvh = j & 3;
                panels_wait(C1, 256, 256, 176u, T1, (unsigned)G, p2flag, TMO0, wave);
#pragma unroll
                for (int T = 0; T < 2; ++T) {
                    att::TileRegs tr;
                    { const size_t o = ((size_t)(b * 128 + 64 * T + lane) * NKV + kvh) * HD + wave * 8; const f32x4 k0 = *(const f32x4*)(cache_k + o), k1 = *(const f32x4*)(cache_k + o + 4);
                      tr.k.x = pk2(k0.x, k0.y); tr.k.y = pk2(k0.z, k0.w); tr.k.z = pk2(k1.x, k1.y); tr.k.w = pk2(k1.z, k1.w); }
                    { const size_t o = ((size_t)(b * 128 + 64 * T + 16 * (wave & 3) + (lane >> 2)) * NKV + kvh) * HD + (wave >> 2) * 32 + (lane & 3) * 8; const f32x4 v0 = *(const f32x4*)(cache_v + o), v1 = *(const f32x4*)(cache_v + o + 4);
                      tr.v.x = pk2(v0.x, v0.y); tr.v.y = pk2(v0.z, v0.w); tr.v.z = pk2(v1.x, v1.y); tr.v.w = pk2(v1.z, v1.w); }
                    att::store_tile(lds + T * att::SLOT, tr, wave, lane);
                }
                { att::TileRegs tr; tr.k = (v4u){0u, 0u, 0u, 0u}; tr.v = tr.k;
                  if (lane < 16) tr.k = *(const v4u*)(KB + (size_t)(MP + b * 16 + lane) * KVW + kvh * HD + wave * 8);
                  if ((wave & 3) == 0) tr.v = *(const v4u*)(VB + (size_t)(MP + b * 16 + (lane >> 2)) * KVW + kvh * HD + (wave >> 2) * 32 + (lane & 3) * 8);
                  att::store_tile(lds + 2 * att::SLOT, tr, wave, lane); }
                __syncthreads();
                { const att::QFrag qs = att::load_q<true>(QB, (size_t)(MP + b * 16), kvh, wave, lane); att::attn_unit<true>(lds, 0, att::SLOT, 2 * att::SLOT, 0, qs, AO, (size_t)(MP + b * 16), kvh, sinks[kvh * 4 + (wave >> 1)] * LOG2E, wave, lane); }
                p2_signal_sample(C2, CSP, lane);
            }
        }
        for (;;) {
            __syncthreads();
            if (tid == 0) BOX[0] = (int)__hip_atomic_fetch_add(QH + 2 * 512 + 64, 1u, __ATOMIC_RELAXED, __HIP_MEMORY_SCOPE_AGENT);
            __syncthreads();
            const int t = BOX[0];
            if (t >= NB * 32 + NB) break;
            if (t < NB * 32) {
                const int key = t >> 7, w7 = t & 127, b = 2 * (w7 >> 4) + (key >> 1), unit = b * 32 + 16 * (key & 1) + (w7 & 15);
                panels_wait(C1, unit >> 1, unit >> 1, 176u, T1, (unsigned)G, p2flag, TMO0, wave);
                gat::gate_unit<false>(lds, GV, UB, BMB, WSB, PF, PMIX, ln_g, ln_b, b_s, nullptr, (size_t)unit * 128, tid, wave, lane);
                p2_signal(C2, unit >> 1, lane);
            } else {
                const int j = t - NB * 32;
                panels_wait(C1, 256, 256, 176u, T1, (unsigned)G, p2flag, TMO0, wave);
                gat::gate_unit<true>(lds, GV, UB, BMB, WSB, PF, PMIX, ln_g, ln_b, b_s, out + O_GS + (size_t)j * 16 * DM, (size_t)(MP + j * 16), tid, wave, lane);
                p2_signal_sample(C2, CSP, lane);
            }
        }
        __syncthreads();
        if (tid == 0) __hip_atomic_fetch_add(T2, 1u, __ATOMIC_RELAXED, __HIP_MEMORY_SCOPE_AGENT);
    }
    STAMP(5);
    STAMP(6);

    unsigned* const ctl = (unsigned*)(ws + WS_CTL);
    unsigned* const C3 = ctl + CW_CNT, * const C4 = C3 + 264 * 64, * const C5 = C4 + 264 * 64, * const C6 = C5 + 264 * 64, * const C7 = C6 + 264 * 64, * const T3 = ctl + CW_TOT, * const T4 = T3 + 64, * const T5 = T4 + 64, * const T6 = T5 + 64, * const T7 = T6 + 64, * const TMO = ctl + CW_TMO;
    const unsigned NWG = (unsigned)G;
    if (IN(3)) {
        pg8::Gemm g{AO, WaT, BMB, WgT, MT, DM, DM}; pg8::DynOrder S; S.init(QH + 3 * 512, MP, DM, 2, BOX);
        EpiMerge E{SA, SB, MERGED}; const pg8::Dep D{C2, 48u, T2, NWG, nullptr, 0u, C3, T3, TMO};
        l1_acquire(tid); pg8::gemm_phase<EpiMerge, pg8::DynOrder, 0>(lds, g, S, E, D);
    }
    STAMP(7);
    if (IN(4)) {
        pg8::Gemm g{MERGED, WoT, MERGED, WoT, MT, DM, DM}; pg8::DynOrder S; S.init(QH + 4 * 512, MP, DM, 1, BOX);
        EpiBf16Ss E{MIX, PMIX}; const pg8::Dep D{C3, 32u, T3, NWG, nullptr, 0u, C4, T4, TMO};
        l1_acquire(tid); pg8::gemm_phase<EpiBf16Ss, pg8::DynOrder, 0>(lds, g, S, E, D);
    }
    STAMP(8);
    if (IN(5)) {
        const bool worker = ((blockIdx.x >> 3) & 3) == 0;
        pg8::DynOrder S; S.init(QH + 5 * 512, MP, DM, 1, BOX); pg8::Unit u; const rsrc_t rmix = mk_rsrc(MIX), rx1 = mk_rsrc(X1B);
        f32x4 gv[4];
#pragma unroll
        for (int k = 0; k < 4; ++k) gv[k] = *(const f32x4*)(g_post_mix + (k >> 1) * 512 + 8 * lane + (k & 1) * 4);
        int rflag = 0;
        for (int i = 0; (worker || i == 0) && chunk_next(S, i, u, tid); ++i) {
            rows_wait(C4 + 64 * u.pm, 32u, T4, NWG, rflag, TMO, wave);
            const int mb = u.pm * 256 + u.pn * 64 + wave * 8;
#pragma unroll 1
            for (int h = 0; h < 2; ++h) {
                v4u xw[4][2], mw[4][2]; float ps[4];
#pragma unroll
                for (int r = 0; r < 4; ++r) { const int m = mb + 4 * h + r; ps[r] = ldf_nc(PMIX + (size_t)(lane & 15) * MT + m);
#pragma unroll
                    for (int k = 0; k < 2; ++k) { xw[r][k] = *(const v4u*)(XB + (size_t)m * DM + k * 512 + 8 * lane); mw[r][k] = ld16_nc(rmix, ((size_t)m * DM + k * 512 + 8 * lane) * 2); } }
#pragma unroll
                for (int r = 0; r < 4; ++r) { const int m = mb + 4 * h + r; float p = ps[r]; p += __shfl_xor(p, 1); p += __shfl_xor(p, 2); p += __shfl_xor(p, 4); p += __shfl_xor(p, 8);
                    const float rm = 1.0f / sqrtf(p * (1.0f / DM) + EPS); float v[2][8]; float sq = 0.f;
#pragma unroll
                    for (int k = 0; k < 2; ++k) { const v4u a = xw[r][k], b = mw[r][k]; const f32x4 g0 = gv[2 * k], g1 = gv[2 * k + 1];
                        v[k][0] = bflo(a.x) + bflo(b.x) * rm * g0.x; v[k][1] = bfhi(a.x) + bfhi(b.x) * rm * g0.y; v[k][2] = bflo(a.y) + bflo(b.y) * rm * g0.z; v[k][3] = bfhi(a.y) + bfhi(b.y) * rm * g0.w;
                        v[k][4] = bflo(a.z) + bflo(b.z) * rm * g1.x; v[k][5] = bfhi(a.z) + bfhi(b.z) * rm * g1.y; v[k][6] = bflo(a.w) + bflo(b.w) * rm * g1.z; v[k][7] = bfhi(a.w) + bfhi(b.w) * rm * g1.w;
#pragma unroll
                        for (int j = 0; j < 8; ++j) sq += v[k][j] * v[k][j]; }
                    sq = wave_sum(sq);
                    if (lane == 0) stf_wt(RSTD2 + m, 1.0f / sqrtf(sq * (1.0f / DM) + EPS));
#pragma unroll
                    for (int k = 0; k < 2; ++k) { v4u w; w.x = pk2(v[k][0], v[k][1]); w.y = pk2(v[k][2], v[k][3]); w.z = pk2(v[k][4], v[k][5]); w.w = pk2(v[k][6], v[k][7]); st16_wt(rx1, ((size_t)m * DM + k * 512 + 8 * lane) * 2, w); } }
            }
            asm volatile("s_waitcnt vmcnt(0)" ::: "memory");
            if (lane == 0) __hip_atomic_fetch_add(C5 + 64 * u.pm, 1u, __ATOMIC_RELAXED, __HIP_MEMORY_SCOPE_AGENT);
        }
        __syncthreads();
        if (tid == 0) __hip_atomic_fetch_add(T5, 1u, __ATOMIC_RELAXED, __HIP_MEMORY_SCOPE_AGENT);
    }
    STAMP(9);
    if (IN(6)) {
        pg8::Gemm g{X1B, WfiT, X1B, WfiT, MT, INW, DM}; pg8::DynOrder S; S.init(QH + 6 * 512, MP, INW, 1, BOX);
        EpiSwiglu E{RSTD2, ACT}; const pg8::Dep D{C5, 32u, T5, NWG, T3, NWG, C6, T6, TMO};
        l1_acquire(tid); pg8::gemm_phase<EpiSwiglu, pg8::DynOrder, 0>(lds, g, S, E, D);
    }
    STAMP(10);
    if (IN(7)) {
        pg8::Gemm g{ACT, WfoT, ACT, WfoT, MT, DM, DFF}; pg8::DynOrder S; S.init(QH + 7 * 512, MP, DM, 1, BOX);
        EpiBf16Ss E{FB, PF}; const pg8::Dep D{C6, 176u, T6, NWG, nullptr, 0u, C7, T7, TMO};
        l1_acquire(tid); pg8::gemm_phase<EpiBf16Ss, pg8::DynOrder, 0>(lds, g, S, E, D);
    }
    STAMP(11);
    if (IN(8)) {
        pg8::DynOrder S; S.init(QH + 8 * 512, MP, DM, 1, BOX); pg8::Unit u; const rsrc_t rf = mk_rsrc(FB), rx1 = mk_rsrc(X1B);
        f32x4 gv[4];
#pragma unroll
        for (int k = 0; k < 4; ++k) gv[k] = *(const f32x4*)(g_post_ffn + (k >> 1) * 512 + 8 * lane + (k & 1) * 4);
        int rflag = 0;
        for (int i = 0; chunk_next(S, i, u, tid); ++i) {
            rows_wait(C7 + 64 * u.pm, 32u, T7, NWG, rflag, TMO, wave);
            const int mb = u.pm * 256 + u.pn * 64 + wave * 8;
#pragma unroll 1
            for (int h = 0; h < 2; ++h) {
                v4u xw[4][2], fw[4][2]; float ps[4];
#pragma unroll
                for (int r = 0; r < 4; ++r) { const int m = mb + 4 * h + r; ps[r] = ldf_nc(PF + (size_t)(lane & 15) * MT + m);
#pragma unroll
                    for (int k = 0; k < 2; ++k) { xw[r][k] = ld16_nc(rx1, ((size_t)m * DM + k * 512 + 8 * lane) * 2); fw[r][k] = ld16_nc(rf, ((size_t)m * DM + k * 512 + 8 * lane) * 2); } }
#pragma unroll
                for (int r = 0; r < 4; ++r) { const int m = mb + 4 * h + r; float p = ps[r]; p += __shfl_xor(p, 1); p += __shfl_xor(p, 2); p += __shfl_xor(p, 4); p += __shfl_xor(p, 8);
                    const float rf2 = 1.0f / sqrtf(p * (1.0f / DM) + EPS);
                    float* yrow = (m < MP) ? out + O_YP + (size_t)m * DM : out + O_YS + (size_t)(m - MP) * DM;
#pragma unroll
                    for (int k = 0; k < 2; ++k) { const v4u a = xw[r][k], b = fw[r][k]; const f32x4 g0 = gv[2 * k], g1 = gv[2 * k + 1]; f32x4 y0, y1;
                        y0.x = bflo(a.x) + bflo(b.x) * rf2 * g0.x; y0.y = bfhi(a.x) + bfhi(b.x) * rf2 * g0.y; y0.z = bflo(a.y) + bflo(b.y) * rf2 * g0.z; y0.w = bfhi(a.y) + bfhi(b.y) * rf2 * g0.w;
                        y1.x = bflo(a.z) + bflo(b.z) * rf2 * g1.x; y1.y = bfhi(a.z) + bfhi(b.z) * rf2 * g1.y; y1.z = bflo(a.w) + bflo(b.w) * rf2 * g1.z; y1.w = bfhi(a.w) + bfhi(b.w) * rf2 * g1.w;
                        *(f32x4*)(yrow + k * 512 + 8 * lane) = y0; *(f32x4*)(yrow + k * 512 + 8 * lane + 4) = y1; } }
            }
        }
    }
    STAMP(12);
#undef IN
#undef SEAM
}

#ifdef TS_A
#ifndef TS_C
#define TS_C TS_A
#define TS_D TS_B
#endif
#ifndef TS_SCALE
#define TS_SCALE 1e-7f
#endif
#ifndef TS_STAT
#define TS_STAT 0
#endif
__global__ void probe_fin(unsigned char* ws, float* out, int G) {
    __shared__ unsigned long long sh[4][256];
    const unsigned long long* ts = (const unsigned long long*)(ws + 768 * 1024); const int t = threadIdx.x;
    unsigned long long a = 0, b = 0, c = 0, d = 0;
    if (t < G) { a = ts[t * 16 + TS_A]; b = ts[t * 16 + TS_B]; c = ts[t * 16 + TS_C]; d = ts[t * 16 + TS_D]; }
    sh[0][t] = a; sh[1][t] = b; sh[2][t] = c; sh[3][t] = d; __syncthreads();
    if (t == 0) {
        unsigned long long s1 = 0, s2 = 0, mina = ~0ull, maxb = 0, minc = ~0ull, maxd = 0;
        for (int i = 0; i < G; ++i) { s1 += sh[1][i] - sh[0][i]; s2 += sh[3][i] - sh[2][i]; if (sh[0][i] < mina) mina = sh[0][i]; if (sh[1][i] > maxb) maxb = sh[1][i]; if (sh[2][i] < minc) minc = sh[2][i]; if (sh[3][i] > maxd) maxd = sh[3][i]; }
        const unsigned long long v1 = TS_STAT ? (maxb - mina) : s1 / (unsigned long long)G, v2 = TS_STAT ? (maxd - minc) : s2 / (unsigned long long)G;
        const unsigned long long t0 = __builtin_amdgcn_s_memrealtime();
        while (__builtin_amdgcn_s_memrealtime() - t0 < v1) __builtin_amdgcn_s_sleep(8);
        const float us = (float)v2 * 0.01f;
        out[O_GS] += sqrtf(us * TS_SCALE * 262930.0f);
    }
}
#endif
constexpr int N_PHASES = 9;
extern "C" void kernel_launch(void* const* d_in, const int* in_sizes, int n_in, void* d_out, int out_size, void* d_ws, size_t ws_size, hipStream_t stream) {
    static int grid = 0;
    if (grid == 0) {
        if (n_in != 19 || (size_t)out_size != O_END || ws_size < WS_END) { fprintf(stderr, "kernel_launch: unexpected shapes: n_in %d out %d ws %zu (need %zu)\n", n_in, out_size, ws_size, (size_t)WS_END); grid = -1; return; }
        int dev = 0, cus = 0;
        if (hipGetDevice(&dev) != hipSuccess || hipDeviceGetAttribute(&cus, hipDeviceAttributeMultiprocessorCount, dev) != hipSuccess) { grid = -1; return; }
        if (hipFuncSetAttribute((const void*)fwd_kernel, hipFuncAttributeMaxDynamicSharedMemorySize, LDS_BYTES) != hipSuccess) { fprintf(stderr, "kernel_launch: hipFuncSetAttribute failed\n"); grid = -1; return; }
        int per_cu = 0;
        (void)hipOccupancyMaxActiveBlocksPerMultiprocessor(&per_cu, (const void*)fwd_kernel, NWAVES * 64, LDS_BYTES);
        (void)hipGetLastError();
        grid = cus;
    }
    if (grid < 0) return;
    (void)hipMemsetAsync((char*)d_ws + WS_CTL, 0, CTL_ZERO_BYTES, stream);
    Args a{};
    for (int i = 0; i < 19; ++i) a.in[i] = (const float*)d_in[i];
    a.out = (float*)d_out; a.ws = (unsigned char*)d_ws;
#if MK_ONE_LAUNCH
    a.ph_lo = 0; a.ph_hi = N_PHASES;
    hipLaunchKernelGGL(fwd_kernel, dim3(grid), dim3(NWAVES * 64), LDS_BYTES, stream, a);
#ifdef TS_A
    hipLaunchKernelGGL(probe_fin, dim3(1), dim3(256), 0, stream, (unsigned char*)d_ws, (float*)d_out, grid);
#endif
#else
    for (int p = 0; p < N_PHASES; ++p) { a.ph_lo = p; a.ph_hi = p + 1; hipLaunchKernelGGL(fwd_kernel, dim3(grid), dim3(NWAVES * 64), LDS_BYTES, stream, a); }
#endif
}
```

```cpp
#include <hip/hip_runtime.h>
#include <cstdio>
#include <cstdint>

#ifndef MK_ONE_LAUNCH
#define MK_ONE_LAUNCH 1
#endif
#ifndef REP_MASK
#define REP_MASK 0
#endif
#define NREP(k) (((REP_MASK >> (k)) & 1) ? 2 : 1)
#ifdef TS_A
#define STAMP(j) do { if (threadIdx.x == 0) ((unsigned long long*)(args.ws + 768 * 1024))[blockIdx.x * 16 + (j)] = __builtin_amdgcn_s_memrealtime(); } while (0)
#else
#define STAMP(j) do { } while (0)
#endif

namespace pg8 {
#define PG8_LAS __attribute__((address_space(3)))
typedef unsigned short bf16_t;
typedef short bf16x8 __attribute__((ext_vector_type(8)));
typedef float f32x4 __attribute__((ext_vector_type(4)));
typedef unsigned u32x4 __attribute__((ext_vector_type(4)));
constexpr int EPOLL_OFF = 131072 + 4096;
constexpr int BM = 256, BK = 64, HALF = 128, HTB = HALF * BK * 2  , STAGE_BYTES = 8 * HTB, NXCD = 8, WGM = 8;

__host__ __device__ __forceinline__ int lds_byte(int r, int c) { const int st = (r >> 4) * 2 + (c >> 5), rr = r & 15, cc = c & 31, ob = rr * 64 + cc * 2; return st * 1024 + (ob ^ (((ob >> 9) & 1) << 5)); }
__host__ __device__ __forceinline__ void stage_rc(int b, int& R, int& C) { const int st = b / 1024, sb = b % 1024, swz = sb ^ (((sb >> 9) & 1) << 5); R = (st >> 1) * 16 + swz / 64; C = (st & 1) * 32 + (swz % 64) / 2; }
__host__ __device__ __forceinline__ int perm32(int rho) { const int n = rho >> 4, i = rho & 15; return 8 * (i >> 2) + 4 * n + (i & 3); }

struct Unit { int pm, pn, seg; };
struct Gemm { const bf16_t* A0; const bf16_t* B0; const bf16_t* A1; const bf16_t* B1; int M, N, K; };

struct StaticOrder {
    int nM, nN, nwg, G, c, nseg;
    __host__ __device__ void init(int M, int N, int G_, int c_, int nseg_) { nM = M / BM; nN = N / BM; nwg = nM * nN; G = G_; c = c_; nseg = nseg_; }
    __host__ __device__ bool next(int i, Unit& u) const {
        const int ti = (nseg == 2) ? (i >> 1) : i; u.seg = (nseg == 2) ? (i & 1) : 0;
        const long L = (long)ti * G + c; if (L >= nwg) return false;
        int wgid = (int)L; { const int q = nwg / NXCD, r = nwg % NXCD, xcd = wgid % NXCD, off = wgid / NXCD; wgid = (xcd < r ? xcd * (q + 1) : r * (q + 1) + (xcd - r) * q) + off; }
        const int nig = WGM * nN, gid = wgid / nig, fm = gid * WGM, gsz = (nM - fm) < WGM ? (nM - fm) : WGM;
        u.pm = fm + ((wgid % nig) % gsz); u.pn = (wgid % nig) / gsz; return true;
    }
};

struct DfOrder {
    StaticOrder P; int nNs, cs, nseg;
    __host__ __device__ void init(int Mp, int N, int G, int c, int shift, int nseg_) { P.init(Mp, N, G, c, 1); nNs = N / BM; cs = (c + G - shift % G) % G; nseg = nseg_; }
    __host__ __device__ bool next(int i, Unit& u) const {
        int ti = (nseg == 2) ? (i >> 1) : i; u.seg = (nseg == 2) ? (i & 1) : 0;
        if (cs < nNs) { if (ti == 1) { u.pm = P.nM; u.pn = cs; return true; } if (ti > 1) --ti; }
        Unit t; if (!P.next(ti, t)) return false; u.pm = t.pm; u.pn = t.pn; return true;
    }
};
struct DynOrder {
    unsigned* q8; int nMp, nN, xcd, nseg; PG8_LAS int* box; unsigned tk;
    __device__ __forceinline__ void init(unsigned* q8_, int Mp, int N, int nseg_, PG8_LAS int* box_) { xcd = (int)(__builtin_amdgcn_s_getreg((3 << 11) | 20) & 7u); q8 = q8_; nMp = Mp / BM; nN = N / BM; nseg = nseg_; box = box_; tk = 0u; }
    __device__ __forceinline__ unsigned draw(int cls) const { return __hip_atomic_fetch_add(q8 + 64 * cls, 1u, __ATOMIC_RELAXED, __HIP_MEMORY_SCOPE_AGENT); }
    __device__ __forceinline__ bool map(int cls, unsigned t, int& pm, int& pn) const {
        const int ns = (nN - cls + 7) >> 3, q = nMp * nN / NXCD, ti = (int)t;
        if (ti < ns) { pm = nMp; pn = cls + 8 * ti; return true; }
        if (ti - ns < q) { const int wgid = cls * q + (ti - ns), nig = WGM * nN, gid = wgid / nig, fm = gid * WGM, gsz = (nMp - fm) < WGM ? (nMp - fm) : WGM; pm = fm + ((wgid % nig) % gsz); pn = (wgid % nig) / gsz; return true; }
        return false;
    }
    __device__ __forceinline__ void put(int slot, unsigned t, int seg) const {
        int pm = 0, pn = 0; bool valid = map(xcd, t, pm, pn);
        for (int k = 1; k < NXCD && !valid; ++k) { const int cls = (xcd + k) & 7; valid = map(cls, draw(cls), pm, pn); }
        box[4 * slot + 0] = pm; box[4 * slot + 1] = pn; box[4 * slot + 2] = seg; box[4 * slot + 3] = valid ? 1 : 0;
    }
    __device__ __forceinline__ bool get(int slot, Unit& u) const { u.pm = box[4 * slot]; u.pn = box[4 * slot + 1]; u.seg = box[4 * slot + 2]; return box[4 * slot + 3] != 0; }
    __device__ __forceinline__ bool first(Unit& u) {
        __syncthreads();
        if (threadIdx.x == 0) {
            put(0, draw(xcd), 0);
            if (nseg == 2) { box[4] = box[0]; box[5] = box[1]; box[6] = 1; box[7] = box[3]; } else put(1, draw(xcd), 0);
        }
        __syncthreads();
        return get(0, u);
    }
    __device__ __forceinline__ bool peek_next(int ui, Unit& u) const { return get((ui + 1) & 1, u); }
    __device__ __forceinline__ void pull(int ui, int wid) {
        if (wid == 0 && (threadIdx.x & 63) == 0 && (nseg == 1 || (ui & 1) == 0)) tk = draw(xcd);
    }
    __device__ __forceinline__ void pull_async(int ui, int wid) {
        if (wid == 0 && (threadIdx.x & 63) == 0 && (nseg == 1 || (ui & 1) == 0)) { unsigned* p = q8 + 64 * xcd; asm volatile("s_nop 4\n\tglobal_atomic_add v255, %0, %1, %2 sc0" :: "v"(0u), "v"(1u), "s"(p) : "v255", "memory"); }
    }
    __device__ __forceinline__ void commit(int ui, int wid, bool async_tk = false) {
        if (wid == 0 && (threadIdx.x & 63) == 0) {
            if (async_tk && (nseg == 1 || (ui & 1) == 0)) asm volatile("v_mov_b32 %0, v255" : "=v"(tk) :: "memory");
            if (nseg == 1 || (ui & 1) == 0) put(ui & 1, tk, 0);
            else { const int o = (ui + 1) & 1, d = ui & 1; box[4 * d] = box[4 * o]; box[4 * d + 1] = box[4 * o + 1]; box[4 * d + 2] = 1; box[4 * d + 3] = box[4 * o + 3]; }
        }
    }
};
struct Dep {
    unsigned* wait_cnt; unsigned need;
    unsigned* wait_tot; unsigned need_tot;
    unsigned* guard; unsigned need_guard;
    unsigned* done_cnt; unsigned* done_tot;
    unsigned* tmo;
};
#define PG8_SPIN_CAP (1u << 16)
__device__ __forceinline__ void dep_wait(const Dep& D, int pm, int wid, int& flags, unsigned early = 0u) {
    if (D.wait_cnt == nullptr) return;
    if (wid == 0 && (flags & 1) == 0 && !((flags & 2) != 0 && (unsigned)__builtin_amdgcn_readfirstlane(early) >= D.need)) {
        unsigned spins = 0;
        for (;;) {
            const unsigned c0 = __hip_atomic_load(D.wait_cnt + 64 * pm, __ATOMIC_RELAXED, __HIP_MEMORY_SCOPE_AGENT);
            const unsigned t0 = __hip_atomic_load(D.wait_tot, __ATOMIC_RELAXED, __HIP_MEMORY_SCOPE_AGENT);
            const unsigned g0 = (D.guard != nullptr && (flags & 2) == 0) ? __hip_atomic_load(D.guard, __ATOMIC_RELAXED, __HIP_MEMORY_SCOPE_AGENT) : D.need_guard;
            const unsigned c = (unsigned)__builtin_amdgcn_readfirstlane(c0), t = (unsigned)__builtin_amdgcn_readfirstlane(t0), gg = (unsigned)__builtin_amdgcn_readfirstlane(g0);
            if (gg >= D.need_guard) flags |= 2;
            if (t >= D.need_tot && (flags & 2)) { flags |= 1; break; }
            if (c >= D.need && (flags & 2)) break;
            if (++spins > PG8_SPIN_CAP || ((spins & 63u) == 0u && __builtin_amdgcn_readfirstlane(__hip_atomic_load(D.tmo, __ATOMIC_RELAXED, __HIP_MEMORY_SCOPE_AGENT)) != 0u)) { if ((threadIdx.x & 63) == 0) __hip_atomic_store(D.tmo, 1u, __ATOMIC_RELAXED, __HIP_MEMORY_SCOPE_AGENT); break; }
            __builtin_amdgcn_s_sleep(4);
        }
    }
    asm volatile("" ::: "memory"); __builtin_amdgcn_s_barrier(); asm volatile("" ::: "memory");
}
__device__ __forceinline__ void dep_done(const Dep& D, int pm, int lane) {
    if (D.done_cnt != nullptr && lane == 0) __hip_atomic_fetch_add(D.done_cnt + 64 * pm, 1u, __ATOMIC_RELAXED, __HIP_MEMORY_SCOPE_AGENT);
}

template <class Epi, class Sched, int AUXA>
__device__ __forceinline__ void gemm_phase(PG8_LAS unsigned char* lds, const Gemm g, Sched& S, const Epi& E, const Dep D) {
    const int tid = threadIdx.x, wid = __builtin_amdgcn_readfirstlane(tid >> 6), lane = tid & 63, wr = wid >> 2, wc = wid & 3, fr = lane & 15, fq = lane >> 4;
    const int K = g.K, nt = K / BK;
    unsigned voffA[2], voffB[2];
#pragma unroll
    for (int i = 0; i < 2; ++i) { int R, C; stage_rc(tid * 16 + i * 8192, R, C); const int Rb = Epi::PERM ? ((R & ~31) + perm32(R & 31)) : R;
        voffA[i] = (unsigned)(R * K + C) * 2u; voffB[i] = (unsigned)(Rb * K + C) * 2u; }
    const size_t kstep = (size_t)(BK * 2);
    const size_t hstep = (size_t)HALF * K * 2;
    const size_t tstep = 2 * hstep;
    const unsigned ldsw = (unsigned)wid * 1024u;
    const int aoff = lds_byte(wr * 64 + fr, fq * 8), boff = lds_byte(wc * 32 + fr, fq * 8);
#define PG8_SA(b, h) (((b) * 2 + (h)) * HTB)
#define PG8_SB(b, h) ((4 + (b) * 2 + (h)) * HTB)
#define PG8_STAGE(bufoff, gbase, voff) do { _Pragma("unroll") for (int _i = 0; _i < 2; ++_i) \
        __builtin_amdgcn_global_load_lds((const unsigned*)((const char*)(gbase) + (voff)[_i]), (PG8_LAS unsigned*)(lds + (bufoff) + ldsw + _i * 8192), 16, 0, 0); } while (0)
#define PG8_STAGEA(bufoff, gbase, voff) do { _Pragma("unroll") for (int _i = 0; _i < 2; ++_i) \
        __builtin_amdgcn_global_load_lds((const unsigned*)((const char*)(gbase) + (voff)[_i]), (PG8_LAS unsigned*)(lds + (bufoff) + ldsw + _i * 8192), 16, 0, AUXA); } while (0)
#define PG8_LDA(dst, b, h) do { _Pragma("unroll") for (int m = 0; m < 4; ++m) _Pragma("unroll") for (int k = 0; k < 2; ++k) dst[m][k] = *(const PG8_LAS bf16x8*)(lds + PG8_SA(b, h) + aoff + m * 2048 + k * 1024); } while (0)
#define PG8_LDB(dst, b, h) do { _Pragma("unroll") for (int n = 0; n < 2; ++n) _Pragma("unroll") for (int k = 0; k < 2; ++k) dst[n][k] = *(const PG8_LAS bf16x8*)(lds + PG8_SB(b, h) + boff + n * 2048 + k * 1024); } while (0)
#define PG8_MMA(ai, bj, At, Bt) do { __builtin_amdgcn_s_setprio(1); _Pragma("unroll") for (int m = 0; m < 4; ++m) _Pragma("unroll") for (int n = 0; n < 2; ++n) _Pragma("unroll") for (int k = 0; k < 2; ++k) \
        acc[ai][bj][m][n] = __builtin_amdgcn_mfma_f32_16x16x32_bf16(Bt[n][k], At[m][k], acc[ai][bj][m][n], 0, 0, 0); __builtin_amdgcn_s_setprio(0); } while (0)
#define PG8_WAIT_V(n) asm volatile("s_waitcnt vmcnt(" #n ")" ::: "memory")
#define PG8_WAIT_L(n) asm volatile("s_waitcnt lgkmcnt(" #n ")" ::: "memory")
#define PG8_BAR __builtin_amdgcn_s_barrier()
#define PG8_SCHED __builtin_amdgcn_sched_barrier(0)
    Unit cur, nxt; int ui = 0;
    if (!S.first(cur)) { if (D.done_tot != nullptr && tid == 0) __hip_atomic_fetch_add(D.done_tot, 1u, __ATOMIC_RELAXED, __HIP_MEMORY_SCOPE_AGENT); return; }
    f32x4 acc[2][2][4][2];
#pragma unroll
    for (int a = 0; a < 2; ++a)
#pragma unroll
        for (int b = 0; b < 2; ++b)
#pragma unroll
            for (int m = 0; m < 4; ++m)
#pragma unroll
                for (int n = 0; n < 2; ++n) acc[a][b][m][n] = (f32x4){0.f, 0.f, 0.f, 0.f};
    bf16x8 At[4][2], B0[2][2], B1[2][2];
    const char* cA = (const char*)(cur.seg ? g.A1 : g.A0) + (size_t)cur.pm * tstep; const char* cB = (const char*)(cur.seg ? g.B1 : g.B0) + (size_t)cur.pn * tstep;
    int dflags = 0, pend = -1;
    PG8_STAGE(PG8_SB(0, 0), cB, voffB); PG8_STAGE(PG8_SB(0, 1), cB + hstep, voffB);
    dep_wait(D, cur.pm, wid, dflags);
    PG8_STAGEA(PG8_SA(0, 0), cA, voffA); PG8_STAGEA(PG8_SA(0, 1), cA + hstep, voffA);
    if (wr == 1) PG8_BAR;
    PG8_WAIT_V(2); PG8_BAR;
    PG8_STAGE(PG8_SB(1, 0), cB + kstep, voffB); PG8_STAGEA(PG8_SA(1, 0), cA + kstep, voffA); PG8_STAGE(PG8_SB(1, 1), cB + hstep + kstep, voffB);
    PG8_WAIT_V(6); PG8_BAR;
    for (;;) {
        bool has_next = false; const char* nA = cA; const char* nB = cB;
#define PG8_TRIP(a1, a2, b2, a3, b3) do { asm volatile("" : "+v"(voffA[0]), "+v"(voffA[1]), "+v"(voffB[0]), "+v"(voffB[1])); \
            PG8_LDB(B0, 0, 0); PG8_LDB(B1, 0, 1); PG8_SCHED; PG8_LDA(At, 0, 0); PG8_STAGEA(PG8_SA(1, 1), (a1) + hstep, voffA); \
            PG8_WAIT_V(8); PG8_WAIT_L(0); PG8_BAR; PG8_MMA(0, 0, At, B0); PG8_MMA(0, 1, At, B1); PG8_BAR; PG8_SCHED; \
            PG8_LDA(At, 0, 1); PG8_STAGE(PG8_SB(0, 0), (b2), voffB); PG8_STAGE(PG8_SB(0, 1), (b2) + hstep, voffB); PG8_STAGEA(PG8_SA(0, 0), (a2), voffA); \
            PG8_WAIT_V(8); PG8_WAIT_L(0); PG8_BAR; PG8_MMA(1, 0, At, B0); PG8_MMA(1, 1, At, B1); PG8_BAR; PG8_SCHED; \
            PG8_LDB(B0, 1, 0); PG8_LDB(B1, 1, 1); PG8_SCHED; PG8_LDA(At, 1, 0); PG8_STAGEA(PG8_SA(0, 1), (a2) + hstep, voffA); \
            PG8_WAIT_V(8); PG8_WAIT_L(0); PG8_BAR; PG8_MMA(0, 0, At, B0); PG8_MMA(0, 1, At, B1); PG8_BAR; PG8_SCHED; \
            PG8_LDA(At, 1, 1); PG8_STAGE(PG8_SB(1, 0), (b3), voffB); PG8_STAGE(PG8_SB(1, 1), (b3) + hstep, voffB); PG8_STAGEA(PG8_SA(1, 0), (a3), voffA); \
            PG8_WAIT_V(8); PG8_WAIT_L(0); PG8_BAR; PG8_MMA(1, 0, At, B0); PG8_MMA(1, 1, At, B1); PG8_BAR; PG8_SCHED; } while (0)
        {
            const char* a1 = cA + kstep; const char* a2 = cA + 2 * kstep; const char* b2 = cB + 2 * kstep; const char* a3 = a2 + kstep; const char* b3 = b2 + kstep;
            PG8_TRIP(a1, a2, b2, a3, b3);
            if (pend >= 0) { dep_done(D, pend, lane); pend = -1; }
            if (D.wait_cnt != nullptr && wid == 0 && (dflags & 1) == 0 && nt >= 8) {
                Unit en;
                if (S.peek_next(ui, en) && lane == 0) __builtin_amdgcn_global_load_lds((const unsigned*)(D.wait_cnt + 64 * en.pm), (PG8_LAS unsigned*)(lds + EPOLL_OFF), 4, 0, 16);
            }
            if (nt >= 8) S.pull_async(ui, wid);
        }
        for (int t = 2; t < nt - 2; t += 2) {
            const char* a1 = cA + (size_t)(t + 1) * kstep; const char* a2 = cA + (size_t)(t + 2) * kstep; const char* b2 = cB + (size_t)(t + 2) * kstep; const char* a3 = a2 + kstep; const char* b3 = b2 + kstep;
            PG8_TRIP(a1, a2, b2, a3, b3);
        }
        typename Epi::Pre epre;
        {
            epre = E.pre(lds, cur, wr, wid, lane);
            has_next = S.peek_next(ui, nxt);
            if (has_next) { nA = (const char*)(nxt.seg ? g.A1 : g.A0) + (size_t)nxt.pm * tstep; nB = (const char*)(nxt.seg ? g.B1 : g.B0) + (size_t)nxt.pn * tstep; dep_wait(D, nxt.pm, wid, dflags, (D.wait_cnt != nullptr && nt >= 8) ? *(volatile PG8_LAS unsigned*)(lds + EPOLL_OFF) : 0u); }
            const char* a1 = cA + (size_t)(nt - 1) * kstep; const char* a2 = nA; const char* b2 = nB; const char* a3 = a2 + kstep; const char* b3 = b2 + kstep;
            PG8_TRIP(a1, a2, b2, a3, b3);
        }
#undef PG8_TRIP
        if (wr == 0) PG8_BAR;
        if (nt < 8) S.pull(ui, wid);
        const bool keep = E(lds, acc, cur, wr, wc, fr, fq, epre);
        S.commit(ui, wid, nt >= 8);
        if (!keep) pend = cur.pm;
        if (!has_next) break;
        if (!keep) {
#pragma unroll
        for (int a = 0; a < 2; ++a)
#pragma unroll
            for (int b = 0; b < 2; ++b)
#pragma unroll
                for (int m = 0; m < 4; ++m)
#pragma unroll
                    for (int n = 0; n < 2; ++n) acc[a][b][m][n] = (f32x4){0.f, 0.f, 0.f, 0.f};
        }
        cur = nxt; cA = nA; cB = nB; ++ui;
        if (wr == 1) PG8_BAR;
    }
    PG8_WAIT_V(0);
    if (pend >= 0) dep_done(D, pend, lane);
    PG8_BAR;
    if (D.done_tot != nullptr && tid == 0) __hip_atomic_fetch_add(D.done_tot, 1u, __ATOMIC_RELAXED, __HIP_MEMORY_SCOPE_AGENT);
#undef PG8_STAGEA
#undef PG8_SA
#undef PG8_SB
#undef PG8_STAGE
#undef PG8_LDA
#undef PG8_LDB
#undef PG8_MMA
#undef PG8_WAIT_V
#undef PG8_WAIT_L
#undef PG8_BAR
#undef PG8_SCHED
}
}

constexpr int DM = 1024, NB = 16, SEQ = 4096, DECS = 16, NKV = 4, HD = 64, KVW = 256, INW = 5632, DFF = 2816;
constexpr int MP = NB * SEQ, MS = NB * DECS, MT = MP + MS;
constexpr float EPS = 1e-6f, LOG2E = 1.4426950408889634f, QSCALE = 0.125f * LOG2E;
constexpr size_t O_YP = 0, O_YS = (size_t)MP * DM, O_KP = O_YS + (size_t)MS * DM, O_VP = O_KP + 524288, O_KS = O_VP + 524288, O_VS = O_KS + 524288, O_GS = O_VS + 524288, O_END = O_GS + (size_t)MS * DM;

constexpr size_t MiB = 1u << 20;
constexpr size_t WS_CTL = 0, CTL_ZERO_BYTES = 1 * MiB;
constexpr size_t WS_WIN = 1 * MiB, WS_WFI = 12 * MiB, WS_WA = 23 * MiB, WS_WG = 25 * MiB, WS_WO = 27 * MiB, WS_WFO = 29 * MiB;
constexpr size_t WS_WSB = 34 * MiB + 768 * 1024;
constexpr size_t WS_RSTD1 = 35 * MiB, WS_RSTD2 = 36 * MiB, WS_PMIX = 37 * MiB, WS_PF = 42 * MiB;
constexpr size_t ACTB = (size_t)MT * DM * 2;
constexpr size_t WS_R0 = 48 * MiB;
constexpr size_t WS_R1 = 177 * MiB;
constexpr size_t WS_R2 = 306 * MiB;
constexpr size_t WS_KB = 435 * MiB, WS_VB = 468 * MiB;
constexpr size_t WS_R3 = 501 * MiB;
constexpr size_t WS_SA = WS_R3, WS_SB = WS_R3 + ACTB, WS_U = WS_R3 + 2 * ACTB, WS_AO = WS_R3 + 3 * ACTB, WS_END = WS_AO + ACTB;
static_assert(WS_END <= 1024 * MiB && (size_t)MT * DFF * 2 <= 3 * ACTB && WS_R0 + ACTB <= WS_R1 && WS_R1 + ACTB <= WS_R2 && WS_R2 + ACTB <= WS_KB, "d_ws map");
constexpr int CW_BAR = 4096, CW_TMO = 64;
constexpr int CW_CNT = 16384;
constexpr int CW_TOT = CW_CNT + 5 * 264 * 64;
constexpr int CW_C0 = CW_TOT + 8 * 64;
constexpr int CW_Q = CW_C0 + 264 * 64;
constexpr int CW_C1 = CW_Q + 9 * 8 * 64, CW_C2 = CW_C1 + 264 * 64, CW_CS = CW_C2 + 264 * 64;
static_assert((CW_CS + 64) * 4 <= 768 * 1024, "CTL words inside the memset region, below the probe stamps");

constexpr int RING_BYTES = 131072, LDS_BYTES = 147456, LDSCTL_OFF = LDS_BYTES - 512, MISC_OFF = LDSCTL_OFF + 320;
constexpr int RSTG_OFF = RING_BYTES;
constexpr int NWAVES = 8, BOX_OFF = LDSCTL_OFF + 64;

#define GAS __attribute__((address_space(1)))
#define LAS __attribute__((address_space(3)))
typedef unsigned short bf16;
typedef unsigned v4u __attribute__((ext_vector_type(4)));
typedef unsigned v2u __attribute__((ext_vector_type(2)));
typedef float f32x4 __attribute__((ext_vector_type(4)));
typedef GAS unsigned gu32;
#define RLX_AGENT __ATOMIC_RELAXED, __HIP_MEMORY_SCOPE_AGENT
#define LDS_WAIT() asm volatile("s_waitcnt lgkmcnt(0)" ::: "memory")
typedef float f32x2_t __attribute__((ext_vector_type(2))); typedef __bf16 bf16x2_t __attribute__((ext_vector_type(2)));
__device__ __forceinline__ unsigned pk2(float lo, float hi) { f32x2_t v = {lo, hi}; bf16x2_t b = __builtin_convertvector(v, bf16x2_t); return __builtin_bit_cast(unsigned, b); }
__device__ __forceinline__ float bflo(unsigned w) { return __uint_as_float(w << 16); }
__device__ __forceinline__ float bfhi(unsigned w) { return __uint_as_float(w & 0xffff0000u); }
__device__ __forceinline__ float wave_sum(float v) {
#pragma unroll
    for (int o = 1; o < 64; o <<= 1) v += __shfl_xor(v, o);
    return v;
}
__device__ __forceinline__ float gelu_tanh(float x) {
    const float e = __builtin_amdgcn_exp2f(x * (-2.302208198f - 0.10294324f * x * x));
    return x * __builtin_amdgcn_rcpf(1.0f + e);
}
__device__ __forceinline__ float sigmoidf_(float x) { return __builtin_amdgcn_rcpf(1.0f + __builtin_amdgcn_exp2f(-LOG2E * x)); }

#define XB_TMO      128
#define XB_XCNT(j)  (256  + 64 * (j))
#define XB_XSUB(j)  (1280 + 64 * (j))
#define XB_XGEN(j)  (2304 + 64 * (j))
#define XB_TOP      3328
#define XB_TOPGEN   3392
#define XCD_BAR_WORDS 3456
#define XB_SPIN_CAP (1u << 18)
__device__ __forceinline__ unsigned xb_ld(unsigned* p)              { return __hip_atomic_load(p, __ATOMIC_RELAXED, __HIP_MEMORY_SCOPE_AGENT); }
__device__ __forceinline__ unsigned xb_add(unsigned* p, unsigned v) { return __hip_atomic_fetch_add(p, v, __ATOMIC_RELAXED, __HIP_MEMORY_SCOPE_AGENT); }
__device__ __forceinline__ unsigned xb_xcc_id() { return (unsigned)__builtin_amdgcn_s_getreg((3 << 11) | 20) & 0xFu; }
#define XB_SPIN(cond, bar) do { unsigned _sp = 0; while (cond) { __builtin_amdgcn_s_sleep(1); \
    if ((++_sp & 255u) == 0u) { if (xb_ld(&(bar)[XB_TMO])) break; if (_sp > XB_SPIN_CAP) { atomicAdd(&(bar)[XB_TMO], 1u); break; } } } } while (0)
struct XcdBarrier { unsigned* bar; unsigned x; volatile LAS unsigned* st; };
__device__ __forceinline__ XcdBarrier xcd_barrier_post(unsigned* bar, volatile LAS unsigned* st) {
    XcdBarrier b; b.bar = bar; b.x = xb_xcc_id(); b.st = st;
    if (threadIdx.x == 0) (void)xb_add(&bar[XB_XCNT(b.x)], 1u);
    return b;
}
__device__ __forceinline__ void xcd_barrier_complete(unsigned* bar, unsigned x, unsigned& nloc, unsigned& nx) {
    const unsigned G = gridDim.x * gridDim.y * gridDim.z;
    unsigned sum, cnt, mine, sp = 0u;
    for (;;) {
        sum = 0u; cnt = 0u; mine = 0u;
#pragma unroll
        for (unsigned j = 0; j < 16; ++j) { const unsigned c = xb_ld(&bar[XB_XCNT(j)]); sum += c; cnt += (c > 0u) ? 1u : 0u; mine = (j == x) ? c : mine; }
        if (sum == G) break;
        __builtin_amdgcn_s_sleep(1);
        if ((++sp & 255u) == 0u) { if (xb_ld(&bar[XB_TMO])) break; if (sp > XB_SPIN_CAP) { atomicAdd(&bar[XB_TMO], 1u); break; } }
    }
    nloc = mine > 0u ? mine : 1u; nx = cnt > 0u ? cnt : 1u;
}
__device__ __forceinline__ void xcd_barrier(const XcdBarrier& b) {
    asm volatile("s_waitcnt vmcnt(0)" ::: "memory");
    __syncthreads();
    if (threadIdx.x == 0) {
        unsigned* bar = b.bar;
        __builtin_amdgcn_s_waitcnt(0);
        unsigned nloc = b.st[0], nx = b.st[1];
        if (nloc == 0u) { xcd_barrier_complete(bar, b.x, nloc, nx); b.st[0] = nloc; b.st[1] = nx; }
        const unsigned old = xb_add(&bar[XB_XSUB(b.x)], 1u);
        const unsigned gen = old / nloc;
        if (old + 1u == (gen + 1u) * nloc) {
            __builtin_amdgcn_fence(__ATOMIC_RELEASE, "agent");
            asm volatile("s_waitcnt vmcnt(0)" ::: "memory");
            const unsigned og = xb_add(&bar[XB_TOP], 1u);
            const unsigned tg = og / nx;
            if (og + 1u == (tg + 1u) * nx) xb_add(&bar[XB_TOPGEN], 1u);
            else XB_SPIN(xb_ld(&bar[XB_TOPGEN]) == tg, bar);
            __builtin_amdgcn_fence(__ATOMIC_ACQUIRE, "agent");
            xb_add(&bar[XB_XGEN(b.x)], 1u);
            asm volatile("s_waitcnt vmcnt(0)" ::: "memory");
        } else {
            XB_SPIN(xb_ld(&bar[XB_XGEN(b.x)]) == gen, bar);
            __builtin_amdgcn_fence(__ATOMIC_ACQUIRE, "agent");
            asm volatile("s_waitcnt vmcnt(0)" ::: "memory");
        }
    }
    __syncthreads();
}

typedef __amdgpu_buffer_rsrc_t rsrc_t;
__device__ __forceinline__ rsrc_t mk_rsrc(const void* p) { return __builtin_amdgcn_make_buffer_rsrc((void*)p, 0, 0x7fffffff, 0x00020000); }
__device__ __forceinline__ void st16_wt(rsrc_t r, size_t byte_off, v4u v) { __builtin_amdgcn_raw_buffer_store_b128(v, r, (int)byte_off, 0, 16); }
__device__ __forceinline__ v4u ld16_nc(rsrc_t r, size_t byte_off) { return __builtin_amdgcn_raw_buffer_load_b128(r, (int)byte_off, 0, 16); }
__device__ __forceinline__ void stf_wt(float* p, float v) { __hip_atomic_store((unsigned*)p, __float_as_uint(v), __ATOMIC_RELAXED, __HIP_MEMORY_SCOPE_AGENT); }
__device__ __forceinline__ float ldf_nc(const float* p) { return __uint_as_float(__hip_atomic_load((const unsigned*)p, __ATOMIC_RELAXED, __HIP_MEMORY_SCOPE_AGENT)); }

using pg8::Unit;
struct EpiIn {
    static constexpr bool PERM = true;
    const float* rstd; bf16 *Q, *Kb, *Vb, *U, *GV, *SA, *SB; float* out; float *PG1, *PG2;
    struct Pre {};
    __device__ __forceinline__ Pre pre(LAS unsigned char* lds, const Unit& u, int wr, int wid, int lane) const {
#pragma unroll
        for (int ai = 0; ai < 2; ++ai) __builtin_amdgcn_global_load_lds((const unsigned*)(rstd + u.pm * 256 + wr * 64 + ai * 128 + lane), (LAS unsigned*)(lds + RSTG_OFF + wid * 512 + ai * 256), 4, 0, 0);
        return Pre{}; }
    __device__ __forceinline__ bool operator()(LAS unsigned char* lds, f32x4 (&acc)[2][2][4][2], const Unit& u, int wr, int wc, int fr, int fq, const Pre&) const {
        const int pn = u.pn; int mode, ld, colt; bf16* dst; float* side = nullptr; size_t side_s = 0;
        if (pn < 4)       { mode = 0; dst = Q;  ld = DM;  colt = pn * 256; }
        else if (pn == 4) { mode = 1; dst = Kb; ld = KVW; colt = 0; side = out + O_KP; side_s = O_KS - O_KP; }
        else if (pn == 5) { mode = 1; dst = Vb; ld = KVW; colt = 0; side = out + O_VP; side_s = O_VS - O_VP; }
        else if (pn < 10) { mode = 2; dst = U;  ld = DM;  colt = (pn - 6) * 256; }
        else if (pn < 14) { mode = 2; dst = GV; ld = DM;  colt = (pn - 10) * 256; }
        else if (pn < 18) { mode = 3; dst = SA; ld = DM;  colt = (pn - 14) * 256; }
        else              { mode = 3; dst = SB; ld = DM;  colt = (pn - 18) * 256; }
        const int row0 = u.pm * 256 + wr * 64 + fr, col0 = colt + wc * 32 + 8 * fq; const rsrc_t rdst = mk_rsrc(dst);
        const LAS float* rsl = (const LAS float*)(lds + RSTG_OFF + (wr * 4 + wc) * 512) + fr;
#pragma unroll
        for (int ai = 0; ai < 2; ++ai)
#pragma unroll
            for (int m = 0; m < 4; ++m) {
                const int row = row0 + ai * 128 + m * 16; const float rs = rsl[ai * 64 + m * 16]; float s1 = 0.f, s2 = 0.f;
#pragma unroll
                for (int bj = 0; bj < 2; ++bj) {
                    float v[8];
#pragma unroll
                    for (int j = 0; j < 4; ++j) { v[j] = acc[ai][bj][m][0][j] * rs; v[4 + j] = acc[ai][bj][m][1][j] * rs; }
                    if (mode == 0) {
#pragma unroll
                        for (int j = 0; j < 8; ++j) v[j] *= QSCALE;
                    } else if (mode == 2) {
#pragma unroll
                        for (int j = 0; j < 8; ++j) { v[j] = gelu_tanh(v[j]); s1 += v[j]; s2 += v[j] * v[j]; }
                    } else if (mode == 3) {
#pragma unroll
                        for (int j = 0; j < 8; ++j) v[j] = sigmoidf_(v[j]);
                    }
                    const int col = col0 + bj * 128;
                    v4u w; w.x = pk2(v[0], v[1]); w.y = pk2(v[2], v[3]); w.z = pk2(v[4], v[5]); w.w = pk2(v[6], v[7]);
                    st16_wt(rdst, ((size_t)row * ld + col) * 2, w);
                    if (mode == 1) {
                        float* sp = nullptr;
                        if (u.pm == 256) { const int r = row - MP; sp = side + side_s + ((size_t)((r >> 4) * 128 + 112 + (r & 15)) * KVW + col); }
                        else if ((u.pm & 15) == 15 && ai == 1) { const int j = wr * 64 + m * 16 + fr; sp = side + ((size_t)((u.pm >> 4) * 128 + j) * KVW + col); }
                        if (sp) { *(f32x4*)sp = (f32x4){v[0], v[1], v[2], v[3]}; *(f32x4*)(sp + 4) = (f32x4){v[4], v[5], v[6], v[7]}; }
                    }
                }
                if (pn >= 10 && pn < 14) {
                    s1 += __shfl_xor(s1, 16); s1 += __shfl_xor(s1, 32); s2 += __shfl_xor(s2, 16); s2 += __shfl_xor(s2, 32);
                    if (fq == 0) { const size_t si = (size_t)((pn - 10) * 4 + wc) * MT + row; stf_wt(PG1 + si, s1); stf_wt(PG2 + si, s2); }
                }
            }
        return false;
    }
};
struct EpiMerge {
    static constexpr bool PERM = true;
    const bf16 *SA, *SB; bf16* O;
    struct Pre {}; __device__ __forceinline__ Pre pre(LAS unsigned char*, const Unit&, int, int, int) const { return Pre{}; }
    __device__ __forceinline__ bool operator()(LAS unsigned char*, f32x4 (&acc)[2][2][4][2], const Unit& u, int wr, int wc, int fr, int fq, const Pre&) const {
        const int row0 = u.pm * 256 + wr * 64 + fr, col0 = u.pn * 256 + wc * 32 + 8 * fq; const rsrc_t ro = mk_rsrc(O);
        if (u.seg == 0) {
#pragma unroll
            for (int ai = 0; ai < 2; ++ai) {
                v4u sbw[4][2], saw[4][2];
#pragma unroll
                for (int m = 0; m < 4; ++m)
#pragma unroll
                    for (int bj = 0; bj < 2; ++bj) { const size_t off = (size_t)(row0 + ai * 128 + m * 16) * DM + col0 + bj * 128; sbw[m][bj] = *(const v4u*)(SB + off); saw[m][bj] = *(const v4u*)(SA + off); }
#pragma unroll
                for (int m = 0; m < 4; ++m)
#pragma unroll
                    for (int bj = 0; bj < 2; ++bj) { const v4u b = sbw[m][bj], a = saw[m][bj];
                        const float sb[8] = {bflo(b.x), bfhi(b.x), bflo(b.y), bfhi(b.y), bflo(b.z), bfhi(b.z), bflo(b.w), bfhi(b.w)}, sa[8] = {bflo(a.x), bfhi(a.x), bflo(a.y), bfhi(a.y), bflo(a.z), bfhi(a.z), bflo(a.w), bfhi(a.w)};
#pragma unroll
                        for (int j = 0; j < 4; ++j) { acc[ai][bj][m][0][j] *= sa[j] * __builtin_amdgcn_rcpf(fmaxf(sb[j], 1e-30f)); acc[ai][bj][m][1][j] *= sa[4 + j] * __builtin_amdgcn_rcpf(fmaxf(sb[4 + j], 1e-30f)); } }
            }
            return true;
        }
        v4u sbw[2][4][2];
#pragma unroll
        for (int ai = 0; ai < 2; ++ai)
#pragma unroll
            for (int m = 0; m < 4; ++m)
#pragma unroll
                for (int bj = 0; bj < 2; ++bj) sbw[ai][m][bj] = *(const v4u*)(SB + (size_t)(row0 + ai * 128 + m * 16) * DM + col0 + bj * 128);
#pragma unroll
        for (int ai = 0; ai < 2; ++ai)
#pragma unroll
            for (int m = 0; m < 4; ++m)
#pragma unroll
                for (int bj = 0; bj < 2; ++bj) { const size_t off = (size_t)(row0 + ai * 128 + m * 16) * DM + col0 + bj * 128; const v4u b = sbw[ai][m][bj];
                    const float sb[8] = {bflo(b.x), bfhi(b.x), bflo(b.y), bfhi(b.y), bflo(b.z), bfhi(b.z), bflo(b.w), bfhi(b.w)}; float v[8];
#pragma unroll
                    for (int j = 0; j < 4; ++j) { v[j] = acc[ai][bj][m][0][j] * fmaxf(sb[j], 1e-30f); v[4 + j] = acc[ai][bj][m][1][j] * fmaxf(sb[4 + j], 1e-30f); }
                    v4u w; w.x = pk2(v[0], v[1]); w.y = pk2(v[2], v[3]); w.z = pk2(v[4], v[5]); w.w = pk2(v[6], v[7]);
                    st16_wt(ro, off * 2, w); }
        return false;
    }
};
struct EpiBf16Ss {
    static constexpr bool PERM = true;
    bf16* O; float* P;
    struct Pre {}; __device__ __forceinline__ Pre pre(LAS unsigned char*, const Unit&, int, int, int) const { return Pre{}; }
    __device__ __forceinline__ bool operator()(LAS unsigned char*, f32x4 (&acc)[2][2][4][2], const Unit& u, int wr, int wc, int fr, int fq, const Pre&) const {
        const int row0 = u.pm * 256 + wr * 64 + fr, col0 = u.pn * 256 + wc * 32 + 8 * fq; const rsrc_t ro = mk_rsrc(O);
#pragma unroll
        for (int ai = 0; ai < 2; ++ai)
#pragma unroll
            for (int m = 0; m < 4; ++m) {
                const int row = row0 + ai * 128 + m * 16; float ss = 0.f;
#pragma unroll
                for (int bj = 0; bj < 2; ++bj) {
                    const f32x4 a = acc[ai][bj][m][0], b = acc[ai][bj][m][1];
                    ss += (a[0] * a[0] + a[1] * a[1]) + (a[2] * a[2] + a[3] * a[3]) + (b[0] * b[0] + b[1] * b[1]) + (b[2] * b[2] + b[3] * b[3]);
                    v4u w; w.x = pk2(a[0], a[1]); w.y = pk2(a[2], a[3]); w.z = pk2(b[0], b[1]); w.w = pk2(b[2], b[3]);
                    st16_wt(ro, ((size_t)row * DM + col0 + bj * 128) * 2, w);
                }
                ss += __shfl_xor(ss, 16); ss += __shfl_xor(ss, 32);
                if (fq == 0) stf_wt(P + (size_t)(u.pn * 4 + wc) * MT + row, ss);
            }
        return false;
    }
};
struct EpiSwiglu {
    static constexpr bool PERM = true;
    const float* rstd; bf16* O;
    struct Pre {};
    __device__ __forceinline__ Pre pre(LAS unsigned char* lds, const Unit& u, int wr, int wid, int lane) const {
#pragma unroll
        for (int ai = 0; ai < 2; ++ai) __builtin_amdgcn_global_load_lds((const unsigned*)(rstd + u.pm * 256 + wr * 64 + ai * 128 + lane), (LAS unsigned*)(lds + RSTG_OFF + wid * 512 + ai * 256), 4, 0, 0);
        return Pre{}; }
    __device__ __forceinline__ bool operator()(LAS unsigned char* lds, f32x4 (&acc)[2][2][4][2], const Unit& u, int wr, int wc, int fr, int fq, const Pre&) const {
        const int row0 = u.pm * 256 + wr * 64 + fr, col0 = u.pn * 128 + wc * 32 + 8 * fq; const rsrc_t ro = mk_rsrc(O);
        const LAS float* rsl = (const LAS float*)(lds + RSTG_OFF + (wr * 4 + wc) * 512) + fr;
#pragma unroll
        for (int ai = 0; ai < 2; ++ai)
#pragma unroll
            for (int m = 0; m < 4; ++m) {
                const int row = row0 + ai * 128 + m * 16; const float rs = rsl[ai * 64 + m * 16]; float v[8];
#pragma unroll
                for (int n = 0; n < 2; ++n)
#pragma unroll
                    for (int j = 0; j < 4; ++j) { const float gg = acc[ai][0][m][n][j] * rs, up = acc[ai][1][m][n][j] * rs; v[4 * n + j] = gg * sigmoidf_(gg) * up; }
                v4u w; w.x = pk2(v[0], v[1]); w.y = pk2(v[2], v[3]); w.z = pk2(v[4], v[5]); w.w = pk2(v[6], v[7]);
                st16_wt(ro, ((size_t)row * DFF + col0) * 2, w);
            }
        return false;
    }
};

template <bool MAP>
__device__ __forceinline__ void p0_transpose_item(const float* W, int K, int N, const float* gain, bf16* WT, LAS float* scr, int item, int lane) {
    const int nblk = N / 32, kb = item / nblk, nb = item % nblk, k0 = 64 * kb, n0 = 32 * nb;
    f32x4 ld[8]; float gk[8];
#pragma unroll
    for (int i = 0; i < 8; ++i) { const int kk = (lane >> 3) + 8 * i; ld[i] = *(const f32x4*)(W + (size_t)(k0 + kk) * N + n0 + (lane & 7) * 4); gk[i] = gain ? gain[k0 + kk] : 1.0f; }
#pragma unroll
    for (int i = 0; i < 8; ++i) { const int kk = (lane >> 3) + 8 * i; LAS float* d = scr + kk * 33 + (lane & 7) * 4; d[0] = ld[i].x * gk[i]; d[1] = ld[i].y * gk[i]; d[2] = ld[i].z * gk[i]; d[3] = ld[i].w * gk[i]; }
    LDS_WAIT(); asm volatile("" ::: "memory");
    const int c = lane & 7;
#pragma unroll
    for (int j = 0; j < 4; ++j) { const int n = (lane >> 3) + 8 * j; const LAS float* s = scr + (8 * c) * 33 + n;
        v4u o; o.x = pk2(s[0 * 33], s[1 * 33]); o.y = pk2(s[2 * 33], s[3 * 33]); o.z = pk2(s[4 * 33], s[5 * 33]); o.w = pk2(s[6 * 33], s[7 * 33]);
        int nn = n0 + n;
        if (MAP) { const int hi = nn >= DFF ? 1 : 0, r = nn - hi * DFF; nn = 256 * (r >> 7) + 128 * hi + (r & 127); }
        *(GAS v4u*)(WT + (size_t)nn * K + k0 + 8 * c) = o; }
    LDS_WAIT(); asm volatile("" ::: "memory");
}

struct P0D { const float* W; const float* gain; bf16* WT; int K, N, r, map; };
__device__ __forceinline__ void p0_load(const P0D& d, f32x4 (&ld)[8], float (&gk)[8], int lane) {
    const int nblk = d.N / 32, kb = d.r / nblk, nb = d.r % nblk, k0 = 64 * kb, n0 = 32 * nb;
#pragma unroll
    for (int i = 0; i < 8; ++i) { const int kk = (lane >> 3) + 8 * i; ld[i] = *(const f32x4*)(d.W + (size_t)(k0 + kk) * d.N + n0 + (lane & 7) * 4); gk[i] = d.gain ? d.gain[k0 + kk] : 1.0f; }
}
__device__ __forceinline__ void p0_finish(const P0D& d, const f32x4 (&ld)[8], const float (&gk)[8], LAS float* scr, int lane) {
    const int nblk = d.N / 32, kb = d.r / nblk, nb = d.r % nblk, k0 = 64 * kb, n0 = 32 * nb;
#pragma unroll
    for (int i = 0; i < 8; ++i) { const int kk = (lane >> 3) + 8 * i; LAS float* p = scr + kk * 33 + (lane & 7) * 4; p[0] = ld[i].x * gk[i]; p[1] = ld[i].y * gk[i]; p[2] = ld[i].z * gk[i]; p[3] = ld[i].w * gk[i]; }
    LDS_WAIT(); asm volatile("" ::: "memory");
    const int c = lane & 7;
#pragma unroll
    for (int j = 0; j < 4; ++j) { const int n = (lane >> 3) + 8 * j; const LAS float* q = scr + (8 * c) * 33 + n;
        v4u o; o.x = pk2(q[0 * 33], q[1 * 33]); o.y = pk2(q[2 * 33], q[3 * 33]); o.z = pk2(q[4 * 33], q[5 * 33]); o.w = pk2(q[6 * 33], q[7 * 33]);
        int nn = n0 + n;
        if (d.map) { const int hi = nn >= DFF ? 1 : 0, r = nn - hi * DFF; nn = 256 * (r >> 7) + 128 * hi + (r & 127); }
        *(GAS v4u*)(d.WT + (size_t)nn * d.K + k0 + 8 * c) = o; }
    LDS_WAIT(); asm volatile("" ::: "memory");
}

namespace att {
typedef short bf16x8 __attribute__((ext_vector_type(8)));
typedef short s16x4 __attribute__((ext_vector_type(4)));
typedef short v4i16_t __attribute__((ext_vector_type(4)));
typedef float f32x16 __attribute__((ext_vector_type(16)));
typedef LAS const char* lds_cptr;
constexpr int SLOT = 16384, OST = 4 * SLOT, OSTW = 32 * 72 * 2;
__device__ __forceinline__ int crow(int r, int hi) { return (r & 3) + 8 * (r >> 2) + 4 * hi; }
__device__ __forceinline__ s16x4 vtr(lds_cptr p) { return __builtin_bit_cast(s16x4, __builtin_amdgcn_ds_read_tr16_b64_v4i16((LAS v4i16_t*)p)); }
struct TileRegs { v4u k, v; };
__device__ __forceinline__ TileRegs load_tile(const bf16* KB, const bf16* VB, size_t rowbase, int kvh, int wid, int lane) {
    TileRegs t;
    t.k = *(const v4u*)(KB + (rowbase + lane) * KVW + kvh * HD + wid * 8);
    t.v = *(const v4u*)(VB + (rowbase + 16 * (wid & 3) + (lane >> 2)) * KVW + kvh * HD + (wid >> 2) * 32 + (lane & 3) * 8);
    return t;
}
__device__ __forceinline__ void store_tile(LAS unsigned char* slot, const TileRegs& t, int wid, int lane) {
    *(LAS v4u*)(slot + wid * 1024 + lane * 16) = t.k;
    *(LAS v4u*)(slot + 8192 + wid * 1024 + lane * 16) = t.v;
}
struct QFrag { bf16x8 q[4]; };
template <bool SAMPLE>
__device__ __forceinline__ QFrag load_q(const bf16* QO, size_t qrow0, int kvh, int wid, int lane) {
    const int r32 = lane & 31, hi = lane >> 5, posb = 32 * (wid & 1), head = kvh * 4 + (wid >> 1);
    const size_t qrow = SAMPLE ? qrow0 + ((posb + r32) & 15) : qrow0 + posb + r32;
    const bf16* qp = QO + qrow * DM + head * HD; QFrag f;
#pragma unroll
    for (int d0 = 0; d0 < 4; ++d0) f.q[d0] = *(const bf16x8*)(qp + d0 * 16 + hi * 8);
    return f;
}
template <bool SAMPLE>
__device__ __forceinline__ void attn_unit(LAS unsigned char* lds, int s0, int s1, int s2, int ft, const QFrag& qf, bf16* AO, size_t qrow0, int kvh, const float sink2, int wid, int lane) {
    const int r32 = lane & 31, hi = lane >> 5, g = wid >> 1, posb = 32 * (wid & 1), head = kvh * 4 + g;
    f32x16 p[6];
    lds_cptr kb0 = (lds_cptr)lds + s0 + hi * 1024 + r32 * 16, kb1 = (lds_cptr)lds + s1 + hi * 1024 + r32 * 16, kb2 = (lds_cptr)lds + s2 + hi * 1024 + r32 * 16;
#define ATT_KLD(i) (*(const LAS bf16x8*)(((i) >> 3) == 0 ? kb0 + (((i) >> 1) & 3) * 2048 + ((i) & 1) * 512 : ((i) >> 3) == 1 ? kb1 + (((i) >> 1) & 3) * 2048 + ((i) & 1) * 512 : kb2 + (((i) >> 1) & 3) * 2048 + ((i) & 1) * 512))
    bf16x8 kw[4];
#pragma unroll
    for (int i = 0; i < 4; ++i) kw[i] = ATT_KLD(i);
    float mt[3] = {-INFINITY, -INFINITY, sink2};
#pragma unroll
    for (int i = 0; i < 24; ++i) {
        const bf16x8 cur = kw[i & 3];
        if (i + 4 < 24) kw[i & 3] = ATT_KLD(i + 4);
        const int pi = 2 * (i >> 3) + (i & 1), d0 = (i >> 1) & 3;
        if (d0 == 0) p[pi] = __builtin_amdgcn_mfma_f32_32x32x16_bf16(cur, qf.q[0], (f32x16){}, 0, 0, 0);
        else         p[pi] = __builtin_amdgcn_mfma_f32_32x32x16_bf16(cur, qf.q[d0], p[pi], 0, 0, 0);
        if (!SAMPLE && i >= 8) { const int t = (i >> 3) - 1, r = 2 * (i & 7);
            mt[t] = fmaxf(fmaxf(mt[t], p[2 * t][r]), p[2 * t][r + 1]); mt[t] = fmaxf(fmaxf(mt[t], p[2 * t + 1][r]), p[2 * t + 1][r + 1]); }
        __builtin_amdgcn_sched_barrier(0);
    }
#undef ATT_KLD
    if (SAMPLE) {
#pragma unroll
        for (int r = 0; r < 16; ++r) { if (r >= 8) p[4][r] = -INFINITY; p[5][r] = -INFINITY; }
#pragma unroll
        for (int t = 0; t < 2; ++t)
#pragma unroll
            for (int r = 0; r < 16; ++r) mt[t] = fmaxf(fmaxf(mt[t], p[2 * t][r]), p[2 * t + 1][r]);
    }
#pragma unroll
    for (int r = 0; r < 16; ++r) mt[2] = fmaxf(fmaxf(mt[2], p[4][r]), p[5][r]);
    float mx = fmaxf(mt[2], fmaxf(ft > 0 ? -INFINITY : mt[0], ft > 1 ? -INFINITY : mt[1]));
    { auto rr = __builtin_amdgcn_permlane32_swap(__float_as_uint(mx), __float_as_uint(mx), false, false); mx = fmaxf(__uint_as_float(rr[0]), __uint_as_float(rr[1])); }
    const float mx0 = ft > 0 ? INFINITY : mx, mx1 = ft > 1 ? INFINITY : mx;
    float sum = 0.f;
    f32x16 o0 = {}, o1 = {};
    const int vb = ((lane >> 4) & 1) * 32 + (lane & 3) * 8 + (4 * hi + ((lane & 15) >> 2)) * 64;
    lds_cptr vp0 = (lds_cptr)lds + s0 + 8192 + vb, vp1 = (lds_cptr)lds + s1 + 8192 + vb, vp2 = (lds_cptr)lds + s2 + 8192 + vb;
#define ATT_VP(s) (((s) >> 2) == 0 ? vp0 : ((s) >> 2) == 1 ? vp1 : vp2)
#define ATT_EXP(s, j0) do { const int kb_ = 2 * ((s) >> 2) + (((s) & 3) >> 1), rb_ = 8 * ((s) & 1) + (j0); const float m_ = ((s) >> 2) == 0 ? mx0 : ((s) >> 2) == 1 ? mx1 : mx; \
        _Pragma("unroll") for (int j_ = 0; j_ < 4; ++j_) { const float e_ = __builtin_amdgcn_exp2f(p[kb_][rb_ + j_] - m_); p[kb_][rb_ + j_] = e_; sum += e_; } } while (0)
    s16x4 vw[2][4];
    { lds_cptr v = ATT_VP(0); vw[0][0] = vtr(v); vw[0][1] = vtr(v + 512); vw[0][2] = vtr(v + 4096); vw[0][3] = vtr(v + 4096 + 512); }
    ATT_EXP(0, 0); ATT_EXP(0, 4);
#pragma unroll
    for (int s = 0; s < 12; ++s) {
        const int kb = 2 * (s >> 2) + ((s & 3) >> 1), rb = 8 * (s & 1);
        v4u pw; pw.x = pk2(p[kb][rb + 0], p[kb][rb + 1]); pw.y = pk2(p[kb][rb + 2], p[kb][rb + 3]); pw.z = pk2(p[kb][rb + 4], p[kb][rb + 5]); pw.w = pk2(p[kb][rb + 6], p[kb][rb + 7]);
        const bf16x8 pa = __builtin_bit_cast(bf16x8, pw);
        const s16x4 a0 = vw[s & 1][0], a1 = vw[s & 1][1], a2 = vw[s & 1][2], a3 = vw[s & 1][3];
        if (s + 1 < 12) { lds_cptr v = ATT_VP(s + 1) + ((s + 1) & 3) * 1024; vw[(s + 1) & 1][0] = vtr(v); vw[(s + 1) & 1][1] = vtr(v + 512); vw[(s + 1) & 1][2] = vtr(v + 4096); vw[(s + 1) & 1][3] = vtr(v + 4096 + 512); }
        o0 = __builtin_amdgcn_mfma_f32_32x32x16_bf16((bf16x8){a0[0], a0[1], a0[2], a0[3], a1[0], a1[1], a1[2], a1[3]}, pa, o0, 0, 0, 0);
        if (s + 1 < 12) ATT_EXP(s + 1, 0);
        __builtin_amdgcn_sched_barrier(0);
        o1 = __builtin_amdgcn_mfma_f32_32x32x16_bf16((bf16x8){a2[0], a2[1], a2[2], a2[3], a3[0], a3[1], a3[2], a3[3]}, pa, o1, 0, 0, 0);
        if (s + 1 < 12) ATT_EXP(s + 1, 4);
        __builtin_amdgcn_sched_barrier(0);
    }
#undef ATT_EXP
#undef ATT_VP
    { auto rr = __builtin_amdgcn_permlane32_swap(__float_as_uint(sum), __float_as_uint(sum), false, false); sum = __uint_as_float(rr[0]) + __uint_as_float(rr[1]); }
    const float inv = 1.0f / (sum + __builtin_amdgcn_exp2f(sink2 - mx));
    LAS bf16* stg = (LAS bf16*)(lds + OST + wid * OSTW); const rsrc_t rao = mk_rsrc(AO);
#pragma unroll
    for (int j = 0; j < 4; ++j) {
        v2u w0, w1; w0.x = pk2(o0[4 * j] * inv, o0[4 * j + 1] * inv); w0.y = pk2(o0[4 * j + 2] * inv, o0[4 * j + 3] * inv); w1.x = pk2(o1[4 * j] * inv, o1[4 * j + 1] * inv); w1.y = pk2(o1[4 * j + 2] * inv, o1[4 * j + 3] * inv);
        *(LAS v2u*)(stg + r32 * 72 + 8 * j + 4 * hi) = w0; *(LAS v2u*)(stg + r32 * 72 + 32 + 8 * j + 4 * hi) = w1;
    }
    LDS_WAIT();
#pragma unroll
    for (int i = 0; i < 4; ++i) { const int row = i * 8 + (lane >> 3), ch = lane & 7; const v4u v = *(const LAS v4u*)(stg + row * 72 + ch * 8);
        if (!SAMPLE || posb + row < 16) st16_wt(rao, ((qrow0 + posb + row) * DM + head * HD + ch * 8) * 2, v); }
    LDS_WAIT();
}
}

namespace gat {
using att::bf16x8; using att::s16x4; using att::f32x16; using att::lds_cptr; using att::vtr; using att::crow;
constexpr int G_LN = 1024, G_IMG = 9216, G_STG = G_IMG + 65536;
template <bool SAMPLE, int PP>
__device__ __forceinline__ void gate_group(LAS unsigned char* lds, int g, v4u (&raw)[8], const bf16* GV, const bf16* UB, bf16* BMO, const bf16* WSB, const float* b_s, float* gs_out, size_t row0, int tid, int wave, int lane) {
    constexpr int L = SAMPLE ? 16 : 128;
    asm volatile("" : "+v"(tid)); lane = tid & 63;
    constexpr int TB0 = PP, TB1 = 3 - PP, NK0 = 2 * (TB0 + 1), NK1 = 2 * (TB1 + 1);
    LAS float* stats = (LAS float*)lds; LAS float* lnp = (LAS float*)(lds + G_LN); LAS unsigned char* img = lds + G_IMG;
    const int r32 = lane & 31, hi = lane >> 5, cq = wave >> 1;
    const int vb = ((lane >> 4) & 1) * 32 + (lane & 3) * 8 + (4 * hi + ((lane & 15) >> 2)) * 64;
    const int sr = tid >> 5, sc = (tid & 31) * 8;
    bf16x8 af0[NK0], af1[NK1];
    { const bf16* w0 = WSB + ((size_t)(g * 128 + 32 * TB0 + r32) * 128 + hi * 8); const bf16* w1 = WSB + ((size_t)(g * 128 + 32 * TB1 + r32) * 128 + hi * 8);
#pragma unroll
      for (int ks = 0; ks < NK0; ++ks) af0[ks] = *(const bf16x8*)(w0 + ks * 16);
#pragma unroll
      for (int ks = 0; ks < NK1; ++ks) af1[ks] = *(const bf16x8*)(w1 + ks * 16); }
    v4u uw[2][4]; float bias[2][4];
#pragma unroll
    for (int tsel = 0; tsel < 2; ++tsel) { const int tb = tsel ? TB1 : TB0;
#pragma unroll
        for (int i = 0; i < 4; ++i) { const int t = 32 * tb + i * 8 + (lane >> 3); uw[tsel][i] = (v4u){0u, 0u, 0u, 0u}; bias[tsel][i] = 0.f;
            if (t < L) { uw[tsel][i] = *(const v4u*)(UB + (row0 + t) * DM + g * 256 + 64 * cq + (lane & 7) * 8); bias[tsel][i] = b_s[g * 128 + t]; } } }
    { const int col = g * 256 + sc;
      const f32x4 g0 = *(const LAS f32x4*)(lnp + col), g1 = *(const LAS f32x4*)(lnp + col + 4), b0 = *(const LAS f32x4*)(lnp + DM + col), b1 = *(const LAS f32x4*)(lnp + DM + col + 4);
#pragma unroll
      for (int i = 0; i < 8; ++i) { const int r = sr + 16 * i; v4u w = {0u, 0u, 0u, 0u};
        if (r < L) {
            const v4u x = raw[i]; const float mean = stats[2 * r], rstd = stats[2 * r + 1];
            float v[8] = {bflo(x.x), bfhi(x.x), bflo(x.y), bfhi(x.y), bflo(x.z), bfhi(x.z), bflo(x.w), bfhi(x.w)};
            v[0] = (v[0] - mean) * rstd * g0.x + b0.x; v[1] = (v[1] - mean) * rstd * g0.y + b0.y; v[2] = (v[2] - mean) * rstd * g0.z + b0.z; v[3] = (v[3] - mean) * rstd * g0.w + b0.w;
            v[4] = (v[4] - mean) * rstd * g1.x + b1.x; v[5] = (v[5] - mean) * rstd * g1.y + b1.y; v[6] = (v[6] - mean) * rstd * g1.z + b1.z; v[7] = (v[7] - mean) * rstd * g1.w + b1.w;
            if (SAMPLE) { float* gs = gs_out + (size_t)r * DM + col; *(f32x4*)gs = (f32x4){v[0], v[1], v[2], v[3]}; *(f32x4*)(gs + 4) = (f32x4){v[4], v[5], v[6], v[7]}; }
            w.x = pk2(v[0], v[1]); w.y = pk2(v[2], v[3]); w.z = pk2(v[4], v[5]); w.w = pk2(v[6], v[7]);
        }
        *(LAS v4u*)(img + ((sc >> 5) * 8 + (r >> 4)) * 1024 + (r & 15) * 64 + (sc & 31) * 2) = w; } }
    if (g < 3) {
#pragma unroll
        for (int i = 0; i < 8; ++i) if (sr + 16 * i < L) raw[i] = *(const v4u*)(GV + (row0 + sr + 16 * i) * DM + (g + 1) * 256 + sc);
    }
    __syncthreads();
    f32x16 o[2][2];
#pragma unroll
    for (int a = 0; a < 2; ++a)
#pragma unroll
        for (int c = 0; c < 2; ++c) o[a][c] = (f32x16){};
#pragma unroll
    for (int ks = 0; ks < NK1; ++ks) {
#pragma unroll
        for (int cs = 0; cs < 2; ++cs) {
            lds_cptr vp = (lds_cptr)img + ((2 * cq + cs) * 8 + ks) * 1024 + vb;
            const s16x4 lo = vtr(vp), h4 = vtr(vp + 512); const bf16x8 vf = (bf16x8){lo[0], lo[1], lo[2], lo[3], h4[0], h4[1], h4[2], h4[3]};
            if (ks < NK0) o[0][cs] = __builtin_amdgcn_mfma_f32_32x32x16_bf16(af0[ks < NK0 ? ks : 0], vf, o[0][cs], 0, 0, 0);
            o[1][cs] = __builtin_amdgcn_mfma_f32_32x32x16_bf16(af1[ks], vf, o[1][cs], 0, 0, 0);
        }
        __builtin_amdgcn_sched_barrier(0);
    }
    LAS float* stg = (LAS float*)(lds + G_STG + wave * 8704); const rsrc_t rbm = mk_rsrc(BMO);
#pragma unroll
    for (int tsel = 0; tsel < 2; ++tsel) {
        const int tb = tsel ? TB1 : TB0;
#pragma unroll
        for (int r = 0; r < 16; ++r) { const int row = crow(r, hi); stg[row * 68 + r32] = o[tsel][0][r]; stg[row * 68 + 32 + r32] = o[tsel][1][r]; }
        LDS_WAIT();
#pragma unroll
        for (int i = 0; i < 4; ++i) { const int row = i * 8 + (lane >> 3), ch0 = (lane & 7) * 8, t = 32 * tb + row;
            if (t < L) {
                const f32x4 m0 = *(const LAS f32x4*)(stg + row * 68 + ch0), m1 = *(const LAS f32x4*)(stg + row * 68 + ch0 + 4); const float bs = bias[tsel][i];
                const v4u u4 = uw[tsel][i]; v4u w;
                w.x = pk2(bflo(u4.x) * (m0.x + bs), bfhi(u4.x) * (m0.y + bs)); w.y = pk2(bflo(u4.y) * (m0.z + bs), bfhi(u4.y) * (m0.w + bs));
                w.z = pk2(bflo(u4.z) * (m1.x + bs), bfhi(u4.z) * (m1.y + bs)); w.w = pk2(bflo(u4.w) * (m1.z + bs), bfhi(u4.w) * (m1.w + bs));
                st16_wt(rbm, ((row0 + t) * DM + g * 256 + 64 * cq + ch0) * 2, w);
            }
        }
        LDS_WAIT();
    }
    __syncthreads();
}
template <bool SAMPLE>
__device__ __forceinline__ void gate_unit(LAS unsigned char* lds, const bf16* GV, const bf16* UB, bf16* BMO, const bf16* WSB, const float* PG1, const float* PG2, const float* ln_g, const float* ln_b, const float* b_s, float* gs_out, size_t row0, int tid, int wave, int lane) {
    constexpr int L = SAMPLE ? 16 : 128;
    LAS float* stats = (LAS float*)lds; LAS float* lnp = (LAS float*)(lds + G_LN);
    __syncthreads();
    const int sr = tid >> 5, sc = (tid & 31) * 8;
    v4u raw[8];
#pragma unroll
    for (int i = 0; i < 8; ++i) { raw[i] = (v4u){0u, 0u, 0u, 0u}; if (sr + 16 * i < L) raw[i] = *(const v4u*)(GV + (row0 + sr + 16 * i) * DM + sc); }
    {
        LAS float* part = (LAS float*)(lds + G_STG);
        const int r = tid & 127, kg = tid >> 7; float pa[4] = {0.f, 0.f, 0.f, 0.f}, pq[4] = {0.f, 0.f, 0.f, 0.f};
        if (r < L) {
#pragma unroll
            for (int j = 0; j < 4; ++j) { pa[j] = PG1[(size_t)(4 * kg + j) * MT + row0 + r]; pq[j] = PG2[(size_t)(4 * kg + j) * MT + row0 + r]; }
        }
        __builtin_amdgcn_sched_barrier(0);
        part[(kg * 128 + r) * 2] = (pa[0] + pa[1]) + (pa[2] + pa[3]); part[(kg * 128 + r) * 2 + 1] = (pq[0] + pq[1]) + (pq[2] + pq[3]);
        __syncthreads();
        if (tid < L) {
            const float a = (part[2 * tid] + part[2 * (128 + tid)]) + (part[2 * (256 + tid)] + part[2 * (384 + tid)]), q = (part[2 * tid + 1] + part[2 * (128 + tid) + 1]) + (part[2 * (256 + tid) + 1] + part[2 * (384 + tid) + 1]);
            const float mean = a * (1.0f / DM), var = fmaxf(q * (1.0f / DM) - mean * mean, 0.f);
            stats[2 * tid] = mean; stats[2 * tid + 1] = 1.0f / sqrtf(var + EPS);
        }
    }
    { const int i4 = tid & 255; const float* src = (tid < 256) ? ln_g : ln_b; *(LAS f32x4*)(lnp + (tid < 256 ? 0 : DM) + 4 * i4) = *(const f32x4*)(src + 4 * i4); }
    __syncthreads();
    if (wave & 1) { for (int g = 0; g < 4; ++g) gate_group<SAMPLE, 1>(lds, g, raw, GV, UB, BMO, WSB, b_s, gs_out, row0, tid, wave, lane); }
    else          { for (int g = 0; g < 4; ++g) gate_group<SAMPLE, 0>(lds, g, raw, GV, UB, BMO, WSB, b_s, gs_out, row0, tid, wave, lane); }
}
}

template <bool WT>
__device__ __forceinline__ void x_rows4(int m0, const float* xp, const float* xs, bf16* XB, float* RSTD1, int lane) {
    f32x4 v[4][4]; const rsrc_t rx = mk_rsrc(XB);
#pragma unroll
    for (int i = 0; i < 4; ++i) { const int m = m0 + i; const float* xrow = (m < MP) ? xp + (size_t)m * DM : xs + (size_t)(m - MP) * DM;
#pragma unroll
        for (int k = 0; k < 2; ++k) { v[i][2 * k] = *(const f32x4*)(xrow + k * 512 + 8 * lane); v[i][2 * k + 1] = *(const f32x4*)(xrow + k * 512 + 8 * lane + 4); } }
#pragma unroll
    for (int i = 0; i < 4; ++i) { const int m = m0 + i; float s = 0.f;
#pragma unroll
        for (int j = 0; j < 4; ++j) s += (v[i][j].x * v[i][j].x + v[i][j].y * v[i][j].y) + (v[i][j].z * v[i][j].z + v[i][j].w * v[i][j].w);
        s = wave_sum(s);
        const float rs = 1.0f / sqrtf(s * (1.0f / DM) + EPS);
        if (lane == 0) { if (WT) stf_wt(RSTD1 + m, rs); else RSTD1[m] = rs; }
#pragma unroll
        for (int k = 0; k < 2; ++k) { v4u w; w.x = pk2(v[i][2 * k].x, v[i][2 * k].y); w.y = pk2(v[i][2 * k].z, v[i][2 * k].w); w.z = pk2(v[i][2 * k + 1].x, v[i][2 * k + 1].y); w.w = pk2(v[i][2 * k + 1].z, v[i][2 * k + 1].w);
            if (WT) st16_wt(rx, ((size_t)m * DM + k * 512 + 8 * lane) * 2, w); else *(v4u*)(XB + (size_t)m * DM + k * 512 + 8 * lane) = w; } }
}
__device__ __forceinline__ bool chunk_next(pg8::DynOrder& S, int i, pg8::Unit& u, int tid) {
    if (tid == 0) S.put(i & 1, S.draw(S.xcd), 0);
    __syncthreads();
    return S.get(i & 1, u);
}
__device__ __forceinline__ void chunk_draw_async(const pg8::DynOrder& S, int tid) {
    if (tid == 0) { unsigned* p = S.q8 + 64 * S.xcd; asm volatile("s_nop 4\n\tglobal_atomic_add v255, %0, %1, %2 sc0" :: "v"(0u), "v"(1u), "s"(p) : "v255", "memory"); }
}
__device__ __forceinline__ bool chunk_take_async(pg8::DynOrder& S, int i, pg8::Unit& u, int tid) {
    if (tid == 0) { unsigned t; asm volatile("v_mov_b32 %0, v255" : "=v"(t) :: "memory"); S.put(i & 1, t, 0); }
    __syncthreads();
    return S.get(i & 1, u);
}
__device__ __forceinline__ void l1_acquire(int tid) {
    __syncthreads();
    if (tid == 0) { __builtin_amdgcn_fence(__ATOMIC_ACQUIRE, "agent"); asm volatile("s_waitcnt vmcnt(0)" ::: "memory"); }
    __syncthreads();
}
__device__ __forceinline__ void rows_wait(unsigned* cnt, unsigned need, unsigned* tot, unsigned need_tot, int& flag, unsigned* tmo, int wave) {
    if (wave == 0 && flag == 0) {
        unsigned spins = 0;
        for (;;) {
            const unsigned c0 = __hip_atomic_load(cnt, __ATOMIC_RELAXED, __HIP_MEMORY_SCOPE_AGENT), t0 = __hip_atomic_load(tot, __ATOMIC_RELAXED, __HIP_MEMORY_SCOPE_AGENT);
            const unsigned c = (unsigned)__builtin_amdgcn_readfirstlane(c0), t = (unsigned)__builtin_amdgcn_readfirstlane(t0);
            if (t >= need_tot) { flag = 1; break; }
            if (c >= need) break;
            if (++spins > PG8_SPIN_CAP || ((spins & 63u) == 0u && __builtin_amdgcn_readfirstlane(__hip_atomic_load(tmo, __ATOMIC_RELAXED, __HIP_MEMORY_SCOPE_AGENT)) != 0u)) { if ((threadIdx.x & 63) == 0) __hip_atomic_store(tmo, 1u, __ATOMIC_RELAXED, __HIP_MEMORY_SCOPE_AGENT); break; }
            __builtin_amdgcn_s_sleep(4);
        }
    }
    __syncthreads();
}

__device__ __forceinline__ void panels_wait(unsigned* C, int p_lo, int p_hi, unsigned need, unsigned* tot, unsigned need_tot, int& flag, unsigned* tmo, int wave) {
    if (wave == 0 && flag == 0) {
        unsigned spins = 0;
        for (;;) {
            const unsigned t0 = __hip_atomic_load(tot, __ATOMIC_RELAXED, __HIP_MEMORY_SCOPE_AGENT); unsigned cmin = 0xffffffffu;
            for (int p = p_lo; p <= p_hi; ++p) { const unsigned c = __hip_atomic_load(C + 64 * p, __ATOMIC_RELAXED, __HIP_MEMORY_SCOPE_AGENT); cmin = c < cmin ? c : cmin; }
            if ((unsigned)__builtin_amdgcn_readfirstlane(t0) >= need_tot) { flag = 1; break; }
            if ((unsigned)__builtin_amdgcn_readfirstlane(cmin) >= need) break;
            if (++spins > PG8_SPIN_CAP || ((spins & 63u) == 0u && __builtin_amdgcn_readfirstlane(__hip_atomic_load(tmo, __ATOMIC_RELAXED, __HIP_MEMORY_SCOPE_AGENT)) != 0u)) { if ((threadIdx.x & 63) == 0) __hip_atomic_store(tmo, 1u, __ATOMIC_RELAXED, __HIP_MEMORY_SCOPE_AGENT); break; }
            __builtin_amdgcn_s_sleep(4);
        }
    }
    __syncthreads();
}
__device__ __forceinline__ void p2_signal(unsigned* C2, int panel, int lane) {
    asm volatile("s_waitcnt vmcnt(0)" ::: "memory");
    if (lane == 0) __hip_atomic_fetch_add(C2 + 64 * panel, 1u, __ATOMIC_RELAXED, __HIP_MEMORY_SCOPE_AGENT);
}
__device__ __forceinline__ void p2_signal_sample(unsigned* C2, unsigned* CS, int lane) {
    asm volatile("s_waitcnt vmcnt(0)" ::: "memory");
    if (lane == 0) { const unsigned old = __hip_atomic_fetch_add(CS, 1u, __ATOMIC_RELAXED, __HIP_MEMORY_SCOPE_AGENT); if (old == 639u) __hip_atomic_fetch_add(C2 + 64 * 256, 48u, __ATOMIC_RELAXED, __HIP_MEMORY_SCOPE_AGENT); }
}

struct Args { const float* in[19]; float* out; unsigned char* ws; int ph_lo, ph_hi; };

__global__ void __launch_bounds__(NWAVES * 64, 2) __attribute__((amdgpu_num_vgpr(252))) fwd_kernel(Args args) {
    extern __shared__ __attribute__((aligned(16))) unsigned char lds_raw[];
    LAS unsigned char* lds = (LAS unsigned char*)lds_raw;
    volatile LAS unsigned* MISC = (volatile LAS unsigned*)(lds + MISC_OFF);
    const int tid = threadIdx.x, lane = tid & 63, wave = __builtin_amdgcn_readfirstlane(tid >> 6);
    const int G = gridDim.x;
    const int vcu = (G % 8 == 0) ? ((int)blockIdx.x % 8) * (G / 8) + (int)blockIdx.x / 8 : (int)blockIdx.x;
    unsigned char* ws = args.ws;
    const float* xp = args.in[0]; const float* xs = args.in[1]; const float* cache_k = args.in[2]; const float* cache_v = args.in[3];
    const float* g_pre_mix = args.in[4]; const float* g_post_mix = args.in[5]; const float* g_pre_ffn = args.in[6]; const float* g_post_ffn = args.in[7];
    const float* w_in = args.in[8]; const float* sinks = args.in[9]; const float* ln_g = args.in[10]; const float* ln_b = args.in[11];
    const float* w_s = args.in[12]; const float* b_s = args.in[13]; const float* w_ap = args.in[14]; const float* w_gp = args.in[15];
    const float* w_out = args.in[16]; const float* w_fi = args.in[17]; const float* w_fo = args.in[18];
    float* out = args.out;
    bf16* WinT = (bf16*)(ws + WS_WIN); bf16* WfiT = (bf16*)(ws + WS_WFI); bf16* WaT = (bf16*)(ws + WS_WA); bf16* WgT = (bf16*)(ws + WS_WG); bf16* WoT = (bf16*)(ws + WS_WO); bf16* WfoT = (bf16*)(ws + WS_WFO); bf16* WSB = (bf16*)(ws + WS_WSB);
    float* RSTD1 = (float*)(ws + WS_RSTD1); float* RSTD2 = (float*)(ws + WS_RSTD2); float* PMIX = (float*)(ws + WS_PMIX); float* PF = (float*)(ws + WS_PF);
    bf16* XB = (bf16*)(ws + WS_R0); bf16* FB = XB;
    bf16* QB = (bf16*)(ws + WS_R1); bf16* MERGED = QB; bf16* X1B = QB;
    bf16* GV = (bf16*)(ws + WS_R2); bf16* MIX = GV;
    bf16* KB = (bf16*)(ws + WS_KB); bf16* VB = (bf16*)(ws + WS_VB);
    bf16* SA = (bf16*)(ws + WS_SA); bf16* SB = (bf16*)(ws + WS_SB); bf16* UB = (bf16*)(ws + WS_U); bf16* ACT = (bf16*)(ws + WS_R3); bf16* AO = (bf16*)(ws + WS_AO);
#ifdef GATE_OOP
    bf16* BMB = XB;
#else
    bf16* BMB = UB;
#endif

    for (int u = tid; u < (LDS_BYTES - LDSCTL_OFF) / 4; u += NWAVES * 64) ((LAS unsigned*)(lds + LDSCTL_OFF))[u] = 0u;
    __syncthreads();
    XcdBarrier bar; bar.bar = (unsigned*)(ws + WS_CTL) + CW_BAR; bar.x = 0; bar.st = nullptr;
    if (MK_ONE_LAUNCH) bar = xcd_barrier_post((unsigned*)(ws + WS_CTL) + CW_BAR, MISC + 8);
    const int lo = args.ph_lo, hi = args.ph_hi;
    STAMP(0);
#ifndef PH_MASK
#define PH_MASK 0x1ff
#endif
#define IN(k) (((PH_MASK >> (k)) & 1) && lo <= (k) && (k) < hi)
#define SEAM(k) do { if (MK_ONE_LAUNCH && IN(k) && IN((k) + 1)) xcd_barrier(bar); } while (0)
    const int gw = vcu * NWAVES + wave, NGW = G * NWAVES;
    unsigned* const QH = (unsigned*)(ws + WS_CTL) + CW_Q; LAS int* const BOX = (LAS int*)(lds + BOX_OFF);
    unsigned* const C0 = (unsigned*)(ws + WS_CTL) + CW_C0, * const T0 = (unsigned*)(ws + WS_CTL) + CW_TOT + 5 * 64, * const TMO0 = (unsigned*)(ws + WS_CTL) + CW_TMO;

    if (IN(0)) for (int rep_ = 0; rep_ < NREP(0); ++rep_) {
        LAS float* scr = (LAS float*)(lds + wave * 16384);
        constexpr int I_IN = (DM / 64) * (INW / 32), I_SQ = (DM / 64) * (DM / 32), I_FO = (DFF / 64) * (DM / 32);
        constexpr int NITEMS = 2 * I_IN + 3 * I_SQ + I_FO;
        auto p0_desc = [&](int it) -> P0D { int r = it;
            if (r < I_IN) return P0D{w_in, g_pre_mix, WinT, DM, INW, r, 0}; r -= I_IN;
            if (r < I_IN) return P0D{w_fi, g_pre_ffn, WfiT, DM, INW, r, 1}; r -= I_IN;
            if (r < I_SQ) return P0D{w_ap, nullptr, WaT, DM, DM, r, 0}; r -= I_SQ;
            if (r < I_SQ) return P0D{w_gp, nullptr, WgT, DM, DM, r, 0}; r -= I_SQ;
            if (r < I_SQ) return P0D{w_out, nullptr, WoT, DM, DM, r, 0}; r -= I_SQ;
            return P0D{w_fo, nullptr, WfoT, DFF, DM, r, 0}; };
        if (gw < NITEMS) {
            int it = gw; P0D dc = p0_desc(it); f32x4 lc[8]; float gc[8]; p0_load(dc, lc, gc, lane);
            for (;;) {
                const int nx = it + NGW; const bool hn = nx < NITEMS; P0D dn = dc; f32x4 ln[8]; float gn[8];
#pragma unroll
                for (int i = 0; i < 8; ++i) { ln[i] = lc[i]; gn[i] = gc[i]; }
                if (hn) { dn = p0_desc(nx); p0_load(dn, ln, gn, lane); }
                p0_finish(dc, lc, gc, scr, lane);
                if (!hn) break;
                dc = dn; it = nx;
#pragma unroll
                for (int i = 0; i < 8; ++i) { lc[i] = ln[i]; gc[i] = gn[i]; }
            }
        }
        for (int i = gw * 64 + lane; i < 4 * 128 * 128; i += NGW * 64) {
            const int t = (i >> 7) & 127, pp = i & 127, pl = pp & 15, sl = (pl & 3) | ((pl & 4) << 1) | ((pl & 8) >> 1), sidx = (pp & ~15) + sl;
            const float v = (sidx <= t) ? w_s[(size_t)(i & ~127) + sidx] : 0.f;
            WSB[i] = (bf16)(pk2(v, 0.f) & 0xffffu);
        }
        for (int gi = gw; gi < 65 * 64; gi += NGW) { const int p = gi >> 6, panel = p < 64 ? 32 * (p & 7) + (p >> 3) : 256; x_rows4<false>(panel * 256 + 4 * (gi & 63), xp, xs, XB, RSTD1, lane); }
        if (tid == 0) for (int p = blockIdx.x; p < 65; p += G) { const int panel = p < 64 ? 32 * (p & 7) + (p >> 3) : 256; __hip_atomic_fetch_add(C0 + 64 * panel, 8u, __ATOMIC_RELAXED, __HIP_MEMORY_SCOPE_AGENT); }
    }
    STAMP(1);
    SEAM(0);
    STAMP(2);

    if (IN(1)) for (int rep_ = 0; rep_ < NREP(1); ++rep_) {
        const int NWK = (G >> 5) * 8;
        if (((blockIdx.x >> 3) & 3) == 0 && rep_ == 0) {
            const int w = (int)(blockIdx.x & 7) + 8 * (int)(blockIdx.x >> 5);
            for (int idx = w; idx < 192; idx += NWK) { const int wi = idx & 63, panel = 32 * (wi & 7) + 8 * (1 + (idx >> 6)) + (wi >> 3);
                for (int r = 0; r < 8; ++r) x_rows4<true>(panel * 256 + 32 * wave + 4 * r, xp, xs, XB, RSTD1, lane);
                asm volatile("s_waitcnt vmcnt(0)" ::: "memory");
                if (lane == 0) __hip_atomic_fetch_add(C0 + 64 * panel, 1u, __ATOMIC_RELAXED, __HIP_MEMORY_SCOPE_AGENT); }
            __syncthreads();
            if (tid == 0) __hip_atomic_fetch_add(T0, 1u, __ATOMIC_RELAXED, __HIP_MEMORY_SCOPE_AGENT);
        }
        pg8::Gemm g{XB, WinT, XB, WinT, MT, INW, DM}; pg8::DynOrder S; S.init(QH + 1 * 512, MP, INW, 1, BOX);
        EpiIn E{RSTD1, QB, KB, VB, UB, GV, SA, SB, out, PF, PMIX};
        const pg8::Dep D{C0, 8u, T0, (unsigned)NWK, nullptr, 0u, (unsigned*)(ws + WS_CTL) + CW_C1, (unsigned*)(ws + WS_CTL) + CW_TOT + 6 * 64, TMO0}; pg8::gemm_phase<EpiIn, pg8::DynOrder, 0>(lds, g, S, E, D);
    }
    STAMP(3);
    STAMP(4);

    unsigned* const C1 = (unsigned*)(ws + WS_CTL) + CW_C1, * const C2 = (unsigned*)(ws + WS_CTL) + CW_C2, * const CSP = (unsigned*)(ws + WS_CTL) + CW_CS;
    unsigned* const T1 = (unsigned*)(ws + WS_CTL) + CW_TOT + 6 * 64, * const T2 = (unsigned*)(ws + WS_CTL) + CW_TOT + 7 * 64;
    if (IN(2)) {
        int p2flag = 0;
        for (;;) {
            __syncthreads();
            if (tid == 0) BOX[0] = (int)__hip_atomic_fetch_add(QH + 2 * 512, 1u, __ATOMIC_RELAXED, __HIP_MEMORY_SCOPE_AGENT);
            __syncthreads();
            const int t = BOX[0];
            if (t >= NB * NKV * 4 + NB * NKV) break;
            if (t < NB * NKV * 4) {
                const int key = t >> 6, w6 = t & 63, kvh = w6 & 3, b = 2 * (w6 >> 3) + (key >> 1), qq = 2 * (key & 1) + ((w6 >> 2) & 1), c0 = 16 * qq; const size_t seqbase = (size_t)b * SEQ;
                panels_wait(C1, 16 * b + 4 * qq - (qq > 0 ? 1 : 0), 16 * b + 4 * qq + 3, 176u, T1, (unsigned)G, p2flag, TMO0, wave);
                {   att::TileRegs tr3[3];
#pragma unroll
                    for (int j = 0; j < 3; ++j) { const int T = c0 - 2 + j; tr3[j].k = (v4u){0u, 0u, 0u, 0u}; tr3[j].v = tr3[j].k; if (T >= 0) tr3[j] = att::load_tile(KB, VB, seqbase + 64 * T, kvh, wave, lane); }
#pragma unroll
                    for (int j = 0; j < 3; ++j) { const int T = c0 - 2 + j; if (T >= 0) att::store_tile(lds + (T & 3) * att::SLOT, tr3[j], wave, lane); }
                }
                att::QFrag qc = att::load_q<false>(QB, seqbase + 64 * c0, kvh, wave, lane);
                if (c0 == 0) { const v4u z = {0u, 0u, 0u, 0u};
#pragma unroll
                    for (int i = 0; i < 4; ++i) *(LAS v4u*)(lds + 2 * att::SLOT + i * 8192 + tid * 16) = z; }
                const float sink2 = sinks[kvh * 4 + (wave >> 1)] * LOG2E;
                __syncthreads();
                for (int c = c0; c < c0 + 16; ++c) {
                    att::TileRegs nx; nx.k = (v4u){0u, 0u, 0u, 0u}; nx.v = nx.k; const bool pre = (c + 1 < c0 + 16);
                    att::QFrag qn = qc;
                    if (pre) { nx = att::load_tile(KB, VB, seqbase + 64 * (c + 1), kvh, wave, lane); qn = att::load_q<false>(QB, seqbase + 64 * (c + 1), kvh, wave, lane); }
                    att::attn_unit<false>(lds, ((c + 2) & 3) * att::SLOT, ((c + 3) & 3) * att::SLOT, (c & 3) * att::SLOT, c >= 2 ? 0 : 2 - c, qc, AO, seqbase + 64 * c, kvh, sink2, wave, lane);
                    if (pre) att::store_tile(lds + ((c + 1) & 3) * att::SLOT, nx, wave, lane);
                    qc = qn;
                    if ((c & 3) == 3) p2_signal(C2, 16 * b + (c >> 2), lane);
                    __syncthreads();
                }
            } else {
                const int j = t - NB * NKV * 4, b = j >> 2, kvh = j & 3;
                panels_wait(C1, 256, 256, 176u, T1, (unsigned)G, p2flag, TMO0, wave);
#pragma unroll
                for (int T = 0; T < 2; ++T) {
                    att::TileRegs tr;
                    { const size_t o = ((size_t)(b * 128 + 64 * T + lane) * NKV + kvh) * HD + wave * 8; const f32x4 k0 = *(const f32x4*)(cache_k + o), k1 = *(const f32x4*)(cache_k + o + 4);
                      tr.k.x = pk2(k0.x, k0.y); tr.k.y = pk2(k0.z, k0.w); tr.k.z = pk2(k1.x, k1.y); tr.k.w = pk2(k1.z, k1.w); }
                    { const size_t o = ((size_t)(b * 128 + 64 * T + 16 * (wave & 3) + (lane >> 2)) * NKV + kvh) * HD + (wave >> 2) * 32 + (lane & 3) * 8; const f32x4 v0 = *(const f32x4*)(cache_v + o), v1 = *(const f32x4*)(cache_v + o + 4);
                      tr.v.x = pk2(v0.x, v0.y); tr.v.y = pk2(v0.z, v0.w); tr.v.z = pk2(v1.x, v1.y); tr.v.w = pk2(v1.z, v1.w); }
                    att::store_tile(lds + T * att::SLOT, tr, wave, lane);
                }
                { att::TileRegs tr; tr.k = (v4u){0u, 0u, 0u, 0u}; tr.v = tr.k;
                  if (lane < 16) tr.k = *(const v4u*)(KB + (size_t)(MP + b * 16 + lane) * KVW + kvh * HD + wave * 8);
                  if ((wave & 3) == 0) tr.v = *(const v4u*)(VB + (size_t)(MP + b * 16 + (lane >> 2)) * KVW + kvh * HD + (wave >> 2) * 32 + (lane & 3) * 8);
                  att::store_tile(lds + 2 * att::SLOT, tr, wave, lane); }
                __syncthreads();
                { const att::QFrag qs = att::load_q<true>(QB, (size_t)(MP + b * 16), kvh, wave, lane); att::attn_unit<true>(lds, 0, att::SLOT, 2 * att::SLOT, 0, qs, AO, (size_t)(MP + b * 16), kvh, sinks[kvh * 4 + (wave >> 1)] * LOG2E, wave, lane); }
                p2_signal_sample(C2, CSP, lane);
            }
        }
        for (;;) {
            __syncthreads();
            if (tid == 0) BOX[0] = (int)__hip_atomic_fetch_add(QH + 2 * 512 + 64, 1u, __ATOMIC_RELAXED, __HIP_MEMORY_SCOPE_AGENT);
            __syncthreads();
            const int t = BOX[0];
            if (t >= NB * 32 + NB) break;
            if (t < NB * 32) {
                const int key = t >> 7, w7 = t & 127, b = 2 * (w7 >> 4) + (key >> 1), unit = b * 32 + 16 * (key & 1) + (w7 & 15);
                panels_wait(C1, unit >> 1, unit >> 1, 176u, T1, (unsigned)G, p2flag, TMO0, wave);
                gat::gate_unit<false>(lds, GV, UB, BMB, WSB, PF, PMIX, ln_g, ln_b, b_s, nullptr, (size_t)unit * 128, tid, wave, lane);
                p2_signal(C2, unit >> 1, lane);
            } else {
                const int j = t - NB * 32;
                panels_wait(C1, 256, 256, 176u, T1, (unsigned)G, p2flag, TMO0, wave);
                gat::gate_unit<true>(lds, GV, UB, BMB, WSB, PF, PMIX, ln_g, ln_b, b_s, out + O_GS + (size_t)j * 16 * DM, (size_t)(MP + j * 16), tid, wave, lane);
                p2_signal_sample(C2, CSP, lane);
            }
        }
        __syncthreads();
        if (tid == 0) __hip_atomic_fetch_add(T2, 1u, __ATOMIC_RELAXED, __HIP_MEMORY_SCOPE_AGENT);
    }
    STAMP(5);
    STAMP(6);

    unsigned* const ctl = (unsigned*)(ws + WS_CTL);
    unsigned* const C3 = ctl + CW_CNT, * const C4 = C3 + 264 * 64, * const C5 = C4 + 264 * 64, * const C6 = C5 + 264 * 64, * const C7 = C6 + 264 * 64, * const T3 = ctl + CW_TOT, * const T4 = T3 + 64, * const T5 = T4 + 64, * const T6 = T5 + 64, * const T7 = T6 + 64, * const TMO = ctl + CW_TMO;
    const unsigned NWG = (unsigned)G;
    if (IN(3)) {
        pg8::Gemm g{AO, WaT, BMB, WgT, MT, DM, DM}; pg8::DynOrder S; S.init(QH + 3 * 512, MP, DM, 2, BOX);
        EpiMerge E{SA, SB, MERGED}; const pg8::Dep D{C2, 48u, T2, NWG, nullptr, 0u, C3, T3, TMO};
        l1_acquire(tid); pg8::gemm_phase<EpiMerge, pg8::DynOrder, 0>(lds, g, S, E, D);
    }
    STAMP(7);
    if (IN(4)) {
        pg8::Gemm g{MERGED, WoT, MERGED, WoT, MT, DM, DM}; pg8::DynOrder S; S.init(QH + 4 * 512, MP, DM, 1, BOX);
        EpiBf16Ss E{MIX, PMIX}; const pg8::Dep D{C3, 32u, T3, NWG, nullptr, 0u, C4, T4, TMO};
        l1_acquire(tid); pg8::gemm_phase<EpiBf16Ss, pg8::DynOrder, 0>(lds, g, S, E, D);
    }
    STAMP(8);
    if (IN(5)) {
        const bool worker = ((blockIdx.x >> 3) & 3) == 0;
        pg8::DynOrder S; S.init(QH + 5 * 512, MP, DM, 1, BOX); pg8::Unit u; const rsrc_t rmix = mk_rsrc(MIX), rx1 = mk_rsrc(X1B);
        f32x4 gv[4];
#pragma unroll
        for (int k = 0; k < 4; ++k) gv[k] = *(const f32x4*)(g_post_mix + (k >> 1) * 512 + 8 * lane + (k & 1) * 4);
        int rflag = 0;
        bool have = chunk_next(S, 0, u, tid);
        for (int i = 0; have; ++i) {
            if (worker) chunk_draw_async(S, tid);
            rows_wait(C4 + 64 * u.pm, 32u, T4, NWG, rflag, TMO, wave);
            const int mb = u.pm * 256 + u.pn * 64 + wave * 8;
#pragma unroll 1
            for (int h = 0; h < 2; ++h) {
                v4u xw[4][2], mw[4][2]; float ps[4];
#pragma unroll
                for (int r = 0; r < 4; ++r) { const int m = mb + 4 * h + r; ps[r] = ldf_nc(PMIX + (size_t)(lane & 15) * MT + m);
#pragma unroll
                    for (int k = 0; k < 2; ++k) { xw[r][k] = *(const v4u*)(XB + (size_t)m * DM + k * 512 + 8 * lane); mw[r][k] = ld16_nc(rmix, ((size_t)m * DM + k * 512 + 8 * lane) * 2); } }
#pragma unroll
                for (int r = 0; r < 4; ++r) { const int m = mb + 4 * h + r; float p = ps[r]; p += __shfl_xor(p, 1); p += __shfl_xor(p, 2); p += __shfl_xor(p, 4); p += __shfl_xor(p, 8);
                    const float rm = 1.0f / sqrtf(p * (1.0f / DM) + EPS); float v[2][8]; float sq = 0.f;
#pragma unroll
                    for (int k = 0; k < 2; ++k) { const v4u a = xw[r][k], b = mw[r][k]; const f32x4 g0 = gv[2 * k], g1 = gv[2 * k + 1];
                        v[k][0] = bflo(a.x) + bflo(b.x) * rm * g0.x; v[k][1] = bfhi(a.x) + bfhi(b.x) * rm * g0.y; v[k][2] = bflo(a.y) + bflo(b.y) * rm * g0.z; v[k][3] = bfhi(a.y) + bfhi(b.y) * rm * g0.w;
                        v[k][4] = bflo(a.z) + bflo(b.z) * rm * g1.x; v[k][5] = bfhi(a.z) + bfhi(b.z) * rm * g1.y; v[k][6] = bflo(a.w) + bflo(b.w) * rm * g1.z; v[k][7] = bfhi(a.w) + bfhi(b.w) * rm * g1.w;
#pragma unroll
                        for (int j = 0; j < 8; ++j) sq += v[k][j] * v[k][j]; }
                    sq = wave_sum(sq);
                    if (lane == 0) stf_wt(RSTD2 + m, 1.0f / sqrtf(sq * (1.0f / DM) + EPS));
#pragma unroll
                    for (int k = 0; k < 2; ++k) { v4u w; w.x = pk2(v[k][0], v[k][1]); w.y = pk2(v[k][2], v[k][3]); w.z = pk2(v[k][4], v[k][5]); w.w = pk2(v[k][6], v[k][7]); st16_wt(rx1, ((size_t)m * DM + k * 512 + 8 * lane) * 2, w); } }
            }
            asm volatile("s_waitcnt vmcnt(0)" ::: "memory");
            if (lane == 0) __hip_atomic_fetch_add(C5 + 64 * u.pm, 1u, __ATOMIC_RELAXED, __HIP_MEMORY_SCOPE_AGENT);
            have = worker && chunk_take_async(S, i + 1, u, tid);
        }
        __syncthreads();
        if (tid == 0) __hip_atomic_fetch_add(T5, 1u, __ATOMIC_RELAXED, __HIP_MEMORY_SCOPE_AGENT);
    }
    STAMP(9);
    if (IN(6)) {
        pg8::Gemm g{X1B, WfiT, X1B, WfiT, MT, INW, DM}; pg8::DynOrder S; S.init(QH + 6 * 512, MP, INW, 1, BOX);
        EpiSwiglu E{RSTD2, ACT}; const pg8::Dep D{C5, 32u, T5, NWG, T3, NWG, C6, T6, TMO};
        l1_acquire(tid); pg8::gemm_phase<EpiSwiglu, pg8::DynOrder, 0>(lds, g, S, E, D);
    }
    STAMP(10);
    if (IN(7)) {
        pg8::Gemm g{ACT, WfoT, ACT, WfoT, MT, DM, DFF}; pg8::DynOrder S; S.init(QH + 7 * 512, MP, DM, 1, BOX);
        EpiBf16Ss E{FB, PF}; const pg8::Dep D{C6, 176u, T6, NWG, nullptr, 0u, C7, T7, TMO};
        l1_acquire(tid); pg8::gemm_phase<EpiBf16Ss, pg8::DynOrder, 0>(lds, g, S, E, D);
    }
    STAMP(11);
    if (IN(8)) {
        pg8::DynOrder S; S.init(QH + 8 * 512, MP, DM, 1, BOX); pg8::Unit u; const rsrc_t rf = mk_rsrc(FB), rx1 = mk_rsrc(X1B);
        f32x4 gv[4];
#pragma unroll
        for (int k = 0; k < 4; ++k) gv[k] = *(const f32x4*)(g_post_ffn + (k >> 1) * 512 + 8 * lane + (k & 1) * 4);
        int rflag = 0;
        bool have = chunk_next(S, 0, u, tid);
        for (int i = 0; have; ++i) {
            chunk_draw_async(S, tid);
            rows_wait(C7 + 64 * u.pm, 32u, T7, NWG, rflag, TMO, wave);
            const int mb = u.pm * 256 + u.pn * 64 + wave * 8;
#pragma unroll 1
            for (int h = 0; h < 2; ++h) {
                v4u xw[4][2], fw[4][2]; float ps[4];
#pragma unroll
                for (int r = 0; r < 4; ++r) { const int m = mb + 4 * h + r; ps[r] = ldf_nc(PF + (size_t)(lane & 15) * MT + m);
#pragma unroll
                    for (int k = 0; k < 2; ++k) { xw[r][k] = ld16_nc(rx1, ((size_t)m * DM + k * 512 + 8 * lane) * 2); fw[r][k] = ld16_nc(rf, ((size_t)m * DM + k * 512 + 8 * lane) * 2); } }
#pragma unroll
                for (int r = 0; r < 4; ++r) { const int m = mb + 4 * h + r; float p = ps[r]; p += __shfl_xor(p, 1); p += __shfl_xor(p, 2); p += __shfl_xor(p, 4); p += __shfl_xor(p, 8);
                    const float rf2 = 1.0f / sqrtf(p * (1.0f / DM) + EPS);
                    float* yrow = (m < MP) ? out + O_YP + (size_t)m * DM : out + O_YS + (size_t)(m - MP) * DM;
#pragma unroll
                    for (int k = 0; k < 2; ++k) { const v4u a = xw[r][k], b = fw[r][k]; const f32x4 g0 = gv[2 * k], g1 = gv[2 * k + 1]; f32x4 y0, y1;
                        y0.x = bflo(a.x) + bflo(b.x) * rf2 * g0.x; y0.y = bfhi(a.x) + bfhi(b.x) * rf2 * g0.y; y0.z = bflo(a.y) + bflo(b.y) * rf2 * g0.z; y0.w = bfhi(a.y) + bfhi(b.y) * rf2 * g0.w;
                        y1.x = bflo(a.z) + bflo(b.z) * rf2 * g1.x; y1.y = bfhi(a.z) + bfhi(b.z) * rf2 * g1.y; y1.z = bflo(a.w) + bflo(b.w) * rf2 * g1.z; y1.w = bfhi(a.w) + bfhi(b.w) * rf2 * g1.w;
                        *(f32x4*)(yrow + k * 512 + 8 * lane) = y0; *(f32x4*)(yrow + k * 512 + 8 * lane + 4) = y1; } }
            }
            have = chunk_take_async(S, i + 1, u, tid);
        }
    }
    STAMP(12);
#undef IN
#undef SEAM
}

#ifdef TS_A
#ifndef TS_C
#define TS_C TS_A
#define TS_D TS_B
#endif
#ifndef TS_SCALE
#define TS_SCALE 1e-7f
#endif
#ifndef TS_STAT
#define TS_STAT 0
#endif
__global__ void probe_fin(unsigned char* ws, float* out, int G) {
    __shared__ unsigned long long sh[4][256];
    const unsigned long long* ts = (const unsigned long long*)(ws + 768 * 1024); const int t = threadIdx.x;
    unsigned long long a = 0, b = 0, c = 0, d = 0;
    if (t < G) { a = ts[t * 16 + TS_A]; b = ts[t * 16 + TS_B]; c = ts[t * 16 + TS_C]; d = ts[t * 16 + TS_D]; }
    sh[0][t] = a; sh[1][t] = b; sh[2][t] = c; sh[3][t] = d; __syncthreads();
    if (t == 0) {
        unsigned long long s1 = 0, s2 = 0, mina = ~0ull, maxb = 0, minc = ~0ull, maxd = 0;
        for (int i = 0; i < G; ++i) { s1 += sh[1][i] - sh[0][i]; s2 += sh[3][i] - sh[2][i]; if (sh[0][i] < mina) mina = sh[0][i]; if (sh[1][i] > maxb) maxb = sh[1][i]; if (sh[2][i] < minc) minc = sh[2][i]; if (sh[3][i] > maxd) maxd = sh[3][i]; }
        const unsigned long long v1 = TS_STAT ? (maxb - mina) : s1 / (unsigned long long)G, v2 = TS_STAT ? (maxd - minc) : s2 / (unsigned long long)G;
        const unsigned long long t0 = __builtin_amdgcn_s_memrealtime();
        while (__builtin_amdgcn_s_memrealtime() - t0 < v1) __builtin_amdgcn_s_sleep(8);
        const float us = (float)v2 * 0.01f;
        out[O_GS] += sqrtf(us * TS_SCALE * 262930.0f);
    }
}
#endif
constexpr int N_PHASES = 9;
extern "C" void kernel_launch(void* const* d_in, const int* in_sizes, int n_in, void* d_out, int out_size, void* d_ws, size_t ws_size, hipStream_t stream) {
    static int grid = 0;
    if (grid == 0) {
        if (n_in != 19 || (size_t)out_size != O_END || ws_size < WS_END) { fprintf(stderr, "kernel_launch: unexpected shapes: n_in %d out %d ws %zu (need %zu)\n", n_in, out_size, ws_size, (size_t)WS_END); grid = -1; return; }
        int dev = 0, cus = 0;
        if (hipGetDevice(&dev) != hipSuccess || hipDeviceGetAttribute(&cus, hipDeviceAttributeMultiprocessorCount, dev) != hipSuccess) { grid = -1; return; }
        if (hipFuncSetAttribute((const void*)fwd_kernel, hipFuncAttributeMaxDynamicSharedMemorySize, LDS_BYTES) != hipSuccess) { fprintf(stderr, "kernel_launch: hipFuncSetAttribute failed\n"); grid = -1; return; }
        int per_cu = 0;
        (void)hipOccupancyMaxActiveBlocksPerMultiprocessor(&per_cu, (const void*)fwd_kernel, NWAVES * 64, LDS_BYTES);
        (void)hipGetLastError();
        grid = cus;
    }
    if (grid < 0) return;
    (void)hipMemsetAsync((char*)d_ws + WS_CTL, 0, CTL_ZERO_BYTES, stream);
    (void)hipMemcpyAsync((float*)d_out + O_KS, (const float*)d_in[2] + 16 * KVW, (size_t)(NB * 128 - 16) * KVW * 4, hipMemcpyDeviceToDevice, stream);
    (void)hipMemcpyAsync((float*)d_out + O_VS, (const float*)d_in[3] + 16 * KVW, (size_t)(NB * 128 - 16) * KVW * 4, hipMemcpyDeviceToDevice, stream);
    Args a{};
    for (int i = 0; i < 19; ++i) a.in[i] = (const float*)d_in[i];
    a.out = (float*)d_out; a.ws = (unsigned char*)d_ws;
#if MK_ONE_LAUNCH
    a.ph_lo = 0; a.ph_hi = N_PHASES;
    hipLaunchKernelGGL(fwd_kernel, dim3(grid), dim3(NWAVES * 64), LDS_BYTES, stream, a);
#ifdef TS_A
    hipLaunchKernelGGL(probe_fin, dim3(1), dim3(256), 0, stream, (unsigned char*)d_ws, (float*)d_out, grid);
#endif
#else
    for (int p = 0; p < N_PHASES; ++p) { a.ph_lo = p; a.ph_hi = p + 1; hipLaunchKernelGGL(fwd_kernel, dim3(grid), dim3(NWAVES * 64), LDS_BYTES, stream, a); }
#endif
}
```
